# Optimizing an MI355X kernel written in HIP

```python
import math
import jax, jax.numpy as jnp
from jax import lax
import numpy as np

D_MODEL = 1024
BATCH = 16
SEQ = 4096
DEPTH = 4

ATT_HEADS = 8
ATT_HEAD_DIM = 64
ATT_W = ATT_HEADS * ATT_HEAD_DIM
Q_BLOCK = 128
SSM_GROUP = 16
SSM_GROUPS = 16
SSM_W = SSM_GROUP * SSM_GROUPS
SSM_STATE = 64
DT_MIN = 1e-3
DT_MAX = 1e-1
CONV_W = 256
CONV_K = 31
N_BRANCH = 3
D_FF = 2816
N_EXPERTS = 8
TOP_K = 2
D_FF_EXPERT = 3584
N_DENSE = (DEPTH + 1) // 2
N_MOE = DEPTH // 2
EPS = 1e-6

Q_END = ATT_W
K_END = 2 * ATT_W
V_END = 3 * ATT_W
F_END = V_END + ATT_HEADS
U_END = F_END + SSM_W
C_END = U_END + 2 * CONV_W
N_IN = C_END + N_BRANCH * D_MODEL
SPLITS = [Q_END, K_END, V_END, F_END, U_END, C_END]

kernel_name = "gated_parallel_fox_s5_conformer_moe_trunk"


def rmsnorm(x, g):
    xf = x.astype(jnp.float32)
    y = xf * lax.rsqrt(jnp.mean(xf * xf, axis=-1, keepdims=True) + EPS) * g.astype(jnp.float32)
    return y.astype(x.dtype)


def fox_attention(q, k, v, logf):
    B, L, H, dh = q.shape
    nb = L // Q_BLOCK
    Fh = jnp.cumsum(logf, axis=1).transpose(0, 2, 1)
    qb = q.astype(jnp.float32).reshape(B, nb, Q_BLOCK, H, dh).transpose(1, 0, 2, 3, 4)
    Fb = Fh.reshape(B, H, nb, Q_BLOCK).transpose(2, 0, 1, 3)
    kf = k.astype(jnp.float32)
    vf = v.astype(jnp.float32)
    kpos = jnp.arange(L)
    scale = dh ** -0.5

    def block(args):
        i, qi, Fi = args
        qpos = i * Q_BLOCK + jnp.arange(Q_BLOCK)
        s = jnp.einsum('bqhd,bkhd->bhqk', qi, kf) * scale
        s = s + Fi[..., None] - Fh[:, :, None, :]
        s = jnp.where(kpos[None, :] <= qpos[:, None], s, -jnp.inf)
        p = jax.nn.softmax(s, axis=-1)
        return jnp.einsum('bhqk,bkhd->bqhd', p, vf)

    out = lax.map(block, (jnp.arange(nb), qb, Fb))
    return out.transpose(1, 0, 2, 3, 4).reshape(B, L, H * dh)


def s5_ssm(u, a_re, a_im, log_dt, b_re, b_im, c_re, c_im, d_skip, w_glu):
    B, L, _ = u.shape
    uf = u.astype(jnp.float32).reshape(B, L, SSM_GROUPS, SSM_GROUP)
    lam = lax.complex(a_re.astype(jnp.float32), a_im.astype(jnp.float32))
    dt = jnp.exp(log_dt.astype(jnp.float32))[:, None]
    a_bar = jnp.exp(lam * dt)
    b = lax.complex(b_re.astype(jnp.float32), b_im.astype(jnp.float32))
    b_bar = ((a_bar - 1.0) / lam)[..., None] * b
    bu = jnp.einsum('blgh,gph->blgp', uf.astype(jnp.complex64), b_bar)
    a_seq = jnp.broadcast_to(a_bar[None, None], (1, L) + a_bar.shape)

    def combine(e1, e2):
        a1, x1 = e1
        a2, x2 = e2
        return a1 * a2, a2 * x1 + x2

    _, xs = lax.associative_scan(combine, (a_seq, bu), axis=1)
    c = lax.complex(c_re.astype(jnp.float32), c_im.astype(jnp.float32))
    y = jnp.real(jnp.einsum('blgp,ghp->blgh', xs, c)) + d_skip.astype(jnp.float32) * uf
    y = jax.nn.gelu(y.reshape(B, L, SSM_W))
    val, gate = jnp.split(y @ w_glu.astype(jnp.float32), 2, axis=-1)
    return val * jax.nn.sigmoid(gate)


def conformer_conv(z, conv_w, conv_b, ln_g, ln_b):
    a, g = jnp.split(z.astype(jnp.float32), 2, axis=-1)
    h = a * jax.nn.sigmoid(g)
    hp = jnp.pad(h, ((0, 0), (CONV_K - 1, 0), (0, 0)))
    y = lax.conv_general_dilated(hp, conv_w.astype(jnp.float32)[:, None, :], window_strides=(1,),
                                 padding='VALID', dimension_numbers=('NWC', 'WIO', 'NWC'),
                                 feature_group_count=CONV_W) + conv_b.astype(jnp.float32)
    mu = jnp.mean(y, axis=-1, keepdims=True)
    var = jnp.mean(jnp.square(y - mu), axis=-1, keepdims=True)
    y = (y - mu) * lax.rsqrt(var + EPS) * ln_g.astype(jnp.float32) + ln_b.astype(jnp.float32)
    return jax.nn.silu(y)


def swiglu(h, w_gate, w_up, w_down):
    return (jax.nn.silu(h @ w_gate) * (h @ w_up)) @ w_down


def moe_swiglu(h, w_router, b_router, w_gate, w_up, w_down):
    B, L, D = h.shape
    t = h.reshape(-1, D)
    logits = (t @ w_router).astype(jnp.float32) + b_router.astype(jnp.float32)
    top_val, top_idx = lax.top_k(logits, TOP_K)
    probs = jax.nn.softmax(top_val, axis=-1)
    weights = jnp.sum(jax.nn.one_hot(top_idx, N_EXPERTS, dtype=jnp.float32) * probs[..., None], axis=1)
    weights = weights.astype(t.dtype)
    out = jnp.zeros_like(t)
    for e in range(N_EXPERTS):
        out = out + weights[:, e:e + 1] * swiglu(t, w_gate[e], w_up[e], w_down[e])
    return out.reshape(B, L, D)


def setup_inputs(seed: int = 0) -> dict:
    key = jax.random.key(seed)
    ks = jax.random.split(key, 32)
    f32 = jnp.float32
    nrm = lambda k, shape, scale: jax.random.normal(k, shape, f32) * scale
    x = jax.random.normal(ks[0], (BATCH, SEQ, D_MODEL), f32)
    g_mix = 1.0 + nrm(ks[1], (DEPTH, D_MODEL), 0.02)
    w_in = nrm(ks[2], (DEPTH, D_MODEL, N_IN), D_MODEL ** -0.5)
    b_in = nrm(ks[3], (DEPTH, N_IN), 0.02)
    b_in = b_in.at[:, V_END:F_END].add(jnp.linspace(1.0, 6.0, ATT_HEADS, dtype=f32))
    n = jnp.arange(SSM_STATE, dtype=f32)
    ssm_a_re = -0.5 + nrm(ks[4], (DEPTH, SSM_GROUPS, SSM_STATE), 0.01)
    ssm_a_im = math.pi * n + nrm(ks[5], (DEPTH, SSM_GROUPS, SSM_STATE), 0.01)
    ssm_log_dt = jax.random.uniform(ks[6], (DEPTH, SSM_GROUPS), f32, math.log(DT_MIN), math.log(DT_MAX))
    bs = (2.0 * SSM_GROUP) ** -0.5
    ssm_b_re = nrm(ks[7], (DEPTH, SSM_GROUPS, SSM_STATE, SSM_GROUP), bs)
    ssm_b_im = nrm(ks[8], (DEPTH, SSM_GROUPS, SSM_STATE, SSM_GROUP), bs)
    cs = (2.0 * SSM_STATE) ** -0.5
    ssm_c_re = nrm(ks[9], (DEPTH, SSM_GROUPS, SSM_GROUP, SSM_STATE), cs)
    ssm_c_im = nrm(ks[10], (DEPTH, SSM_GROUPS, SSM_GROUP, SSM_STATE), cs)
    ssm_d = nrm(ks[11], (DEPTH, SSM_GROUPS, SSM_GROUP), 0.5)
    ssm_w_glu = nrm(ks[12], (DEPTH, SSM_W, 2 * SSM_W), SSM_W ** -0.5)
    conv_w = nrm(ks[13], (DEPTH, CONV_K, CONV_W), CONV_K ** -0.5)
    conv_b = nrm(ks[14], (DEPTH, CONV_W), 0.02)
    conv_ln_g = 1.0 + nrm(ks[15], (DEPTH, CONV_W), 0.02)
    conv_ln_b = nrm(ks[16], (DEPTH, CONV_W), 0.02)
    w_att_out = nrm(ks[17], (DEPTH, ATT_W, D_MODEL), ATT_W ** -0.5)
    w_ssm_out = nrm(ks[18], (DEPTH, SSM_W, D_MODEL), SSM_W ** -0.5)
    w_conv_out = nrm(ks[19], (DEPTH, CONV_W, D_MODEL), CONV_W ** -0.5)
    w_o = nrm(ks[20], (DEPTH, D_MODEL, D_MODEL), D_MODEL ** -0.5)
    g_ffn = 1.0 + nrm(ks[21], (DEPTH, D_MODEL), 0.02)
    ffn_w_gate = nrm(ks[22], (N_DENSE, D_MODEL, D_FF), D_MODEL ** -0.5)
    ffn_w_up = nrm(ks[23], (N_DENSE, D_MODEL, D_FF), D_MODEL ** -0.5)
    ffn_w_down = nrm(ks[24], (N_DENSE, D_FF, D_MODEL), D_FF ** -0.5)
    moe_w_router = nrm(ks[25], (N_MOE, D_MODEL, N_EXPERTS), D_MODEL ** -0.5)
    moe_b_router = nrm(ks[26], (N_MOE, N_EXPERTS), 0.01)
    moe_w_gate = nrm(ks[27], (N_MOE, N_EXPERTS, D_MODEL, D_FF_EXPERT), D_MODEL ** -0.5)
    moe_w_up = nrm(ks[28], (N_MOE, N_EXPERTS, D_MODEL, D_FF_EXPERT), D_MODEL ** -0.5)
    moe_w_down = nrm(ks[29], (N_MOE, N_EXPERTS, D_FF_EXPERT, D_MODEL), D_FF_EXPERT ** -0.5)
    g_final = 1.0 + nrm(ks[30], (D_MODEL,), 0.02)
    return {"x": x, "g_mix": g_mix, "w_in": w_in, "b_in": b_in,
            "ssm_a_re": ssm_a_re, "ssm_a_im": ssm_a_im, "ssm_log_dt": ssm_log_dt,
            "ssm_b_re": ssm_b_re, "ssm_b_im": ssm_b_im, "ssm_c_re": ssm_c_re, "ssm_c_im": ssm_c_im,
            "ssm_d": ssm_d, "ssm_w_glu": ssm_w_glu,
            "conv_w": conv_w, "conv_b": conv_b, "conv_ln_g": conv_ln_g, "conv_ln_b": conv_ln_b,
            "w_att_out": w_att_out, "w_ssm_out": w_ssm_out, "w_conv_out": w_conv_out, "w_o": w_o,
            "g_ffn": g_ffn, "ffn_w_gate": ffn_w_gate, "ffn_w_up": ffn_w_up, "ffn_w_down": ffn_w_down,
            "moe_w_router": moe_w_router, "moe_b_router": moe_b_router,
            "moe_w_gate": moe_w_gate, "moe_w_up": moe_w_up, "moe_w_down": moe_w_down,
            "g_final": g_final}


def reference(x, g_mix, w_in, b_in, ssm_a_re, ssm_a_im, ssm_log_dt, ssm_b_re, ssm_b_im,
              ssm_c_re, ssm_c_im, ssm_d, ssm_w_glu, conv_w, conv_b, conv_ln_g, conv_ln_b,
              w_att_out, w_ssm_out, w_conv_out, w_o, g_ffn, ffn_w_gate, ffn_w_up, ffn_w_down,
              moe_w_router, moe_b_router, moe_w_gate, moe_w_up, moe_w_down, g_final):
    B, L, D = x.shape
    dt = x.dtype
    for l in range(DEPTH):
        h = rmsnorm(x, g_mix[l])
        proj = h @ w_in[l] + b_in[l]
        q, k, v, fz, u, cz, gz = jnp.split(proj, SPLITS, axis=-1)
        hs = (B, L, ATT_HEADS, ATT_HEAD_DIM)
        logf = jax.nn.log_sigmoid(fz.astype(jnp.float32))
        att = fox_attention(q.reshape(hs), k.reshape(hs), v.reshape(hs), logf).astype(dt)
        ssm = s5_ssm(u, ssm_a_re[l], ssm_a_im[l], ssm_log_dt[l], ssm_b_re[l], ssm_b_im[l],
                     ssm_c_re[l], ssm_c_im[l], ssm_d[l], ssm_w_glu[l]).astype(dt)
        conv = conformer_conv(cz, conv_w[l], conv_b[l], conv_ln_g[l], conv_ln_b[l]).astype(dt)
        gates = jax.nn.sigmoid(gz).reshape(B, L, N_BRANCH, D)
        merged = (gates[:, :, 0] * (att @ w_att_out[l])
                  + gates[:, :, 1] * (ssm @ w_ssm_out[l])
                  + gates[:, :, 2] * (conv @ w_conv_out[l]))
        x = x + merged @ w_o[l]
        h = rmsnorm(x, g_ffn[l])
        if l % 2 == 0:
            i = l // 2
            f = swiglu(h, ffn_w_gate[i], ffn_w_up[i], ffn_w_down[i])
        else:
            i = l // 2
            f = moe_swiglu(h, moe_w_router[i], moe_b_router[i], moe_w_gate[i], moe_w_up[i], moe_w_down[i])
        x = x + f.astype(dt)
    return rmsnorm(x, g_final)
```

```cpp
#include <hip/hip_runtime.h>
#include <cstdio>
#include <cstdint>
#include <cmath>
#define MK_N_LAUNCHES 1
namespace pg8 {
#define PG8_LAS __attribute__((address_space(3)))
typedef unsigned short bf16_t;
typedef short bf16x8 __attribute__((ext_vector_type(8)));
typedef float f32x4 __attribute__((ext_vector_type(4)));
typedef float f32x2 __attribute__((ext_vector_type(2)));
typedef unsigned u32x4 __attribute__((ext_vector_type(4)));
constexpr int BM = 256, BK = 64, HALF = 128, HTB = HALF * BK * 2  , STAGE_BYTES = 8 * HTB, NXCD = 8, WGM = 8;

__host__ __device__ __forceinline__ int lds_byte(int r, int c) { const int st = (r >> 4) * 2 + (c >> 5), rr = r & 15, cc = c & 31, ob = rr * 64 + cc * 2; return st * 1024 + (ob ^ (((ob >> 9) & 1) << 5)); }
__host__ __device__ __forceinline__ void stage_rc(int b, int& R, int& C) { const int st = b / 1024, sb = b % 1024, swz = sb ^ (((sb >> 9) & 1) << 5); R = (st >> 1) * 16 + swz / 64; C = (st & 1) * 32 + (swz % 64) / 2; }
__host__ __device__ __forceinline__ int perm32(int rho) { const int n = rho >> 4, i = rho & 15; return 8 * (i >> 2) + 4 * n + (i & 3); }

struct Unit { int pm, pn, arow, brow; };
struct Gemm { const bf16_t* A; const bf16_t* Bt; int lda, ldb, K; };

struct StaticOrder {
    int nM, nN, nwg, G, c;
    __host__ __device__ void init(int nM_, int nN_, int G_, int c_) { nM = nM_; nN = nN_; nwg = nM * nN; G = G_; c = c_; }
    __host__ __device__ bool next(int i, Unit& u) const {
        const long L = (long)i * G + c; if (L >= nwg) return false;
        int wgid = (int)L; { const int q = nwg / NXCD, r = nwg % NXCD, xcd = wgid % NXCD, off = wgid / NXCD; wgid = (xcd < r ? xcd * (q + 1) : r * (q + 1) + (xcd - r) * q) + off; }
        const int nig = WGM * nN, gid = wgid / nig, fm = gid * WGM, gsz = (nM - fm) < WGM ? (nM - fm) : WGM;
        u.pm = fm + ((wgid % nig) % gsz); u.pn = (wgid % nig) / gsz; u.arow = u.pm * BM; u.brow = u.pn * BM; return true;
    }
};

__device__ __forceinline__ unsigned cvt_pk_bf16(float lo, float hi) { unsigned r; asm volatile("v_cvt_pk_bf16_f32 %0, %1, %2" : "=v"(r) : "v"(lo), "v"(hi)); return r; }

template <class Epi, class Sched, bool ALIGN_EPI = false, bool SP2 = false>
__device__ __forceinline__ void gemm_phase(PG8_LAS unsigned char* lds, const Gemm g, const Sched& S, const Epi& E) {
    int tid_ = threadIdx.x; asm volatile("" : "+v"(tid_));
    const int tid = tid_, wid = __builtin_amdgcn_readfirstlane(tid >> 6), lane = tid & 63, wr = wid >> 2, wc = wid & 3, fr = lane & 15, fq = lane >> 4;
    const char* gA = (const char*)g.A; const char* gB = (const char*)g.Bt; asm volatile("" : "+s"(gA), "+s"(gB));
    int K_ = g.K; asm volatile("" : "+s"(K_));
    const int nt = K_ / BK, lda = g.lda, ldb = g.ldb;
    unsigned voffA[2], voffB[2];
#pragma unroll
    for (int i = 0; i < 2; ++i) { int R, C; stage_rc(tid * 16 + i * 8192, R, C); const int Rb = Epi::PERM ? ((R & ~31) + perm32(R & 31)) : R;
        voffA[i] = (unsigned)(R * lda + C) * 2u; voffB[i] = (unsigned)(Rb * ldb + C) * 2u; }
    const size_t kstep = (size_t)(BK * 2);
    const size_t hstepA = (size_t)HALF * lda * 2, hstepB = (size_t)HALF * ldb * 2;
    const unsigned ldsw = (unsigned)wid * 1024u;
    const int aoff = lds_byte(wr * 64 + fr, fq * 8), boff = lds_byte(wc * 32 + fr, fq * 8);
#define PG8_SA(b, h) (((b) * 2 + (h)) * HTB)
#define PG8_SB(b, h) ((4 + (b) * 2 + (h)) * HTB)
#define PG8_STAGE(bufoff, gbase, voff) do { _Pragma("unroll") for (int _i = 0; _i < 2; ++_i) \
        __builtin_amdgcn_global_load_lds((const unsigned*)((const char*)(gbase) + (voff)[_i]), (PG8_LAS unsigned*)(lds + (bufoff) + ldsw + _i * 8192), 16, 0, 0); } while (0)
#define PG8_LDA(dst, b, h) do { _Pragma("unroll") for (int m = 0; m < 4; ++m) _Pragma("unroll") for (int k = 0; k < 2; ++k) dst[m][k] = *(const PG8_LAS bf16x8*)(lds + PG8_SA(b, h) + aoff + m * 2048 + k * 1024); } while (0)
#define PG8_LDB(dst, b, h) do { _Pragma("unroll") for (int n = 0; n < 2; ++n) _Pragma("unroll") for (int k = 0; k < 2; ++k) dst[n][k] = *(const PG8_LAS bf16x8*)(lds + PG8_SB(b, h) + boff + n * 2048 + k * 1024); } while (0)
#define PG8_MMA(ai, bj, At, Bt) do { __builtin_amdgcn_s_setprio(1); _Pragma("unroll") for (int m = 0; m < 4; ++m) _Pragma("unroll") for (int n = 0; n < 2; ++n) _Pragma("unroll") for (int k = 0; k < 2; ++k) \
        acc[ai][bj][m][n] = __builtin_amdgcn_mfma_f32_16x16x32_bf16(Bt[n][k], At[m][k], acc[ai][bj][m][n], 0, 0, 0); __builtin_amdgcn_s_setprio(0); } while (0)
#define PG8_WAIT_V(n) asm volatile("s_waitcnt vmcnt(" #n ")" ::: "memory")
#define PG8_WAIT_L(n) asm volatile("s_waitcnt lgkmcnt(" #n ")" ::: "memory")
#define PG8_BAR __builtin_amdgcn_s_barrier()
#define PG8_SCHED __builtin_amdgcn_sched_barrier(0)
    Unit cur, nxt; int ui = 0;
    if (!S.next(0, cur)) return;
    f32x4 acc[2][2][4][2];
#pragma unroll
    for (int a = 0; a < 2; ++a)
#pragma unroll
        for (int b = 0; b < 2; ++b)
#pragma unroll
            for (int m = 0; m < 4; ++m)
#pragma unroll
                for (int n = 0; n < 2; ++n) acc[a][b][m][n] = (f32x4){0.f, 0.f, 0.f, 0.f};
    bf16x8 At[4][2], B0[2][2], B1[2][2];
    const char* cA = gA + (size_t)cur.arow * lda * 2; const char* cB = gB + (size_t)cur.brow * ldb * 2;
    if constexpr (SP2) {
        PG8_STAGE(PG8_SB(0, 0), cB, voffB); PG8_STAGE(PG8_SB(0, 1), cB + hstepB, voffB); PG8_STAGE(PG8_SA(0, 0), cA, voffA); PG8_STAGE(PG8_SA(0, 1), cA + hstepA, voffA);
        if (wr == 1) PG8_BAR;
        PG8_WAIT_V(2); PG8_BAR;
        PG8_STAGE(PG8_SB(1, 0), cB + kstep, voffB); PG8_STAGE(PG8_SA(1, 0), cA + kstep, voffA); PG8_STAGE(PG8_SB(1, 1), cB + hstepB + kstep, voffB);
        PG8_WAIT_V(6); PG8_BAR;
    } else {
        PG8_STAGE(PG8_SB(0, 0), cB, voffB); PG8_STAGE(PG8_SA(0, 0), cA, voffA); PG8_STAGE(PG8_SB(0, 1), cB + hstepB, voffB); PG8_STAGE(PG8_SA(0, 1), cA + hstepA, voffA);
        if (wr == 1) PG8_BAR;
        PG8_WAIT_V(4); PG8_BAR;
        PG8_STAGE(PG8_SB(1, 0), cB + kstep, voffB); PG8_STAGE(PG8_SA(1, 0), cA + kstep, voffA); PG8_STAGE(PG8_SB(1, 1), cB + hstepB + kstep, voffB);
        PG8_WAIT_V(6); PG8_BAR;
    }
    for (;;) {
        const bool has_next = S.next(ui + 1, nxt);
        const char* nA = has_next ? gA + (size_t)nxt.arow * lda * 2 : cA; const char* nB = has_next ? gB + (size_t)nxt.brow * ldb * 2 : cB;
        for (int t = 0; t < nt; t += 2) {
            const bool last = (t == nt - 2);
            const char* a1 = cA + (size_t)(t + 1) * kstep;
            const char* a2 = last ? nA : cA + (size_t)(t + 2) * kstep; const char* b2 = last ? nB : cB + (size_t)(t + 2) * kstep;
            const char* a3 = a2 + kstep; const char* b3 = b2 + kstep;
            if constexpr (SP2) {
            PG8_LDB(B0, 0, 0); PG8_LDB(B1, 0, 1); PG8_SCHED; PG8_LDA(At, 0, 0); PG8_STAGE(PG8_SA(1, 1), a1 + hstepA, voffA);
            PG8_WAIT_V(8); PG8_WAIT_L(0); PG8_BAR; PG8_MMA(0, 0, At, B0); PG8_MMA(0, 1, At, B1); PG8_BAR; PG8_SCHED;
            PG8_LDA(At, 0, 1); PG8_STAGE(PG8_SB(0, 0), b2, voffB); PG8_STAGE(PG8_SB(0, 1), b2 + hstepB, voffB); PG8_STAGE(PG8_SA(0, 0), a2, voffA);
            PG8_WAIT_V(8); PG8_WAIT_L(0); PG8_BAR; PG8_MMA(1, 0, At, B0); PG8_MMA(1, 1, At, B1); PG8_BAR; PG8_SCHED;
            PG8_LDB(B0, 1, 0); PG8_LDB(B1, 1, 1); PG8_SCHED; PG8_LDA(At, 1, 0); PG8_STAGE(PG8_SA(0, 1), a2 + hstepA, voffA);
            PG8_WAIT_V(8); PG8_WAIT_L(0); PG8_BAR; PG8_MMA(0, 0, At, B0); PG8_MMA(0, 1, At, B1); PG8_BAR; PG8_SCHED;
            PG8_LDA(At, 1, 1); PG8_STAGE(PG8_SB(1, 0), b3, voffB); PG8_STAGE(PG8_SB(1, 1), b3 + hstepB, voffB); PG8_STAGE(PG8_SA(1, 0), a3, voffA);
            PG8_WAIT_V(8); PG8_WAIT_L(0); PG8_BAR; PG8_MMA(1, 0, At, B0); PG8_MMA(1, 1, At, B1); PG8_BAR; PG8_SCHED;
            } else {
            PG8_LDB(B0, 0, 0); PG8_SCHED; PG8_LDA(At, 0, 0); PG8_STAGE(PG8_SA(1, 1), a1 + hstepA, voffA);
            PG8_WAIT_L(8); PG8_BAR; PG8_WAIT_L(0); PG8_MMA(0, 0, At, B0); PG8_BAR; PG8_SCHED;
            PG8_LDB(B1, 0, 1); PG8_STAGE(PG8_SB(0, 0), b2, voffB);
            PG8_BAR; PG8_WAIT_L(0); PG8_MMA(0, 1, At, B1); PG8_BAR;
            PG8_LDA(At, 0, 1); PG8_STAGE(PG8_SA(0, 0), a2, voffA);
            PG8_BAR; PG8_WAIT_L(0); PG8_MMA(1, 0, At, B0); PG8_BAR; PG8_SCHED;
            PG8_STAGE(PG8_SB(0, 1), b2 + hstepB, voffB);
            PG8_WAIT_V(6); PG8_BAR; PG8_MMA(1, 1, At, B1); PG8_BAR;
            PG8_LDB(B0, 1, 0); PG8_SCHED; PG8_LDA(At, 1, 0); PG8_STAGE(PG8_SA(0, 1), a2 + hstepA, voffA);
            PG8_WAIT_L(8); PG8_BAR; PG8_WAIT_L(0); PG8_MMA(0, 0, At, B0); PG8_BAR; PG8_SCHED;
            PG8_LDB(B1, 1, 1); PG8_STAGE(PG8_SB(1, 0), b3, voffB);
            PG8_BAR; PG8_WAIT_L(0); PG8_MMA(0, 1, At, B1); PG8_BAR;
            PG8_LDA(At, 1, 1); PG8_STAGE(PG8_SA(1, 0), a3, voffA);
            PG8_BAR; PG8_WAIT_L(0); PG8_MMA(1, 0, At, B0); PG8_BAR; PG8_SCHED;
            PG8_STAGE(PG8_SB(1, 1), b3 + hstepB, voffB);
            PG8_WAIT_V(6); PG8_BAR; PG8_MMA(1, 1, At, B1); PG8_BAR;
            }
        }
        if constexpr (ALIGN_EPI) { if (wr == 0) PG8_BAR; }
        E(acc, cur, wr, wc, fr, fq);
        if (!has_next) break;
#pragma unroll
        for (int a = 0; a < 2; ++a)
#pragma unroll
            for (int b = 0; b < 2; ++b)
#pragma unroll
                for (int m = 0; m < 4; ++m)
#pragma unroll
                    for (int n = 0; n < 2; ++n) acc[a][b][m][n] = (f32x4){0.f, 0.f, 0.f, 0.f};
        cur = nxt; cA = nA; cB = nB; ++ui;
        if constexpr (ALIGN_EPI) { if (wr == 1) PG8_BAR; }
    }
    PG8_WAIT_V(0);
    if constexpr (!ALIGN_EPI) { if (wr == 0) PG8_BAR; }
    PG8_BAR;
#undef PG8_SA
#undef PG8_SB
#undef PG8_STAGE
#undef PG8_LDA
#undef PG8_LDB
#undef PG8_MMA
#undef PG8_WAIT_V
#undef PG8_WAIT_L
#undef PG8_BAR
#undef PG8_SCHED
}
}
constexpr int NWAVES = 8;
constexpr int BATCH = 16, SEQ = 4096, D = 1024, DEPTH = 4, M = BATCH * SEQ;
constexpr int NH = 8, HD = 64, ATT_W = 512, SSM_W = 256, SSM_G = 16, SSM_P = 64, SSM_H = 16, CONV_W = 256, CONV_K = 31;
constexpr int N_IN = 5384, N_INP = 5632, D_FF = 2816, NE = 8, D_FFE = 3584;
constexpr float EPS = 1e-6f;
constexpr float LOG2E = 1.4426950408889634f;
constexpr float QSCALE = 0.125f * LOG2E;
constexpr int MOE_ROWS_CAP = 133120;
constexpr int MOE_NCHUNK = 3, MOE_CHUNK_TILES_CAP = 174;

constexpr size_t MiB = 1u << 20;
constexpr size_t WS_CTL = 0, CTL_ZERO_BYTES = 1 * MiB;
constexpr size_t WS_BPERM = 1 * MiB;
constexpr size_t WS_TOKE = 2 * MiB;
constexpr size_t WS_TOKW = 3 * MiB;
constexpr size_t WS_CNTW = 4 * MiB;
constexpr size_t WS_META = 4 * MiB + 512 * 1024;
constexpr size_t WS_RDEST = 5 * MiB;
constexpr size_t WS_RW = 6 * MiB;
constexpr size_t WS_RRSTD = 7 * MiB;
constexpr size_t WS_WMIX = 16 * MiB, WMIX_STRIDE = 16 * MiB;
constexpr size_t WM_IN = 0, WM_GLU = 11 * MiB, WM_A = WM_GLU + 256 * 1024, WM_S = WM_A + 1 * MiB, WM_C = WM_S + 512 * 1024, WM_O = WM_C + 512 * 1024;
constexpr size_t WS_WDENSE = 80 * MiB, WDENSE_STRIDE = 16 * MiB + 512 * 1024;
constexpr size_t WD_GU = 0, WD_D = 11 * MiB;
constexpr size_t WS_WMOE = 113 * MiB;
constexpr size_t WMOE_GU = 0, WMOE_D = 112 * MiB;
constexpr size_t WS_XB = 281 * MiB;
constexpr size_t WS_SSQ = 409 * MiB;
constexpr size_t WS_LOGF = 413 * MiB;
constexpr size_t WS_FH = 415 * MiB;
constexpr size_t WS_BIG = 417 * MiB;
constexpr size_t WS_GATES = WS_BIG;
constexpr size_t WS_YG = WS_BIG + 384 * MiB;
constexpr size_t WS_SSMO = WS_YG + 32 * MiB;
constexpr size_t WS_CONVO = WS_SSMO + 32 * MiB;
constexpr size_t WS_HID = WS_BIG;
constexpr size_t WS_XG = WS_BIG;
constexpr size_t WS_MHID = WS_BIG + 260 * MiB;
constexpr size_t WS_END = WS_MHID + 305 * MiB;
static_assert(WS_CONVO + 32 * MiB <= WS_END && WS_HID + 352 * MiB <= WS_END, "ws map");
constexpr size_t DO_Q = 0, DO_K = 64 * MiB, DO_V = 128 * MiB, DO_U = 192 * MiB, DO_HC = 224 * MiB, DO_MERGED = 64 * MiB;

constexpr int CW_TMO = 0, CW_CODE = 1;
constexpr int CW_BAR = 4096;

constexpr int RING_OFF = 0, RING_BYTES = 131072;
constexpr int LDSCTL_OFF = RING_BYTES, MISC_OFF = LDSCTL_OFF + 320;
constexpr int LDS_BYTES = 147456;

#define GAS __attribute__((address_space(1)))
#define LAS __attribute__((address_space(3)))
typedef unsigned short bf16;
typedef unsigned v4u __attribute__((ext_vector_type(4)));
typedef unsigned v2u __attribute__((ext_vector_type(2)));
typedef float f32x4 __attribute__((ext_vector_type(4)));
typedef float f32x2 __attribute__((ext_vector_type(2)));
typedef GAS unsigned gu32;
#define RLX_AGENT __ATOMIC_RELAXED, __HIP_MEMORY_SCOPE_AGENT
#define LDS_WAIT() asm volatile("s_waitcnt lgkmcnt(0)" ::: "memory")
#define VM_WAIT() asm volatile("s_waitcnt vmcnt(0)" ::: "memory")
__device__ __forceinline__ unsigned f2bf(float f) { unsigned u = __builtin_bit_cast(unsigned, f); return (u + 0x7fffu + ((u >> 16) & 1u)) >> 16; }
__device__ __forceinline__ unsigned pk2(float lo, float hi) { return pg8::cvt_pk_bf16(lo, hi); }
__device__ __forceinline__ float bflo(unsigned u) { return __builtin_bit_cast(float, u << 16); }
__device__ __forceinline__ float bfhi(unsigned u) { return __builtin_bit_cast(float, u & 0xffff0000u); }
__device__ __forceinline__ float bf1(bf16 h) { return __builtin_bit_cast(float, (unsigned)h << 16); }
__device__ __forceinline__ float sigmoidf_(float x) { return 1.0f / (1.0f + __expf(-x)); }
__device__ __forceinline__ float wave_sum(float v) {
#pragma unroll
    for (int o = 1; o < 64; o <<= 1) v += __shfl_xor(v, o);
    return v;
}

#define XB_TMO      128
#define XB_XCNT(j)  (256  + 64 * (j))
#define XB_XSUB(j)  (1280 + 64 * (j))
#define XB_XGEN(j)  (2304 + 64 * (j))
#define XB_TOP      3328
#define XB_TOPGEN   3392
#define XCD_BAR_WORDS 3456
#define XB_SPIN_CAP (1u << 18)

__device__ __forceinline__ unsigned xb_ld(unsigned* p)              { return __hip_atomic_load(p, __ATOMIC_RELAXED, __HIP_MEMORY_SCOPE_AGENT); }
__device__ __forceinline__ unsigned xb_add(unsigned* p, unsigned v) { return __hip_atomic_fetch_add(p, v, __ATOMIC_RELAXED, __HIP_MEMORY_SCOPE_AGENT); }
__device__ __forceinline__ unsigned xb_xcc_id() { return (unsigned)__builtin_amdgcn_s_getreg((3 << 11) | 20) & 0xFu; }
#define XB_SPIN(cond, bar) do { unsigned _sp = 0; while (cond) { __builtin_amdgcn_s_sleep(1); \
    if ((++_sp & 255u) == 0u) { if (xb_ld(&(bar)[XB_TMO])) break; if (_sp > XB_SPIN_CAP) { atomicAdd(&(bar)[XB_TMO], 1u); break; } } } } while (0)

struct XcdBarrier {
    unsigned* bar; unsigned x;
    volatile LAS unsigned* st;
};
__device__ __forceinline__ XcdBarrier xcd_barrier_post(unsigned* bar, volatile LAS unsigned* st) {
    XcdBarrier b; b.bar = bar; b.x = xb_xcc_id(); b.st = st;
    if (threadIdx.x == 0) (void)xb_add(&bar[XB_XCNT(b.x)], 1u);
    return b;
}
__device__ __forceinline__ void xcd_barrier_complete(unsigned* bar, unsigned x, unsigned& nloc, unsigned& nx) {
    const unsigned G = gridDim.x * gridDim.y * gridDim.z;
    unsigned sum, cnt, mine, sp = 0u;
    for (;;) {
        sum = 0u; cnt = 0u; mine = 0u;
#pragma unroll
        for (unsigned j = 0; j < 16; ++j) { const unsigned c = xb_ld(&bar[XB_XCNT(j)]); sum += c; cnt += (c > 0u) ? 1u : 0u; mine = (j == x) ? c : mine; }
        if (sum == G) break;
        __builtin_amdgcn_s_sleep(1);
        if ((++sp & 255u) == 0u) { if (xb_ld(&bar[XB_TMO])) break; if (sp > XB_SPIN_CAP) { atomicAdd(&bar[XB_TMO], 1u); break; } }
    }
    nloc = mine > 0u ? mine : 1u; nx = cnt > 0u ? cnt : 1u;
}
__device__ __forceinline__ void xcd_barrier(const XcdBarrier& b) {
    asm volatile("s_waitcnt vmcnt(0)" ::: "memory");
    __syncthreads();
    if (threadIdx.x == 0) {
        unsigned* bar = b.bar;
        __builtin_amdgcn_s_waitcnt(0);
        unsigned nloc = b.st[0], nx = b.st[1];
        if (nloc == 0u) { xcd_barrier_complete(bar, b.x, nloc, nx); b.st[0] = nloc; b.st[1] = nx; }
        const unsigned old = xb_add(&bar[XB_XSUB(b.x)], 1u);
        const unsigned gen = old / nloc;
        if (old + 1u == (gen + 1u) * nloc) {
            __builtin_amdgcn_fence(__ATOMIC_RELEASE, "agent");
            asm volatile("s_waitcnt vmcnt(0)" ::: "memory");
            const unsigned og = xb_add(&bar[XB_TOP], 1u);
            const unsigned tg = og / nx;
            if (og + 1u == (tg + 1u) * nx) xb_add(&bar[XB_TOPGEN], 1u);
            else XB_SPIN(xb_ld(&bar[XB_TOPGEN]) == tg, bar);
            __builtin_amdgcn_fence(__ATOMIC_ACQUIRE, "agent");
            xb_add(&bar[XB_XGEN(b.x)], 1u);
            asm volatile("s_waitcnt vmcnt(0)" ::: "memory");
        } else {
            XB_SPIN(xb_ld(&bar[XB_XGEN(b.x)]) == gen, bar);
            __builtin_amdgcn_fence(__ATOMIC_ACQUIRE, "agent");
            asm volatile("s_waitcnt vmcnt(0)" ::: "memory");
        }
    }
    __syncthreads();
}
typedef pg8::f32x4 A4;
typedef A4 AccT[2][2][4][2];

__device__ __forceinline__ float row_rstd(const float* ssq, int row) {
    const f32x4* p = (const f32x4*)(ssq + (size_t)row * 16);
    const f32x4 a = p[0], b = p[1], c = p[2], d = p[3];
    const float s = (((a.x + a.y) + (a.z + a.w)) + ((b.x + b.y) + (b.z + b.w))) + (((c.x + c.y) + (c.z + c.w)) + ((d.x + d.y) + (d.z + d.w)));
    return rsqrtf(s * (1.0f / 1024.0f) + EPS);
}
__device__ __forceinline__ v4u pack8(const A4& v0, const A4& v1) { v4u w; w.x = pk2(v0[0], v0[1]); w.y = pk2(v0[2], v0[3]); w.z = pk2(v1[0], v1[1]); w.w = pk2(v1[2], v1[3]); return w; }
__device__ __forceinline__ void unpack8(const v4u w, A4& v0, A4& v1) { v0 = (A4){bflo(w.x), bfhi(w.x), bflo(w.y), bfhi(w.y)}; v1 = (A4){bflo(w.z), bfhi(w.z), bflo(w.w), bfhi(w.w)}; }
__device__ __forceinline__ A4 sig4(const A4& z) { return (A4){sigmoidf_(z[0]), sigmoidf_(z[1]), sigmoidf_(z[2]), sigmoidf_(z[3])}; }
__device__ __forceinline__ float logsig(float z) { return fminf(z, 0.f) - __logf(1.0f + __expf(-fabsf(z))); }

struct EpiInProj {
    static constexpr bool PERM = true;
    unsigned char* outb; unsigned char* wsb; int layer;
    __device__ __forceinline__ void operator()(const AccT& acc, const pg8::Unit& u, int wr, int wc, int fr, int fq) const {
        const int pn = u.pn, row0 = u.pm * 256 + wr * 64 + fr, cw = wc * 32 + 8 * fq;
        bf16* const Q = (bf16*)(outb + DO_Q); bf16* const K = (bf16*)(outb + DO_K); bf16* const V = (bf16*)(outb + DO_V); bf16* const U = (bf16*)(outb + DO_U); bf16* const HC = (bf16*)(outb + DO_HC);
        bf16* const G = (bf16*)(wsb + WS_GATES); float* const logf = (float*)(wsb + WS_LOGF); const float* const bias = (const float*)(wsb + WS_BPERM) + layer * N_INP; const float* const ssq = (const float*)(wsb + WS_SSQ);
        float rs[2][4];
#pragma unroll
        for (int ai = 0; ai < 2; ++ai)
#pragma unroll
            for (int m = 0; m < 4; ++m) rs[ai][m] = row_rstd(ssq, row0 + ai * 128 + m * 16);
        A4 bv[2][2];
#pragma unroll
        for (int bj = 0; bj < 2; ++bj)
#pragma unroll
            for (int n = 0; n < 2; ++n) bv[bj][n] = *(const A4*)(bias + pn * 256 + bj * 128 + cw + 4 * n);
        if (pn == 7 || pn == 8) {
#pragma unroll
            for (int ai = 0; ai < 2; ++ai)
#pragma unroll
                for (int m = 0; m < 4; ++m) { const int row = row0 + ai * 128 + m * 16; const float r = rs[ai][m];
                    const A4 a0 = acc[ai][0][m][0] * r + bv[0][0], a1 = acc[ai][0][m][1] * r + bv[0][1], g0 = acc[ai][1][m][0] * r + bv[1][0], g1 = acc[ai][1][m][1] * r + bv[1][1];
                    *(v4u*)(HC + (size_t)row * 256 + (pn - 7) * 128 + cw) = pack8(a0 * sig4(g0), a1 * sig4(g1)); asm volatile("" ::: "memory"); }
        } else if (pn == 21) {
            if (wc == 0 && fq == 0) {
#pragma unroll
                for (int ai = 0; ai < 2; ++ai)
#pragma unroll
                    for (int m = 0; m < 4; ++m) { const int row = row0 + ai * 128 + m * 16; const float r = rs[ai][m];
                        const A4 z0 = acc[ai][0][m][0] * r + bv[0][0], z1 = acc[ai][0][m][1] * r + bv[0][1];
                        *(A4*)(logf + (size_t)row * 8) = (A4){logsig(z0[0]), logsig(z0[1]), logsig(z0[2]), logsig(z0[3])};
                        *(A4*)(logf + (size_t)row * 8 + 4) = (A4){logsig(z1[0]), logsig(z1[1]), logsig(z1[2]), logsig(z1[3])}; }
            }
        } else {
            bf16* base; int ld, col0; float sc = 1.f; bool sg = false;
            if (pn < 6) { base = pn < 2 ? Q : (pn < 4 ? K : V); ld = 512; col0 = (pn & 1) * 256; sc = pn < 2 ? QSCALE : 1.f; }
            else if (pn == 6) { base = U; ld = 256; col0 = 0; }
            else { base = G; ld = 3072; col0 = (pn - 9) * 256; sg = true; }
#pragma unroll
            for (int ai = 0; ai < 2; ++ai)
#pragma unroll
                for (int m = 0; m < 4; ++m) { const int row = row0 + ai * 128 + m * 16; const float r = rs[ai][m]; bf16* rowp = base + (size_t)row * ld + col0 + cw;
#pragma unroll
                    for (int bj = 0; bj < 2; ++bj) { A4 v0 = acc[ai][bj][m][0] * r + bv[bj][0], v1 = acc[ai][bj][m][1] * r + bv[bj][1];
                        if (sg) { v0 = sig4(v0); v1 = sig4(v1); }
                        v0 = v0 * sc; v1 = v1 * sc; *(v4u*)(rowp + bj * 128) = pack8(v0, v1); } asm volatile("" ::: "memory"); }
        }
    }
};

template <bool MOE> struct EpiSwiGlu {
    static constexpr bool PERM = true;
    bf16* Hd; int ldh; const float* rsrc;
    __device__ __forceinline__ void operator()(const AccT& acc, const pg8::Unit& u, int wr, int wc, int fr, int fq) const {
        const int row0 = u.pm * 256 + wr * 64 + fr, cw = wc * 32 + 8 * fq;
        float rs[2][4];
#pragma unroll
        for (int ai = 0; ai < 2; ++ai)
#pragma unroll
            for (int m = 0; m < 4; ++m) { const int row = row0 + ai * 128 + m * 16; rs[ai][m] = MOE ? rsrc[row] : row_rstd(rsrc, row); }
#pragma unroll
        for (int ai = 0; ai < 2; ++ai)
#pragma unroll
            for (int m = 0; m < 4; ++m) { const int row = row0 + ai * 128 + m * 16; const float r = rs[ai][m];
                A4 o[2];
#pragma unroll
                for (int n = 0; n < 2; ++n) { const A4 g = acc[ai][0][m][n] * r, up = acc[ai][1][m][n] * r; o[n] = g * sig4(g) * up; }
                *(v4u*)(Hd + (size_t)row * ldh + u.pn * 128 + cw) = pack8(o[0], o[1]); asm volatile("" ::: "memory"); }
    }
};
struct EpiGluSsm {
    static constexpr bool PERM = true;
    bf16* O;
    __device__ __forceinline__ void operator()(const AccT& acc, const pg8::Unit& u, int wr, int wc, int fr, int fq) const {
        const int row0 = u.pm * 256 + wr * 64 + fr, cw = wc * 32 + 8 * fq;
#pragma unroll
        for (int ai = 0; ai < 2; ++ai)
#pragma unroll
            for (int m = 0; m < 4; ++m) { const int row = row0 + ai * 128 + m * 16;
                *(v4u*)(O + (size_t)row * 256 + u.pn * 128 + cw) = pack8(acc[ai][0][m][0] * sig4(acc[ai][1][m][0]), acc[ai][0][m][1] * sig4(acc[ai][1][m][1])); }
    }
};
template <int I> struct EpiMerge {
    static constexpr bool PERM = true;
    const bf16* G; bf16* Mg;
    __device__ __forceinline__ void operator()(const AccT& acc, const pg8::Unit& u, int wr, int wc, int fr, int fq) const {
        const int row0 = u.pm * 256 + wr * 64 + fr, col0 = u.pn * 256 + wc * 32 + 8 * fq;
        v4u gl[3][2], ol[3][2];
#define MG_LOAD(buf, grp) do { const int row_ = row0 + ((grp) >> 2) * 128 + ((grp) & 3) * 16; _Pragma("unroll") for (int bj = 0; bj < 2; ++bj) { \
            gl[buf][bj] = *(const v4u*)(G + (size_t)row_ * 3072 + I * 1024 + col0 + bj * 128); if (I > 0) ol[buf][bj] = *(const v4u*)(Mg + (size_t)row_ * 1024 + col0 + bj * 128); } } while (0)
        MG_LOAD(0, 0); MG_LOAD(1, 1);
#pragma unroll
        for (int grp = 0; grp < 8; ++grp) {
            if (grp + 2 < 8) MG_LOAD((grp + 2) % 3, grp + 2);
            asm volatile("" ::: "memory");
            const int ai = grp >> 2, m = grp & 3, row = row0 + ai * 128 + m * 16;
#pragma unroll
            for (int bj = 0; bj < 2; ++bj) { A4 g0, g1; unpack8(gl[grp % 3][bj], g0, g1);
                A4 v0 = g0 * acc[ai][bj][m][0], v1 = g1 * acc[ai][bj][m][1];
                if (I > 0) { A4 o0, o1; unpack8(ol[grp % 3][bj], o0, o1); v0 = v0 + o0; v1 = v1 + o1; }
                *(v4u*)(Mg + (size_t)row * 1024 + col0 + bj * 128) = pack8(v0, v1); }
        }
#undef MG_LOAD
    }
};
struct EpiResid {
    static constexpr bool PERM = true;
    bf16* X; float* ssq;
    __device__ __forceinline__ void operator()(const AccT& acc, const pg8::Unit& u, int wr, int wc, int fr, int fq) const {
        const int row0 = u.pm * 256 + wr * 64 + fr, col0 = u.pn * 256 + wc * 32 + 8 * fq;
        v4u ol[3][2];
#define RS_LOAD(buf, grp) do { const int row_ = row0 + ((grp) >> 2) * 128 + ((grp) & 3) * 16; _Pragma("unroll") for (int bj = 0; bj < 2; ++bj) ol[buf][bj] = *(const v4u*)(X + (size_t)row_ * 1024 + col0 + bj * 128); } while (0)
        RS_LOAD(0, 0); RS_LOAD(1, 1);
#pragma unroll
        for (int grp = 0; grp < 8; ++grp) {
            if (grp + 2 < 8) RS_LOAD((grp + 2) % 3, grp + 2);
            asm volatile("" ::: "memory");
            const int ai = grp >> 2, m = grp & 3, row = row0 + ai * 128 + m * 16; float ss = 0.f;
#pragma unroll
            for (int bj = 0; bj < 2; ++bj) { A4 o0, o1; unpack8(ol[grp % 3][bj], o0, o1); o0 = o0 + acc[ai][bj][m][0]; o1 = o1 + acc[ai][bj][m][1];
                const v4u w = pack8(o0, o1); *(v4u*)(X + (size_t)row * 1024 + col0 + bj * 128) = w; unpack8(w, o0, o1);
                ss += (o0[0] * o0[0] + o0[1] * o0[1]) + (o0[2] * o0[2] + o0[3] * o0[3]) + (o1[0] * o1[0] + o1[1] * o1[1]) + (o1[2] * o1[2] + o1[3] * o1[3]); }
            ss += __shfl_xor(ss, 16); ss += __shfl_xor(ss, 32);
            if (fq == 0) ssq[(size_t)row * 16 + u.pn * 4 + wc] = ss;
        }
#undef RS_LOAD
    }
};
struct EpiMoeDown {
    static constexpr bool PERM = true;
    bf16* Y; const int* rdest; const float* rw;
    __device__ __forceinline__ void operator()(const AccT& acc, const pg8::Unit& u, int wr, int wc, int fr, int fq) const {
        const int row0 = u.pm * 256 + wr * 64 + fr, cw = wc * 32 + 8 * fq;
        int ds[2][4]; float wsv[2][4];
#pragma unroll
        for (int ai = 0; ai < 2; ++ai)
#pragma unroll
            for (int m = 0; m < 4; ++m) { const int row = row0 + ai * 128 + m * 16; ds[ai][m] = rdest[row]; wsv[ai][m] = rw[row]; }
#pragma unroll
        for (int ai = 0; ai < 2; ++ai)
#pragma unroll
            for (int m = 0; m < 4; ++m) { const int dest = ds[ai][m]; const float w = wsv[ai][m];
                if (dest >= 0) {
#pragma unroll
                    for (int bj = 0; bj < 2; ++bj) *(v4u*)(Y + (size_t)dest * 1024 + u.pn * 256 + bj * 128 + cw) = pack8(acc[ai][bj][m][0] * w, acc[ai][bj][m][1] * w); }
                asm volatile("" ::: "memory"); }
    }
};
struct MoeOrder {
    pg8::StaticOrder so; int tile0, a_tile_off, b_rows; int s1, s2, s3, s4, s5, s6, s7;
    __device__ __forceinline__ bool next(int i, pg8::Unit& u) const {
        if (!so.next(i, u)) return false;
        const int gt = tile0 + u.pm;
        const int e = (gt >= s1) + (gt >= s2) + (gt >= s3) + (gt >= s4) + (gt >= s5) + (gt >= s6) + (gt >= s7);
        u.arow = (a_tile_off + u.pm) * 256; u.brow = e * b_rows + u.pn * 256; return true;
    }
};
struct Args { const float* in[31]; unsigned char* out; unsigned char* ws; int ph_lo, ph_hi, use_bar, pad; };
struct Frame {
    LAS unsigned char* lds;
    volatile LAS unsigned* MISC;
    gu32* ctl;
    int tid, lane, wave, G, gw, NGW;
};

__device__ __forceinline__ int inproj_dest(int n) {
    if (n < 1536) return n;
    if (n < 1544) return 5376 + (n - 1536);
    if (n < 1800) return 1536 + (n - 1544);
    if (n < 2056) { const int c = n - 1800; return 1792 + (c >> 7) * 256 + (c & 127); }
    if (n < 2312) { const int c = n - 2056; return 1792 + (c >> 7) * 256 + 128 + (c & 127); }
    return 2304 + (n - 2312);
}
__device__ __forceinline__ int inproj_src(int d) {
    if (d < 1536) return d;
    if (d < 1792) return 1544 + (d - 1536);
    if (d < 2304) { const int t = (d - 1792) >> 8, r = (d - 1792) & 255; return r < 128 ? 1800 + t * 128 + r : 2056 + t * 128 + (r - 128); }
    if (d < 5376) return 2312 + (d - 2304);
    return (d - 5376) < 8 ? 1536 + (d - 5376) : -1;
}
__device__ __forceinline__ int map_row(int kind, int off, int n) {
    if (kind == 0) return n + off;
    if (kind == 1) return (n >> 7) * 256 + (n & 127) + off;
    if (kind == 2) { const int j = n & 255; return (j >> 7) * 256 + (j & 127) + ((n >> 8) ? 128 : 0); }
    return inproj_dest(n);
}
__device__ __forceinline__ void cvt_item(const float* W, int K, int N, const float* gk, bf16* WT, int kind, int off, LAS float* scr, int item, int lane) {
    const int nblk = (N + 31) >> 5, kb = item / nblk, nb = item - kb * nblk, k0 = 64 * kb, n0 = 32 * nb;
    const int n = n0 + (lane & 31);
#pragma unroll 8
    for (int i = 0; i < 32; ++i) { const int kk = 2 * i + (lane >> 5); float v = 0.f;
        if (n < N) { v = W[(size_t)(k0 + kk) * N + n]; if (gk) v *= gk[k0 + kk]; }
        scr[kk * 33 + (lane & 31)] = v; }
    LDS_WAIT(); asm volatile("" ::: "memory");
    const int c = lane & 7;
#pragma unroll
    for (int j = 0; j < 4; ++j) { const int nl = (lane >> 3) + 8 * j; const int nn = n0 + nl; const LAS float* s = scr + (8 * c) * 33 + nl;
        if (nn < N) { v4u o; o.x = pk2(s[0 * 33], s[1 * 33]); o.y = pk2(s[2 * 33], s[3 * 33]); o.z = pk2(s[4 * 33], s[5 * 33]); o.w = pk2(s[6 * 33], s[7 * 33]);
            *(v4u*)(WT + (size_t)map_row(kind, off, nn) * K + k0 + 8 * c) = o; } }
    LDS_WAIT(); asm volatile("" ::: "memory");
}
__device__ __forceinline__ void cvt_job(const float* W, int K, int N, const float* gk, bf16* WT, int kind, int off, LAS float* scr, int lane, int& base, int gwl, int ngw) {
    const int items = (K >> 6) * ((N + 31) >> 5);
    const int first = (gwl - (base % ngw) + ngw) % ngw;
    for (int it = first; it < items; it += ngw) cvt_item(W, K, N, gk, WT, kind, off, scr, it, lane);
    base += items;
}
__device__ __forceinline__ void cvt_moe_layer(const Args& a, int i, int l, LAS float* scr, int lane, int gwl, int ngw) {
    bf16* wgu = (bf16*)(a.ws + WS_WMOE + WMOE_GU); bf16* wd = (bf16*)(a.ws + WS_WMOE + WMOE_D); int base = 0;
    for (int e = 0; e < NE; ++e) {
        const size_t wo = (size_t)(i * NE + e) * D * D_FFE;
        cvt_job(a.in[27] + wo, D, D_FFE, a.in[21] + l * D, wgu + (size_t)e * 7168 * D, 1, 0, scr, lane, base, gwl, ngw);
        cvt_job(a.in[28] + wo, D, D_FFE, a.in[21] + l * D, wgu + (size_t)e * 7168 * D, 1, 128, scr, lane, base, gwl, ngw);
        cvt_job(a.in[29] + wo, D_FFE, D, nullptr, wd + (size_t)e * D * D_FFE, 0, 0, scr, lane, base, gwl, ngw);
    }
}

__device__ __forceinline__ void p0_prologue(Frame& F, const Args& a) {
    LAS float* scr = (LAS float*)(F.lds + RING_OFF + F.wave * 16384);
    int base = 0;
    for (int l = 0; l < DEPTH; ++l) {
        unsigned char* wm = a.ws + WS_WMIX + (size_t)l * WMIX_STRIDE;
        cvt_job(a.in[2] + (size_t)l * D * N_IN, D, N_IN, a.in[1] + l * D, (bf16*)(wm + WM_IN), 3, 0, scr, F.lane, base, F.gw, F.NGW);
        cvt_job(a.in[12] + (size_t)l * 256 * 512, 256, 512, nullptr, (bf16*)(wm + WM_GLU), 2, 0, scr, F.lane, base, F.gw, F.NGW);
        cvt_job(a.in[17] + (size_t)l * 512 * D, 512, D, nullptr, (bf16*)(wm + WM_A), 0, 0, scr, F.lane, base, F.gw, F.NGW);
        cvt_job(a.in[18] + (size_t)l * 256 * D, 256, D, nullptr, (bf16*)(wm + WM_S), 0, 0, scr, F.lane, base, F.gw, F.NGW);
        cvt_job(a.in[19] + (size_t)l * 256 * D, 256, D, nullptr, (bf16*)(wm + WM_C), 0, 0, scr, F.lane, base, F.gw, F.NGW);
        cvt_job(a.in[20] + (size_t)l * D * D, D, D, nullptr, (bf16*)(wm + WM_O), 0, 0, scr, F.lane, base, F.gw, F.NGW);
    }
    for (int i = 0; i < 2; ++i) {
        unsigned char* wd = a.ws + WS_WDENSE + (size_t)i * WDENSE_STRIDE;
        cvt_job(a.in[22] + (size_t)i * D * D_FF, D, D_FF, a.in[21] + (2 * i) * D, (bf16*)(wd + WD_GU), 1, 0, scr, F.lane, base, F.gw, F.NGW);
        cvt_job(a.in[23] + (size_t)i * D * D_FF, D, D_FF, a.in[21] + (2 * i) * D, (bf16*)(wd + WD_GU), 1, 128, scr, F.lane, base, F.gw, F.NGW);
        cvt_job(a.in[24] + (size_t)i * D_FF * D, D_FF, D, nullptr, (bf16*)(wd + WD_D), 0, 0, scr, F.lane, base, F.gw, F.NGW);
    }
    float* bperm = (float*)(a.ws + WS_BPERM);
    for (int idx = F.gw * 64 + F.lane; idx < DEPTH * N_INP; idx += F.NGW * 64) { const int l = idx / N_INP, d = idx - l * N_INP, n = inproj_src(d); bperm[idx] = n >= 0 ? a.in[3][l * N_IN + n] : 0.f; }
    bf16* xb = (bf16*)(a.ws + WS_XB); float* ssq = (float*)(a.ws + WS_SSQ);
    for (int m = F.gw; m < M; m += F.NGW) {
        const f32x4* xr = (const f32x4*)(a.in[0] + (size_t)m * D) + F.lane; float ss = 0.f;
#pragma unroll
        for (int j = 0; j < 4; ++j) { const f32x4 v = xr[64 * j]; v2u w; w.x = pk2(v.x, v.y); w.y = pk2(v.z, v.w);
            *(v2u*)(xb + (size_t)m * D + 256 * j + 4 * F.lane) = w;
            const float a0 = bflo(w.x), a1 = bfhi(w.x), a2 = bflo(w.y), a3 = bfhi(w.y); ss += (a0 * a0 + a1 * a1) + (a2 * a2 + a3 * a3); }
        const float tot = wave_sum(ss);
        if (F.lane < 16) ssq[(size_t)m * 16 + F.lane] = F.lane == 0 ? tot : 0.f;
    }
}

__device__ __forceinline__ void t1_cumsum(const Args& a, int bh, int lane) {
    const float* logf = (const float*)(a.ws + WS_LOGF); float* Fh = (float*)(a.ws + WS_FH);
    const int b = bh >> 3, h = bh & 7; const float* p = logf + ((size_t)b * SEQ + 64 * lane) * 8 + h;
    float s = 0.f;
    for (int j = 0; j < 64; ++j) s += p[j * 8];
    float v = s;
#pragma unroll
    for (int o = 1; o < 64; o <<= 1) { const float t = __shfl_up(v, o); if (lane >= o) v += t; }
    float run = v - s; float* o = Fh + (size_t)bh * SEQ + 64 * lane;
    for (int j = 0; j < 64; ++j) { run += p[j * 8]; o[j] = run; }
}
__device__ __forceinline__ void t1_conv(const Args& a, int l, int blk, int lane) {
    const bf16* HC = (const bf16*)(a.out + DO_HC); bf16* CO = (bf16*)(a.ws + WS_CONVO);
    const float* cw = a.in[13] + (size_t)l * CONV_K * CONV_W + 4 * lane;
    const f32x4 cb = *(const f32x4*)(a.in[14] + l * CONV_W + 4 * lane), lg = *(const f32x4*)(a.in[15] + l * CONV_W + 4 * lane), lb = *(const f32x4*)(a.in[16] + l * CONV_W + 4 * lane);
    for (int i = 0; i < 32; ++i) {
        const int m = blk * 32 + i, tl = m & (SEQ - 1);
        f32x4 y = cb;
        for (int k = 0; k < CONV_K; ++k) { const int tt = tl - (CONV_K - 1) + k;
            if (tt >= 0) { const v2u hv = *(const v2u*)(HC + (size_t)(m - (CONV_K - 1) + k) * CONV_W + 4 * lane); const f32x4 w = *(const f32x4*)(cw + k * CONV_W);
                y.x += w.x * bflo(hv.x); y.y += w.y * bfhi(hv.x); y.z += w.z * bflo(hv.y); y.w += w.w * bfhi(hv.y); } }
        const float mu = wave_sum((y.x + y.y) + (y.z + y.w)) * (1.f / 256.f);
        const f32x4 dl = y - mu;
        const float var = wave_sum((dl.x * dl.x + dl.y * dl.y) + (dl.z * dl.z + dl.w * dl.w)) * (1.f / 256.f);
        const float rs = rsqrtf(var + EPS);
        f32x4 z = dl * rs * lg + lb;
        z.x *= sigmoidf_(z.x); z.y *= sigmoidf_(z.y); z.z *= sigmoidf_(z.z); z.w *= sigmoidf_(z.w);
        v2u o; o.x = pk2(z.x, z.y); o.y = pk2(z.z, z.w);
        *(v2u*)(CO + (size_t)m * CONV_W + 4 * lane) = o;
    }
}
__device__ __forceinline__ float gelu_tanh(float y) {
    const float z = 0.7978845608028654f * (y + 0.044715f * y * y * y);
    const float th = 1.0f - 2.0f / (__expf(2.0f * z) + 1.0f);
    return 0.5f * y * (1.0f + th);
}
__device__ __forceinline__ void t1_ssm_scan(const Args& a, int l, int b, int g, int lane) {
    const bf16* U = (const bf16*)(a.out + DO_U); bf16* YG = (bf16*)(a.ws + WS_YG);
    const int lg = l * SSM_G + g, p = lane;
    const float lam_re = a.in[4][lg * SSM_P + p], lam_im = a.in[5][lg * SSM_P + p], dt = expf(a.in[6][lg]);
    const float mag = expf(lam_re * dt); float sn, cs; sincosf(lam_im * dt, &sn, &cs);
    const float ar = mag * cs, ai = mag * sn;
    const float nr = ar - 1.0f, ni = ai, den = lam_re * lam_re + lam_im * lam_im;
    const float cr = (nr * lam_re + ni * lam_im) / den, ci = (ni * lam_re - nr * lam_im) / den;
    float br[16], bi[16], cre[16], cim[16], dq[16];
#pragma unroll
    for (int h = 0; h < 16; ++h) {
        const float bre = a.in[7][((size_t)lg * SSM_P + p) * SSM_H + h], bim = a.in[8][((size_t)lg * SSM_P + p) * SSM_H + h];
        br[h] = cr * bre - ci * bim; bi[h] = cr * bim + ci * bre;
        cre[h] = a.in[9][((size_t)lg * SSM_H + h) * SSM_P + p]; cim[h] = a.in[10][((size_t)lg * SSM_H + h) * SSM_P + p];
        dq[h] = lane == 0 ? a.in[11][lg * SSM_H + h] : 0.f;
    }
    float xr = 0.f, xi = 0.f;
    const bf16* up = U + (size_t)b * SEQ * SSM_W + 16 * g;
    bf16* yp = YG + (size_t)b * SEQ * SSM_W + 16 * g + (lane >> 2);
    const bool b5 = (lane & 32) != 0, b4 = (lane & 16) != 0, b3 = (lane & 8) != 0, b2 = (lane & 4) != 0;
    v4u c0 = *(const v4u*)(up + (size_t)lane * SSM_W), c1 = *(const v4u*)(up + (size_t)lane * SSM_W + 8);
    for (int blk = 0; blk < SEQ / 64; ++blk) {
        v4u n0 = c0, n1 = c1;
        if (blk + 1 < SEQ / 64) { n0 = *(const v4u*)(up + (size_t)((blk + 1) * 64 + lane) * SSM_W); n1 = *(const v4u*)(up + (size_t)((blk + 1) * 64 + lane) * SSM_W + 8); }
#pragma unroll 2
        for (int j = 0; j < 64; ++j) {
            unsigned w[8];
            w[0] = __builtin_amdgcn_readlane(c0.x, j); w[1] = __builtin_amdgcn_readlane(c0.y, j); w[2] = __builtin_amdgcn_readlane(c0.z, j); w[3] = __builtin_amdgcn_readlane(c0.w, j);
            w[4] = __builtin_amdgcn_readlane(c1.x, j); w[5] = __builtin_amdgcn_readlane(c1.y, j); w[6] = __builtin_amdgcn_readlane(c1.z, j); w[7] = __builtin_amdgcn_readlane(c1.w, j);
            float u[16];
#pragma unroll
            for (int k = 0; k < 8; ++k) { u[2 * k] = bflo(w[k]); u[2 * k + 1] = bfhi(w[k]); }
            float bur = 0.f, bui = 0.f;
#pragma unroll
            for (int h = 0; h < 16; ++h) { bur += br[h] * u[h]; bui += bi[h] * u[h]; }
            const float nxr = ar * xr - ai * xi + bur, nxi = ar * xi + ai * xr + bui; xr = nxr; xi = nxi;
            float v[16];
#pragma unroll
            for (int h = 0; h < 16; ++h) v[h] = cre[h] * xr - cim[h] * xi + dq[h] * u[h];
            float w8[8], w4[4], w2[2];
#pragma unroll
            for (int i = 0; i < 8; ++i) { const float keep = b5 ? v[i + 8] : v[i], send = b5 ? v[i] : v[i + 8]; w8[i] = keep + __shfl_xor(send, 32); }
#pragma unroll
            for (int i = 0; i < 4; ++i) { const float keep = b4 ? w8[i + 4] : w8[i], send = b4 ? w8[i] : w8[i + 4]; w4[i] = keep + __shfl_xor(send, 16); }
#pragma unroll
            for (int i = 0; i < 2; ++i) { const float keep = b3 ? w4[i + 2] : w4[i], send = b3 ? w4[i] : w4[i + 2]; w2[i] = keep + __shfl_xor(send, 8); }
            float w1; { const float keep = b2 ? w2[1] : w2[0], send = b2 ? w2[0] : w2[1]; w1 = keep + __shfl_xor(send, 4); }
            w1 += __shfl_xor(w1, 2); w1 += __shfl_xor(w1, 1);
            if ((lane & 3) == 0) yp[(size_t)(blk * 64 + j) * SSM_W] = (bf16)f2bf(gelu_tanh(w1));
        }
        c0 = n0; c1 = n1;
    }
}

__device__ __forceinline__ void attn_naive_unit(const Args& a, int bh, int qb, int lane) {
    bf16* Q = (bf16*)(a.out + DO_Q); const bf16* Kb = (const bf16*)(a.out + DO_K); const bf16* Vb = (const bf16*)(a.out + DO_V);
    const float* Fh = (const float*)(a.ws + WS_FH) + (size_t)bh * SEQ;
    const int b = bh >> 3, h = bh & 7, i = qb * 32 + (lane >> 1), hf = lane & 1;
    bf16* qp = Q + ((size_t)b * SEQ + i) * ATT_W + h * HD + 32 * hf;
    float q[32], o[32];
#pragma unroll
    for (int c = 0; c < 4; ++c) { const v4u w = *(const v4u*)(qp + 8 * c); q[8 * c] = bflo(w.x); q[8 * c + 1] = bfhi(w.x); q[8 * c + 2] = bflo(w.y); q[8 * c + 3] = bfhi(w.y); q[8 * c + 4] = bflo(w.z); q[8 * c + 5] = bfhi(w.z); q[8 * c + 6] = bflo(w.w); q[8 * c + 7] = bfhi(w.w); }
#pragma unroll
    for (int d = 0; d < 32; ++d) o[d] = 0.f;
    const float Fi = Fh[i] * LOG2E; float mx = -INFINITY, lsum = 0.f;
    const int nk = qb * 32 + 32;
    const bf16* kp = Kb + (size_t)b * SEQ * ATT_W + h * HD + 32 * hf; const bf16* vp = Vb + (size_t)b * SEQ * ATT_W + h * HD + 32 * hf;
    for (int j = 0; j < nk; ++j) {
        float s = 0.f;
#pragma unroll
        for (int c = 0; c < 4; ++c) { const v4u w = *(const v4u*)(kp + (size_t)j * ATT_W + 8 * c);
            s += q[8 * c] * bflo(w.x) + q[8 * c + 1] * bfhi(w.x) + q[8 * c + 2] * bflo(w.y) + q[8 * c + 3] * bfhi(w.y) + q[8 * c + 4] * bflo(w.z) + q[8 * c + 5] * bfhi(w.z) + q[8 * c + 6] * bflo(w.w) + q[8 * c + 7] * bfhi(w.w); }
        s += __shfl_xor(s, 1);
        s += Fi - Fh[j] * LOG2E;
        if (j > i) s = -INFINITY;
        const float mn = fmaxf(mx, s), corr = __builtin_amdgcn_exp2f(mx - mn), pr = __builtin_amdgcn_exp2f(s - mn);
        mx = mn; lsum = lsum * corr + pr;
#pragma unroll
        for (int c = 0; c < 4; ++c) { const v4u w = *(const v4u*)(vp + (size_t)j * ATT_W + 8 * c);
            o[8 * c] = o[8 * c] * corr + pr * bflo(w.x); o[8 * c + 1] = o[8 * c + 1] * corr + pr * bfhi(w.x); o[8 * c + 2] = o[8 * c + 2] * corr + pr * bflo(w.y); o[8 * c + 3] = o[8 * c + 3] * corr + pr * bfhi(w.y);
            o[8 * c + 4] = o[8 * c + 4] * corr + pr * bflo(w.z); o[8 * c + 5] = o[8 * c + 5] * corr + pr * bfhi(w.z); o[8 * c + 6] = o[8 * c + 6] * corr + pr * bflo(w.w); o[8 * c + 7] = o[8 * c + 7] * corr + pr * bfhi(w.w); }
    }
    const float il = 1.0f / lsum;
#pragma unroll
    for (int c = 0; c < 4; ++c) { v4u w; w.x = pk2(o[8 * c] * il, o[8 * c + 1] * il); w.y = pk2(o[8 * c + 2] * il, o[8 * c + 3] * il); w.z = pk2(o[8 * c + 4] * il, o[8 * c + 5] * il); w.w = pk2(o[8 * c + 6] * il, o[8 * c + 7] * il); *(v4u*)(qp + 8 * c) = w; }
}
__device__ __forceinline__ void attn_naive(Frame& F, const Args& a) {
    for (int wt = F.gw; wt < BATCH * NH * 16; wt += F.NGW) {
        const int bh = wt >> 4, r = wt & 15;
        for (int ui = 0; ui < 8; ++ui) { const int pr_ = ui >> 1, qb = (ui & 1) ? (127 - 16 * pr_ - r) : (16 * pr_ + r); attn_naive_unit(a, bh, qb, F.lane); }
    }
}

__device__ __forceinline__ void moe_route(Frame& F, const Args& a, int l, int i) {
    const bf16* xb = (const bf16*)(a.ws + WS_XB); const float* ssq = (const float*)(a.ws + WS_SSQ);
    int* toke = (int*)(a.ws + WS_TOKE); float* tokw = (float*)(a.ws + WS_TOKW); int* cntw = (int*)(a.ws + WS_CNTW);
    const int lane = F.lane, k0 = 16 * lane;
    float wr[16][8];
#pragma unroll
    for (int j = 0; j < 16; ++j) { const float gk = a.in[21][l * D + k0 + j];
        const f32x4 w0 = *(const f32x4*)(a.in[25] + ((size_t)i * D + k0 + j) * NE), w1 = *(const f32x4*)(a.in[25] + ((size_t)i * D + k0 + j) * NE + 4);
        wr[j][0] = gk * w0.x; wr[j][1] = gk * w0.y; wr[j][2] = gk * w0.z; wr[j][3] = gk * w0.w; wr[j][4] = gk * w1.x; wr[j][5] = gk * w1.y; wr[j][6] = gk * w1.z; wr[j][7] = gk * w1.w; }
    float rb[8];
#pragma unroll
    for (int e = 0; e < 8; ++e) rb[e] = a.in[26][i * NE + e];
    const bool b5 = (lane & 32) != 0, b4 = (lane & 16) != 0, b3 = (lane & 8) != 0;
    for (int run = F.gw; run < M / 32; run += F.NGW) {
        int cnt[8];
#pragma unroll
        for (int e = 0; e < 8; ++e) cnt[e] = 0;
        for (int ti = 0; ti < 32; ++ti) {
            const int t = run * 32 + ti;
            const v4u x0 = *(const v4u*)(xb + (size_t)t * D + k0), x1 = *(const v4u*)(xb + (size_t)t * D + k0 + 8);
            float xv[16] = {bflo(x0.x), bfhi(x0.x), bflo(x0.y), bfhi(x0.y), bflo(x0.z), bfhi(x0.z), bflo(x0.w), bfhi(x0.w), bflo(x1.x), bfhi(x1.x), bflo(x1.y), bfhi(x1.y), bflo(x1.z), bfhi(x1.z), bflo(x1.w), bfhi(x1.w)};
            float v[8];
#pragma unroll
            for (int e = 0; e < 8; ++e) { float s = 0.f;
#pragma unroll
                for (int j = 0; j < 16; ++j) s += xv[j] * wr[j][e];
                v[e] = s; }
            float w4[4], w2[2];
#pragma unroll
            for (int q = 0; q < 4; ++q) { const float keep = b5 ? v[q + 4] : v[q], send = b5 ? v[q] : v[q + 4]; w4[q] = keep + __shfl_xor(send, 32); }
#pragma unroll
            for (int q = 0; q < 2; ++q) { const float keep = b4 ? w4[q + 2] : w4[q], send = b4 ? w4[q] : w4[q + 2]; w2[q] = keep + __shfl_xor(send, 16); }
            float w1; { const float keep = b3 ? w2[1] : w2[0], send = b3 ? w2[0] : w2[1]; w1 = keep + __shfl_xor(send, 8); }
            w1 += __shfl_xor(w1, 4); w1 += __shfl_xor(w1, 2); w1 += __shfl_xor(w1, 1);
            const float rstd = row_rstd(ssq, t);
            float lg[8];
#pragma unroll
            for (int e = 0; e < 8; ++e) lg[e] = __builtin_bit_cast(float, __builtin_amdgcn_readlane(__builtin_bit_cast(int, w1), 8 * e)) * rstd + rb[e];
            int e0 = 0; float l0 = lg[0];
#pragma unroll
            for (int e = 1; e < 8; ++e) if (lg[e] > l0) { l0 = lg[e]; e0 = e; }
            int e1 = -1; float l1 = -INFINITY;
#pragma unroll
            for (int e = 0; e < 8; ++e) if (e != e0 && lg[e] > l1) { l1 = lg[e]; e1 = e; }
            const float p0 = 1.0f / (1.0f + __expf(l1 - l0)), p1 = 1.0f - p0;
            if (lane == 0) { toke[t] = e0 | (e1 << 8); tokw[2 * t] = p0; tokw[2 * t + 1] = p1; }
#pragma unroll
            for (int e = 0; e < 8; ++e) cnt[e] += (e0 == e) + (e1 == e);
        }
        int cv = 0;
#pragma unroll
        for (int e = 0; e < 8; ++e) if (lane == e) cv = cnt[e];
        if (lane < 8) cntw[run * 8 + lane] = cv;
    }
}
__device__ __forceinline__ int wave_sum_i(int v) {
#pragma unroll
    for (int o = 1; o < 64; o <<= 1) v += __shfl_xor(v, o);
    return v;
}
__device__ __forceinline__ void moe_slots(Frame& F, const Args& a) {
    const bf16* xb = (const bf16*)(a.ws + WS_XB); const float* ssq = (const float*)(a.ws + WS_SSQ); bf16* xg = (bf16*)(a.ws + WS_XG);
    const int* toke = (const int*)(a.ws + WS_TOKE); const float* tokw = (const float*)(a.ws + WS_TOKW); const int* cntw = (const int*)(a.ws + WS_CNTW);
    int* meta = (int*)(a.ws + WS_META); int* rdest = (int*)(a.ws + WS_RDEST); float* rw = (float*)(a.ws + WS_RW); float* rrstd = (float*)(a.ws + WS_RRSTD);
    const int lane = F.lane;
    for (int run = F.gw; run < M / 32; run += F.NGW) {
        int pre[8], tot[8];
#pragma unroll
        for (int e = 0; e < 8; ++e) { pre[e] = 0; tot[e] = 0; }
        for (int r2 = lane; r2 < M / 32; r2 += 64) {
            const int4 c0 = *(const int4*)(cntw + r2 * 8), c1 = *(const int4*)(cntw + r2 * 8 + 4); const int f = r2 < run ? 1 : 0;
            tot[0] += c0.x; tot[1] += c0.y; tot[2] += c0.z; tot[3] += c0.w; tot[4] += c1.x; tot[5] += c1.y; tot[6] += c1.z; tot[7] += c1.w;
            pre[0] += f * c0.x; pre[1] += f * c0.y; pre[2] += f * c0.z; pre[3] += f * c0.w; pre[4] += f * c1.x; pre[5] += f * c1.y; pre[6] += f * c1.z; pre[7] += f * c1.w;
        }
        int seg[9]; seg[0] = 0;
#pragma unroll
        for (int e = 0; e < 8; ++e) { tot[e] = __builtin_amdgcn_readfirstlane(wave_sum_i(tot[e])); pre[e] = __builtin_amdgcn_readfirstlane(wave_sum_i(pre[e])); seg[e + 1] = seg[e] + ((tot[e] + 255) & ~255); }
        if (run == 0 && lane < 9) { int sv = 0;
#pragma unroll
            for (int e = 0; e < 9; ++e) if (lane == e) sv = seg[e] >> 8;
            meta[lane] = sv; }
        if (run < 8) {
#pragma unroll
            for (int e = 0; e < 8; ++e) if (run == e) { for (int r = tot[e] + lane; r < ((tot[e] + 255) & ~255); r += 64) { rdest[seg[e] + r] = -1; rw[seg[e] + r] = 0.f; rrstd[seg[e] + r] = 0.f; } }
        }
        int base[8];
#pragma unroll
        for (int e = 0; e < 8; ++e) base[e] = seg[e] + pre[e];
        for (int ti = 0; ti < 32; ++ti) {
            const int t = run * 32 + ti; const int ee = __builtin_amdgcn_readfirstlane(toke[t]); const int e0 = ee & 255, e1 = ee >> 8;
            int s0 = 0, s1 = 0;
#pragma unroll
            for (int e = 0; e < 8; ++e) { if (e0 == e) { s0 = base[e]; base[e] += 1; } if (e1 == e) { s1 = base[e]; base[e] += 1; } }
            if (lane == 0) { const float rstd = row_rstd(ssq, t); rdest[s0] = 2 * t; rdest[s1] = 2 * t + 1; rw[s0] = tokw[2 * t]; rw[s1] = tokw[2 * t + 1]; rrstd[s0] = rstd; rrstd[s1] = rstd; }
            const v4u x0 = *(const v4u*)(xb + (size_t)t * D + 16 * lane), x1 = *(const v4u*)(xb + (size_t)t * D + 16 * lane + 8);
            *(v4u*)(xg + (size_t)s0 * D + 16 * lane) = x0; *(v4u*)(xg + (size_t)s0 * D + 16 * lane + 8) = x1;
            *(v4u*)(xg + (size_t)s1 * D + 16 * lane) = x0; *(v4u*)(xg + (size_t)s1 * D + 16 * lane + 8) = x1;
        }
    }
}
__device__ __forceinline__ void moe_combine(Frame& F, const Args& a, bool last) {
    bf16* xb = (bf16*)(a.ws + WS_XB); float* ssq = (float*)(a.ws + WS_SSQ); const bf16* yb = (const bf16*)a.out; float* outp = (float*)a.out;
    const int lane = F.lane;
    for (int t = F.gw; t < M; t += F.NGW) {
        const v4u x0 = *(const v4u*)(xb + (size_t)t * D + 16 * lane), x1 = *(const v4u*)(xb + (size_t)t * D + 16 * lane + 8);
        const v4u y00 = *(const v4u*)(yb + (size_t)(2 * t) * D + 16 * lane), y01 = *(const v4u*)(yb + (size_t)(2 * t) * D + 16 * lane + 8);
        const v4u y10 = *(const v4u*)(yb + (size_t)(2 * t + 1) * D + 16 * lane), y11 = *(const v4u*)(yb + (size_t)(2 * t + 1) * D + 16 * lane + 8);
        A4 xa, xb_, xc, xd, t0, t1;
        unpack8(x0, xa, xb_); unpack8(x1, xc, xd);
        unpack8(y00, t0, t1); xa = xa + t0; xb_ = xb_ + t1; unpack8(y01, t0, t1); xc = xc + t0; xd = xd + t1;
        unpack8(y10, t0, t1); xa = xa + t0; xb_ = xb_ + t1; unpack8(y11, t0, t1); xc = xc + t0; xd = xd + t1;
        if (!last) {
            const v4u w0 = pack8(xa, xb_), w1 = pack8(xc, xd);
            *(v4u*)(xb + (size_t)t * D + 16 * lane) = w0; *(v4u*)(xb + (size_t)t * D + 16 * lane + 8) = w1;
            unpack8(w0, xa, xb_); unpack8(w1, xc, xd);
        }
        float ss = 0.f;
#pragma unroll
        for (int j = 0; j < 4; ++j) ss += xa[j] * xa[j] + xb_[j] * xb_[j] + xc[j] * xc[j] + xd[j] * xd[j];
        const float tot = wave_sum(ss);
        if (!last) { if (lane < 16) ssq[(size_t)t * 16 + lane] = lane == 0 ? tot : 0.f; }
        else {
            const float r = rsqrtf(tot * (1.0f / 1024.0f) + EPS); const f32x4* gf = (const f32x4*)(a.in[30] + 16 * lane); f32x4* op = (f32x4*)(outp + (size_t)t * D + 16 * lane);
            op[0] = xa * r * gf[0]; op[1] = xb_ * r * gf[1]; op[2] = xc * r * gf[2]; op[3] = xd * r * gf[3];
        }
    }
}
#ifndef MK_N_LAUNCHES
#define MK_N_LAUNCHES 1
#endif
constexpr int N_PHASES = 1 + 2 * (7 + 14);

__global__ void __launch_bounds__(NWAVES * 64, 2) fwd(Args args) {
    extern __shared__ __attribute__((aligned(16))) unsigned char lds[];
    Frame F;
    F.lds = (LAS unsigned char*)lds;
    F.MISC = (volatile LAS unsigned*)(F.lds + MISC_OFF);
    F.tid = threadIdx.x; F.lane = F.tid & 63; F.wave = __builtin_amdgcn_readfirstlane(F.tid >> 6);
    F.G = gridDim.x; F.gw = blockIdx.x * NWAVES + F.wave; F.NGW = F.G * NWAVES;
    unsigned char* ws = args.ws;
    F.ctl = (gu32*)(ws + WS_CTL);
    for (int u = F.tid; u < (LDS_BYTES - LDSCTL_OFF) / 4; u += NWAVES * 64) ((LAS unsigned*)(F.lds + LDSCTL_OFF))[u] = 0u;
    __syncthreads();
    XcdBarrier bar; bar.bar = (unsigned*)(F.ctl + CW_BAR); bar.x = 0; bar.st = nullptr;
    if (args.use_bar) bar = xcd_barrier_post((unsigned*)(F.ctl + CW_BAR), F.MISC + 8);
    const int lo = args.ph_lo, hi = args.ph_hi; int ph = 0;
#ifndef MERGE_MASK
#define MERGE_MASK 7
#endif
#ifndef PHASE_MASK
#define PHASE_MASK 0xffffffffu
#endif
#define INP(k) ((lo <= ph && ph < hi) && ((PHASE_MASK >> (k)) & 1u))
#define OPQ() Frame Fp = F; { int l_ = F.lane; asm volatile("" : "+v"(l_)); Fp.lane = l_; Fp.tid = (F.wave << 6) | l_; }
#define SEAM() do { if (lo <= ph && ph + 1 < hi) xcd_barrier(bar); ++ph; } while (0)
    const int bid = (int)blockIdx.x;
    LAS unsigned char* ring = F.lds + RING_OFF;
#define XB ((bf16*)(ws + WS_XB))
#define SSQ ((float*)(ws + WS_SSQ))
#define Qb ((bf16*)(args.out + DO_Q))
#define MRG ((bf16*)(args.out + DO_MERGED))
#define GATES ((bf16*)(ws + WS_GATES))
#define YG ((bf16*)(ws + WS_YG))
#define SSMO ((bf16*)(ws + WS_SSMO))
#define CONVO ((bf16*)(ws + WS_CONVO))

    if (INP(0)) { OPQ(); p0_prologue(Fp, args); } SEAM();

    for (int l = 0; l < DEPTH; ++l) {
        unsigned char* wm = ws + WS_WMIX + (size_t)l * WMIX_STRIDE;
        if (INP(1)) {
            pg8::Gemm g{XB, (const bf16*)(wm + WM_IN), D, D, D}; pg8::StaticOrder S; S.init(M / 256, N_INP / 256, F.G, bid);
            EpiInProj E{args.out, ws, l};
            pg8::gemm_phase<EpiInProj, pg8::StaticOrder, true, true>(ring, g, S, E);
        } SEAM();
        if (INP(2)) {
            OPQ();
            if (F.wave == 0) { for (int unit = bid; unit < BATCH * SSM_G; unit += F.G) t1_ssm_scan(args, l, unit >> 4, unit & 15, Fp.lane); }
            else {
                const int gwl = bid * 7 + (F.wave - 1), ngw = F.G * 7;
                for (int bh = gwl; bh < BATCH * NH; bh += ngw) t1_cumsum(args, bh, Fp.lane);
                for (int blk = gwl; blk < M / 32; blk += ngw) t1_conv(args, l, blk, Fp.lane);
                if (l & 1) cvt_moe_layer(args, l >> 1, l, (LAS float*)(F.lds + RING_OFF + F.wave * 16384), Fp.lane, gwl, ngw);
            }
        } SEAM();
        if (INP(3)) {
            { pg8::Gemm g{YG, (const bf16*)(wm + WM_GLU), 256, 256, 256}; pg8::StaticOrder S; S.init(M / 256, 2, F.G, bid); EpiGluSsm E{SSMO};
              pg8::gemm_phase<EpiGluSsm, pg8::StaticOrder, true, true>(ring, g, S, E); }
            { OPQ(); attn_naive(Fp, args); }
        } SEAM();
        if (INP(4)) {
            pg8::StaticOrder S; S.init(M / 256, 4, F.G, bid);
            if (MERGE_MASK & 1) { pg8::Gemm g{Qb, (const bf16*)(wm + WM_A), 512, 512, 512}; EpiMerge<0> E{GATES, MRG}; pg8::gemm_phase<EpiMerge<0>, pg8::StaticOrder, true, true>(ring, g, S, E); }
            if (MERGE_MASK & 2) { pg8::Gemm g{SSMO, (const bf16*)(wm + WM_S), 256, 256, 256}; EpiMerge<1> E{GATES, MRG}; pg8::gemm_phase<EpiMerge<1>, pg8::StaticOrder, true, true>(ring, g, S, E); }
            if (MERGE_MASK & 4) { pg8::Gemm g{CONVO, (const bf16*)(wm + WM_C), 256, 256, 256}; EpiMerge<2> E{GATES, MRG}; pg8::gemm_phase<EpiMerge<2>, pg8::StaticOrder, true, true>(ring, g, S, E); }
        } SEAM();
        if (INP(5)) {
            pg8::Gemm g{MRG, (const bf16*)(wm + WM_O), D, D, D}; pg8::StaticOrder S; S.init(M / 256, 4, F.G, bid); EpiResid E{XB, SSQ};
            pg8::gemm_phase<EpiResid, pg8::StaticOrder, true, true>(ring, g, S, E);
        } SEAM();
        if (!(l & 1)) {
            unsigned char* wd = ws + WS_WDENSE + (size_t)(l >> 1) * WDENSE_STRIDE; bf16* const HID = (bf16*)(ws + WS_HID);
            if (INP(6)) {
                pg8::Gemm g{XB, (const bf16*)(wd + WD_GU), D, D, D}; pg8::StaticOrder S; S.init(M / 256, 2 * D_FF / 256, F.G, bid); EpiSwiGlu<false> E{HID, D_FF, SSQ};
                pg8::gemm_phase<EpiSwiGlu<false>, pg8::StaticOrder, true, true>(ring, g, S, E);
            } SEAM();
            if (INP(7)) {
                pg8::Gemm g{HID, (const bf16*)(wd + WD_D), D_FF, D_FF, D_FF}; pg8::StaticOrder S; S.init(M / 256, 4, F.G, bid); EpiResid E{XB, SSQ};
                pg8::gemm_phase<EpiResid, pg8::StaticOrder, true, true>(ring, g, S, E);
            } SEAM();
        } else {
            if (INP(8)) { OPQ(); moe_route(Fp, args, l, l >> 1); } SEAM();
            if (INP(9)) { OPQ(); moe_slots(Fp, args); } SEAM();
            const int* meta = (const int*)(ws + WS_META);
            for (int ch = 0; ch < MOE_NCHUNK; ++ch) {
                if (INP(10)) {
                    const int total = meta[8], per = (total + MOE_NCHUNK - 1) / MOE_NCHUNK, tile0 = ch * per; int nM = total - tile0; nM = nM < 0 ? 0 : (nM > per ? per : nM);
                    pg8::Gemm g{(const bf16*)(ws + WS_XG), (const bf16*)(ws + WS_WMOE + WMOE_GU), D, D, D};
                    MoeOrder S; S.so.init(nM, 2 * D_FFE / 256, F.G, bid); S.tile0 = tile0; S.a_tile_off = tile0; S.b_rows = 2 * D_FFE;
                    S.s1 = meta[1]; S.s2 = meta[2]; S.s3 = meta[3]; S.s4 = meta[4]; S.s5 = meta[5]; S.s6 = meta[6]; S.s7 = meta[7];
                    EpiSwiGlu<true> E{(bf16*)(ws + WS_MHID), D_FFE, (const float*)(ws + WS_RRSTD) + (size_t)tile0 * 256};
                    pg8::gemm_phase<EpiSwiGlu<true>, MoeOrder, true, true>(ring, g, S, E);
                } SEAM();
                if (INP(11)) {
                    const int total = meta[8], per = (total + MOE_NCHUNK - 1) / MOE_NCHUNK, tile0 = ch * per; int nM = total - tile0; nM = nM < 0 ? 0 : (nM > per ? per : nM);
                    pg8::Gemm g{(const bf16*)(ws + WS_MHID), (const bf16*)(ws + WS_WMOE + WMOE_D), D_FFE, D_FFE, D_FFE};
                    MoeOrder S; S.so.init(nM, 4, F.G, bid); S.tile0 = tile0; S.a_tile_off = 0; S.b_rows = D;
                    S.s1 = meta[1]; S.s2 = meta[2]; S.s3 = meta[3]; S.s4 = meta[4]; S.s5 = meta[5]; S.s6 = meta[6]; S.s7 = meta[7];
                    EpiMoeDown E{(bf16*)args.out, (const int*)(ws + WS_RDEST) + (size_t)tile0 * 256, (const float*)(ws + WS_RW) + (size_t)tile0 * 256};
                    pg8::gemm_phase<EpiMoeDown, MoeOrder, true, true>(ring, g, S, E);
                } SEAM();
            }
            if (INP(12)) { OPQ(); moe_combine(Fp, args, l == DEPTH - 1); } SEAM();
        }
    }
#undef INP
#undef SEAM
}

extern "C" void kernel_launch(void* const* d_in, const int* in_sizes, int n_in, void* d_out, int out_size, void* d_ws, size_t ws_size, hipStream_t stream) {
    static int grid = 0;
    if (grid == 0) {
        if (n_in != 31 || in_sizes[0] != M * D || out_size != M * D || ws_size < WS_END) { fprintf(stderr, "kernel_launch: unexpected shapes/workspace (n_in %d, ws %zu, need %zu); nothing launched\n", n_in, ws_size, (size_t)WS_END); grid = -1; return; }
        int dev = 0, cus = 0, per_cu = 0;
        if (hipGetDevice(&dev) != hipSuccess || hipDeviceGetAttribute(&cus, hipDeviceAttributeMultiprocessorCount, dev) != hipSuccess) { grid = -1; return; }
        if (hipFuncSetAttribute((const void*)fwd, hipFuncAttributeMaxDynamicSharedMemorySize, LDS_BYTES) != hipSuccess) { fprintf(stderr, "kernel_launch: hipFuncSetAttribute failed\n"); grid = -1; return; }
        if (hipOccupancyMaxActiveBlocksPerMultiprocessor(&per_cu, (const void*)fwd, NWAVES * 64, LDS_BYTES) != hipSuccess || per_cu < 1)
            fprintf(stderr, "kernel_launch: note: occupancy query reports %d workgroups per CU\n", per_cu);
        (void)hipGetLastError();
        grid = cus;
    }
    if (grid < 0) return;
    if (hipMemsetAsync((char*)d_ws + WS_CTL, 0, CTL_ZERO_BYTES, stream) != hipSuccess) return;
    Args a{};
    for (int i = 0; i < 31; ++i) a.in[i] = (const float*)d_in[i];
    a.out = (unsigned char*)d_out; a.ws = (unsigned char*)d_ws; a.pad = 0;
#if MK_N_LAUNCHES == 1
    a.ph_lo = 0; a.ph_hi = N_PHASES; a.use_bar = 1;
    hipLaunchKernelGGL(fwd, dim3(grid), dim3(NWAVES * 64), LDS_BYTES, stream, a);
#else
    for (int p = 0; p < N_PHASES; ++p) { a.ph_lo = p; a.ph_hi = p + 1; a.use_bar = 0; hipLaunchKernelGGL(fwd, dim3(grid), dim3(NWAVES * 64), LDS_BYTES, stream, a); }
#endif
}
```

```cpp
#include <hip/hip_runtime.h>
#include <cstdio>
#include <cstdint>
#include <hip/hip_bf16.h>
#include <cmath>
#ifndef ATTN_FAST
#define ATTN_FAST 1
#endif
#define MK_N_LAUNCHES 1
__device__ __forceinline__ int lane_id_fresh() { int l; asm volatile("v_mbcnt_lo_u32_b32 %0, -1, 0\n\tv_mbcnt_hi_u32_b32 %0, -1, %0" : "=v"(l)); return l; }
namespace pg8 {
#define PG8_LAS __attribute__((address_space(3)))
typedef unsigned short bf16_t;
typedef short bf16x8 __attribute__((ext_vector_type(8)));
typedef float f32x4 __attribute__((ext_vector_type(4)));
typedef float f32x2 __attribute__((ext_vector_type(2)));
typedef unsigned u32x4 __attribute__((ext_vector_type(4)));
constexpr int BM = 256, BK = 64, HALF = 128, HTB = HALF * BK * 2  , STAGE_BYTES = 8 * HTB, NXCD = 8, WGM = 8;

__host__ __device__ __forceinline__ int lds_byte(int r, int c) { const int st = (r >> 4) * 2 + (c >> 5), rr = r & 15, cc = c & 31, ob = rr * 64 + cc * 2; return st * 1024 + (ob ^ (((ob >> 9) & 1) << 5)); }
__host__ __device__ __forceinline__ void stage_rc(int b, int& R, int& C) { const int st = b / 1024, sb = b % 1024, swz = sb ^ (((sb >> 9) & 1) << 5); R = (st >> 1) * 16 + swz / 64; C = (st & 1) * 32 + (swz % 64) / 2; }
__host__ __device__ __forceinline__ int perm32(int rho) { const int n = rho >> 4, i = rho & 15; return 8 * (i >> 2) + 4 * n + (i & 3); }

struct Unit { int pm, pn, arow, brow; };
struct Gemm { const bf16_t* A; const bf16_t* Bt; int lda, ldb, K; };

struct StaticOrder {
    int nM, nN, nwg, G, c;
    __host__ __device__ void init(int nM_, int nN_, int G_, int c_) { nM = nM_; nN = nN_; nwg = nM * nN; G = G_; c = c_; }
    __host__ __device__ bool next(int i, Unit& u) const {
        const long L = (long)i * G + c; if (L >= nwg) return false;
        int wgid = (int)L; { const int q = nwg / NXCD, r = nwg % NXCD, xcd = wgid % NXCD, off = wgid / NXCD; wgid = (xcd < r ? xcd * (q + 1) : r * (q + 1) + (xcd - r) * q) + off; }
        const int nig = WGM * nN, gid = wgid / nig, fm = gid * WGM, gsz = (nM - fm) < WGM ? (nM - fm) : WGM;
        u.pm = fm + ((wgid % nig) % gsz); u.pn = (wgid % nig) / gsz; u.arow = u.pm * BM; u.brow = u.pn * BM; return true;
    }
};

__device__ __forceinline__ unsigned cvt_pk_bf16(float lo, float hi) { unsigned r; asm volatile("v_cvt_pk_bf16_f32 %0, %1, %2" : "=v"(r) : "v"(lo), "v"(hi)); return r; }

template <class Epi, class Sched, bool ALIGN_EPI = false, bool SP2 = false>
__device__ __forceinline__ void gemm_phase(PG8_LAS unsigned char* lds, const Gemm g, const Sched& S, const Epi& E, const int wave_id) {
    const int tid_ = lane_id_fresh() | (wave_id << 6);
    const int tid = tid_, wid = __builtin_amdgcn_readfirstlane(tid >> 6), lane = tid & 63, wr = wid >> 2, wc = wid & 3, fr = lane & 15, fq = lane >> 4;
    const char* gA = (const char*)g.A; const char* gB = (const char*)g.Bt; asm volatile("" : "+s"(gA), "+s"(gB));
    int K_ = g.K; asm volatile("" : "+s"(K_));
    const int nt = K_ / BK, lda = g.lda, ldb = g.ldb;
    unsigned voffA[2], voffB[2];
#pragma unroll
    for (int i = 0; i < 2; ++i) { int R, C; stage_rc(tid * 16 + i * 8192, R, C); const int Rb = Epi::PERM ? ((R & ~31) + perm32(R & 31)) : R;
        voffA[i] = (unsigned)(R * lda + C) * 2u; voffB[i] = (unsigned)(Rb * ldb + C) * 2u; }
    const size_t kstep = (size_t)(BK * 2);
    const size_t hstepA = (size_t)HALF * lda * 2, hstepB = (size_t)HALF * ldb * 2;
    const unsigned ldsw = (unsigned)wid * 1024u;
    const int aoff = lds_byte(wr * 64 + fr, fq * 8), boff = lds_byte(wc * 32 + fr, fq * 8);
#define PG8_SA(b, h) (((b) * 2 + (h)) * HTB)
#define PG8_SB(b, h) ((4 + (b) * 2 + (h)) * HTB)
#define PG8_STAGE(bufoff, gbase, voff) do { _Pragma("unroll") for (int _i = 0; _i < 2; ++_i) \
        __builtin_amdgcn_global_load_lds((const unsigned*)((const char*)(gbase) + (voff)[_i]), (PG8_LAS unsigned*)(lds + (bufoff) + ldsw + _i * 8192), 16, 0, 0); } while (0)
#define PG8_LDA(dst, b, h) do { _Pragma("unroll") for (int m = 0; m < 4; ++m) _Pragma("unroll") for (int k = 0; k < 2; ++k) dst[m][k] = *(const PG8_LAS bf16x8*)(lds + PG8_SA(b, h) + aoff + m * 2048 + k * 1024); } while (0)
#define PG8_LDB(dst, b, h) do { _Pragma("unroll") for (int n = 0; n < 2; ++n) _Pragma("unroll") for (int k = 0; k < 2; ++k) dst[n][k] = *(const PG8_LAS bf16x8*)(lds + PG8_SB(b, h) + boff + n * 2048 + k * 1024); } while (0)
#define PG8_MMA(ai, bj, At, Bt) do { __builtin_amdgcn_s_setprio(1); _Pragma("unroll") for (int m = 0; m < 4; ++m) _Pragma("unroll") for (int n = 0; n < 2; ++n) _Pragma("unroll") for (int k = 0; k < 2; ++k) \
        acc[ai][bj][m][n] = __builtin_amdgcn_mfma_f32_16x16x32_bf16(Bt[n][k], At[m][k], acc[ai][bj][m][n], 0, 0, 0); __builtin_amdgcn_s_setprio(0); } while (0)
#define PG8_WAIT_V(n) asm volatile("s_waitcnt vmcnt(" #n ")" ::: "memory")
#define PG8_WAIT_L(n) asm volatile("s_waitcnt lgkmcnt(" #n ")" ::: "memory")
#define PG8_BAR __builtin_amdgcn_s_barrier()
#define PG8_SCHED __builtin_amdgcn_sched_barrier(0)
    Unit cur, nxt; int ui = 0;
    if (!S.next(0, cur)) return;
    f32x4 acc[2][2][4][2];
#pragma unroll
    for (int a = 0; a < 2; ++a)
#pragma unroll
        for (int b = 0; b < 2; ++b)
#pragma unroll
            for (int m = 0; m < 4; ++m)
#pragma unroll
                for (int n = 0; n < 2; ++n) acc[a][b][m][n] = (f32x4){0.f, 0.f, 0.f, 0.f};
    bf16x8 At[4][2], B0[2][2], B1[2][2];
    const char* cA = gA + (size_t)cur.arow * lda * 2; const char* cB = gB + (size_t)cur.brow * ldb * 2;
    if constexpr (SP2) {
        PG8_STAGE(PG8_SB(0, 0), cB, voffB); PG8_STAGE(PG8_SB(0, 1), cB + hstepB, voffB); PG8_STAGE(PG8_SA(0, 0), cA, voffA); PG8_STAGE(PG8_SA(0, 1), cA + hstepA, voffA);
        if (wr == 1) PG8_BAR;
        PG8_WAIT_V(2); PG8_BAR;
        PG8_STAGE(PG8_SB(1, 0), cB + kstep, voffB); PG8_STAGE(PG8_SA(1, 0), cA + kstep, voffA); PG8_STAGE(PG8_SB(1, 1), cB + hstepB + kstep, voffB);
        PG8_WAIT_V(6); PG8_BAR;
    } else {
        PG8_STAGE(PG8_SB(0, 0), cB, voffB); PG8_STAGE(PG8_SA(0, 0), cA, voffA); PG8_STAGE(PG8_SB(0, 1), cB + hstepB, voffB); PG8_STAGE(PG8_SA(0, 1), cA + hstepA, voffA);
        if (wr == 1) PG8_BAR;
        PG8_WAIT_V(4); PG8_BAR;
        PG8_STAGE(PG8_SB(1, 0), cB + kstep, voffB); PG8_STAGE(PG8_SA(1, 0), cA + kstep, voffA); PG8_STAGE(PG8_SB(1, 1), cB + hstepB + kstep, voffB);
        PG8_WAIT_V(6); PG8_BAR;
    }
    for (;;) {
        const bool has_next = S.next(ui + 1, nxt);
        const char* nA = has_next ? gA + (size_t)nxt.arow * lda * 2 : cA; const char* nB = has_next ? gB + (size_t)nxt.brow * ldb * 2 : cB;
        for (int t = 0; t < nt; t += 2) {
            const bool last = (t == nt - 2);
            const char* a1 = cA + (size_t)(t + 1) * kstep;
            const char* a2 = last ? nA : cA + (size_t)(t + 2) * kstep; const char* b2 = last ? nB : cB + (size_t)(t + 2) * kstep;
            const char* a3 = a2 + kstep; const char* b3 = b2 + kstep;
            if constexpr (SP2) {
            PG8_LDB(B0, 0, 0); PG8_LDB(B1, 0, 1); PG8_SCHED; PG8_LDA(At, 0, 0); PG8_STAGE(PG8_SA(1, 1), a1 + hstepA, voffA);
            PG8_WAIT_V(8); PG8_WAIT_L(0); PG8_BAR; PG8_MMA(0, 0, At, B0); PG8_MMA(0, 1, At, B1); PG8_BAR; PG8_SCHED;
            PG8_LDA(At, 0, 1); PG8_STAGE(PG8_SB(0, 0), b2, voffB); PG8_STAGE(PG8_SB(0, 1), b2 + hstepB, voffB); PG8_STAGE(PG8_SA(0, 0), a2, voffA);
            PG8_WAIT_V(8); PG8_WAIT_L(0); PG8_BAR; PG8_MMA(1, 0, At, B0); PG8_MMA(1, 1, At, B1); PG8_BAR; PG8_SCHED;
            PG8_LDB(B0, 1, 0); PG8_LDB(B1, 1, 1); PG8_SCHED; PG8_LDA(At, 1, 0); PG8_STAGE(PG8_SA(0, 1), a2 + hstepA, voffA);
            PG8_WAIT_V(8); PG8_WAIT_L(0); PG8_BAR; PG8_MMA(0, 0, At, B0); PG8_MMA(0, 1, At, B1); PG8_BAR; PG8_SCHED;
            PG8_LDA(At, 1, 1); PG8_STAGE(PG8_SB(1, 0), b3, voffB); PG8_STAGE(PG8_SB(1, 1), b3 + hstepB, voffB); PG8_STAGE(PG8_SA(1, 0), a3, voffA);
            PG8_WAIT_V(8); PG8_WAIT_L(0); PG8_BAR; PG8_MMA(1, 0, At, B0); PG8_MMA(1, 1, At, B1); PG8_BAR; PG8_SCHED;
            } else {
            PG8_LDB(B0, 0, 0); PG8_SCHED; PG8_LDA(At, 0, 0); PG8_STAGE(PG8_SA(1, 1), a1 + hstepA, voffA);
            PG8_WAIT_L(8); PG8_BAR; PG8_WAIT_L(0); PG8_MMA(0, 0, At, B0); PG8_BAR; PG8_SCHED;
            PG8_LDB(B1, 0, 1); PG8_STAGE(PG8_SB(0, 0), b2, voffB);
            PG8_BAR; PG8_WAIT_L(0); PG8_MMA(0, 1, At, B1); PG8_BAR;
            PG8_LDA(At, 0, 1); PG8_STAGE(PG8_SA(0, 0), a2, voffA);
            PG8_BAR; PG8_WAIT_L(0); PG8_MMA(1, 0, At, B0); PG8_BAR; PG8_SCHED;
            PG8_STAGE(PG8_SB(0, 1), b2 + hstepB, voffB);
            PG8_WAIT_V(6); PG8_BAR; PG8_MMA(1, 1, At, B1); PG8_BAR;
            PG8_LDB(B0, 1, 0); PG8_SCHED; PG8_LDA(At, 1, 0); PG8_STAGE(PG8_SA(0, 1), a2 + hstepA, voffA);
            PG8_WAIT_L(8); PG8_BAR; PG8_WAIT_L(0); PG8_MMA(0, 0, At, B0); PG8_BAR; PG8_SCHED;
            PG8_LDB(B1, 1, 1); PG8_STAGE(PG8_SB(1, 0), b3, voffB);
            PG8_BAR; PG8_WAIT_L(0); PG8_MMA(0, 1, At, B1); PG8_BAR;
            PG8_LDA(At, 1, 1); PG8_STAGE(PG8_SA(1, 0), a3, voffA);
            PG8_BAR; PG8_WAIT_L(0); PG8_MMA(1, 0, At, B0); PG8_BAR; PG8_SCHED;
            PG8_STAGE(PG8_SB(1, 1), b3 + hstepB, voffB);
            PG8_WAIT_V(6); PG8_BAR; PG8_MMA(1, 1, At, B1); PG8_BAR;
            }
        }
        if constexpr (ALIGN_EPI) { if (wr == 0) PG8_BAR; }
        E(acc, cur, wr, wc, fr, fq);
        if (!has_next) break;
#pragma unroll
        for (int a = 0; a < 2; ++a)
#pragma unroll
            for (int b = 0; b < 2; ++b)
#pragma unroll
                for (int m = 0; m < 4; ++m)
#pragma unroll
                    for (int n = 0; n < 2; ++n) acc[a][b][m][n] = (f32x4){0.f, 0.f, 0.f, 0.f};
        cur = nxt; cA = nA; cB = nB; ++ui;
        if constexpr (ALIGN_EPI) { if (wr == 1) PG8_BAR; }
    }
    PG8_WAIT_V(0);
    if constexpr (!ALIGN_EPI) { if (wr == 0) PG8_BAR; }
    PG8_BAR;
#undef PG8_SA
#undef PG8_SB
#undef PG8_STAGE
#undef PG8_LDA
#undef PG8_LDB
#undef PG8_MMA
#undef PG8_WAIT_V
#undef PG8_WAIT_L
#undef PG8_BAR
#undef PG8_SCHED
}
}
constexpr int NWAVES = 8;
constexpr int BATCH = 16, SEQ = 4096, D = 1024, DEPTH = 4, M = BATCH * SEQ;
constexpr int NH = 8, HD = 64, ATT_W = 512, SSM_W = 256, SSM_G = 16, SSM_P = 64, SSM_H = 16, CONV_W = 256, CONV_K = 31;
constexpr int N_IN = 5384, N_INP = 5632, D_FF = 2816, NE = 8, D_FFE = 3584;
constexpr float EPS = 1e-6f;
constexpr float LOG2E = 1.4426950408889634f;
constexpr float QSCALE = 0.125f * LOG2E;
constexpr int MOE_ROWS_CAP = 133120;
constexpr int MOE_NCHUNK = 3, MOE_CHUNK_TILES_CAP = 174;

constexpr size_t MiB = 1u << 20;
constexpr size_t WS_CTL = 0, CTL_ZERO_BYTES = 1 * MiB;
constexpr size_t WS_BPERM = 1 * MiB;
constexpr size_t WS_TOKE = 2 * MiB;
constexpr size_t WS_TOKW = 3 * MiB;
constexpr size_t WS_CNTW = 4 * MiB;
constexpr size_t WS_META = 4 * MiB + 512 * 1024;
constexpr size_t WS_RDEST = 5 * MiB;
constexpr size_t WS_RW = 6 * MiB;
constexpr size_t WS_RRSTD = 7 * MiB;
constexpr size_t WS_WMIX = 16 * MiB, WMIX_STRIDE = 16 * MiB;
constexpr size_t WM_IN = 0, WM_GLU = 11 * MiB, WM_A = WM_GLU + 256 * 1024, WM_S = WM_A + 1 * MiB, WM_C = WM_S + 512 * 1024, WM_O = WM_C + 512 * 1024;
constexpr size_t WS_WDENSE = 80 * MiB, WDENSE_STRIDE = 16 * MiB + 512 * 1024;
constexpr size_t WD_GU = 0, WD_D = 11 * MiB;
constexpr size_t WS_WMOE = 113 * MiB;
constexpr size_t WMOE_GU = 0, WMOE_D = 112 * MiB;
constexpr size_t WS_XB = 281 * MiB;
constexpr size_t WS_SSQ = 409 * MiB;
constexpr size_t WS_LOGF = 413 * MiB;
constexpr size_t WS_FH = 415 * MiB;
constexpr size_t WS_BIG = 417 * MiB;
constexpr size_t WS_GATES = WS_BIG;
constexpr size_t WS_YG = WS_BIG + 384 * MiB;
constexpr size_t WS_SSMO = WS_YG + 32 * MiB;
constexpr size_t WS_CONVO = WS_SSMO + 32 * MiB;
constexpr size_t WS_HID = WS_BIG;
constexpr size_t WS_XG = WS_BIG;
constexpr size_t WS_MHID = WS_BIG + 260 * MiB;
constexpr size_t WS_END = WS_MHID + 305 * MiB;
static_assert(WS_CONVO + 32 * MiB <= WS_END && WS_HID + 352 * MiB <= WS_END, "ws map");
constexpr size_t DO_Q = 0, DO_K = 64 * MiB, DO_V = 128 * MiB, DO_U = 192 * MiB, DO_HC = 224 * MiB, DO_MERGED = 64 * MiB;

constexpr int CW_TMO = 0, CW_CODE = 1;
constexpr int CW_BAR = 4096;

constexpr int RING_OFF = 0, RING_BYTES = 131072;
constexpr int LDSCTL_OFF = RING_BYTES, MISC_OFF = LDSCTL_OFF + 320;
constexpr int LDS_BYTES = 147456;

#define GAS __attribute__((address_space(1)))
#define LAS __attribute__((address_space(3)))
typedef unsigned short bf16;
typedef unsigned v4u __attribute__((ext_vector_type(4)));
typedef unsigned v2u __attribute__((ext_vector_type(2)));
typedef float f32x4 __attribute__((ext_vector_type(4)));
typedef float f32x2 __attribute__((ext_vector_type(2)));
typedef GAS unsigned gu32;
#define RLX_AGENT __ATOMIC_RELAXED, __HIP_MEMORY_SCOPE_AGENT
#define LDS_WAIT() asm volatile("s_waitcnt lgkmcnt(0)" ::: "memory")
#define VM_WAIT() asm volatile("s_waitcnt vmcnt(0)" ::: "memory")
__device__ __forceinline__ unsigned f2bf(float f) { unsigned u = __builtin_bit_cast(unsigned, f); return (u + 0x7fffu + ((u >> 16) & 1u)) >> 16; }
__device__ __forceinline__ unsigned pk2(float lo, float hi) { return pg8::cvt_pk_bf16(lo, hi); }
__device__ __forceinline__ float bflo(unsigned u) { return __builtin_bit_cast(float, u << 16); }
__device__ __forceinline__ float bfhi(unsigned u) { return __builtin_bit_cast(float, u & 0xffff0000u); }
__device__ __forceinline__ float bf1(bf16 h) { return __builtin_bit_cast(float, (unsigned)h << 16); }
__device__ __forceinline__ float sigmoidf_(float x) { return 1.0f / (1.0f + __expf(-x)); }
__device__ __forceinline__ float wave_sum(float v) {
#pragma unroll
    for (int o = 1; o < 64; o <<= 1) v += __shfl_xor(v, o);
    return v;
}

#define XB_TMO      128
#define XB_XCNT(j)  (256  + 64 * (j))
#define XB_XSUB(j)  (1280 + 64 * (j))
#define XB_XGEN(j)  (2304 + 64 * (j))
#define XB_TOP      3328
#define XB_TOPGEN   3392
#define XCD_BAR_WORDS 3456
#define XB_SPIN_CAP (1u << 18)

__device__ __forceinline__ unsigned xb_ld(unsigned* p)              { return __hip_atomic_load(p, __ATOMIC_RELAXED, __HIP_MEMORY_SCOPE_AGENT); }
__device__ __forceinline__ unsigned xb_add(unsigned* p, unsigned v) { return __hip_atomic_fetch_add(p, v, __ATOMIC_RELAXED, __HIP_MEMORY_SCOPE_AGENT); }
__device__ __forceinline__ unsigned xb_xcc_id() { return (unsigned)__builtin_amdgcn_s_getreg((3 << 11) | 20) & 0xFu; }
#define XB_SPIN(cond, bar) do { unsigned _sp = 0; while (cond) { __builtin_amdgcn_s_sleep(1); \
    if ((++_sp & 255u) == 0u) { if (xb_ld(&(bar)[XB_TMO])) break; if (_sp > XB_SPIN_CAP) { atomicAdd(&(bar)[XB_TMO], 1u); break; } } } } while (0)

struct XcdBarrier {
    unsigned* bar; unsigned x;
    volatile LAS unsigned* st;
};
__device__ __forceinline__ bool xb_thread0(int wave_id) { return wave_id == 0 && lane_id_fresh() == 0; }
__device__ __forceinline__ XcdBarrier xcd_barrier_post(unsigned* bar, volatile LAS unsigned* st, int wave_id) {
    XcdBarrier b; b.bar = bar; b.x = xb_xcc_id(); b.st = st;
    if (xb_thread0(wave_id)) (void)xb_add(&bar[XB_XCNT(b.x)], 1u);
    return b;
}
__device__ __forceinline__ void xcd_barrier_complete(unsigned* bar, unsigned x, unsigned& nloc, unsigned& nx) {
    const unsigned G = gridDim.x * gridDim.y * gridDim.z;
    unsigned sum, cnt, mine, sp = 0u;
    for (;;) {
        sum = 0u; cnt = 0u; mine = 0u;
#pragma unroll
        for (unsigned j = 0; j < 16; ++j) { const unsigned c = xb_ld(&bar[XB_XCNT(j)]); sum += c; cnt += (c > 0u) ? 1u : 0u; mine = (j == x) ? c : mine; }
        if (sum == G) break;
        __builtin_amdgcn_s_sleep(1);
        if ((++sp & 255u) == 0u) { if (xb_ld(&bar[XB_TMO])) break; if (sp > XB_SPIN_CAP) { atomicAdd(&bar[XB_TMO], 1u); break; } }
    }
    nloc = mine > 0u ? mine : 1u; nx = cnt > 0u ? cnt : 1u;
}
__device__ __forceinline__ void xcd_barrier(const XcdBarrier& b, int wave_id) {
    asm volatile("s_waitcnt vmcnt(0)" ::: "memory");
    __syncthreads();
    if (xb_thread0(wave_id)) {
        unsigned* bar = b.bar;
        __builtin_amdgcn_s_waitcnt(0);
        unsigned nloc = b.st[0], nx = b.st[1];
        if (nloc == 0u) { xcd_barrier_complete(bar, b.x, nloc, nx); b.st[0] = nloc; b.st[1] = nx; }
        const unsigned old = xb_add(&bar[XB_XSUB(b.x)], 1u);
        const unsigned gen = old / nloc;
        if (old + 1u == (gen + 1u) * nloc) {
            __builtin_amdgcn_fence(__ATOMIC_RELEASE, "agent");
            asm volatile("s_waitcnt vmcnt(0)" ::: "memory");
            const unsigned og = xb_add(&bar[XB_TOP], 1u);
            const unsigned tg = og / nx;
            if (og + 1u == (tg + 1u) * nx) xb_add(&bar[XB_TOPGEN], 1u);
            else XB_SPIN(xb_ld(&bar[XB_TOPGEN]) == tg, bar);
            __builtin_amdgcn_fence(__ATOMIC_ACQUIRE, "agent");
            xb_add(&bar[XB_XGEN(b.x)], 1u);
            asm volatile("s_waitcnt vmcnt(0)" ::: "memory");
        } else {
            XB_SPIN(xb_ld(&bar[XB_XGEN(b.x)]) == gen, bar);
            __builtin_amdgcn_fence(__ATOMIC_ACQUIRE, "agent");
            asm volatile("s_waitcnt vmcnt(0)" ::: "memory");
        }
    }
    __syncthreads();
}


namespace attn_body {
using bf16=__hip_bfloat16;
using bf16x8=__attribute__((ext_vector_type(8)))short;
using s16x4=__attribute__((ext_vector_type(4)))short;
using f32x16=__attribute__((ext_vector_type(16)))float;
using u32x4=__attribute__((ext_vector_type(4)))unsigned;
using f32x4_t=__attribute__((ext_vector_type(4)))float;
constexpr int BATCH=16,NHEAD=8,SEQ=4096,D=64,DM=NHEAD*D;
constexpr int NW=8,QBLK=32,QB=QBLK*NW,KVBLK=64,NQB=SEQ/QB;
constexpr int ATTN_PITCH=DM, ATTN_UNIT_ROWS=QB;
__device__ __forceinline__ int crow(int r,int hi){return (r&3)+8*(r>>2)+4*hi;}
#define SBAR() __builtin_amdgcn_sched_barrier(0)
__device__ __forceinline__ void cmask(f32x16&p0,f32x16&p1,int jb,int qrel,int hi){
  const float NEG=-INFINITY; int kb=64*jb+4*hi;
  #pragma unroll
  for(int r=0;r<16;++r){int kv=kb+(r&3)+8*(r>>2); if(kv>qrel)p0[r]=NEG; if(kv+32>qrel)p1[r]=NEG;}
}

constexpr int NSLOT=3, SLOTB=8192;
constexpr int LDS_K=0, LDS_V=NSLOT*SLOTB, LDS_WS=2*NSLOT*SLOTB, LDS_OST=LDS_WS+NW*64*4, LDS_KB=LDS_OST+NW*4096, LDS_BYTES=LDS_KB+SEQ*4;
constexpr float C2=0.125f*1.4426950408889634f;
__device__ __forceinline__ void glds16(const void*gsrc,unsigned lds_dst){unsigned keep;
  asm volatile("s_mov_b32 %0, m0\n\ts_mov_b32 m0, %2\n\ts_nop 0\n\tglobal_load_lds_dwordx4 %1, off\n\ts_mov_b32 m0, %0":"=&s"(keep):"v"(gsrc),"s"(lds_dst):"memory");}
__device__ __forceinline__ float max3f(float a,float b,float c){float r;asm("v_max3_f32 %0, %1, %2, %3":"=v"(r):"v"(a),"v"(b),"v"(c));return r;}
__device__ __forceinline__ float max2f(float a,float b){float r;asm("v_max_f32_e32 %0, %1, %2":"=v"(r):"v"(a),"v"(b));return r;}
__device__ __forceinline__ float fadd_s(float a,float b){float r;asm("v_add_f32_e32 %0, %1, %2":"=v"(r):"v"(a),"v"(b));return r;}
__device__ __forceinline__ float fsub_s(float a,float b){float r;asm("v_sub_f32_e32 %0, %1, %2":"=v"(r):"v"(a),"v"(b));return r;}
typedef float f32x2_t __attribute__((ext_vector_type(2))); typedef __bf16 bf16x2_t __attribute__((ext_vector_type(2)));
__device__ __forceinline__ unsigned cvtpk_s(float lo,float hi){f32x2_t v={lo,hi};bf16x2_t b=__builtin_convertvector(v,bf16x2_t);return __builtin_bit_cast(unsigned,b);}
#define WAIT_BAR(N) asm volatile("s_waitcnt vmcnt(" #N ") lgkmcnt(0)\n\ts_barrier":::"memory")

__device__ __forceinline__ void qkt(f32x16&p0,f32x16&p1,const char*Kslot,const bf16x8*qr,const f32x16&negm,int r32,int hi){
  const char*kb=Kslot+hi*1024+r32*16;
  #pragma unroll
  for(int d0=0;d0<4;++d0){
    const bf16x8 b0=*reinterpret_cast<const bf16x8*>(kb+d0*2048);
    const bf16x8 b1=*reinterpret_cast<const bf16x8*>(kb+d0*2048+512);
    if(d0==0){p0=__builtin_amdgcn_mfma_f32_32x32x16_bf16(b0,qr[0],negm,0,0,0);p1=__builtin_amdgcn_mfma_f32_32x32x16_bf16(b1,qr[0],negm,0,0,0);}
    else{p0=__builtin_amdgcn_mfma_f32_32x32x16_bf16(b0,qr[d0],p0,0,0,0);p1=__builtin_amdgcn_mfma_f32_32x32x16_bf16(b1,qr[d0],p1,0,0,0);}}
}
typedef __attribute__((address_space(3))) const char* lds_cptr;
typedef short v4i16_t __attribute__((ext_vector_type(4)));
__device__ __forceinline__ void kload8(bf16x8*kf,lds_cptr kp){
  kf[0]=*(const __attribute__((address_space(3))) bf16x8*)(kp);      kf[1]=*(const __attribute__((address_space(3))) bf16x8*)(kp+512);
  kf[2]=*(const __attribute__((address_space(3))) bf16x8*)(kp+2048); kf[3]=*(const __attribute__((address_space(3))) bf16x8*)(kp+2560);
  kf[4]=*(const __attribute__((address_space(3))) bf16x8*)(kp+4096); kf[5]=*(const __attribute__((address_space(3))) bf16x8*)(kp+4608);
  kf[6]=*(const __attribute__((address_space(3))) bf16x8*)(kp+6144); kf[7]=*(const __attribute__((address_space(3))) bf16x8*)(kp+6656);
}
__device__ __forceinline__ void kload2(bf16x8*kf,lds_cptr kp,int j){ kf[2*j]=*(const __attribute__((address_space(3))) bf16x8*)(kp+j*2048); kf[2*j+1]=*(const __attribute__((address_space(3))) bf16x8*)(kp+j*2048+512); }
__device__ __forceinline__ s16x4 vtr(lds_cptr p){ return __builtin_bit_cast(s16x4,__builtin_amdgcn_ds_read_tr16_b64_v4i16((__attribute__((address_space(3))) v4i16_t*)p)); }
__device__ __forceinline__ float rowmax(const f32x16&p0,const f32x16&p1){
  float a=max3f(p0[0],p0[1],p1[0]),b=max3f(p0[2],p0[3],p1[1]);a=max3f(a,p1[2],p1[3]);
  #pragma unroll
  for(int r=4;r<16;r+=4){a=max3f(a,p0[r],p0[r+1]);b=max3f(b,p0[r+2],p0[r+3]);a=max3f(a,p1[r],p1[r+1]);b=max3f(b,p1[r+2],p1[r+3]);}
  const float m=max2f(a,b);
  auto rr=__builtin_amdgcn_permlane32_swap(__float_as_uint(m),__float_as_uint(m),false,false);
  return max2f(__uint_as_float(rr[0]),__uint_as_float(rr[1]));
}
__device__ __forceinline__ void pv(f32x16*o,int vb,bf16x8 pa0,bf16x8 pa1,bf16x8 pa2,bf16x8 pa3){
  #pragma unroll
  for(int d0=0;d0<2;++d0){s16x4 lo[4],hi[4];
    #pragma unroll
    for(int ks=0;ks<4;++ks){
      asm volatile("ds_read_b64_tr_b16 %0,%1 offset:%c2":"=&v"(lo[ks]):"v"(vb),"i"(d0*4096+ks*1024):"memory");
      asm volatile("ds_read_b64_tr_b16 %0,%1 offset:%c2":"=&v"(hi[ks]):"v"(vb),"i"(d0*4096+ks*1024+512):"memory");}
    asm volatile("s_waitcnt lgkmcnt(0)":::"memory");SBAR();
    #define PK(k) (bf16x8){lo[k][0],lo[k][1],lo[k][2],lo[k][3],hi[k][0],hi[k][1],hi[k][2],hi[k][3]}
    o[d0]=__builtin_amdgcn_mfma_f32_32x32x16_bf16(pa0,PK(0),o[d0],0,0,0);
    o[d0]=__builtin_amdgcn_mfma_f32_32x32x16_bf16(pa1,PK(1),o[d0],0,0,0);
    o[d0]=__builtin_amdgcn_mfma_f32_32x32x16_bf16(pa2,PK(2),o[d0],0,0,0);
    o[d0]=__builtin_amdgcn_mfma_f32_32x32x16_bf16(pa3,PK(3),o[d0],0,0,0);
    #undef PK
  }
}

#ifndef ATTN_STORE16
#define ATTN_STORE16(p,v) (*(u32x4*)(p)=(v))
#endif
template<int THRL> __device__ __forceinline__ void attn_unit(int b,int h,int qb,const bf16*Q,const bf16*__restrict__ K,const bf16*__restrict__ V,bf16*O,const float*Fh,char*shm,const int wave_id){
  const int tid_=lane_id_fresh()|(wave_id<<6);
  const int tid=tid_,lane=tid&63,r32=lane&31,hi=lane>>5; const int wid=__builtin_amdgcn_readfirstlane(tid>>6);
  const long rowbase=(long)b*SEQ; const int q0=qb*QB;
  const bf16*Qw=Q+(rowbase+q0+wid*QBLK)*DM+h*D;
  const bf16*Kh=K+rowbase*DM+h*D,*Vh=V+rowbase*DM+h*D;
  const lds_cptr shm3=(lds_cptr)shm;
  const unsigned lds0=(unsigned)(uintptr_t)shm;
  float*wsf=(float*)(shm+LDS_WS)+wid*64;
  const bf16*ksrc=Kh+(long)lane*DM+wid*8;
  const bf16*vsrc=Vh+(long)(16*(wid&3)+(lane>>2))*DM+(wid>>2)*32+(lane&3)*8;
  const unsigned kdst=lds0+LDS_K+wid*1024, vdst=lds0+LDS_V+wid*1024;
  #define DMA_K(t,slot) glds16(ksrc+(long)(t)*KVBLK*DM,(unsigned)__builtin_amdgcn_readfirstlane(kdst+(slot)))
  #define DMA_V(t,slot) glds16(vsrc+(long)(t)*KVBLK*DM,(unsigned)__builtin_amdgcn_readfirstlane(vdst+(slot)))
  const int vb0=(int)(lds0+LDS_V)+((lane>>4)&1)*32+(lane&3)*8+(4*hi+((lane&15)>>2))*64;
  const char*Kbase=shm+LDS_K; bf16x8 kf[8];
  const lds_cptr kp0=shm3+LDS_K+hi*1024+r32*16; const lds_cptr vp0=shm3+LDS_V+((lane>>4)&1)*32+(lane&3)*8+(4*hi+((lane&15)>>2))*64;
  const int NT=(q0+QB)/KVBLK;
  DMA_K(0,0);DMA_V(0,0);DMA_K(1,SLOTB);
  bf16x8 qr[4];
  #pragma unroll
  for(int d0=0;d0<4;++d0)qr[d0]=*reinterpret_cast<const bf16x8*>(&Qw[(long)r32*DM+d0*16+hi*8]);
  { const float fref=Fh[q0]; __attribute__((address_space(3))) float* kbt=(__attribute__((address_space(3))) float*)(shm3+LDS_KB);
    for(int k=tid;k<q0+QB;k+=NW*64) kbt[k]=(fref-Fh[k])*1.4426950408889634f; }
  const __attribute__((address_space(3))) float* kbp=(const __attribute__((address_space(3))) float*)(shm3+LDS_KB)+4*hi;
  #define BIAS(P0,P1,t) do{ const __attribute__((address_space(3))) float* kp_=kbp+(t)*KVBLK; \
    _Pragma("unroll") for(int j_=0;j_<4;++j_){ const f32x4_t b0_=*(const __attribute__((address_space(3))) f32x4_t*)(kp_+8*j_); const f32x4_t b1_=*(const __attribute__((address_space(3))) f32x4_t*)(kp_+32+8*j_); \
      P0[4*j_]+=b0_[0];P0[4*j_+1]+=b0_[1];P0[4*j_+2]+=b0_[2];P0[4*j_+3]+=b0_[3]; P1[4*j_]+=b1_[0];P1[4*j_+1]+=b1_[1];P1[4*j_+2]+=b1_[2];P1[4*j_+3]+=b1_[3]; } }while(0)
  float mhat=0.f,l_reg=0.f;f32x16 o[2];o[0]=f32x16{};o[1]=f32x16{};f32x16 negm=f32x16{};asm volatile("":"+v"(negm));
  const int qrel=wid*QBLK+r32;
  #define CMASK(P0,P1,t) do{int jb_=(t)-(NT-4); if(jb_>=0)cmask(P0,P1,jb_,qrel,hi);}while(0)
  bool resc=false;
  #define START(P0,P1) do{ const float rm=rowmax(P0,P1); resc=false; \
    { const float dl=rm; mhat=fadd_s(mhat,dl); \
      _Pragma("unroll") for(int r=0;r<16;++r){P0[r]=fsub_s(P0[r],dl);P1[r]=fsub_s(P1[r],dl);} \
      _Pragma("unroll") for(int r=0;r<16;++r)negm[r]=-mhat; asm volatile("":"+v"(negm)); } \
    _Pragma("unroll") for(int r=0;r<16;++r)P0[r]=__builtin_amdgcn_exp2f(P0[r]); }while(0)
  #define RESC() do{ if(resc){ asm volatile("s_waitcnt lgkmcnt(0)":::"memory"); \
      _Pragma("unroll") for(int d_=0;d_<2;++d_) _Pragma("unroll") for(int r=0;r<16;++r)o[d_][r]*=wsf[crow(r,hi)]; } }while(0)
  f32x16 pA0,pA1,pB0,pB1;
  int sl_prev=0,sl_cur=0,sl_next=SLOTB;
  #define ROT() do{sl_prev=sl_cur;sl_cur=sl_next;sl_next=(sl_next==(NSLOT-1)*SLOTB)?0:sl_next+SLOTB;}while(0)
  DMA_K(2,2*SLOTB);
  WAIT_BAR(3);
  qkt(pA0,pA1,Kbase,qr,negm,r32,hi);asm volatile("s_nop 15\n\ts_nop 7":"+v"(pA0),"+v"(pA1));BIAS(pA0,pA1,0);CMASK(pA0,pA1,0);
  START(pA0,pA1);
  _Pragma("unroll") for(int r=0;r<16;++r)pA1[r]=__builtin_amdgcn_exp2f(pA1[r]);
  WAIT_BAR(0);
  DMA_K(3,0);DMA_V(1,SLOTB);
  ROT();
  kload8(kf,kp0+sl_cur);
  WAIT_BAR(2);
  s16x4 vlo[8],vhi[8]; u32x4 pw0,pw1,pw2,pw3;
  #define PKW(P,B) cvtpk_s(P[B],P[B+1])
  #define PAF(k) __builtin_bit_cast(bf16x8,pw##k)
  #define VFR(i) (bf16x8){vlo[i][0],vlo[i][1],vlo[i][2],vlo[i][3],vhi[i][0],vhi[i][1],vhi[i][2],vhi[i][3]}
  #define PIN(x) asm volatile("":"+v"(x))
  #define MX3(a,b,c) __builtin_fmaxf(__builtin_fmaxf((a),(b)),(c))
  #define GAPA(MF,A0,A1,A2,A3,W0,W1,PW) do{ MF; sacc+=A0; sacc+=A1; sacc+=A2; sacc+=A3; PIN(sacc); W0; W1; PIN(PW); SBAR(); }while(0)
  #define EX(v) __builtin_amdgcn_exp2f(v)
  #define GAPB(MF,X,B) do{ MF; X[B]=EX(X[B]); X[B+1]=EX(X[B+1]); X[B+2]=EX(X[B+2]); X[B+3]=EX(X[B+3]); PIN(X); SBAR(); }while(0)
  #define VRD(i) do{ vlo[i]=vtr(vp_+(((i)>>2)*4096+((i)&3)*1024)); vhi[i]=vtr(vp_+(((i)>>2)*4096+((i)&3)*1024+512)); }while(0)
  #define KRD(G,j) do{ if(G){ kload2(kf,kp0+sl_next,j); SBAR(); } }while(0)
  #define STEP(C0,C1,P0,P1,t,GK,GV,GL) do{ SBAR(); \
    const lds_cptr vp_=vp0+sl_prev; \
    VRD(0); SBAR(); float sacc=(P0[0]+P0[1]); \
    GAPA(C0=__builtin_amdgcn_mfma_f32_32x32x16_bf16(kf[0],qr[0],negm,0,0,0), P0[2],P0[3],P0[4],P0[5],     pw0[0]=PKW(P0,0), pw0[1]=PKW(P0,2), pw0); \
    VRD(4); SBAR(); GAPA(C1=__builtin_amdgcn_mfma_f32_32x32x16_bf16(kf[1],qr[0],negm,0,0,0), P0[6],P0[7],P0[8],P0[9],     pw0[2]=PKW(P0,4), pw0[3]=PKW(P0,6), pw0); \
    VRD(1); SBAR(); GAPA(C0=__builtin_amdgcn_mfma_f32_32x32x16_bf16(kf[2],qr[1],C0,0,0,0),   P0[10],P0[11],P0[12],P0[13], pw1[0]=PKW(P0,8), pw1[1]=PKW(P0,10), pw1); \
    VRD(5); SBAR(); GAPA(C1=__builtin_amdgcn_mfma_f32_32x32x16_bf16(kf[3],qr[1],C1,0,0,0),   P0[14],P0[15],P1[0],P1[1],   pw1[2]=PKW(P0,12),pw1[3]=PKW(P0,14), pw1); \
    VRD(2); SBAR(); GAPA(C0=__builtin_amdgcn_mfma_f32_32x32x16_bf16(kf[4],qr[2],C0,0,0,0),   P1[2],P1[3],P1[4],P1[5],     pw2[0]=PKW(P1,0), pw2[1]=PKW(P1,2), pw2); \
    VRD(6); SBAR(); GAPA(C1=__builtin_amdgcn_mfma_f32_32x32x16_bf16(kf[5],qr[2],C1,0,0,0),   P1[6],P1[7],P1[8],P1[9],     pw2[2]=PKW(P1,4), pw2[3]=PKW(P1,6), pw2); \
    VRD(3); SBAR(); GAPA(C0=__builtin_amdgcn_mfma_f32_32x32x16_bf16(kf[6],qr[3],C0,0,0,0),   P1[10],P1[11],P1[12],P1[13], pw3[0]=PKW(P1,8), pw3[1]=PKW(P1,10), pw3); \
    VRD(7); SBAR(); GAPA(C1=__builtin_amdgcn_mfma_f32_32x32x16_bf16(kf[7],qr[3],C1,0,0,0),   P1[14],P1[15],0.f,0.f,       pw3[2]=PKW(P1,12),pw3[3]=PKW(P1,14), pw3); \
    l_reg+=sacc; \
    if(GK){DMA_K((t)+3,sl_cur);} if(GV){DMA_V((t)+1,sl_next);} \
    BIAS(C0,C1,t); CMASK(C0,C1,t); \
    { float a=MX3(C0[0],C0[1],C1[0]),b=MX3(C0[2],C0[3],C1[1]); a=MX3(a,C1[2],C1[3]); \
      _Pragma("unroll") for(int r=4;r<16;r+=4){a=MX3(a,C0[r],C0[r+1]);b=MX3(b,C0[r+2],C0[r+3]);a=MX3(a,C1[r],C1[r+1]);b=MX3(b,C1[r+2],C1[r+3]);} \
      float rm=__builtin_fmaxf(a,b); { auto rr=__builtin_amdgcn_permlane32_swap(__float_as_uint(rm),__float_as_uint(rm),false,false); rm=__builtin_fmaxf(__uint_as_float(rr[0]),__uint_as_float(rr[1])); } \
      resc=false; \
      if(__builtin_expect(__any(rm>(float)THRL),0)){ const float dl=__builtin_fmaxf(rm,0.f); mhat+=dl; \
        _Pragma("unroll") for(int r=0;r<16;++r){C0[r]-=dl;C1[r]-=dl;} \
        _Pragma("unroll") for(int r=0;r<16;++r)negm[r]=-mhat; asm volatile("":"+v"(negm)); \
        const float f=__builtin_amdgcn_exp2f(-dl); l_reg*=f; if(hi==0)wsf[r32]=f; resc=true; } } \
    SBAR(); \
    GAPB(o[0]=__builtin_amdgcn_mfma_f32_32x32x16_bf16(PAF(0),VFR(0),o[0],0,0,0), C0,0); \
    GAPB(o[1]=__builtin_amdgcn_mfma_f32_32x32x16_bf16(PAF(0),VFR(4),o[1],0,0,0), C0,4); \
    KRD(GL,0); GAPB(o[0]=__builtin_amdgcn_mfma_f32_32x32x16_bf16(PAF(1),VFR(1),o[0],0,0,0), C0,8); \
    KRD(GL,1); GAPB(o[1]=__builtin_amdgcn_mfma_f32_32x32x16_bf16(PAF(1),VFR(5),o[1],0,0,0), C0,12); \
    KRD(GL,2); GAPB(o[0]=__builtin_amdgcn_mfma_f32_32x32x16_bf16(PAF(2),VFR(2),o[0],0,0,0), C1,0); \
    KRD(GL,3); GAPB(o[1]=__builtin_amdgcn_mfma_f32_32x32x16_bf16(PAF(2),VFR(6),o[1],0,0,0), C1,4); \
    GAPB(o[0]=__builtin_amdgcn_mfma_f32_32x32x16_bf16(PAF(3),VFR(3),o[0],0,0,0), C1,8); \
    GAPB(o[1]=__builtin_amdgcn_mfma_f32_32x32x16_bf16(PAF(3),VFR(7),o[1],0,0,0), C1,12); \
    }while(0)
  int t=1;
  #undef CMASK
  #define CMASK(P0,P1,t) do{}while(0)
  for(;t+5<NT;t+=2){
    STEP(pB0,pB1,pA0,pA1,t,true,true,true);     WAIT_BAR(2); RESC(); ROT();
    STEP(pA0,pA1,pB0,pB1,t+1,true,true,true);   WAIT_BAR(2); RESC(); ROT();
  }
  #undef CMASK
  #define CMASK(P0,P1,t) do{int jb_=(t)-(NT-4); if(jb_>=0)cmask(P0,P1,jb_,qrel,hi);}while(0)
  #define ENDW(tt) do{ if((tt)+3<NT){WAIT_BAR(2);} else if((tt)+2<NT){WAIT_BAR(1);} else {WAIT_BAR(0);} }while(0)
  for(;t+1<NT;t+=2){
    STEP(pB0,pB1,pA0,pA1,t,(t+3<NT),(t+1<NT),(t+1<NT));       ENDW(t);   RESC(); ROT();
    STEP(pA0,pA1,pB0,pB1,t+1,(t+4<NT),(t+2<NT),(t+2<NT));     ENDW(t+1); RESC(); ROT();
  }
  STEP(pB0,pB1,pA0,pA1,NT-1,false,false,false); RESC();
  { float sacc=pB0[0]+pB0[1]; _Pragma("unroll") for(int r=2;r<16;++r)sacc+=pB0[r]; _Pragma("unroll") for(int r=0;r<16;++r)sacc+=pB1[r]; l_reg+=sacc;
    pw0=(u32x4){PKW(pB0,0),PKW(pB0,2),PKW(pB0,4),PKW(pB0,6)};pw1=(u32x4){PKW(pB0,8),PKW(pB0,10),PKW(pB0,12),PKW(pB0,14)};pw2=(u32x4){PKW(pB1,0),PKW(pB1,2),PKW(pB1,4),PKW(pB1,6)};pw3=(u32x4){PKW(pB1,8),PKW(pB1,10),PKW(pB1,12),PKW(pB1,14)};
    SBAR(); pv(o,vb0+sl_cur,PAF(0),PAF(1),PAF(2),PAF(3)); }
  #undef PKW
  #undef PAF
  #undef VFR
  #undef PIN
  #undef MX3
  #undef GAPA
  #undef GAPB
  #undef EX
  #undef VRD
  #undef KRD
  #undef STEP
  #undef ENDW
  {auto rr=__builtin_amdgcn_permlane32_swap(__float_as_uint(l_reg),__float_as_uint(l_reg),false,false);l_reg=__uint_as_float(rr[0])+__uint_as_float(rr[1]);}
  if(hi==0)wsf[32+r32]=l_reg;asm volatile("s_waitcnt lgkmcnt(0)":::"memory");
  float rli[16];
  #pragma unroll
  for(int r=0;r<16;++r)rli[r]=__builtin_amdgcn_rcpf(wsf[32+crow(r,hi)]);
  bf16*Ow=O+(rowbase+q0+wid*QBLK)*DM+h*D;
  { bf16*stg=(bf16*)(shm+LDS_OST)+wid*2048;
    #pragma unroll
    for(int r=0;r<16;++r){const int orow=crow(r,hi);
      #pragma unroll
      for(int d0=0;d0<2;++d0)stg[orow*64+d0*32+r32]=__float2bfloat16(o[d0][r]*rli[r]);}
    asm volatile("s_waitcnt lgkmcnt(0)":::"memory");
    #pragma unroll
    for(int i=0;i<4;++i){const int row=i*8+(lane>>3),ch=lane&7; const u32x4 v=*(const u32x4*)(stg+row*64+ch*8); ATTN_STORE16(Ow+(long)row*DM+ch*8,v);} }
  asm volatile("s_waitcnt lgkmcnt(0)\n\ts_barrier":::"memory");
  #undef BIAS
  #undef DMA_K
  #undef DMA_V
  #undef CMASK
  #undef START
  #undef RESC
  #undef ROT
}
constexpr int ATTN_LDS_BYTES=LDS_BYTES;
struct AttnTensors { const bf16* Q; const bf16* K; const bf16* V; bf16* O; const float* Fh; };
struct AttnUnit { int bh; int qb; };
struct StaticOrder {
  int vcu,G;
  __device__ __forceinline__ explicit StaticOrder(int grid,int block):vcu((grid%8==0)?(block%8)*(grid/8)+block/8:block),G(grid){}
  __device__ __forceinline__ bool next(int i,AttnUnit&u)const{ const int L=(i>>3)*G+vcu; if(L>=BATCH*NHEAD*2)return false; const int ii=i&7,s=4*(L&1)+(ii>>1); u.bh=L>>1; u.qb=(ii&1)?15-s:s; return true; }
  __device__ __forceinline__ void a_ready(const AttnUnit&)const{}
  __device__ __forceinline__ void done(const AttnUnit&)const{}
};
template<class Sched,int THRL=8> __device__ __forceinline__ void attn_phase(char*lds,const AttnTensors&T,const Sched&S,const int wave_id){
  AttnUnit u;
  for(int i=0;S.next(i,u);++i){ S.a_ready(u); attn_unit<THRL>(u.bh/NHEAD,u.bh%NHEAD,u.qb,T.Q,T.K,T.V,T.O,T.Fh+(size_t)u.bh*SEQ,lds,wave_id); S.done(u); }
}
#undef SBAR
#undef WAIT_BAR
}
typedef pg8::f32x4 A4;
typedef A4 AccT[2][2][4][2];

__device__ __forceinline__ float row_rstd(const float* ssq, int row) {
    const f32x4* p = (const f32x4*)(ssq + (size_t)row * 16);
    const f32x4 a = p[0], b = p[1], c = p[2], d = p[3];
    const float s = (((a.x + a.y) + (a.z + a.w)) + ((b.x + b.y) + (b.z + b.w))) + (((c.x + c.y) + (c.z + c.w)) + ((d.x + d.y) + (d.z + d.w)));
    return rsqrtf(s * (1.0f / 1024.0f) + EPS);
}
__device__ __forceinline__ v4u pack8(const A4& v0, const A4& v1) { v4u w; w.x = pk2(v0[0], v0[1]); w.y = pk2(v0[2], v0[3]); w.z = pk2(v1[0], v1[1]); w.w = pk2(v1[2], v1[3]); return w; }
__device__ __forceinline__ void unpack8(const v4u w, A4& v0, A4& v1) { v0 = (A4){bflo(w.x), bfhi(w.x), bflo(w.y), bfhi(w.y)}; v1 = (A4){bflo(w.z), bfhi(w.z), bflo(w.w), bfhi(w.w)}; }
__device__ __forceinline__ A4 sig4(const A4& z) { return (A4){sigmoidf_(z[0]), sigmoidf_(z[1]), sigmoidf_(z[2]), sigmoidf_(z[3])}; }
__device__ __forceinline__ float logsig(float z) { return fminf(z, 0.f) - __logf(1.0f + __expf(-fabsf(z))); }

struct EpiInProj {
    static constexpr bool PERM = true;
    unsigned char* outb; unsigned char* wsb; int layer;
    __device__ __forceinline__ void operator()(const AccT& acc, const pg8::Unit& u, int wr, int wc, int fr, int fq) const {
        const int pn = u.pn, row0 = u.pm * 256 + wr * 64 + fr, cw = wc * 32 + 8 * fq;
        bf16* const Q = (bf16*)(outb + DO_Q); bf16* const K = (bf16*)(outb + DO_K); bf16* const V = (bf16*)(outb + DO_V); bf16* const U = (bf16*)(outb + DO_U); bf16* const HC = (bf16*)(outb + DO_HC);
        bf16* const G = (bf16*)(wsb + WS_GATES); float* const logf = (float*)(wsb + WS_LOGF); const float* const bias = (const float*)(wsb + WS_BPERM) + layer * N_INP; const float* const ssq = (const float*)(wsb + WS_SSQ);
        float rs[2][4];
#pragma unroll
        for (int ai = 0; ai < 2; ++ai)
#pragma unroll
            for (int m = 0; m < 4; ++m) rs[ai][m] = row_rstd(ssq, row0 + ai * 128 + m * 16);
        A4 bv[2][2];
#pragma unroll
        for (int bj = 0; bj < 2; ++bj)
#pragma unroll
            for (int n = 0; n < 2; ++n) bv[bj][n] = *(const A4*)(bias + pn * 256 + bj * 128 + cw + 4 * n);
        if (pn == 7 || pn == 8) {
#pragma unroll
            for (int ai = 0; ai < 2; ++ai)
#pragma unroll
                for (int m = 0; m < 4; ++m) { const int row = row0 + ai * 128 + m * 16; const float r = rs[ai][m];
                    const A4 a0 = acc[ai][0][m][0] * r + bv[0][0], a1 = acc[ai][0][m][1] * r + bv[0][1], g0 = acc[ai][1][m][0] * r + bv[1][0], g1 = acc[ai][1][m][1] * r + bv[1][1];
                    *(v4u*)(HC + (size_t)row * 256 + (pn - 7) * 128 + cw) = pack8(a0 * sig4(g0), a1 * sig4(g1)); asm volatile("" ::: "memory"); }
        } else if (pn == 21) {
            if (wc == 0 && fq == 0) {
#pragma unroll
                for (int ai = 0; ai < 2; ++ai)
#pragma unroll
                    for (int m = 0; m < 4; ++m) { const int row = row0 + ai * 128 + m * 16; const float r = rs[ai][m];
                        const A4 z0 = acc[ai][0][m][0] * r + bv[0][0], z1 = acc[ai][0][m][1] * r + bv[0][1];
                        *(A4*)(logf + (size_t)row * 8) = (A4){logsig(z0[0]), logsig(z0[1]), logsig(z0[2]), logsig(z0[3])};
                        *(A4*)(logf + (size_t)row * 8 + 4) = (A4){logsig(z1[0]), logsig(z1[1]), logsig(z1[2]), logsig(z1[3])}; }
            }
        } else {
            bf16* base; int ld, col0; float sc = 1.f; bool sg = false;
            if (pn < 6) { base = pn < 2 ? Q : (pn < 4 ? K : V); ld = 512; col0 = (pn & 1) * 256; sc = pn < 2 ? QSCALE : 1.f; }
            else if (pn == 6) { base = U; ld = 256; col0 = 0; }
            else { base = G; ld = 3072; col0 = (pn - 9) * 256; sg = true; }
#pragma unroll
            for (int ai = 0; ai < 2; ++ai)
#pragma unroll
                for (int m = 0; m < 4; ++m) { const int row = row0 + ai * 128 + m * 16; const float r = rs[ai][m]; bf16* rowp = base + (size_t)row * ld + col0 + cw;
#pragma unroll
                    for (int bj = 0; bj < 2; ++bj) { A4 v0 = acc[ai][bj][m][0] * r + bv[bj][0], v1 = acc[ai][bj][m][1] * r + bv[bj][1];
                        if (sg) { v0 = sig4(v0); v1 = sig4(v1); }
                        v0 = v0 * sc; v1 = v1 * sc; *(v4u*)(rowp + bj * 128) = pack8(v0, v1); } asm volatile("" ::: "memory"); }
        }
    }
};

template <bool MOE> struct EpiSwiGlu {
    static constexpr bool PERM = true;
    bf16* Hd; int ldh; const float* rsrc;
    __device__ __forceinline__ void operator()(const AccT& acc, const pg8::Unit& u, int wr, int wc, int fr, int fq) const {
        const int row0 = u.pm * 256 + wr * 64 + fr, cw = wc * 32 + 8 * fq;
        float rs[2][4];
#pragma unroll
        for (int ai = 0; ai < 2; ++ai)
#pragma unroll
            for (int m = 0; m < 4; ++m) { const int row = row0 + ai * 128 + m * 16; rs[ai][m] = MOE ? rsrc[row] : row_rstd(rsrc, row); }
#pragma unroll
        for (int ai = 0; ai < 2; ++ai)
#pragma unroll
            for (int m = 0; m < 4; ++m) { const int row = row0 + ai * 128 + m * 16; const float r = rs[ai][m];
                A4 o[2];
#pragma unroll
                for (int n = 0; n < 2; ++n) { const A4 g = acc[ai][0][m][n] * r, up = acc[ai][1][m][n] * r; o[n] = g * sig4(g) * up; }
                *(v4u*)(Hd + (size_t)row * ldh + u.pn * 128 + cw) = pack8(o[0], o[1]); asm volatile("" ::: "memory"); }
    }
};
struct EpiGluSsm {
    static constexpr bool PERM = true;
    bf16* O;
    __device__ __forceinline__ void operator()(const AccT& acc, const pg8::Unit& u, int wr, int wc, int fr, int fq) const {
        const int row0 = u.pm * 256 + wr * 64 + fr, cw = wc * 32 + 8 * fq;
#pragma unroll
        for (int ai = 0; ai < 2; ++ai)
#pragma unroll
            for (int m = 0; m < 4; ++m) { const int row = row0 + ai * 128 + m * 16;
                *(v4u*)(O + (size_t)row * 256 + u.pn * 128 + cw) = pack8(acc[ai][0][m][0] * sig4(acc[ai][1][m][0]), acc[ai][0][m][1] * sig4(acc[ai][1][m][1])); }
    }
};
template <int I> struct EpiMerge {
    static constexpr bool PERM = true;
    const bf16* G; bf16* Mg;
    __device__ __forceinline__ void operator()(const AccT& acc, const pg8::Unit& u, int wr, int wc, int fr, int fq) const {
        const int row0 = u.pm * 256 + wr * 64 + fr, col0 = u.pn * 256 + wc * 32 + 8 * fq;
        v4u gl[3][2], ol[3][2];
#define MG_LOAD(buf, grp) do { const int row_ = row0 + ((grp) >> 2) * 128 + ((grp) & 3) * 16; _Pragma("unroll") for (int bj = 0; bj < 2; ++bj) { \
            gl[buf][bj] = *(const v4u*)(G + (size_t)row_ * 3072 + I * 1024 + col0 + bj * 128); if (I > 0) ol[buf][bj] = *(const v4u*)(Mg + (size_t)row_ * 1024 + col0 + bj * 128); } } while (0)
        MG_LOAD(0, 0); MG_LOAD(1, 1);
#pragma unroll
        for (int grp = 0; grp < 8; ++grp) {
            if (grp + 2 < 8) MG_LOAD((grp + 2) % 3, grp + 2);
            asm volatile("" ::: "memory");
            const int ai = grp >> 2, m = grp & 3, row = row0 + ai * 128 + m * 16;
#pragma unroll
            for (int bj = 0; bj < 2; ++bj) { A4 g0, g1; unpack8(gl[grp % 3][bj], g0, g1);
                A4 v0 = g0 * acc[ai][bj][m][0], v1 = g1 * acc[ai][bj][m][1];
                if (I > 0) { A4 o0, o1; unpack8(ol[grp % 3][bj], o0, o1); v0 = v0 + o0; v1 = v1 + o1; }
                *(v4u*)(Mg + (size_t)row * 1024 + col0 + bj * 128) = pack8(v0, v1); }
        }
#undef MG_LOAD
    }
};
struct EpiResid {
    static constexpr bool PERM = true;
    bf16* X; float* ssq;
    __device__ __forceinline__ void operator()(const AccT& acc, const pg8::Unit& u, int wr, int wc, int fr, int fq) const {
        const int row0 = u.pm * 256 + wr * 64 + fr, col0 = u.pn * 256 + wc * 32 + 8 * fq;
        v4u ol[3][2];
#define RS_LOAD(buf, grp) do { const int row_ = row0 + ((grp) >> 2) * 128 + ((grp) & 3) * 16; _Pragma("unroll") for (int bj = 0; bj < 2; ++bj) ol[buf][bj] = *(const v4u*)(X + (size_t)row_ * 1024 + col0 + bj * 128); } while (0)
        RS_LOAD(0, 0); RS_LOAD(1, 1);
#pragma unroll
        for (int grp = 0; grp < 8; ++grp) {
            if (grp + 2 < 8) RS_LOAD((grp + 2) % 3, grp + 2);
            asm volatile("" ::: "memory");
            const int ai = grp >> 2, m = grp & 3, row = row0 + ai * 128 + m * 16; float ss = 0.f;
#pragma unroll
            for (int bj = 0; bj < 2; ++bj) { A4 o0, o1; unpack8(ol[grp % 3][bj], o0, o1); o0 = o0 + acc[ai][bj][m][0]; o1 = o1 + acc[ai][bj][m][1];
                const v4u w = pack8(o0, o1); *(v4u*)(X + (size_t)row * 1024 + col0 + bj * 128) = w; unpack8(w, o0, o1);
                ss += (o0[0] * o0[0] + o0[1] * o0[1]) + (o0[2] * o0[2] + o0[3] * o0[3]) + (o1[0] * o1[0] + o1[1] * o1[1]) + (o1[2] * o1[2] + o1[3] * o1[3]); }
            ss += __shfl_xor(ss, 16); ss += __shfl_xor(ss, 32);
            if (fq == 0) ssq[(size_t)row * 16 + u.pn * 4 + wc] = ss;
        }
#undef RS_LOAD
    }
};
struct EpiMoeDown {
    static constexpr bool PERM = true;
    bf16* Y; const int* rdest; const float* rw;
    __device__ __forceinline__ void operator()(const AccT& acc, const pg8::Unit& u, int wr, int wc, int fr, int fq) const {
        const int row0 = u.pm * 256 + wr * 64 + fr, cw = wc * 32 + 8 * fq;
        int ds[2][4]; float wsv[2][4];
#pragma unroll
        for (int ai = 0; ai < 2; ++ai)
#pragma unroll
            for (int m = 0; m < 4; ++m) { const int row = row0 + ai * 128 + m * 16; ds[ai][m] = rdest[row]; wsv[ai][m] = rw[row]; }
#pragma unroll
        for (int ai = 0; ai < 2; ++ai)
#pragma unroll
            for (int m = 0; m < 4; ++m) { const int dest = ds[ai][m]; const float w = wsv[ai][m];
                if (dest >= 0) {
#pragma unroll
                    for (int bj = 0; bj < 2; ++bj) *(v4u*)(Y + (size_t)dest * 1024 + u.pn * 256 + bj * 128 + cw) = pack8(acc[ai][bj][m][0] * w, acc[ai][bj][m][1] * w); }
                asm volatile("" ::: "memory"); }
    }
};
struct MoeOrder {
    pg8::StaticOrder so; int tile0, a_tile_off, b_rows; int s1, s2, s3, s4, s5, s6, s7;
    __device__ __forceinline__ bool next(int i, pg8::Unit& u) const {
        if (!so.next(i, u)) return false;
        const int gt = tile0 + u.pm;
        const int e = (gt >= s1) + (gt >= s2) + (gt >= s3) + (gt >= s4) + (gt >= s5) + (gt >= s6) + (gt >= s7);
        u.arow = (a_tile_off + u.pm) * 256; u.brow = e * b_rows + u.pn * 256; return true;
    }
};
struct Args { const float* in[31]; unsigned char* out; unsigned char* ws; int ph_lo, ph_hi, use_bar, pad; };
struct Frame {
    LAS unsigned char* lds;
    volatile LAS unsigned* MISC;
    gu32* ctl;
    int tid, lane, wave, G, gw, NGW;
};

__device__ __forceinline__ int inproj_dest(int n) {
    if (n < 1536) return n;
    if (n < 1544) return 5376 + (n - 1536);
    if (n < 1800) return 1536 + (n - 1544);
    if (n < 2056) { const int c = n - 1800; return 1792 + (c >> 7) * 256 + (c & 127); }
    if (n < 2312) { const int c = n - 2056; return 1792 + (c >> 7) * 256 + 128 + (c & 127); }
    return 2304 + (n - 2312);
}
__device__ __forceinline__ int inproj_src(int d) {
    if (d < 1536) return d;
    if (d < 1792) return 1544 + (d - 1536);
    if (d < 2304) { const int t = (d - 1792) >> 8, r = (d - 1792) & 255; return r < 128 ? 1800 + t * 128 + r : 2056 + t * 128 + (r - 128); }
    if (d < 5376) return 2312 + (d - 2304);
    return (d - 5376) < 8 ? 1536 + (d - 5376) : -1;
}
__device__ __forceinline__ int map_row(int kind, int off, int n) {
    if (kind == 0) return n + off;
    if (kind == 1) return (n >> 7) * 256 + (n & 127) + off;
    if (kind == 2) { const int j = n & 255; return (j >> 7) * 256 + (j & 127) + ((n >> 8) ? 128 : 0); }
    return inproj_dest(n);
}
__device__ __forceinline__ void cvt_item(const float* W, int K, int N, const float* gk, bf16* WT, int kind, int off, LAS float* scr, int item, int lane) {
    const int nblk = (N + 31) >> 5, kb = item / nblk, nb = item - kb * nblk, k0 = 64 * kb, n0 = 32 * nb;
    const int n = n0 + (lane & 31);
#pragma unroll 8
    for (int i = 0; i < 32; ++i) { const int kk = 2 * i + (lane >> 5); float v = 0.f;
        if (n < N) { v = W[(size_t)(k0 + kk) * N + n]; if (gk) v *= gk[k0 + kk]; }
        scr[kk * 33 + (lane & 31)] = v; }
    LDS_WAIT(); asm volatile("" ::: "memory");
    const int c = lane & 7;
#pragma unroll
    for (int j = 0; j < 4; ++j) { const int nl = (lane >> 3) + 8 * j; const int nn = n0 + nl; const LAS float* s = scr + (8 * c) * 33 + nl;
        if (nn < N) { v4u o; o.x = pk2(s[0 * 33], s[1 * 33]); o.y = pk2(s[2 * 33], s[3 * 33]); o.z = pk2(s[4 * 33], s[5 * 33]); o.w = pk2(s[6 * 33], s[7 * 33]);
            *(v4u*)(WT + (size_t)map_row(kind, off, nn) * K + k0 + 8 * c) = o; } }
    LDS_WAIT(); asm volatile("" ::: "memory");
}
__device__ __forceinline__ void cvt_job(const float* W, int K, int N, const float* gk, bf16* WT, int kind, int off, LAS float* scr, int lane, int& base, int gwl, int ngw) {
    const int items = (K >> 6) * ((N + 31) >> 5);
    const int first = (gwl - (base % ngw) + ngw) % ngw;
    for (int it = first; it < items; it += ngw) cvt_item(W, K, N, gk, WT, kind, off, scr, it, lane);
    base += items;
}
__device__ __forceinline__ void cvt_moe_layer(const Args& a, int i, int l, LAS float* scr, int lane, int gwl, int ngw) {
    bf16* wgu = (bf16*)(a.ws + WS_WMOE + WMOE_GU); bf16* wd = (bf16*)(a.ws + WS_WMOE + WMOE_D); int base = 0;
    for (int e = 0; e < NE; ++e) {
        const size_t wo = (size_t)(i * NE + e) * D * D_FFE;
        cvt_job(a.in[27] + wo, D, D_FFE, a.in[21] + l * D, wgu + (size_t)e * 7168 * D, 1, 0, scr, lane, base, gwl, ngw);
        cvt_job(a.in[28] + wo, D, D_FFE, a.in[21] + l * D, wgu + (size_t)e * 7168 * D, 1, 128, scr, lane, base, gwl, ngw);
        cvt_job(a.in[29] + wo, D_FFE, D, nullptr, wd + (size_t)e * D * D_FFE, 0, 0, scr, lane, base, gwl, ngw);
    }
}

__device__ __forceinline__ void p0_prologue(Frame& F, const Args& a) {
    LAS float* scr = (LAS float*)(F.lds + RING_OFF + F.wave * 16384);
    int base = 0;
    for (int l = 0; l < DEPTH; ++l) {
        unsigned char* wm = a.ws + WS_WMIX + (size_t)l * WMIX_STRIDE;
        cvt_job(a.in[2] + (size_t)l * D * N_IN, D, N_IN, a.in[1] + l * D, (bf16*)(wm + WM_IN), 3, 0, scr, F.lane, base, F.gw, F.NGW);
        cvt_job(a.in[12] + (size_t)l * 256 * 512, 256, 512, nullptr, (bf16*)(wm + WM_GLU), 2, 0, scr, F.lane, base, F.gw, F.NGW);
        cvt_job(a.in[17] + (size_t)l * 512 * D, 512, D, nullptr, (bf16*)(wm + WM_A), 0, 0, scr, F.lane, base, F.gw, F.NGW);
        cvt_job(a.in[18] + (size_t)l * 256 * D, 256, D, nullptr, (bf16*)(wm + WM_S), 0, 0, scr, F.lane, base, F.gw, F.NGW);
        cvt_job(a.in[19] + (size_t)l * 256 * D, 256, D, nullptr, (bf16*)(wm + WM_C), 0, 0, scr, F.lane, base, F.gw, F.NGW);
        cvt_job(a.in[20] + (size_t)l * D * D, D, D, nullptr, (bf16*)(wm + WM_O), 0, 0, scr, F.lane, base, F.gw, F.NGW);
    }
    for (int i = 0; i < 2; ++i) {
        unsigned char* wd = a.ws + WS_WDENSE + (size_t)i * WDENSE_STRIDE;
        cvt_job(a.in[22] + (size_t)i * D * D_FF, D, D_FF, a.in[21] + (2 * i) * D, (bf16*)(wd + WD_GU), 1, 0, scr, F.lane, base, F.gw, F.NGW);
        cvt_job(a.in[23] + (size_t)i * D * D_FF, D, D_FF, a.in[21] + (2 * i) * D, (bf16*)(wd + WD_GU), 1, 128, scr, F.lane, base, F.gw, F.NGW);
        cvt_job(a.in[24] + (size_t)i * D_FF * D, D_FF, D, nullptr, (bf16*)(wd + WD_D), 0, 0, scr, F.lane, base, F.gw, F.NGW);
    }
    float* bperm = (float*)(a.ws + WS_BPERM);
    for (int idx = F.gw * 64 + F.lane; idx < DEPTH * N_INP; idx += F.NGW * 64) { const int l = idx / N_INP, d = idx - l * N_INP, n = inproj_src(d); bperm[idx] = n >= 0 ? a.in[3][l * N_IN + n] : 0.f; }
    bf16* xb = (bf16*)(a.ws + WS_XB); float* ssq = (float*)(a.ws + WS_SSQ);
    for (int m = F.gw; m < M; m += F.NGW) {
        const f32x4* xr = (const f32x4*)(a.in[0] + (size_t)m * D) + F.lane; float ss = 0.f;
#pragma unroll
        for (int j = 0; j < 4; ++j) { const f32x4 v = xr[64 * j]; v2u w; w.x = pk2(v.x, v.y); w.y = pk2(v.z, v.w);
            *(v2u*)(xb + (size_t)m * D + 256 * j + 4 * F.lane) = w;
            const float a0 = bflo(w.x), a1 = bfhi(w.x), a2 = bflo(w.y), a3 = bfhi(w.y); ss += (a0 * a0 + a1 * a1) + (a2 * a2 + a3 * a3); }
        const float tot = wave_sum(ss);
        if (F.lane < 16) ssq[(size_t)m * 16 + F.lane] = F.lane == 0 ? tot : 0.f;
    }
}

__device__ __forceinline__ void t1_cumsum(const Args& a, int bh, int lane) {
    const float* logf = (const float*)(a.ws + WS_LOGF); float* Fh = (float*)(a.ws + WS_FH);
    const int b = bh >> 3, h = bh & 7; const float* p = logf + ((size_t)b * SEQ + 64 * lane) * 8 + h;
    float s = 0.f;
    for (int j = 0; j < 64; ++j) s += p[j * 8];
    float v = s;
#pragma unroll
    for (int o = 1; o < 64; o <<= 1) { const float t = __shfl_up(v, o); if (lane >= o) v += t; }
    float run = v - s; float* o = Fh + (size_t)bh * SEQ + 64 * lane;
    for (int j = 0; j < 64; ++j) { run += p[j * 8]; o[j] = run; }
}
__device__ __forceinline__ void t1_conv(const Args& a, int l, int blk, int lane) {
    const bf16* HC = (const bf16*)(a.out + DO_HC); bf16* CO = (bf16*)(a.ws + WS_CONVO);
    const float* cw = a.in[13] + (size_t)l * CONV_K * CONV_W + 4 * lane;
    const f32x4 cb = *(const f32x4*)(a.in[14] + l * CONV_W + 4 * lane), lg = *(const f32x4*)(a.in[15] + l * CONV_W + 4 * lane), lb = *(const f32x4*)(a.in[16] + l * CONV_W + 4 * lane);
    for (int i = 0; i < 32; ++i) {
        const int m = blk * 32 + i, tl = m & (SEQ - 1);
        f32x4 y = cb;
        for (int k = 0; k < CONV_K; ++k) { const int tt = tl - (CONV_K - 1) + k;
            if (tt >= 0) { const v2u hv = *(const v2u*)(HC + (size_t)(m - (CONV_K - 1) + k) * CONV_W + 4 * lane); const f32x4 w = *(const f32x4*)(cw + k * CONV_W);
                y.x += w.x * bflo(hv.x); y.y += w.y * bfhi(hv.x); y.z += w.z * bflo(hv.y); y.w += w.w * bfhi(hv.y); } }
        const float mu = wave_sum((y.x + y.y) + (y.z + y.w)) * (1.f / 256.f);
        const f32x4 dl = y - mu;
        const float var = wave_sum((dl.x * dl.x + dl.y * dl.y) + (dl.z * dl.z + dl.w * dl.w)) * (1.f / 256.f);
        const float rs = rsqrtf(var + EPS);
        f32x4 z = dl * rs * lg + lb;
        z.x *= sigmoidf_(z.x); z.y *= sigmoidf_(z.y); z.z *= sigmoidf_(z.z); z.w *= sigmoidf_(z.w);
        v2u o; o.x = pk2(z.x, z.y); o.y = pk2(z.z, z.w);
        *(v2u*)(CO + (size_t)m * CONV_W + 4 * lane) = o;
    }
}
__device__ __forceinline__ float gelu_tanh(float y) {
    const float z = 0.7978845608028654f * (y + 0.044715f * y * y * y);
    const float th = 1.0f - 2.0f / (__expf(2.0f * z) + 1.0f);
    return 0.5f * y * (1.0f + th);
}
__device__ __forceinline__ void t1_ssm_scan(const Args& a, int l, int b, int g, int lane) {
    const bf16* U = (const bf16*)(a.out + DO_U); bf16* YG = (bf16*)(a.ws + WS_YG);
    const int lg = l * SSM_G + g, p = lane;
    const float lam_re = a.in[4][lg * SSM_P + p], lam_im = a.in[5][lg * SSM_P + p], dt = expf(a.in[6][lg]);
    const float mag = expf(lam_re * dt); float sn, cs; sincosf(lam_im * dt, &sn, &cs);
    const float ar = mag * cs, ai = mag * sn;
    const float nr = ar - 1.0f, ni = ai, den = lam_re * lam_re + lam_im * lam_im;
    const float cr = (nr * lam_re + ni * lam_im) / den, ci = (ni * lam_re - nr * lam_im) / den;
    float br[16], bi[16], cre[16], cim[16], dq[16];
#pragma unroll
    for (int h = 0; h < 16; ++h) {
        const float bre = a.in[7][((size_t)lg * SSM_P + p) * SSM_H + h], bim = a.in[8][((size_t)lg * SSM_P + p) * SSM_H + h];
        br[h] = cr * bre - ci * bim; bi[h] = cr * bim + ci * bre;
        cre[h] = a.in[9][((size_t)lg * SSM_H + h) * SSM_P + p]; cim[h] = a.in[10][((size_t)lg * SSM_H + h) * SSM_P + p];
        dq[h] = lane == 0 ? a.in[11][lg * SSM_H + h] : 0.f;
    }
    float xr = 0.f, xi = 0.f;
    const bf16* up = U + (size_t)b * SEQ * SSM_W + 16 * g;
    bf16* yp = YG + (size_t)b * SEQ * SSM_W + 16 * g + (lane >> 2);
    const bool b5 = (lane & 32) != 0, b4 = (lane & 16) != 0, b3 = (lane & 8) != 0, b2 = (lane & 4) != 0;
    v4u c0 = *(const v4u*)(up + (size_t)lane * SSM_W), c1 = *(const v4u*)(up + (size_t)lane * SSM_W + 8);
    for (int blk = 0; blk < SEQ / 64; ++blk) {
        v4u n0 = c0, n1 = c1;
        if (blk + 1 < SEQ / 64) { n0 = *(const v4u*)(up + (size_t)((blk + 1) * 64 + lane) * SSM_W); n1 = *(const v4u*)(up + (size_t)((blk + 1) * 64 + lane) * SSM_W + 8); }
#pragma unroll 2
        for (int j = 0; j < 64; ++j) {
            unsigned w[8];
            w[0] = __builtin_amdgcn_readlane(c0.x, j); w[1] = __builtin_amdgcn_readlane(c0.y, j); w[2] = __builtin_amdgcn_readlane(c0.z, j); w[3] = __builtin_amdgcn_readlane(c0.w, j);
            w[4] = __builtin_amdgcn_readlane(c1.x, j); w[5] = __builtin_amdgcn_readlane(c1.y, j); w[6] = __builtin_amdgcn_readlane(c1.z, j); w[7] = __builtin_amdgcn_readlane(c1.w, j);
            float u[16];
#pragma unroll
            for (int k = 0; k < 8; ++k) { u[2 * k] = bflo(w[k]); u[2 * k + 1] = bfhi(w[k]); }
            float bur = 0.f, bui = 0.f;
#pragma unroll
            for (int h = 0; h < 16; ++h) { bur += br[h] * u[h]; bui += bi[h] * u[h]; }
            const float nxr = ar * xr - ai * xi + bur, nxi = ar * xi + ai * xr + bui; xr = nxr; xi = nxi;
            float v[16];
#pragma unroll
            for (int h = 0; h < 16; ++h) v[h] = cre[h] * xr - cim[h] * xi + dq[h] * u[h];
            float w8[8], w4[4], w2[2];
#pragma unroll
            for (int i = 0; i < 8; ++i) { const float keep = b5 ? v[i + 8] : v[i], send = b5 ? v[i] : v[i + 8]; w8[i] = keep + __shfl_xor(send, 32); }
#pragma unroll
            for (int i = 0; i < 4; ++i) { const float keep = b4 ? w8[i + 4] : w8[i], send = b4 ? w8[i] : w8[i + 4]; w4[i] = keep + __shfl_xor(send, 16); }
#pragma unroll
            for (int i = 0; i < 2; ++i) { const float keep = b3 ? w4[i + 2] : w4[i], send = b3 ? w4[i] : w4[i + 2]; w2[i] = keep + __shfl_xor(send, 8); }
            float w1; { const float keep = b2 ? w2[1] : w2[0], send = b2 ? w2[0] : w2[1]; w1 = keep + __shfl_xor(send, 4); }
            w1 += __shfl_xor(w1, 2); w1 += __shfl_xor(w1, 1);
            if ((lane & 3) == 0) yp[(size_t)(blk * 64 + j) * SSM_W] = (bf16)f2bf(gelu_tanh(w1));
        }
        c0 = n0; c1 = n1;
    }
}

__device__ __forceinline__ void attn_naive_unit(const Args& a, int bh, int qb, int lane) {
    bf16* Q = (bf16*)(a.out + DO_Q); const bf16* Kb = (const bf16*)(a.out + DO_K); const bf16* Vb = (const bf16*)(a.out + DO_V);
    const float* Fh = (const float*)(a.ws + WS_FH) + (size_t)bh * SEQ;
    const int b = bh >> 3, h = bh & 7, i = qb * 32 + (lane >> 1), hf = lane & 1;
    bf16* qp = Q + ((size_t)b * SEQ + i) * ATT_W + h * HD + 32 * hf;
    float q[32], o[32];
#pragma unroll
    for (int c = 0; c < 4; ++c) { const v4u w = *(const v4u*)(qp + 8 * c); q[8 * c] = bflo(w.x); q[8 * c + 1] = bfhi(w.x); q[8 * c + 2] = bflo(w.y); q[8 * c + 3] = bfhi(w.y); q[8 * c + 4] = bflo(w.z); q[8 * c + 5] = bfhi(w.z); q[8 * c + 6] = bflo(w.w); q[8 * c + 7] = bfhi(w.w); }
#pragma unroll
    for (int d = 0; d < 32; ++d) o[d] = 0.f;
    const float Fi = Fh[i] * LOG2E; float mx = -INFINITY, lsum = 0.f;
    const int nk = qb * 32 + 32;
    const bf16* kp = Kb + (size_t)b * SEQ * ATT_W + h * HD + 32 * hf; const bf16* vp = Vb + (size_t)b * SEQ * ATT_W + h * HD + 32 * hf;
    for (int j = 0; j < nk; ++j) {
        float s = 0.f;
#pragma unroll
        for (int c = 0; c < 4; ++c) { const v4u w = *(const v4u*)(kp + (size_t)j * ATT_W + 8 * c);
            s += q[8 * c] * bflo(w.x) + q[8 * c + 1] * bfhi(w.x) + q[8 * c + 2] * bflo(w.y) + q[8 * c + 3] * bfhi(w.y) + q[8 * c + 4] * bflo(w.z) + q[8 * c + 5] * bfhi(w.z) + q[8 * c + 6] * bflo(w.w) + q[8 * c + 7] * bfhi(w.w); }
        s += __shfl_xor(s, 1);
        s += Fi - Fh[j] * LOG2E;
        if (j > i) s = -INFINITY;
        const float mn = fmaxf(mx, s), corr = __builtin_amdgcn_exp2f(mx - mn), pr = __builtin_amdgcn_exp2f(s - mn);
        mx = mn; lsum = lsum * corr + pr;
#pragma unroll
        for (int c = 0; c < 4; ++c) { const v4u w = *(const v4u*)(vp + (size_t)j * ATT_W + 8 * c);
            o[8 * c] = o[8 * c] * corr + pr * bflo(w.x); o[8 * c + 1] = o[8 * c + 1] * corr + pr * bfhi(w.x); o[8 * c + 2] = o[8 * c + 2] * corr + pr * bflo(w.y); o[8 * c + 3] = o[8 * c + 3] * corr + pr * bfhi(w.y);
            o[8 * c + 4] = o[8 * c + 4] * corr + pr * bflo(w.z); o[8 * c + 5] = o[8 * c + 5] * corr + pr * bfhi(w.z); o[8 * c + 6] = o[8 * c + 6] * corr + pr * bflo(w.w); o[8 * c + 7] = o[8 * c + 7] * corr + pr * bfhi(w.w); }
    }
    const float il = 1.0f / lsum;
#pragma unroll
    for (int c = 0; c < 4; ++c) { v4u w; w.x = pk2(o[8 * c] * il, o[8 * c + 1] * il); w.y = pk2(o[8 * c + 2] * il, o[8 * c + 3] * il); w.z = pk2(o[8 * c + 4] * il, o[8 * c + 5] * il); w.w = pk2(o[8 * c + 6] * il, o[8 * c + 7] * il); *(v4u*)(qp + 8 * c) = w; }
}
__device__ __forceinline__ void attn_naive(Frame& F, const Args& a) {
    for (int wt = F.gw; wt < BATCH * NH * 16; wt += F.NGW) {
        const int bh = wt >> 4, r = wt & 15;
        for (int ui = 0; ui < 8; ++ui) { const int pr_ = ui >> 1, qb = (ui & 1) ? (127 - 16 * pr_ - r) : (16 * pr_ + r); attn_naive_unit(a, bh, qb, F.lane); }
    }
}

__device__ __forceinline__ void moe_route(Frame& F, const Args& a, int l, int i) {
    const bf16* xb = (const bf16*)(a.ws + WS_XB); const float* ssq = (const float*)(a.ws + WS_SSQ);
    int* toke = (int*)(a.ws + WS_TOKE); float* tokw = (float*)(a.ws + WS_TOKW); int* cntw = (int*)(a.ws + WS_CNTW);
    const int lane = F.lane, k0 = 16 * lane;
    float wr[16][8];
#pragma unroll
    for (int j = 0; j < 16; ++j) { const float gk = a.in[21][l * D + k0 + j];
        const f32x4 w0 = *(const f32x4*)(a.in[25] + ((size_t)i * D + k0 + j) * NE), w1 = *(const f32x4*)(a.in[25] + ((size_t)i * D + k0 + j) * NE + 4);
        wr[j][0] = gk * w0.x; wr[j][1] = gk * w0.y; wr[j][2] = gk * w0.z; wr[j][3] = gk * w0.w; wr[j][4] = gk * w1.x; wr[j][5] = gk * w1.y; wr[j][6] = gk * w1.z; wr[j][7] = gk * w1.w; }
    float rb[8];
#pragma unroll
    for (int e = 0; e < 8; ++e) rb[e] = a.in[26][i * NE + e];
    const bool b5 = (lane & 32) != 0, b4 = (lane & 16) != 0, b3 = (lane & 8) != 0;
    for (int run = F.gw; run < M / 32; run += F.NGW) {
        int cnt[8];
#pragma unroll
        for (int e = 0; e < 8; ++e) cnt[e] = 0;
        for (int ti = 0; ti < 32; ++ti) {
            const int t = run * 32 + ti;
            const v4u x0 = *(const v4u*)(xb + (size_t)t * D + k0), x1 = *(const v4u*)(xb + (size_t)t * D + k0 + 8);
            float xv[16] = {bflo(x0.x), bfhi(x0.x), bflo(x0.y), bfhi(x0.y), bflo(x0.z), bfhi(x0.z), bflo(x0.w), bfhi(x0.w), bflo(x1.x), bfhi(x1.x), bflo(x1.y), bfhi(x1.y), bflo(x1.z), bfhi(x1.z), bflo(x1.w), bfhi(x1.w)};
            float v[8];
#pragma unroll
            for (int e = 0; e < 8; ++e) { float s = 0.f;
#pragma unroll
                for (int j = 0; j < 16; ++j) s += xv[j] * wr[j][e];
                v[e] = s; }
            float w4[4], w2[2];
#pragma unroll
            for (int q = 0; q < 4; ++q) { const float keep = b5 ? v[q + 4] : v[q], send = b5 ? v[q] : v[q + 4]; w4[q] = keep + __shfl_xor(send, 32); }
#pragma unroll
            for (int q = 0; q < 2; ++q) { const float keep = b4 ? w4[q + 2] : w4[q], send = b4 ? w4[q] : w4[q + 2]; w2[q] = keep + __shfl_xor(send, 16); }
            float w1; { const float keep = b3 ? w2[1] : w2[0], send = b3 ? w2[0] : w2[1]; w1 = keep + __shfl_xor(send, 8); }
            w1 += __shfl_xor(w1, 4); w1 += __shfl_xor(w1, 2); w1 += __shfl_xor(w1, 1);
            const float rstd = row_rstd(ssq, t);
            float lg[8];
#pragma unroll
            for (int e = 0; e < 8; ++e) lg[e] = __builtin_bit_cast(float, __builtin_amdgcn_readlane(__builtin_bit_cast(int, w1), 8 * e)) * rstd + rb[e];
            int e0 = 0; float l0 = lg[0];
#pragma unroll
            for (int e = 1; e < 8; ++e) if (lg[e] > l0) { l0 = lg[e]; e0 = e; }
            int e1 = -1; float l1 = -INFINITY;
#pragma unroll
            for (int e = 0; e < 8; ++e) if (e != e0 && lg[e] > l1) { l1 = lg[e]; e1 = e; }
            const float p0 = 1.0f / (1.0f + __expf(l1 - l0)), p1 = 1.0f - p0;
            if (lane == 0) { toke[t] = e0 | (e1 << 8); tokw[2 * t] = p0; tokw[2 * t + 1] = p1; }
#pragma unroll
            for (int e = 0; e < 8; ++e) cnt[e] += (e0 == e) + (e1 == e);
        }
        int cv = 0;
#pragma unroll
        for (int e = 0; e < 8; ++e) if (lane == e) cv = cnt[e];
        if (lane < 8) cntw[run * 8 + lane] = cv;
    }
}
__device__ __forceinline__ int wave_sum_i(int v) {
#pragma unroll
    for (int o = 1; o < 64; o <<= 1) v += __shfl_xor(v, o);
    return v;
}
__device__ __forceinline__ void moe_slots(Frame& F, const Args& a) {
    const bf16* xb = (const bf16*)(a.ws + WS_XB); const float* ssq = (const float*)(a.ws + WS_SSQ); bf16* xg = (bf16*)(a.ws + WS_XG);
    const int* toke = (const int*)(a.ws + WS_TOKE); const float* tokw = (const float*)(a.ws + WS_TOKW); const int* cntw = (const int*)(a.ws + WS_CNTW);
    int* meta = (int*)(a.ws + WS_META); int* rdest = (int*)(a.ws + WS_RDEST); float* rw = (float*)(a.ws + WS_RW); float* rrstd = (float*)(a.ws + WS_RRSTD);
    const int lane = F.lane;
    for (int run = F.gw; run < M / 32; run += F.NGW) {
        int pre[8], tot[8];
#pragma unroll
        for (int e = 0; e < 8; ++e) { pre[e] = 0; tot[e] = 0; }
        for (int r2 = lane; r2 < M / 32; r2 += 64) {
            const int4 c0 = *(const int4*)(cntw + r2 * 8), c1 = *(const int4*)(cntw + r2 * 8 + 4); const int f = r2 < run ? 1 : 0;
            tot[0] += c0.x; tot[1] += c0.y; tot[2] += c0.z; tot[3] += c0.w; tot[4] += c1.x; tot[5] += c1.y; tot[6] += c1.z; tot[7] += c1.w;
            pre[0] += f * c0.x; pre[1] += f * c0.y; pre[2] += f * c0.z; pre[3] += f * c0.w; pre[4] += f * c1.x; pre[5] += f * c1.y; pre[6] += f * c1.z; pre[7] += f * c1.w;
        }
        int seg[9]; seg[0] = 0;
#pragma unroll
        for (int e = 0; e < 8; ++e) { tot[e] = __builtin_amdgcn_readfirstlane(wave_sum_i(tot[e])); pre[e] = __builtin_amdgcn_readfirstlane(wave_sum_i(pre[e])); seg[e + 1] = seg[e] + ((tot[e] + 255) & ~255); }
        if (run == 0 && lane < 9) { int sv = 0;
#pragma unroll
            for (int e = 0; e < 9; ++e) if (lane == e) sv = seg[e] >> 8;
            meta[lane] = sv; }
        if (run < 8) {
#pragma unroll
            for (int e = 0; e < 8; ++e) if (run == e) { for (int r = tot[e] + lane; r < ((tot[e] + 255) & ~255); r += 64) { rdest[seg[e] + r] = -1; rw[seg[e] + r] = 0.f; rrstd[seg[e] + r] = 0.f; } }
        }
        int base[8];
#pragma unroll
        for (int e = 0; e < 8; ++e) base[e] = seg[e] + pre[e];
        for (int ti = 0; ti < 32; ++ti) {
            const int t = run * 32 + ti; const int ee = __builtin_amdgcn_readfirstlane(toke[t]); const int e0 = ee & 255, e1 = ee >> 8;
            int s0 = 0, s1 = 0;
#pragma unroll
            for (int e = 0; e < 8; ++e) { if (e0 == e) { s0 = base[e]; base[e] += 1; } if (e1 == e) { s1 = base[e]; base[e] += 1; } }
            if (lane == 0) { const float rstd = row_rstd(ssq, t); rdest[s0] = 2 * t; rdest[s1] = 2 * t + 1; rw[s0] = tokw[2 * t]; rw[s1] = tokw[2 * t + 1]; rrstd[s0] = rstd; rrstd[s1] = rstd; }
            const v4u x0 = *(const v4u*)(xb + (size_t)t * D + 16 * lane), x1 = *(const v4u*)(xb + (size_t)t * D + 16 * lane + 8);
            *(v4u*)(xg + (size_t)s0 * D + 16 * lane) = x0; *(v4u*)(xg + (size_t)s0 * D + 16 * lane + 8) = x1;
            *(v4u*)(xg + (size_t)s1 * D + 16 * lane) = x0; *(v4u*)(xg + (size_t)s1 * D + 16 * lane + 8) = x1;
        }
    }
}
__device__ __forceinline__ void moe_combine(Frame& F, const Args& a, bool last) {
    bf16* xb = (bf16*)(a.ws + WS_XB); float* ssq = (float*)(a.ws + WS_SSQ); const bf16* yb = (const bf16*)a.out; float* outp = (float*)a.out;
    const int lane = F.lane;
    for (int t = F.gw; t < M; t += F.NGW) {
        const v4u x0 = *(const v4u*)(xb + (size_t)t * D + 16 * lane), x1 = *(const v4u*)(xb + (size_t)t * D + 16 * lane + 8);
        const v4u y00 = *(const v4u*)(yb + (size_t)(2 * t) * D + 16 * lane), y01 = *(const v4u*)(yb + (size_t)(2 * t) * D + 16 * lane + 8);
        const v4u y10 = *(const v4u*)(yb + (size_t)(2 * t + 1) * D + 16 * lane), y11 = *(const v4u*)(yb + (size_t)(2 * t + 1) * D + 16 * lane + 8);
        A4 xa, xb_, xc, xd, t0, t1;
        unpack8(x0, xa, xb_); unpack8(x1, xc, xd);
        unpack8(y00, t0, t1); xa = xa + t0; xb_ = xb_ + t1; unpack8(y01, t0, t1); xc = xc + t0; xd = xd + t1;
        unpack8(y10, t0, t1); xa = xa + t0; xb_ = xb_ + t1; unpack8(y11, t0, t1); xc = xc + t0; xd = xd + t1;
        if (!last) {
            const v4u w0 = pack8(xa, xb_), w1 = pack8(xc, xd);
            *(v4u*)(xb + (size_t)t * D + 16 * lane) = w0; *(v4u*)(xb + (size_t)t * D + 16 * lane + 8) = w1;
            unpack8(w0, xa, xb_); unpack8(w1, xc, xd);
        }
        float ss = 0.f;
#pragma unroll
        for (int j = 0; j < 4; ++j) ss += xa[j] * xa[j] + xb_[j] * xb_[j] + xc[j] * xc[j] + xd[j] * xd[j];
        const float tot = wave_sum(ss);
        if (!last) { if (lane < 16) ssq[(size_t)t * 16 + lane] = lane == 0 ? tot : 0.f; }
        else {
            const float r = rsqrtf(tot * (1.0f / 1024.0f) + EPS); const f32x4* gf = (const f32x4*)(a.in[30] + 16 * lane); f32x4* op = (f32x4*)(outp + (size_t)t * D + 16 * lane);
            op[0] = xa * r * gf[0]; op[1] = xb_ * r * gf[1]; op[2] = xc * r * gf[2]; op[3] = xd * r * gf[3];
        }
    }
}
#ifndef MK_N_LAUNCHES
#define MK_N_LAUNCHES 1
#endif
constexpr int N_PHASES = 1 + 2 * (7 + 14);

__global__ void __launch_bounds__(NWAVES * 64, 2) fwd(Args args) {
    extern __shared__ __attribute__((aligned(16))) unsigned char lds[];
    Frame F;
    F.lds = (LAS unsigned char*)lds;
    F.MISC = (volatile LAS unsigned*)(F.lds + MISC_OFF);
    F.tid = threadIdx.x; F.lane = F.tid & 63; F.wave = __builtin_amdgcn_readfirstlane(F.tid >> 6);
    F.G = gridDim.x; F.gw = blockIdx.x * NWAVES + F.wave; F.NGW = F.G * NWAVES;
    unsigned char* ws = args.ws;
    F.ctl = (gu32*)(ws + WS_CTL);
    for (int u = F.tid; u < (LDS_BYTES - LDSCTL_OFF) / 4; u += NWAVES * 64) ((LAS unsigned*)(F.lds + LDSCTL_OFF))[u] = 0u;
    __syncthreads();
    XcdBarrier bar; bar.bar = (unsigned*)(F.ctl + CW_BAR); bar.x = 0; bar.st = nullptr;
    if (args.use_bar) bar = xcd_barrier_post((unsigned*)(F.ctl + CW_BAR), F.MISC + 8, F.wave);
    const int lo = args.ph_lo, hi = args.ph_hi; int ph = 0;
#ifndef MERGE_MASK
#define MERGE_MASK 7
#endif
#ifndef PHASE_MASK
#define PHASE_MASK 0xffffffffu
#endif
#define INP(k) ((lo <= ph && ph < hi) && ((PHASE_MASK >> (k)) & 1u))
#define OPQ() Frame Fp = F; { const int l_ = lane_id_fresh(); Fp.lane = l_; Fp.tid = (F.wave << 6) | l_; }
#define SEAM() do { if (lo <= ph && ph + 1 < hi) xcd_barrier(bar, F.wave); ++ph; } while (0)
#define BIDQ() ({ int b_ = (int)blockIdx.x; asm volatile("" : "+s"(b_)); b_; })
    LAS unsigned char* ring = F.lds + RING_OFF;
#define XB ((bf16*)(ws + WS_XB))
#define SSQ ((float*)(ws + WS_SSQ))
#define Qb ((bf16*)(args.out + DO_Q))
#define MRG ((bf16*)(args.out + DO_MERGED))
#define GATES ((bf16*)(ws + WS_GATES))
#define YG ((bf16*)(ws + WS_YG))
#define SSMO ((bf16*)(ws + WS_SSMO))
#define CONVO ((bf16*)(ws + WS_CONVO))

    if (INP(0)) { OPQ(); p0_prologue(Fp, args); } SEAM();

    for (int l = 0; l < DEPTH; ++l) {
        unsigned char* wm = ws + WS_WMIX + (size_t)l * WMIX_STRIDE;
        if (INP(1)) {
            pg8::Gemm g{XB, (const bf16*)(wm + WM_IN), D, D, D}; pg8::StaticOrder S; S.init(M / 256, N_INP / 256, F.G, BIDQ());
            EpiInProj E{args.out, ws, l};
            pg8::gemm_phase<EpiInProj, pg8::StaticOrder, true, true>(ring, g, S, E, F.wave);
        } SEAM();
        if (INP(2)) {
            OPQ();
            if (F.wave == 0) { for (int unit = BIDQ(); unit < BATCH * SSM_G; unit += F.G) t1_ssm_scan(args, l, unit >> 4, unit & 15, Fp.lane); }
            else {
                const int gwl = BIDQ() * 7 + (F.wave - 1), ngw = F.G * 7;
                for (int bh = gwl; bh < BATCH * NH; bh += ngw) t1_cumsum(args, bh, Fp.lane);
                for (int blk = gwl; blk < M / 32; blk += ngw) t1_conv(args, l, blk, Fp.lane);
                if (l & 1) cvt_moe_layer(args, l >> 1, l, (LAS float*)(F.lds + RING_OFF + F.wave * 16384), Fp.lane, gwl, ngw);
            }
        } SEAM();
        if (INP(3)) {
            { pg8::Gemm g{YG, (const bf16*)(wm + WM_GLU), 256, 256, 256}; pg8::StaticOrder S; S.init(M / 256, 2, F.G, BIDQ()); EpiGluSsm E{SSMO};
              pg8::gemm_phase<EpiGluSsm, pg8::StaticOrder, true, true>(ring, g, S, E, F.wave); }
#if ATTN_FAST
            { const attn_body::AttnTensors AT{(const attn_body::bf16*)Qb, (const attn_body::bf16*)(args.out + DO_K), (const attn_body::bf16*)(args.out + DO_V), (attn_body::bf16*)Qb, (const float*)(ws + WS_FH)};
              const attn_body::StaticOrder SA((int)F.G, BIDQ());
              attn_body::attn_phase<attn_body::StaticOrder>((char*)lds + RING_OFF, AT, SA, F.wave); }
#else
            { OPQ(); attn_naive(Fp, args); }
#endif
        } SEAM();
        if (INP(4)) {
            pg8::StaticOrder S; S.init(M / 256, 4, F.G, BIDQ());
            if (MERGE_MASK & 1) { pg8::Gemm g{Qb, (const bf16*)(wm + WM_A), 512, 512, 512}; EpiMerge<0> E{GATES, MRG}; pg8::gemm_phase<EpiMerge<0>, pg8::StaticOrder, true, true>(ring, g, S, E, F.wave); }
            if (MERGE_MASK & 2) { pg8::Gemm g{SSMO, (const bf16*)(wm + WM_S), 256, 256, 256}; EpiMerge<1> E{GATES, MRG}; pg8::gemm_phase<EpiMerge<1>, pg8::StaticOrder, true, true>(ring, g, S, E, F.wave); }
            if (MERGE_MASK & 4) { pg8::Gemm g{CONVO, (const bf16*)(wm + WM_C), 256, 256, 256}; EpiMerge<2> E{GATES, MRG}; pg8::gemm_phase<EpiMerge<2>, pg8::StaticOrder, true, true>(ring, g, S, E, F.wave); }
        } SEAM();
        if (INP(5)) {
            pg8::Gemm g{MRG, (const bf16*)(wm + WM_O), D, D, D}; pg8::StaticOrder S; S.init(M / 256, 4, F.G, BIDQ()); EpiResid E{XB, SSQ};
            pg8::gemm_phase<EpiResid, pg8::StaticOrder, true, true>(ring, g, S, E, F.wave);
        } SEAM();
        if (!(l & 1)) {
            unsigned char* wd = ws + WS_WDENSE + (size_t)(l >> 1) * WDENSE_STRIDE; bf16* const HID = (bf16*)(ws + WS_HID);
            if (INP(6)) {
                pg8::Gemm g{XB, (const bf16*)(wd + WD_GU), D, D, D}; pg8::StaticOrder S; S.init(M / 256, 2 * D_FF / 256, F.G, BIDQ()); EpiSwiGlu<false> E{HID, D_FF, SSQ};
                pg8::gemm_phase<EpiSwiGlu<false>, pg8::StaticOrder, true, true>(ring, g, S, E, F.wave);
            } SEAM();
            if (INP(7)) {
                pg8::Gemm g{HID, (const bf16*)(wd + WD_D), D_FF, D_FF, D_FF}; pg8::StaticOrder S; S.init(M / 256, 4, F.G, BIDQ()); EpiResid E{XB, SSQ};
                pg8::gemm_phase<EpiResid, pg8::StaticOrder, true, true>(ring, g, S, E, F.wave);
            } SEAM();
        } else {
            if (INP(8)) { OPQ(); moe_route(Fp, args, l, l >> 1); } SEAM();
            if (INP(9)) { OPQ(); moe_slots(Fp, args); } SEAM();
            const int* meta = (const int*)(ws + WS_META);
            for (int ch = 0; ch < MOE_NCHUNK; ++ch) {
                if (INP(10)) {
                    const int total = meta[8], per = (total + MOE_NCHUNK - 1) / MOE_NCHUNK, tile0 = ch * per; int nM = total - tile0; nM = nM < 0 ? 0 : (nM > per ? per : nM);
                    pg8::Gemm g{(const bf16*)(ws + WS_XG), (const bf16*)(ws + WS_WMOE + WMOE_GU), D, D, D};
                    MoeOrder S; S.so.init(nM, 2 * D_FFE / 256, F.G, BIDQ()); S.tile0 = tile0; S.a_tile_off = tile0; S.b_rows = 2 * D_FFE;
                    S.s1 = meta[1]; S.s2 = meta[2]; S.s3 = meta[3]; S.s4 = meta[4]; S.s5 = meta[5]; S.s6 = meta[6]; S.s7 = meta[7];
                    EpiSwiGlu<true> E{(bf16*)(ws + WS_MHID), D_FFE, (const float*)(ws + WS_RRSTD) + (size_t)tile0 * 256};
                    pg8::gemm_phase<EpiSwiGlu<true>, MoeOrder, true, true>(ring, g, S, E, F.wave);
                } SEAM();
                if (INP(11)) {
                    const int total = meta[8], per = (total + MOE_NCHUNK - 1) / MOE_NCHUNK, tile0 = ch * per; int nM = total - tile0; nM = nM < 0 ? 0 : (nM > per ? per : nM);
                    pg8::Gemm g{(const bf16*)(ws + WS_MHID), (const bf16*)(ws + WS_WMOE + WMOE_D), D_FFE, D_FFE, D_FFE};
                    MoeOrder S; S.so.init(nM, 4, F.G, BIDQ()); S.tile0 = tile0; S.a_tile_off = 0; S.b_rows = D;
                    S.s1 = meta[1]; S.s2 = meta[2]; S.s3 = meta[3]; S.s4 = meta[4]; S.s5 = meta[5]; S.s6 = meta[6]; S.s7 = meta[7];
                    EpiMoeDown E{(bf16*)args.out, (const int*)(ws + WS_RDEST) + (size_t)tile0 * 256, (const float*)(ws + WS_RW) + (size_t)tile0 * 256};
                    pg8::gemm_phase<EpiMoeDown, MoeOrder, true, true>(ring, g, S, E, F.wave);
                } SEAM();
            }
            if (INP(12)) { OPQ(); moe_combine(Fp, args, l == DEPTH - 1); } SEAM();
        }
    }
#undef INP
#undef BIDQ
#undef OPQ
#undef SEAM
}

extern "C" void kernel_launch(void* const* d_in, const int* in_sizes, int n_in, void* d_out, int out_size, void* d_ws, size_t ws_size, hipStream_t stream) {
    static int grid = 0;
    if (grid == 0) {
        if (n_in != 31 || in_sizes[0] != M * D || out_size != M * D || ws_size < WS_END) { fprintf(stderr, "kernel_launch: unexpected shapes/workspace (n_in %d, ws %zu, need %zu); nothing launched\n", n_in, ws_size, (size_t)WS_END); grid = -1; return; }
        int dev = 0, cus = 0, per_cu = 0;
        if (hipGetDevice(&dev) != hipSuccess || hipDeviceGetAttribute(&cus, hipDeviceAttributeMultiprocessorCount, dev) != hipSuccess) { grid = -1; return; }
        if (hipFuncSetAttribute((const void*)fwd, hipFuncAttributeMaxDynamicSharedMemorySize, LDS_BYTES) != hipSuccess) { fprintf(stderr, "kernel_launch: hipFuncSetAttribute failed\n"); grid = -1; return; }
        if (hipOccupancyMaxActiveBlocksPerMultiprocessor(&per_cu, (const void*)fwd, NWAVES * 64, LDS_BYTES) != hipSuccess || per_cu < 1)
            fprintf(stderr, "kernel_launch: note: occupancy query reports %d workgroups per CU\n", per_cu);
        (void)hipGetLastError();
        grid = cus;
    }
    if (grid < 0) return;
    if (hipMemsetAsync((char*)d_ws + WS_CTL, 0, CTL_ZERO_BYTES, stream) != hipSuccess) return;
    Args a{};
    for (int i = 0; i < 31; ++i) a.in[i] = (const float*)d_in[i];
    a.out = (unsigned char*)d_out; a.ws = (unsigned char*)d_ws; a.pad = 0;
#if MK_N_LAUNCHES == 1
    a.ph_lo = 0; a.ph_hi = N_PHASES; a.use_bar = 1;
    hipLaunchKernelGGL(fwd, dim3(grid), dim3(NWAVES * 64), LDS_BYTES, stream, a);
#else
    for (int p = 0; p < N_PHASES; ++p) { a.ph_lo = p; a.ph_hi = p + 1; a.use_bar = 0; hipLaunchKernelGGL(fwd, dim3(grid), dim3(NWAVES * 64), LDS_BYTES, stream, a); }
#endif
}
```

```cpp
#include <hip/hip_runtime.h>
#include <cstdio>
#include <cstdint>
#include <hip/hip_bf16.h>
#include <cmath>
#ifndef ATTN_FAST
#define ATTN_FAST 1
#endif
#define MK_N_LAUNCHES 1
__device__ __forceinline__ int lane_id_fresh() { int l; asm volatile("v_mbcnt_lo_u32_b32 %0, -1, 0\n\tv_mbcnt_hi_u32_b32 %0, -1, %0" : "=v"(l)); return l; }
namespace pg8 {
#define PG8_LAS __attribute__((address_space(3)))
typedef unsigned short bf16_t;
typedef short bf16x8 __attribute__((ext_vector_type(8)));
typedef float f32x4 __attribute__((ext_vector_type(4)));
typedef float f32x2 __attribute__((ext_vector_type(2)));
typedef unsigned u32x4 __attribute__((ext_vector_type(4)));
constexpr int BM = 256, BK = 64, HALF = 128, HTB = HALF * BK * 2  , STAGE_BYTES = 8 * HTB, NXCD = 8, WGM = 8;

__host__ __device__ __forceinline__ int lds_byte(int r, int c) { const int st = (r >> 4) * 2 + (c >> 5), rr = r & 15, cc = c & 31, ob = rr * 64 + cc * 2; return st * 1024 + (ob ^ (((ob >> 9) & 1) << 5)); }
__host__ __device__ __forceinline__ void stage_rc(int b, int& R, int& C) { const int st = b / 1024, sb = b % 1024, swz = sb ^ (((sb >> 9) & 1) << 5); R = (st >> 1) * 16 + swz / 64; C = (st & 1) * 32 + (swz % 64) / 2; }
__host__ __device__ __forceinline__ int perm32(int rho) { const int n = rho >> 4, i = rho & 15; return 8 * (i >> 2) + 4 * n + (i & 3); }

struct Unit { int pm, pn, arow, brow; };
struct Gemm { const bf16_t* A; const bf16_t* Bt; int lda, ldb, K; };

struct StaticOrder {
    int nM, nN, nwg, G, c;
    __host__ __device__ void init(int nM_, int nN_, int G_, int c_) { nM = nM_; nN = nN_; nwg = nM * nN; G = G_; c = c_; }
    __host__ __device__ bool next(int i, Unit& u) const {
        const long L = (long)i * G + c; if (L >= nwg) return false;
        int wgid = (int)L; { const int q = nwg / NXCD, r = nwg % NXCD, xcd = wgid % NXCD, off = wgid / NXCD; wgid = (xcd < r ? xcd * (q + 1) : r * (q + 1) + (xcd - r) * q) + off; }
        const int nig = WGM * nN, gid = wgid / nig, fm = gid * WGM, gsz = (nM - fm) < WGM ? (nM - fm) : WGM;
        u.pm = fm + ((wgid % nig) % gsz); u.pn = (wgid % nig) / gsz; u.arow = u.pm * BM; u.brow = u.pn * BM; return true;
    }
};

__device__ __forceinline__ unsigned cvt_pk_bf16(float lo, float hi) { unsigned r; asm volatile("v_cvt_pk_bf16_f32 %0, %1, %2" : "=v"(r) : "v"(lo), "v"(hi)); return r; }

template <class Epi, class Sched, bool ALIGN_EPI = false, bool SP2 = false>
__device__ __forceinline__ void gemm_phase(PG8_LAS unsigned char* lds, const Gemm g, const Sched& S, const Epi& E, const int wave_id) {
    const int tid_ = lane_id_fresh() | (wave_id << 6);
    const int tid = tid_, wid = __builtin_amdgcn_readfirstlane(tid >> 6), lane = tid & 63, wr = wid >> 2, wc = wid & 3, fr = lane & 15, fq = lane >> 4;
    const char* gA = (const char*)g.A; const char* gB = (const char*)g.Bt; asm volatile("" : "+s"(gA), "+s"(gB));
    int K_ = g.K; asm volatile("" : "+s"(K_));
    const int nt = K_ / BK, lda = g.lda, ldb = g.ldb;
    unsigned voffA[2], voffB[2];
#pragma unroll
    for (int i = 0; i < 2; ++i) { int R, C; stage_rc(tid * 16 + i * 8192, R, C); const int Rb = Epi::PERM ? ((R & ~31) + perm32(R & 31)) : R;
        voffA[i] = (unsigned)(R * lda + C) * 2u; voffB[i] = (unsigned)(Rb * ldb + C) * 2u; }
    const size_t kstep = (size_t)(BK * 2);
    const size_t hstepA = (size_t)HALF * lda * 2, hstepB = (size_t)HALF * ldb * 2;
    const unsigned ldsw = (unsigned)wid * 1024u;
    const int aoff = lds_byte(wr * 64 + fr, fq * 8), boff = lds_byte(wc * 32 + fr, fq * 8);
#define PG8_SA(b, h) (((b) * 2 + (h)) * HTB)
#define PG8_SB(b, h) ((4 + (b) * 2 + (h)) * HTB)
#define PG8_STAGE(bufoff, gbase, voff) do { _Pragma("unroll") for (int _i = 0; _i < 2; ++_i) \
        __builtin_amdgcn_global_load_lds((const unsigned*)((const char*)(gbase) + (voff)[_i]), (PG8_LAS unsigned*)(lds + (bufoff) + ldsw + _i * 8192), 16, 0, 0); } while (0)
#define PG8_LDA(dst, b, h) do { _Pragma("unroll") for (int m = 0; m < 4; ++m) _Pragma("unroll") for (int k = 0; k < 2; ++k) dst[m][k] = *(const PG8_LAS bf16x8*)(lds + PG8_SA(b, h) + aoff + m * 2048 + k * 1024); } while (0)
#define PG8_LDB(dst, b, h) do { _Pragma("unroll") for (int n = 0; n < 2; ++n) _Pragma("unroll") for (int k = 0; k < 2; ++k) dst[n][k] = *(const PG8_LAS bf16x8*)(lds + PG8_SB(b, h) + boff + n * 2048 + k * 1024); } while (0)
#define PG8_MMA(ai, bj, At, Bt) do { __builtin_amdgcn_s_setprio(1); _Pragma("unroll") for (int m = 0; m < 4; ++m) _Pragma("unroll") for (int n = 0; n < 2; ++n) _Pragma("unroll") for (int k = 0; k < 2; ++k) \
        acc[ai][bj][m][n] = __builtin_amdgcn_mfma_f32_16x16x32_bf16(Bt[n][k], At[m][k], acc[ai][bj][m][n], 0, 0, 0); __builtin_amdgcn_s_setprio(0); } while (0)
#define PG8_WAIT_V(n) asm volatile("s_waitcnt vmcnt(" #n ")" ::: "memory")
#define PG8_WAIT_L(n) asm volatile("s_waitcnt lgkmcnt(" #n ")" ::: "memory")
#define PG8_BAR __builtin_amdgcn_s_barrier()
#define PG8_SCHED __builtin_amdgcn_sched_barrier(0)
    Unit cur, nxt; int ui = 0;
    if (!S.next(0, cur)) return;
    f32x4 acc[2][2][4][2];
#pragma unroll
    for (int a = 0; a < 2; ++a)
#pragma unroll
        for (int b = 0; b < 2; ++b)
#pragma unroll
            for (int m = 0; m < 4; ++m)
#pragma unroll
                for (int n = 0; n < 2; ++n) acc[a][b][m][n] = (f32x4){0.f, 0.f, 0.f, 0.f};
    bf16x8 At[4][2], B0[2][2], B1[2][2];
    const char* cA = gA + (size_t)cur.arow * lda * 2; const char* cB = gB + (size_t)cur.brow * ldb * 2;
    if constexpr (SP2) {
        PG8_STAGE(PG8_SB(0, 0), cB, voffB); PG8_STAGE(PG8_SB(0, 1), cB + hstepB, voffB); PG8_STAGE(PG8_SA(0, 0), cA, voffA); PG8_STAGE(PG8_SA(0, 1), cA + hstepA, voffA);
        if (wr == 1) PG8_BAR;
        PG8_WAIT_V(2); PG8_BAR;
        PG8_STAGE(PG8_SB(1, 0), cB + kstep, voffB); PG8_STAGE(PG8_SA(1, 0), cA + kstep, voffA); PG8_STAGE(PG8_SB(1, 1), cB + hstepB + kstep, voffB);
        PG8_WAIT_V(6); PG8_BAR;
    } else {
        PG8_STAGE(PG8_SB(0, 0), cB, voffB); PG8_STAGE(PG8_SA(0, 0), cA, voffA); PG8_STAGE(PG8_SB(0, 1), cB + hstepB, voffB); PG8_STAGE(PG8_SA(0, 1), cA + hstepA, voffA);
        if (wr == 1) PG8_BAR;
        PG8_WAIT_V(4); PG8_BAR;
        PG8_STAGE(PG8_SB(1, 0), cB + kstep, voffB); PG8_STAGE(PG8_SA(1, 0), cA + kstep, voffA); PG8_STAGE(PG8_SB(1, 1), cB + hstepB + kstep, voffB);
        PG8_WAIT_V(6); PG8_BAR;
    }
    for (;;) {
        const bool has_next = S.next(ui + 1, nxt);
        const char* nA = has_next ? gA + (size_t)nxt.arow * lda * 2 : cA; const char* nB = has_next ? gB + (size_t)nxt.brow * ldb * 2 : cB;
        for (int t = 0; t < nt; t += 2) {
            const bool last = (t == nt - 2);
            const char* a1 = cA + (size_t)(t + 1) * kstep;
            const char* a2 = last ? nA : cA + (size_t)(t + 2) * kstep; const char* b2 = last ? nB : cB + (size_t)(t + 2) * kstep;
            const char* a3 = a2 + kstep; const char* b3 = b2 + kstep;
            if constexpr (SP2) {
            PG8_LDB(B0, 0, 0); PG8_LDB(B1, 0, 1); PG8_SCHED; PG8_LDA(At, 0, 0); PG8_STAGE(PG8_SA(1, 1), a1 + hstepA, voffA);
            PG8_WAIT_V(8); PG8_WAIT_L(0); PG8_BAR; PG8_MMA(0, 0, At, B0); PG8_MMA(0, 1, At, B1); PG8_BAR; PG8_SCHED;
            PG8_LDA(At, 0, 1); PG8_STAGE(PG8_SB(0, 0), b2, voffB); PG8_STAGE(PG8_SB(0, 1), b2 + hstepB, voffB); PG8_STAGE(PG8_SA(0, 0), a2, voffA);
            PG8_WAIT_V(8); PG8_WAIT_L(0); PG8_BAR; PG8_MMA(1, 0, At, B0); PG8_MMA(1, 1, At, B1); PG8_BAR; PG8_SCHED;
            PG8_LDB(B0, 1, 0); PG8_LDB(B1, 1, 1); PG8_SCHED; PG8_LDA(At, 1, 0); PG8_STAGE(PG8_SA(0, 1), a2 + hstepA, voffA);
            PG8_WAIT_V(8); PG8_WAIT_L(0); PG8_BAR; PG8_MMA(0, 0, At, B0); PG8_MMA(0, 1, At, B1); PG8_BAR; PG8_SCHED;
            PG8_LDA(At, 1, 1); PG8_STAGE(PG8_SB(1, 0), b3, voffB); PG8_STAGE(PG8_SB(1, 1), b3 + hstepB, voffB); PG8_STAGE(PG8_SA(1, 0), a3, voffA);
            PG8_WAIT_V(8); PG8_WAIT_L(0); PG8_BAR; PG8_MMA(1, 0, At, B0); PG8_MMA(1, 1, At, B1); PG8_BAR; PG8_SCHED;
            } else {
            PG8_LDB(B0, 0, 0); PG8_SCHED; PG8_LDA(At, 0, 0); PG8_STAGE(PG8_SA(1, 1), a1 + hstepA, voffA);
            PG8_WAIT_L(8); PG8_BAR; PG8_WAIT_L(0); PG8_MMA(0, 0, At, B0); PG8_BAR; PG8_SCHED;
            PG8_LDB(B1, 0, 1); PG8_STAGE(PG8_SB(0, 0), b2, voffB);
            PG8_BAR; PG8_WAIT_L(0); PG8_MMA(0, 1, At, B1); PG8_BAR;
            PG8_LDA(At, 0, 1); PG8_STAGE(PG8_SA(0, 0), a2, voffA);
            PG8_BAR; PG8_WAIT_L(0); PG8_MMA(1, 0, At, B0); PG8_BAR; PG8_SCHED;
            PG8_STAGE(PG8_SB(0, 1), b2 + hstepB, voffB);
            PG8_WAIT_V(6); PG8_BAR; PG8_MMA(1, 1, At, B1); PG8_BAR;
            PG8_LDB(B0, 1, 0); PG8_SCHED; PG8_LDA(At, 1, 0); PG8_STAGE(PG8_SA(0, 1), a2 + hstepA, voffA);
            PG8_WAIT_L(8); PG8_BAR; PG8_WAIT_L(0); PG8_MMA(0, 0, At, B0); PG8_BAR; PG8_SCHED;
            PG8_LDB(B1, 1, 1); PG8_STAGE(PG8_SB(1, 0), b3, voffB);
            PG8_BAR; PG8_WAIT_L(0); PG8_MMA(0, 1, At, B1); PG8_BAR;
            PG8_LDA(At, 1, 1); PG8_STAGE(PG8_SA(1, 0), a3, voffA);
            PG8_BAR; PG8_WAIT_L(0); PG8_MMA(1, 0, At, B0); PG8_BAR; PG8_SCHED;
            PG8_STAGE(PG8_SB(1, 1), b3 + hstepB, voffB);
            PG8_WAIT_V(6); PG8_BAR; PG8_MMA(1, 1, At, B1); PG8_BAR;
            }
        }
        if constexpr (ALIGN_EPI) { if (wr == 0) PG8_BAR; }
        E(acc, cur, wr, wc, fr, fq);
        if (!has_next) break;
#pragma unroll
        for (int a = 0; a < 2; ++a)
#pragma unroll
            for (int b = 0; b < 2; ++b)
#pragma unroll
                for (int m = 0; m < 4; ++m)
#pragma unroll
                    for (int n = 0; n < 2; ++n) acc[a][b][m][n] = (f32x4){0.f, 0.f, 0.f, 0.f};
        cur = nxt; cA = nA; cB = nB; ++ui;
        if constexpr (ALIGN_EPI) { if (wr == 1) PG8_BAR; }
    }
    PG8_WAIT_V(0);
    if constexpr (!ALIGN_EPI) { if (wr == 0) PG8_BAR; }
    PG8_BAR;
#undef PG8_SA
#undef PG8_SB
#undef PG8_STAGE
#undef PG8_LDA
#undef PG8_LDB
#undef PG8_MMA
#undef PG8_WAIT_V
#undef PG8_WAIT_L
#undef PG8_BAR
#undef PG8_SCHED
}
}
constexpr int NWAVES = 8;
constexpr int BATCH = 16, SEQ = 4096, D = 1024, DEPTH = 4, M = BATCH * SEQ;
constexpr int NH = 8, HD = 64, ATT_W = 512, SSM_W = 256, SSM_G = 16, SSM_P = 64, SSM_H = 16, CONV_W = 256, CONV_K = 31;
constexpr int N_IN = 5384, N_INP = 5632, D_FF = 2816, NE = 8, D_FFE = 3584;
constexpr float EPS = 1e-6f;
constexpr float LOG2E = 1.4426950408889634f;
constexpr float QSCALE = 0.125f * LOG2E;
constexpr int MOE_ROWS_CAP = 133120;
constexpr int MOE_NCHUNK = 3, MOE_CHUNK_TILES_CAP = 174;

constexpr size_t MiB = 1u << 20;
constexpr size_t WS_CTL = 0, CTL_ZERO_BYTES = 1 * MiB;
constexpr size_t WS_BPERM = 1 * MiB;
constexpr size_t WS_TOKE = 2 * MiB;
constexpr size_t WS_TOKW = 3 * MiB;
constexpr size_t WS_CNTW = 4 * MiB;
constexpr size_t WS_META = 4 * MiB + 512 * 1024;
constexpr size_t WS_RDEST = 5 * MiB;
constexpr size_t WS_RW = 6 * MiB;
constexpr size_t WS_RRSTD = 7 * MiB;
constexpr size_t WS_WMIX = 16 * MiB, WMIX_STRIDE = 16 * MiB;
constexpr size_t WM_IN = 0, WM_GLU = 11 * MiB, WM_A = WM_GLU + 256 * 1024, WM_S = WM_A + 1 * MiB, WM_C = WM_S + 512 * 1024, WM_O = WM_C + 512 * 1024;
constexpr size_t WS_WDENSE = 80 * MiB, WDENSE_STRIDE = 16 * MiB + 512 * 1024;
constexpr size_t WD_GU = 0, WD_D = 11 * MiB;
constexpr size_t WS_WMOE = 113 * MiB;
constexpr size_t WMOE_GU = 0, WMOE_D = 112 * MiB;
constexpr size_t WS_XB = 281 * MiB;
constexpr size_t WS_SSQ = 409 * MiB;
constexpr size_t WS_LOGF = 413 * MiB;
constexpr size_t WS_FH = 415 * MiB;
constexpr size_t WS_BIG = 417 * MiB;
constexpr size_t WS_GATES = WS_BIG;
constexpr size_t WS_YG = WS_BIG + 384 * MiB;
constexpr size_t WS_SSMO = WS_YG + 32 * MiB;
constexpr size_t WS_CONVO = WS_SSMO + 32 * MiB;
constexpr size_t WS_HID = WS_BIG;
constexpr size_t WS_XG = WS_BIG;
constexpr size_t WS_MHID = WS_BIG + 260 * MiB;
constexpr size_t WS_UA = WS_CONVO + 32 * MiB;
constexpr size_t WS_MV = WS_UA + 36 * MiB;
constexpr size_t WS_WG = WS_MV + 36 * MiB;
constexpr size_t WS_SST = WS_WG + 8 * MiB;
constexpr size_t WS_APOW = 8 * MiB;
constexpr size_t WS_BBAR = 11 * MiB;
constexpr size_t WS_KTAB = 12 * MiB;
constexpr size_t WS_END = WS_SST + 8 * MiB;
static_assert(WS_MHID + 305 * MiB <= WS_END, "ws map");
static_assert(WS_CONVO + 32 * MiB <= WS_END && WS_HID + 352 * MiB <= WS_END, "ws map");
constexpr size_t DO_Q = 0, DO_K = 64 * MiB, DO_V = 128 * MiB, DO_U = 192 * MiB, DO_HC = 224 * MiB, DO_MERGED = 64 * MiB;

constexpr int CW_TMO = 0, CW_CODE = 1;
constexpr int CW_BAR = 4096;

constexpr int RING_OFF = 0, RING_BYTES = 131072;
constexpr int LDSCTL_OFF = RING_BYTES, MISC_OFF = LDSCTL_OFF + 320;
constexpr int LDS_BYTES = 147456;

#define GAS __attribute__((address_space(1)))
#define LAS __attribute__((address_space(3)))
typedef unsigned short bf16;
typedef unsigned v4u __attribute__((ext_vector_type(4)));
typedef unsigned v2u __attribute__((ext_vector_type(2)));
typedef float f32x4 __attribute__((ext_vector_type(4)));
typedef float f32x2 __attribute__((ext_vector_type(2)));
typedef GAS unsigned gu32;
#define RLX_AGENT __ATOMIC_RELAXED, __HIP_MEMORY_SCOPE_AGENT
#define LDS_WAIT() asm volatile("s_waitcnt lgkmcnt(0)" ::: "memory")
#define VM_WAIT() asm volatile("s_waitcnt vmcnt(0)" ::: "memory")
__device__ __forceinline__ unsigned f2bf(float f) { unsigned u = __builtin_bit_cast(unsigned, f); return (u + 0x7fffu + ((u >> 16) & 1u)) >> 16; }
__device__ __forceinline__ unsigned pk2(float lo, float hi) { return pg8::cvt_pk_bf16(lo, hi); }
__device__ __forceinline__ float bflo(unsigned u) { return __builtin_bit_cast(float, u << 16); }
__device__ __forceinline__ float bfhi(unsigned u) { return __builtin_bit_cast(float, u & 0xffff0000u); }
__device__ __forceinline__ float bf1(bf16 h) { return __builtin_bit_cast(float, (unsigned)h << 16); }
__device__ __forceinline__ float sigmoidf_(float x) { return 1.0f / (1.0f + __expf(-x)); }
__device__ __forceinline__ float wave_sum(float v) {
#pragma unroll
    for (int o = 1; o < 64; o <<= 1) v += __shfl_xor(v, o);
    return v;
}

#define XB_TMO      128
#define XB_XCNT(j)  (256  + 64 * (j))
#define XB_XSUB(j)  (1280 + 64 * (j))
#define XB_XGEN(j)  (2304 + 64 * (j))
#define XB_TOP      3328
#define XB_TOPGEN   3392
#define XCD_BAR_WORDS 3456
#define XB_SPIN_CAP (1u << 18)

__device__ __forceinline__ unsigned xb_ld(unsigned* p)              { return __hip_atomic_load(p, __ATOMIC_RELAXED, __HIP_MEMORY_SCOPE_AGENT); }
__device__ __forceinline__ unsigned xb_add(unsigned* p, unsigned v) { return __hip_atomic_fetch_add(p, v, __ATOMIC_RELAXED, __HIP_MEMORY_SCOPE_AGENT); }
__device__ __forceinline__ unsigned xb_xcc_id() { return (unsigned)__builtin_amdgcn_s_getreg((3 << 11) | 20) & 0xFu; }
#define XB_SPIN(cond, bar) do { unsigned _sp = 0; while (cond) { __builtin_amdgcn_s_sleep(1); \
    if ((++_sp & 255u) == 0u) { if (xb_ld(&(bar)[XB_TMO])) break; if (_sp > XB_SPIN_CAP) { atomicAdd(&(bar)[XB_TMO], 1u); break; } } } } while (0)

struct XcdBarrier {
    unsigned* bar; unsigned x;
    volatile LAS unsigned* st;
};
__device__ __forceinline__ bool xb_thread0(int wave_id) { return wave_id == 0 && lane_id_fresh() == 0; }
__device__ __forceinline__ XcdBarrier xcd_barrier_post(unsigned* bar, volatile LAS unsigned* st, int wave_id) {
    XcdBarrier b; b.bar = bar; b.x = xb_xcc_id(); b.st = st;
    if (xb_thread0(wave_id)) (void)xb_add(&bar[XB_XCNT(b.x)], 1u);
    return b;
}
__device__ __forceinline__ void xcd_barrier_complete(unsigned* bar, unsigned x, unsigned& nloc, unsigned& nx) {
    const unsigned G = gridDim.x * gridDim.y * gridDim.z;
    unsigned sum, cnt, mine, sp = 0u;
    for (;;) {
        sum = 0u; cnt = 0u; mine = 0u;
#pragma unroll
        for (unsigned j = 0; j < 16; ++j) { const unsigned c = xb_ld(&bar[XB_XCNT(j)]); sum += c; cnt += (c > 0u) ? 1u : 0u; mine = (j == x) ? c : mine; }
        if (sum == G) break;
        __builtin_amdgcn_s_sleep(1);
        if ((++sp & 255u) == 0u) { if (xb_ld(&bar[XB_TMO])) break; if (sp > XB_SPIN_CAP) { atomicAdd(&bar[XB_TMO], 1u); break; } }
    }
    nloc = mine > 0u ? mine : 1u; nx = cnt > 0u ? cnt : 1u;
}
__device__ __forceinline__ void xcd_barrier(const XcdBarrier& b, int wave_id) {
    asm volatile("s_waitcnt vmcnt(0)" ::: "memory");
    __syncthreads();
    if (xb_thread0(wave_id)) {
        unsigned* bar = b.bar;
        __builtin_amdgcn_s_waitcnt(0);
        unsigned nloc = b.st[0], nx = b.st[1];
        if (nloc == 0u) { xcd_barrier_complete(bar, b.x, nloc, nx); b.st[0] = nloc; b.st[1] = nx; }
        const unsigned old = xb_add(&bar[XB_XSUB(b.x)], 1u);
        const unsigned gen = old / nloc;
        if (old + 1u == (gen + 1u) * nloc) {
            __builtin_amdgcn_fence(__ATOMIC_RELEASE, "agent");
            asm volatile("s_waitcnt vmcnt(0)" ::: "memory");
            const unsigned og = xb_add(&bar[XB_TOP], 1u);
            const unsigned tg = og / nx;
            if (og + 1u == (tg + 1u) * nx) xb_add(&bar[XB_TOPGEN], 1u);
            else XB_SPIN(xb_ld(&bar[XB_TOPGEN]) == tg, bar);
            __builtin_amdgcn_fence(__ATOMIC_ACQUIRE, "agent");
            xb_add(&bar[XB_XGEN(b.x)], 1u);
            asm volatile("s_waitcnt vmcnt(0)" ::: "memory");
        } else {
            XB_SPIN(xb_ld(&bar[XB_XGEN(b.x)]) == gen, bar);
            __builtin_amdgcn_fence(__ATOMIC_ACQUIRE, "agent");
            asm volatile("s_waitcnt vmcnt(0)" ::: "memory");
        }
    }
    __syncthreads();
}


namespace attn_body {
using bf16=__hip_bfloat16;
using bf16x8=__attribute__((ext_vector_type(8)))short;
using s16x4=__attribute__((ext_vector_type(4)))short;
using f32x16=__attribute__((ext_vector_type(16)))float;
using u32x4=__attribute__((ext_vector_type(4)))unsigned;
using f32x4_t=__attribute__((ext_vector_type(4)))float;
constexpr int BATCH=16,NHEAD=8,SEQ=4096,D=64,DM=NHEAD*D;
constexpr int NW=8,QBLK=32,QB=QBLK*NW,KVBLK=64,NQB=SEQ/QB;
constexpr int ATTN_PITCH=DM, ATTN_UNIT_ROWS=QB;
__device__ __forceinline__ int crow(int r,int hi){return (r&3)+8*(r>>2)+4*hi;}
#define SBAR() __builtin_amdgcn_sched_barrier(0)
__device__ __forceinline__ void cmask(f32x16&p0,f32x16&p1,int jb,int qrel,int hi){
  const float NEG=-INFINITY; int kb=64*jb+4*hi;
  #pragma unroll
  for(int r=0;r<16;++r){int kv=kb+(r&3)+8*(r>>2); if(kv>qrel)p0[r]=NEG; if(kv+32>qrel)p1[r]=NEG;}
}

constexpr int NSLOT=3, SLOTB=8192;
constexpr int LDS_K=0, LDS_V=NSLOT*SLOTB, LDS_WS=2*NSLOT*SLOTB, LDS_OST=LDS_WS+NW*64*4, LDS_KB=LDS_OST+NW*4096, LDS_BYTES=LDS_KB+SEQ*4;
constexpr float C2=0.125f*1.4426950408889634f;
__device__ __forceinline__ void glds16(const void*gsrc,unsigned lds_dst){unsigned keep;
  asm volatile("s_mov_b32 %0, m0\n\ts_mov_b32 m0, %2\n\ts_nop 0\n\tglobal_load_lds_dwordx4 %1, off\n\ts_mov_b32 m0, %0":"=&s"(keep):"v"(gsrc),"s"(lds_dst):"memory");}
__device__ __forceinline__ float max3f(float a,float b,float c){float r;asm("v_max3_f32 %0, %1, %2, %3":"=v"(r):"v"(a),"v"(b),"v"(c));return r;}
__device__ __forceinline__ float max2f(float a,float b){float r;asm("v_max_f32_e32 %0, %1, %2":"=v"(r):"v"(a),"v"(b));return r;}
__device__ __forceinline__ float fadd_s(float a,float b){float r;asm("v_add_f32_e32 %0, %1, %2":"=v"(r):"v"(a),"v"(b));return r;}
__device__ __forceinline__ float fsub_s(float a,float b){float r;asm("v_sub_f32_e32 %0, %1, %2":"=v"(r):"v"(a),"v"(b));return r;}
typedef float f32x2_t __attribute__((ext_vector_type(2))); typedef __bf16 bf16x2_t __attribute__((ext_vector_type(2)));
__device__ __forceinline__ unsigned cvtpk_s(float lo,float hi){f32x2_t v={lo,hi};bf16x2_t b=__builtin_convertvector(v,bf16x2_t);return __builtin_bit_cast(unsigned,b);}
#define WAIT_BAR(N) asm volatile("s_waitcnt vmcnt(" #N ") lgkmcnt(0)\n\ts_barrier":::"memory")

__device__ __forceinline__ void qkt(f32x16&p0,f32x16&p1,const char*Kslot,const bf16x8*qr,const f32x16&negm,int r32,int hi){
  const char*kb=Kslot+hi*1024+r32*16;
  #pragma unroll
  for(int d0=0;d0<4;++d0){
    const bf16x8 b0=*reinterpret_cast<const bf16x8*>(kb+d0*2048);
    const bf16x8 b1=*reinterpret_cast<const bf16x8*>(kb+d0*2048+512);
    if(d0==0){p0=__builtin_amdgcn_mfma_f32_32x32x16_bf16(b0,qr[0],negm,0,0,0);p1=__builtin_amdgcn_mfma_f32_32x32x16_bf16(b1,qr[0],negm,0,0,0);}
    else{p0=__builtin_amdgcn_mfma_f32_32x32x16_bf16(b0,qr[d0],p0,0,0,0);p1=__builtin_amdgcn_mfma_f32_32x32x16_bf16(b1,qr[d0],p1,0,0,0);}}
}
typedef __attribute__((address_space(3))) const char* lds_cptr;
typedef short v4i16_t __attribute__((ext_vector_type(4)));
__device__ __forceinline__ void kload8(bf16x8*kf,lds_cptr kp){
  kf[0]=*(const __attribute__((address_space(3))) bf16x8*)(kp);      kf[1]=*(const __attribute__((address_space(3))) bf16x8*)(kp+512);
  kf[2]=*(const __attribute__((address_space(3))) bf16x8*)(kp+2048); kf[3]=*(const __attribute__((address_space(3))) bf16x8*)(kp+2560);
  kf[4]=*(const __attribute__((address_space(3))) bf16x8*)(kp+4096); kf[5]=*(const __attribute__((address_space(3))) bf16x8*)(kp+4608);
  kf[6]=*(const __attribute__((address_space(3))) bf16x8*)(kp+6144); kf[7]=*(const __attribute__((address_space(3))) bf16x8*)(kp+6656);
}
__device__ __forceinline__ void kload2(bf16x8*kf,lds_cptr kp,int j){ kf[2*j]=*(const __attribute__((address_space(3))) bf16x8*)(kp+j*2048); kf[2*j+1]=*(const __attribute__((address_space(3))) bf16x8*)(kp+j*2048+512); }
__device__ __forceinline__ s16x4 vtr(lds_cptr p){ return __builtin_bit_cast(s16x4,__builtin_amdgcn_ds_read_tr16_b64_v4i16((__attribute__((address_space(3))) v4i16_t*)p)); }
__device__ __forceinline__ float rowmax(const f32x16&p0,const f32x16&p1){
  float a=max3f(p0[0],p0[1],p1[0]),b=max3f(p0[2],p0[3],p1[1]);a=max3f(a,p1[2],p1[3]);
  #pragma unroll
  for(int r=4;r<16;r+=4){a=max3f(a,p0[r],p0[r+1]);b=max3f(b,p0[r+2],p0[r+3]);a=max3f(a,p1[r],p1[r+1]);b=max3f(b,p1[r+2],p1[r+3]);}
  const float m=max2f(a,b);
  auto rr=__builtin_amdgcn_permlane32_swap(__float_as_uint(m),__float_as_uint(m),false,false);
  return max2f(__uint_as_float(rr[0]),__uint_as_float(rr[1]));
}
__device__ __forceinline__ void pv(f32x16*o,int vb,bf16x8 pa0,bf16x8 pa1,bf16x8 pa2,bf16x8 pa3){
  #pragma unroll
  for(int d0=0;d0<2;++d0){s16x4 lo[4],hi[4];
    #pragma unroll
    for(int ks=0;ks<4;++ks){
      asm volatile("ds_read_b64_tr_b16 %0,%1 offset:%c2":"=&v"(lo[ks]):"v"(vb),"i"(d0*4096+ks*1024):"memory");
      asm volatile("ds_read_b64_tr_b16 %0,%1 offset:%c2":"=&v"(hi[ks]):"v"(vb),"i"(d0*4096+ks*1024+512):"memory");}
    asm volatile("s_waitcnt lgkmcnt(0)":::"memory");SBAR();
    #define PK(k) (bf16x8){lo[k][0],lo[k][1],lo[k][2],lo[k][3],hi[k][0],hi[k][1],hi[k][2],hi[k][3]}
    o[d0]=__builtin_amdgcn_mfma_f32_32x32x16_bf16(pa0,PK(0),o[d0],0,0,0);
    o[d0]=__builtin_amdgcn_mfma_f32_32x32x16_bf16(pa1,PK(1),o[d0],0,0,0);
    o[d0]=__builtin_amdgcn_mfma_f32_32x32x16_bf16(pa2,PK(2),o[d0],0,0,0);
    o[d0]=__builtin_amdgcn_mfma_f32_32x32x16_bf16(pa3,PK(3),o[d0],0,0,0);
    #undef PK
  }
}

#ifndef ATTN_STORE16
#define ATTN_STORE16(p,v) (*(u32x4*)(p)=(v))
#endif
template<int THRL> __device__ __forceinline__ void attn_unit(int b,int h,int qb,const bf16*Q,const bf16*__restrict__ K,const bf16*__restrict__ V,bf16*O,const float*Fh,char*shm,const int wave_id){
  const int tid_=lane_id_fresh()|(wave_id<<6);
  const int tid=tid_,lane=tid&63,r32=lane&31,hi=lane>>5; const int wid=__builtin_amdgcn_readfirstlane(tid>>6);
  const long rowbase=(long)b*SEQ; const int q0=qb*QB;
  const bf16*Qw=Q+(rowbase+q0+wid*QBLK)*DM+h*D;
  const bf16*Kh=K+rowbase*DM+h*D,*Vh=V+rowbase*DM+h*D;
  const lds_cptr shm3=(lds_cptr)shm;
  const unsigned lds0=(unsigned)(uintptr_t)shm;
  float*wsf=(float*)(shm+LDS_WS)+wid*64;
  const bf16*ksrc=Kh+(long)lane*DM+wid*8;
  const bf16*vsrc=Vh+(long)(16*(wid&3)+(lane>>2))*DM+(wid>>2)*32+(lane&3)*8;
  const unsigned kdst=lds0+LDS_K+wid*1024, vdst=lds0+LDS_V+wid*1024;
  #define DMA_K(t,slot) glds16(ksrc+(long)(t)*KVBLK*DM,(unsigned)__builtin_amdgcn_readfirstlane(kdst+(slot)))
  #define DMA_V(t,slot) glds16(vsrc+(long)(t)*KVBLK*DM,(unsigned)__builtin_amdgcn_readfirstlane(vdst+(slot)))
  const int vb0=(int)(lds0+LDS_V)+((lane>>4)&1)*32+(lane&3)*8+(4*hi+((lane&15)>>2))*64;
  const char*Kbase=shm+LDS_K; bf16x8 kf[8];
  const lds_cptr kp0=shm3+LDS_K+hi*1024+r32*16; const lds_cptr vp0=shm3+LDS_V+((lane>>4)&1)*32+(lane&3)*8+(4*hi+((lane&15)>>2))*64;
  const int NT=(q0+QB)/KVBLK;
  DMA_K(0,0);DMA_V(0,0);DMA_K(1,SLOTB);
  bf16x8 qr[4];
  #pragma unroll
  for(int d0=0;d0<4;++d0)qr[d0]=*reinterpret_cast<const bf16x8*>(&Qw[(long)r32*DM+d0*16+hi*8]);
  { const float fref=Fh[q0]; __attribute__((address_space(3))) float* kbt=(__attribute__((address_space(3))) float*)(shm3+LDS_KB);
    for(int k=tid;k<q0+QB;k+=NW*64) kbt[k]=(fref-Fh[k])*1.4426950408889634f; }
  const __attribute__((address_space(3))) float* kbp=(const __attribute__((address_space(3))) float*)(shm3+LDS_KB)+4*hi;
  #define BIAS(P0,P1,t) do{ const __attribute__((address_space(3))) float* kp_=kbp+(t)*KVBLK; \
    _Pragma("unroll") for(int j_=0;j_<4;++j_){ const f32x4_t b0_=*(const __attribute__((address_space(3))) f32x4_t*)(kp_+8*j_); const f32x4_t b1_=*(const __attribute__((address_space(3))) f32x4_t*)(kp_+32+8*j_); \
      P0[4*j_]+=b0_[0];P0[4*j_+1]+=b0_[1];P0[4*j_+2]+=b0_[2];P0[4*j_+3]+=b0_[3]; P1[4*j_]+=b1_[0];P1[4*j_+1]+=b1_[1];P1[4*j_+2]+=b1_[2];P1[4*j_+3]+=b1_[3]; } }while(0)
  float mhat=0.f,l_reg=0.f;f32x16 o[2];o[0]=f32x16{};o[1]=f32x16{};f32x16 negm=f32x16{};asm volatile("":"+v"(negm));
  const int qrel=wid*QBLK+r32;
  #define CMASK(P0,P1,t) do{int jb_=(t)-(NT-4); if(jb_>=0)cmask(P0,P1,jb_,qrel,hi);}while(0)
  bool resc=false;
  #define START(P0,P1) do{ const float rm=rowmax(P0,P1); resc=false; \
    { const float dl=rm; mhat=fadd_s(mhat,dl); \
      _Pragma("unroll") for(int r=0;r<16;++r){P0[r]=fsub_s(P0[r],dl);P1[r]=fsub_s(P1[r],dl);} \
      _Pragma("unroll") for(int r=0;r<16;++r)negm[r]=-mhat; asm volatile("":"+v"(negm)); } \
    _Pragma("unroll") for(int r=0;r<16;++r)P0[r]=__builtin_amdgcn_exp2f(P0[r]); }while(0)
  #define RESC() do{ if(resc){ asm volatile("s_waitcnt lgkmcnt(0)":::"memory"); \
      _Pragma("unroll") for(int d_=0;d_<2;++d_) _Pragma("unroll") for(int r=0;r<16;++r)o[d_][r]*=wsf[crow(r,hi)]; } }while(0)
  f32x16 pA0,pA1,pB0,pB1;
  int sl_prev=0,sl_cur=0,sl_next=SLOTB;
  #define ROT() do{sl_prev=sl_cur;sl_cur=sl_next;sl_next=(sl_next==(NSLOT-1)*SLOTB)?0:sl_next+SLOTB;}while(0)
  DMA_K(2,2*SLOTB);
  WAIT_BAR(3);
  qkt(pA0,pA1,Kbase,qr,negm,r32,hi);asm volatile("s_nop 15\n\ts_nop 7":"+v"(pA0),"+v"(pA1));BIAS(pA0,pA1,0);CMASK(pA0,pA1,0);
  START(pA0,pA1);
  _Pragma("unroll") for(int r=0;r<16;++r)pA1[r]=__builtin_amdgcn_exp2f(pA1[r]);
  WAIT_BAR(0);
  DMA_K(3,0);DMA_V(1,SLOTB);
  ROT();
  kload8(kf,kp0+sl_cur);
  WAIT_BAR(2);
  s16x4 vlo[8],vhi[8]; u32x4 pw0,pw1,pw2,pw3;
  #define PKW(P,B) cvtpk_s(P[B],P[B+1])
  #define PAF(k) __builtin_bit_cast(bf16x8,pw##k)
  #define VFR(i) (bf16x8){vlo[i][0],vlo[i][1],vlo[i][2],vlo[i][3],vhi[i][0],vhi[i][1],vhi[i][2],vhi[i][3]}
  #define PIN(x) asm volatile("":"+v"(x))
  #define MX3(a,b,c) __builtin_fmaxf(__builtin_fmaxf((a),(b)),(c))
  #define GAPA(MF,A0,A1,A2,A3,W0,W1,PW) do{ MF; sacc+=A0; sacc+=A1; sacc+=A2; sacc+=A3; PIN(sacc); W0; W1; PIN(PW); SBAR(); }while(0)
  #define EX(v) __builtin_amdgcn_exp2f(v)
  #define GAPB(MF,X,B) do{ MF; X[B]=EX(X[B]); X[B+1]=EX(X[B+1]); X[B+2]=EX(X[B+2]); X[B+3]=EX(X[B+3]); PIN(X); SBAR(); }while(0)
  #define VRD(i) do{ vlo[i]=vtr(vp_+(((i)>>2)*4096+((i)&3)*1024)); vhi[i]=vtr(vp_+(((i)>>2)*4096+((i)&3)*1024+512)); }while(0)
  #define KRD(G,j) do{ if(G){ kload2(kf,kp0+sl_next,j); SBAR(); } }while(0)
  #define STEP(C0,C1,P0,P1,t,GK,GV,GL) do{ SBAR(); \
    const lds_cptr vp_=vp0+sl_prev; \
    VRD(0); SBAR(); float sacc=(P0[0]+P0[1]); \
    GAPA(C0=__builtin_amdgcn_mfma_f32_32x32x16_bf16(kf[0],qr[0],negm,0,0,0), P0[2],P0[3],P0[4],P0[5],     pw0[0]=PKW(P0,0), pw0[1]=PKW(P0,2), pw0); \
    VRD(4); SBAR(); GAPA(C1=__builtin_amdgcn_mfma_f32_32x32x16_bf16(kf[1],qr[0],negm,0,0,0), P0[6],P0[7],P0[8],P0[9],     pw0[2]=PKW(P0,4), pw0[3]=PKW(P0,6), pw0); \
    VRD(1); SBAR(); GAPA(C0=__builtin_amdgcn_mfma_f32_32x32x16_bf16(kf[2],qr[1],C0,0,0,0),   P0[10],P0[11],P0[12],P0[13], pw1[0]=PKW(P0,8), pw1[1]=PKW(P0,10), pw1); \
    VRD(5); SBAR(); GAPA(C1=__builtin_amdgcn_mfma_f32_32x32x16_bf16(kf[3],qr[1],C1,0,0,0),   P0[14],P0[15],P1[0],P1[1],   pw1[2]=PKW(P0,12),pw1[3]=PKW(P0,14), pw1); \
    VRD(2); SBAR(); GAPA(C0=__builtin_amdgcn_mfma_f32_32x32x16_bf16(kf[4],qr[2],C0,0,0,0),   P1[2],P1[3],P1[4],P1[5],     pw2[0]=PKW(P1,0), pw2[1]=PKW(P1,2), pw2); \
    VRD(6); SBAR(); GAPA(C1=__builtin_amdgcn_mfma_f32_32x32x16_bf16(kf[5],qr[2],C1,0,0,0),   P1[6],P1[7],P1[8],P1[9],     pw2[2]=PKW(P1,4), pw2[3]=PKW(P1,6), pw2); \
    VRD(3); SBAR(); GAPA(C0=__builtin_amdgcn_mfma_f32_32x32x16_bf16(kf[6],qr[3],C0,0,0,0),   P1[10],P1[11],P1[12],P1[13], pw3[0]=PKW(P1,8), pw3[1]=PKW(P1,10), pw3); \
    VRD(7); SBAR(); GAPA(C1=__builtin_amdgcn_mfma_f32_32x32x16_bf16(kf[7],qr[3],C1,0,0,0),   P1[14],P1[15],0.f,0.f,       pw3[2]=PKW(P1,12),pw3[3]=PKW(P1,14), pw3); \
    l_reg+=sacc; \
    if(GK){DMA_K((t)+3,sl_cur);} if(GV){DMA_V((t)+1,sl_next);} \
    BIAS(C0,C1,t); CMASK(C0,C1,t); \
    { float a=MX3(C0[0],C0[1],C1[0]),b=MX3(C0[2],C0[3],C1[1]); a=MX3(a,C1[2],C1[3]); \
      _Pragma("unroll") for(int r=4;r<16;r+=4){a=MX3(a,C0[r],C0[r+1]);b=MX3(b,C0[r+2],C0[r+3]);a=MX3(a,C1[r],C1[r+1]);b=MX3(b,C1[r+2],C1[r+3]);} \
      float rm=__builtin_fmaxf(a,b); { auto rr=__builtin_amdgcn_permlane32_swap(__float_as_uint(rm),__float_as_uint(rm),false,false); rm=__builtin_fmaxf(__uint_as_float(rr[0]),__uint_as_float(rr[1])); } \
      resc=false; \
      if(__builtin_expect(__any(rm>(float)THRL),0)){ const float dl=__builtin_fmaxf(rm,0.f); mhat+=dl; \
        _Pragma("unroll") for(int r=0;r<16;++r){C0[r]-=dl;C1[r]-=dl;} \
        _Pragma("unroll") for(int r=0;r<16;++r)negm[r]=-mhat; asm volatile("":"+v"(negm)); \
        const float f=__builtin_amdgcn_exp2f(-dl); l_reg*=f; if(hi==0)wsf[r32]=f; resc=true; } } \
    SBAR(); \
    GAPB(o[0]=__builtin_amdgcn_mfma_f32_32x32x16_bf16(PAF(0),VFR(0),o[0],0,0,0), C0,0); \
    GAPB(o[1]=__builtin_amdgcn_mfma_f32_32x32x16_bf16(PAF(0),VFR(4),o[1],0,0,0), C0,4); \
    KRD(GL,0); GAPB(o[0]=__builtin_amdgcn_mfma_f32_32x32x16_bf16(PAF(1),VFR(1),o[0],0,0,0), C0,8); \
    KRD(GL,1); GAPB(o[1]=__builtin_amdgcn_mfma_f32_32x32x16_bf16(PAF(1),VFR(5),o[1],0,0,0), C0,12); \
    KRD(GL,2); GAPB(o[0]=__builtin_amdgcn_mfma_f32_32x32x16_bf16(PAF(2),VFR(2),o[0],0,0,0), C1,0); \
    KRD(GL,3); GAPB(o[1]=__builtin_amdgcn_mfma_f32_32x32x16_bf16(PAF(2),VFR(6),o[1],0,0,0), C1,4); \
    GAPB(o[0]=__builtin_amdgcn_mfma_f32_32x32x16_bf16(PAF(3),VFR(3),o[0],0,0,0), C1,8); \
    GAPB(o[1]=__builtin_amdgcn_mfma_f32_32x32x16_bf16(PAF(3),VFR(7),o[1],0,0,0), C1,12); \
    }while(0)
  int t=1;
  #undef CMASK
  #define CMASK(P0,P1,t) do{}while(0)
  for(;t+5<NT;t+=2){
    STEP(pB0,pB1,pA0,pA1,t,true,true,true);     WAIT_BAR(2); RESC(); ROT();
    STEP(pA0,pA1,pB0,pB1,t+1,true,true,true);   WAIT_BAR(2); RESC(); ROT();
  }
  #undef CMASK
  #define CMASK(P0,P1,t) do{int jb_=(t)-(NT-4); if(jb_>=0)cmask(P0,P1,jb_,qrel,hi);}while(0)
  #define ENDW(tt) do{ if((tt)+3<NT){WAIT_BAR(2);} else if((tt)+2<NT){WAIT_BAR(1);} else {WAIT_BAR(0);} }while(0)
  for(;t+1<NT;t+=2){
    STEP(pB0,pB1,pA0,pA1,t,(t+3<NT),(t+1<NT),(t+1<NT));       ENDW(t);   RESC(); ROT();
    STEP(pA0,pA1,pB0,pB1,t+1,(t+4<NT),(t+2<NT),(t+2<NT));     ENDW(t+1); RESC(); ROT();
  }
  STEP(pB0,pB1,pA0,pA1,NT-1,false,false,false); RESC();
  { float sacc=pB0[0]+pB0[1]; _Pragma("unroll") for(int r=2;r<16;++r)sacc+=pB0[r]; _Pragma("unroll") for(int r=0;r<16;++r)sacc+=pB1[r]; l_reg+=sacc;
    pw0=(u32x4){PKW(pB0,0),PKW(pB0,2),PKW(pB0,4),PKW(pB0,6)};pw1=(u32x4){PKW(pB0,8),PKW(pB0,10),PKW(pB0,12),PKW(pB0,14)};pw2=(u32x4){PKW(pB1,0),PKW(pB1,2),PKW(pB1,4),PKW(pB1,6)};pw3=(u32x4){PKW(pB1,8),PKW(pB1,10),PKW(pB1,12),PKW(pB1,14)};
    SBAR(); pv(o,vb0+sl_cur,PAF(0),PAF(1),PAF(2),PAF(3)); }
  #undef PKW
  #undef PAF
  #undef VFR
  #undef PIN
  #undef MX3
  #undef GAPA
  #undef GAPB
  #undef EX
  #undef VRD
  #undef KRD
  #undef STEP
  #undef ENDW
  {auto rr=__builtin_amdgcn_permlane32_swap(__float_as_uint(l_reg),__float_as_uint(l_reg),false,false);l_reg=__uint_as_float(rr[0])+__uint_as_float(rr[1]);}
  if(hi==0)wsf[32+r32]=l_reg;asm volatile("s_waitcnt lgkmcnt(0)":::"memory");
  float rli[16];
  #pragma unroll
  for(int r=0;r<16;++r)rli[r]=__builtin_amdgcn_rcpf(wsf[32+crow(r,hi)]);
  bf16*Ow=O+(rowbase+q0+wid*QBLK)*DM+h*D;
  { bf16*stg=(bf16*)(shm+LDS_OST)+wid*2048;
    #pragma unroll
    for(int r=0;r<16;++r){const int orow=crow(r,hi);
      #pragma unroll
      for(int d0=0;d0<2;++d0)stg[orow*64+d0*32+r32]=__float2bfloat16(o[d0][r]*rli[r]);}
    asm volatile("s_waitcnt lgkmcnt(0)":::"memory");
    #pragma unroll
    for(int i=0;i<4;++i){const int row=i*8+(lane>>3),ch=lane&7; const u32x4 v=*(const u32x4*)(stg+row*64+ch*8); ATTN_STORE16(Ow+(long)row*DM+ch*8,v);} }
  asm volatile("s_waitcnt lgkmcnt(0)\n\ts_barrier":::"memory");
  #undef BIAS
  #undef DMA_K
  #undef DMA_V
  #undef CMASK
  #undef START
  #undef RESC
  #undef ROT
}
constexpr int ATTN_LDS_BYTES=LDS_BYTES;
struct AttnTensors { const bf16* Q; const bf16* K; const bf16* V; bf16* O; const float* Fh; };
struct AttnUnit { int bh; int qb; };
struct StaticOrder {
  int vcu,G;
  __device__ __forceinline__ explicit StaticOrder(int grid,int block):vcu((grid%8==0)?(block%8)*(grid/8)+block/8:block),G(grid){}
  __device__ __forceinline__ bool next(int i,AttnUnit&u)const{ const int L=(i>>3)*G+vcu; if(L>=BATCH*NHEAD*2)return false; const int ii=i&7,s=4*(L&1)+(ii>>1); u.bh=L>>1; u.qb=(ii&1)?15-s:s; return true; }
  __device__ __forceinline__ void a_ready(const AttnUnit&)const{}
  __device__ __forceinline__ void done(const AttnUnit&)const{}
};
template<class Sched,int THRL=8> __device__ __forceinline__ void attn_phase(char*lds,const AttnTensors&T,const Sched&S,const int wave_id){
  AttnUnit u;
  for(int i=0;S.next(i,u);++i){ S.a_ready(u); attn_unit<THRL>(u.bh/NHEAD,u.bh%NHEAD,u.qb,T.Q,T.K,T.V,T.O,T.Fh+(size_t)u.bh*SEQ,lds,wave_id); S.done(u); }
}
#undef SBAR
#undef WAIT_BAR
}
typedef pg8::f32x4 A4;
typedef A4 AccT[2][2][4][2];

__device__ __forceinline__ float row_rstd(const float* ssq, int row) {
    const f32x4* p = (const f32x4*)(ssq + (size_t)row * 16);
    const f32x4 a = p[0], b = p[1], c = p[2], d = p[3];
    const float s = (((a.x + a.y) + (a.z + a.w)) + ((b.x + b.y) + (b.z + b.w))) + (((c.x + c.y) + (c.z + c.w)) + ((d.x + d.y) + (d.z + d.w)));
    return rsqrtf(s * (1.0f / 1024.0f) + EPS);
}
__device__ __forceinline__ v4u pack8(const A4& v0, const A4& v1) { v4u w; w.x = pk2(v0[0], v0[1]); w.y = pk2(v0[2], v0[3]); w.z = pk2(v1[0], v1[1]); w.w = pk2(v1[2], v1[3]); return w; }
__device__ __forceinline__ void unpack8(const v4u w, A4& v0, A4& v1) { v0 = (A4){bflo(w.x), bfhi(w.x), bflo(w.y), bfhi(w.y)}; v1 = (A4){bflo(w.z), bfhi(w.z), bflo(w.w), bfhi(w.w)}; }
__device__ __forceinline__ A4 sig4(const A4& z) { return (A4){sigmoidf_(z[0]), sigmoidf_(z[1]), sigmoidf_(z[2]), sigmoidf_(z[3])}; }
__device__ __forceinline__ float logsig(float z) { return fminf(z, 0.f) - __logf(1.0f + __expf(-fabsf(z))); }

struct EpiInProj {
    static constexpr bool PERM = true;
    unsigned char* outb; unsigned char* wsb; int layer;
    __device__ __forceinline__ void operator()(const AccT& acc, const pg8::Unit& u, int wr, int wc, int fr, int fq) const {
        const int pn = u.pn, row0 = u.pm * 256 + wr * 64 + fr, cw = wc * 32 + 8 * fq;
        bf16* const Q = (bf16*)(outb + DO_Q); bf16* const K = (bf16*)(outb + DO_K); bf16* const V = (bf16*)(outb + DO_V); bf16* const U = (bf16*)(outb + DO_U); bf16* const HC = (bf16*)(outb + DO_HC);
        bf16* const G = (bf16*)(wsb + WS_GATES); float* const logf = (float*)(wsb + WS_LOGF); const float* const bias = (const float*)(wsb + WS_BPERM) + layer * N_INP; const float* const ssq = (const float*)(wsb + WS_SSQ);
        float rs[2][4];
#pragma unroll
        for (int ai = 0; ai < 2; ++ai)
#pragma unroll
            for (int m = 0; m < 4; ++m) rs[ai][m] = row_rstd(ssq, row0 + ai * 128 + m * 16);
        A4 bv[2][2];
#pragma unroll
        for (int bj = 0; bj < 2; ++bj)
#pragma unroll
            for (int n = 0; n < 2; ++n) bv[bj][n] = *(const A4*)(bias + pn * 256 + bj * 128 + cw + 4 * n);
        if (pn == 7 || pn == 8) {
#pragma unroll
            for (int ai = 0; ai < 2; ++ai)
#pragma unroll
                for (int m = 0; m < 4; ++m) { const int row = row0 + ai * 128 + m * 16; const float r = rs[ai][m];
                    const A4 a0 = acc[ai][0][m][0] * r + bv[0][0], a1 = acc[ai][0][m][1] * r + bv[0][1], g0 = acc[ai][1][m][0] * r + bv[1][0], g1 = acc[ai][1][m][1] * r + bv[1][1];
                    *(v4u*)(HC + (size_t)row * 256 + (pn - 7) * 128 + cw) = pack8(a0 * sig4(g0), a1 * sig4(g1)); asm volatile("" ::: "memory"); }
        } else if (pn == 21) {
            if (wc == 0 && fq == 0) {
#pragma unroll
                for (int ai = 0; ai < 2; ++ai)
#pragma unroll
                    for (int m = 0; m < 4; ++m) { const int row = row0 + ai * 128 + m * 16; const float r = rs[ai][m];
                        const A4 z0 = acc[ai][0][m][0] * r + bv[0][0], z1 = acc[ai][0][m][1] * r + bv[0][1];
                        *(A4*)(logf + (size_t)row * 8) = (A4){logsig(z0[0]), logsig(z0[1]), logsig(z0[2]), logsig(z0[3])};
                        *(A4*)(logf + (size_t)row * 8 + 4) = (A4){logsig(z1[0]), logsig(z1[1]), logsig(z1[2]), logsig(z1[3])}; }
            }
        } else {
            bf16* base; int ld, col0; float sc = 1.f; bool sg = false;
            if (pn < 6) { base = pn < 2 ? Q : (pn < 4 ? K : V); ld = 512; col0 = (pn & 1) * 256; sc = pn < 2 ? QSCALE : 1.f; }
            else if (pn == 6) { base = U; ld = 256; col0 = 0; }
            else { base = G; ld = 3072; col0 = (pn - 9) * 256; sg = true; }
#pragma unroll
            for (int ai = 0; ai < 2; ++ai)
#pragma unroll
                for (int m = 0; m < 4; ++m) { const int row = row0 + ai * 128 + m * 16; const float r = rs[ai][m]; bf16* rowp = base + (size_t)row * ld + col0 + cw;
#pragma unroll
                    for (int bj = 0; bj < 2; ++bj) { A4 v0 = acc[ai][bj][m][0] * r + bv[bj][0], v1 = acc[ai][bj][m][1] * r + bv[bj][1];
                        if (sg) { v0 = sig4(v0); v1 = sig4(v1); }
                        v0 = v0 * sc; v1 = v1 * sc; *(v4u*)(rowp + bj * 128) = pack8(v0, v1); } asm volatile("" ::: "memory"); }
        }
    }
};

template <bool MOE> struct EpiSwiGlu {
    static constexpr bool PERM = true;
    bf16* Hd; int ldh; const float* rsrc;
    __device__ __forceinline__ void operator()(const AccT& acc, const pg8::Unit& u, int wr, int wc, int fr, int fq) const {
        const int row0 = u.pm * 256 + wr * 64 + fr, cw = wc * 32 + 8 * fq;
        float rs[2][4];
#pragma unroll
        for (int ai = 0; ai < 2; ++ai)
#pragma unroll
            for (int m = 0; m < 4; ++m) { const int row = row0 + ai * 128 + m * 16; rs[ai][m] = MOE ? rsrc[row] : row_rstd(rsrc, row); }
#pragma unroll
        for (int ai = 0; ai < 2; ++ai)
#pragma unroll
            for (int m = 0; m < 4; ++m) { const int row = row0 + ai * 128 + m * 16; const float r = rs[ai][m];
                A4 o[2];
#pragma unroll
                for (int n = 0; n < 2; ++n) { const A4 g = acc[ai][0][m][n] * r, up = acc[ai][1][m][n] * r; o[n] = g * sig4(g) * up; }
                *(v4u*)(Hd + (size_t)row * ldh + u.pn * 128 + cw) = pack8(o[0], o[1]); asm volatile("" ::: "memory"); }
    }
};
struct EpiGluSsm {
    static constexpr bool PERM = true;
    bf16* O;
    __device__ __forceinline__ void operator()(const AccT& acc, const pg8::Unit& u, int wr, int wc, int fr, int fq) const {
        const int row0 = u.pm * 256 + wr * 64 + fr, cw = wc * 32 + 8 * fq;
#pragma unroll
        for (int ai = 0; ai < 2; ++ai)
#pragma unroll
            for (int m = 0; m < 4; ++m) { const int row = row0 + ai * 128 + m * 16;
                *(v4u*)(O + (size_t)row * 256 + u.pn * 128 + cw) = pack8(acc[ai][0][m][0] * sig4(acc[ai][1][m][0]), acc[ai][0][m][1] * sig4(acc[ai][1][m][1])); }
    }
};
template <int I> struct EpiMerge {
    static constexpr bool PERM = true;
    const bf16* G; bf16* Mg;
    __device__ __forceinline__ void operator()(const AccT& acc, const pg8::Unit& u, int wr, int wc, int fr, int fq) const {
        const int row0 = u.pm * 256 + wr * 64 + fr, col0 = u.pn * 256 + wc * 32 + 8 * fq;
        v4u gl[3][2], ol[3][2];
#define MG_LOAD(buf, grp) do { const int row_ = row0 + ((grp) >> 2) * 128 + ((grp) & 3) * 16; _Pragma("unroll") for (int bj = 0; bj < 2; ++bj) { \
            gl[buf][bj] = *(const v4u*)(G + (size_t)row_ * 3072 + I * 1024 + col0 + bj * 128); if (I > 0) ol[buf][bj] = *(const v4u*)(Mg + (size_t)row_ * 1024 + col0 + bj * 128); } } while (0)
        MG_LOAD(0, 0); MG_LOAD(1, 1);
#pragma unroll
        for (int grp = 0; grp < 8; ++grp) {
            if (grp + 2 < 8) MG_LOAD((grp + 2) % 3, grp + 2);
            asm volatile("" ::: "memory");
            const int ai = grp >> 2, m = grp & 3, row = row0 + ai * 128 + m * 16;
#pragma unroll
            for (int bj = 0; bj < 2; ++bj) { A4 g0, g1; unpack8(gl[grp % 3][bj], g0, g1);
                A4 v0 = g0 * acc[ai][bj][m][0], v1 = g1 * acc[ai][bj][m][1];
                if (I > 0) { A4 o0, o1; unpack8(ol[grp % 3][bj], o0, o1); v0 = v0 + o0; v1 = v1 + o1; }
                *(v4u*)(Mg + (size_t)row * 1024 + col0 + bj * 128) = pack8(v0, v1); }
        }
#undef MG_LOAD
    }
};
struct EpiResid {
    static constexpr bool PERM = true;
    bf16* X; float* ssq;
    __device__ __forceinline__ void operator()(const AccT& acc, const pg8::Unit& u, int wr, int wc, int fr, int fq) const {
        const int row0 = u.pm * 256 + wr * 64 + fr, col0 = u.pn * 256 + wc * 32 + 8 * fq;
        v4u ol[3][2];
#define RS_LOAD(buf, grp) do { const int row_ = row0 + ((grp) >> 2) * 128 + ((grp) & 3) * 16; _Pragma("unroll") for (int bj = 0; bj < 2; ++bj) ol[buf][bj] = *(const v4u*)(X + (size_t)row_ * 1024 + col0 + bj * 128); } while (0)
        RS_LOAD(0, 0); RS_LOAD(1, 1);
#pragma unroll
        for (int grp = 0; grp < 8; ++grp) {
            if (grp + 2 < 8) RS_LOAD((grp + 2) % 3, grp + 2);
            asm volatile("" ::: "memory");
            const int ai = grp >> 2, m = grp & 3, row = row0 + ai * 128 + m * 16; float ss = 0.f;
#pragma unroll
            for (int bj = 0; bj < 2; ++bj) { A4 o0, o1; unpack8(ol[grp % 3][bj], o0, o1); o0 = o0 + acc[ai][bj][m][0]; o1 = o1 + acc[ai][bj][m][1];
                const v4u w = pack8(o0, o1); *(v4u*)(X + (size_t)row * 1024 + col0 + bj * 128) = w; unpack8(w, o0, o1);
                ss += (o0[0] * o0[0] + o0[1] * o0[1]) + (o0[2] * o0[2] + o0[3] * o0[3]) + (o1[0] * o1[0] + o1[1] * o1[1]) + (o1[2] * o1[2] + o1[3] * o1[3]); }
            ss += __shfl_xor(ss, 16); ss += __shfl_xor(ss, 32);
            if (fq == 0) ssq[(size_t)row * 16 + u.pn * 4 + wc] = ss;
        }
#undef RS_LOAD
    }
};
struct EpiMoeDown {
    static constexpr bool PERM = true;
    bf16* Y; const int* rdest; const float* rw;
    __device__ __forceinline__ void operator()(const AccT& acc, const pg8::Unit& u, int wr, int wc, int fr, int fq) const {
        const int row0 = u.pm * 256 + wr * 64 + fr, cw = wc * 32 + 8 * fq;
        int ds[2][4]; float wsv[2][4];
#pragma unroll
        for (int ai = 0; ai < 2; ++ai)
#pragma unroll
            for (int m = 0; m < 4; ++m) { const int row = row0 + ai * 128 + m * 16; ds[ai][m] = rdest[row]; wsv[ai][m] = rw[row]; }
#pragma unroll
        for (int ai = 0; ai < 2; ++ai)
#pragma unroll
            for (int m = 0; m < 4; ++m) { const int dest = ds[ai][m]; const float w = wsv[ai][m];
                if (dest >= 0) {
#pragma unroll
                    for (int bj = 0; bj < 2; ++bj) *(v4u*)(Y + (size_t)dest * 1024 + u.pn * 256 + bj * 128 + cw) = pack8(acc[ai][bj][m][0] * w, acc[ai][bj][m][1] * w); }
                asm volatile("" ::: "memory"); }
    }
};
struct MoeOrder {
    pg8::StaticOrder so; int tile0, a_tile_off, b_rows; int s1, s2, s3, s4, s5, s6, s7;
    __device__ __forceinline__ bool next(int i, pg8::Unit& u) const {
        if (!so.next(i, u)) return false;
        const int gt = tile0 + u.pm;
        const int e = (gt >= s1) + (gt >= s2) + (gt >= s3) + (gt >= s4) + (gt >= s5) + (gt >= s6) + (gt >= s7);
        u.arow = (a_tile_off + u.pm) * 256; u.brow = e * b_rows + u.pn * 256; return true;
    }
};
struct Args { const float* in[31]; unsigned char* out; unsigned char* ws; int ph_lo, ph_hi, use_bar, pad; };
struct Frame {
    LAS unsigned char* lds;
    volatile LAS unsigned* MISC;
    gu32* ctl;
    int tid, lane, wave, G, gw, NGW;
};

__device__ __forceinline__ int inproj_dest(int n) {
    if (n < 1536) return n;
    if (n < 1544) return 5376 + (n - 1536);
    if (n < 1800) return 1536 + (n - 1544);
    if (n < 2056) { const int c = n - 1800; return 1792 + (c >> 7) * 256 + (c & 127); }
    if (n < 2312) { const int c = n - 2056; return 1792 + (c >> 7) * 256 + 128 + (c & 127); }
    return 2304 + (n - 2312);
}
__device__ __forceinline__ int inproj_src(int d) {
    if (d < 1536) return d;
    if (d < 1792) return 1544 + (d - 1536);
    if (d < 2304) { const int t = (d - 1792) >> 8, r = (d - 1792) & 255; return r < 128 ? 1800 + t * 128 + r : 2056 + t * 128 + (r - 128); }
    if (d < 5376) return 2312 + (d - 2304);
    return (d - 5376) < 8 ? 1536 + (d - 5376) : -1;
}
__device__ __forceinline__ int map_row(int kind, int off, int n) {
    if (kind == 0) return n + off;
    if (kind == 1) return (n >> 7) * 256 + (n & 127) + off;
    if (kind == 2) { const int j = n & 255; return (j >> 7) * 256 + (j & 127) + ((n >> 8) ? 128 : 0); }
    return inproj_dest(n);
}
__device__ __forceinline__ void cvt_item(const float* W, int K, int N, const float* gk, bf16* WT, int kind, int off, LAS float* scr, int item, int lane) {
    const int nblk = (N + 31) >> 5, kb = item / nblk, nb = item - kb * nblk, k0 = 64 * kb, n0 = 32 * nb;
    const int n = n0 + (lane & 31);
#pragma unroll 8
    for (int i = 0; i < 32; ++i) { const int kk = 2 * i + (lane >> 5); float v = 0.f;
        if (n < N) { v = W[(size_t)(k0 + kk) * N + n]; if (gk) v *= gk[k0 + kk]; }
        scr[kk * 33 + (lane & 31)] = v; }
    LDS_WAIT(); asm volatile("" ::: "memory");
    const int c = lane & 7;
#pragma unroll
    for (int j = 0; j < 4; ++j) { const int nl = (lane >> 3) + 8 * j; const int nn = n0 + nl; const LAS float* s = scr + (8 * c) * 33 + nl;
        if (nn < N) { v4u o; o.x = pk2(s[0 * 33], s[1 * 33]); o.y = pk2(s[2 * 33], s[3 * 33]); o.z = pk2(s[4 * 33], s[5 * 33]); o.w = pk2(s[6 * 33], s[7 * 33]);
            *(v4u*)(WT + (size_t)map_row(kind, off, nn) * K + k0 + 8 * c) = o; } }
    LDS_WAIT(); asm volatile("" ::: "memory");
}
__device__ __forceinline__ void cvt_job(const float* W, int K, int N, const float* gk, bf16* WT, int kind, int off, LAS float* scr, int lane, int& base, int gwl, int ngw) {
    const int items = (K >> 6) * ((N + 31) >> 5);
    const int first = (gwl - (base % ngw) + ngw) % ngw;
    for (int it = first; it < items; it += ngw) cvt_item(W, K, N, gk, WT, kind, off, scr, it, lane);
    base += items;
}
__device__ __forceinline__ void cvt_moe_layer(const Args& a, int i, int l, LAS float* scr, int lane, int gwl, int ngw) {
    bf16* wgu = (bf16*)(a.ws + WS_WMOE + WMOE_GU); bf16* wd = (bf16*)(a.ws + WS_WMOE + WMOE_D); int base = 0;
    for (int e = 0; e < NE; ++e) {
        const size_t wo = (size_t)(i * NE + e) * D * D_FFE;
        cvt_job(a.in[27] + wo, D, D_FFE, a.in[21] + l * D, wgu + (size_t)e * 7168 * D, 1, 0, scr, lane, base, gwl, ngw);
        cvt_job(a.in[28] + wo, D, D_FFE, a.in[21] + l * D, wgu + (size_t)e * 7168 * D, 1, 128, scr, lane, base, gwl, ngw);
        cvt_job(a.in[29] + wo, D_FFE, D, nullptr, wd + (size_t)e * D * D_FFE, 0, 0, scr, lane, base, gwl, ngw);
    }
}

__device__ __forceinline__ void p0_prologue(Frame& F, const Args& a) {
    LAS float* scr = (LAS float*)(F.lds + RING_OFF + F.wave * 16384);
    int base = 0;
    for (int l = 0; l < DEPTH; ++l) {
        unsigned char* wm = a.ws + WS_WMIX + (size_t)l * WMIX_STRIDE;
        cvt_job(a.in[2] + (size_t)l * D * N_IN, D, N_IN, a.in[1] + l * D, (bf16*)(wm + WM_IN), 3, 0, scr, F.lane, base, F.gw, F.NGW);
        cvt_job(a.in[12] + (size_t)l * 256 * 512, 256, 512, nullptr, (bf16*)(wm + WM_GLU), 2, 0, scr, F.lane, base, F.gw, F.NGW);
        cvt_job(a.in[17] + (size_t)l * 512 * D, 512, D, nullptr, (bf16*)(wm + WM_A), 0, 0, scr, F.lane, base, F.gw, F.NGW);
        cvt_job(a.in[18] + (size_t)l * 256 * D, 256, D, nullptr, (bf16*)(wm + WM_S), 0, 0, scr, F.lane, base, F.gw, F.NGW);
        cvt_job(a.in[19] + (size_t)l * 256 * D, 256, D, nullptr, (bf16*)(wm + WM_C), 0, 0, scr, F.lane, base, F.gw, F.NGW);
        cvt_job(a.in[20] + (size_t)l * D * D, D, D, nullptr, (bf16*)(wm + WM_O), 0, 0, scr, F.lane, base, F.gw, F.NGW);
    }
    for (int i = 0; i < 2; ++i) {
        unsigned char* wd = a.ws + WS_WDENSE + (size_t)i * WDENSE_STRIDE;
        cvt_job(a.in[22] + (size_t)i * D * D_FF, D, D_FF, a.in[21] + (2 * i) * D, (bf16*)(wd + WD_GU), 1, 0, scr, F.lane, base, F.gw, F.NGW);
        cvt_job(a.in[23] + (size_t)i * D * D_FF, D, D_FF, a.in[21] + (2 * i) * D, (bf16*)(wd + WD_GU), 1, 128, scr, F.lane, base, F.gw, F.NGW);
        cvt_job(a.in[24] + (size_t)i * D_FF * D, D_FF, D, nullptr, (bf16*)(wd + WD_D), 0, 0, scr, F.lane, base, F.gw, F.NGW);
    }
    float* bperm = (float*)(a.ws + WS_BPERM);
    for (int idx = F.gw * 64 + F.lane; idx < DEPTH * N_INP; idx += F.NGW * 64) { const int l = idx / N_INP, d = idx - l * N_INP, n = inproj_src(d); bperm[idx] = n >= 0 ? a.in[3][l * N_IN + n] : 0.f; }
    bf16* xb = (bf16*)(a.ws + WS_XB); float* ssq = (float*)(a.ws + WS_SSQ);
    for (int m = F.gw; m < M; m += F.NGW) {
        const f32x4* xr = (const f32x4*)(a.in[0] + (size_t)m * D) + F.lane; float ss = 0.f;
#pragma unroll
        for (int j = 0; j < 4; ++j) { const f32x4 v = xr[64 * j]; v2u w; w.x = pk2(v.x, v.y); w.y = pk2(v.z, v.w);
            *(v2u*)(xb + (size_t)m * D + 256 * j + 4 * F.lane) = w;
            const float a0 = bflo(w.x), a1 = bfhi(w.x), a2 = bflo(w.y), a3 = bfhi(w.y); ss += (a0 * a0 + a1 * a1) + (a2 * a2 + a3 * a3); }
        const float tot = wave_sum(ss);
        if (F.lane < 16) ssq[(size_t)m * 16 + F.lane] = F.lane == 0 ? tot : 0.f;
    }
}

__device__ __forceinline__ void t1_cumsum(const Args& a, int bh, int lane) {
    const float* logf = (const float*)(a.ws + WS_LOGF); float* Fh = (float*)(a.ws + WS_FH);
    const int b = bh >> 3, h = bh & 7; const float* p = logf + ((size_t)b * SEQ + 64 * lane) * 8 + h;
    float s = 0.f;
    for (int j = 0; j < 64; ++j) s += p[j * 8];
    float v = s;
#pragma unroll
    for (int o = 1; o < 64; o <<= 1) { const float t = __shfl_up(v, o); if (lane >= o) v += t; }
    float run = v - s; float* o = Fh + (size_t)bh * SEQ + 64 * lane;
    for (int j = 0; j < 64; ++j) { run += p[j * 8]; o[j] = run; }
}
__device__ __forceinline__ void t1_conv(const Args& a, int l, int blk, int lane) {
    const bf16* HC = (const bf16*)(a.out + DO_HC); bf16* CO = (bf16*)(a.ws + WS_CONVO);
    const float* cw = a.in[13] + (size_t)l * CONV_K * CONV_W + 4 * lane;
    const f32x4 cb = *(const f32x4*)(a.in[14] + l * CONV_W + 4 * lane), lg = *(const f32x4*)(a.in[15] + l * CONV_W + 4 * lane), lb = *(const f32x4*)(a.in[16] + l * CONV_W + 4 * lane);
    for (int i = 0; i < 32; ++i) {
        const int m = blk * 32 + i, tl = m & (SEQ - 1);
        f32x4 y = cb;
        for (int k = 0; k < CONV_K; ++k) { const int tt = tl - (CONV_K - 1) + k;
            if (tt >= 0) { const v2u hv = *(const v2u*)(HC + (size_t)(m - (CONV_K - 1) + k) * CONV_W + 4 * lane); const f32x4 w = *(const f32x4*)(cw + k * CONV_W);
                y.x += w.x * bflo(hv.x); y.y += w.y * bfhi(hv.x); y.z += w.z * bflo(hv.y); y.w += w.w * bfhi(hv.y); } }
        const float mu = wave_sum((y.x + y.y) + (y.z + y.w)) * (1.f / 256.f);
        const f32x4 dl = y - mu;
        const float var = wave_sum((dl.x * dl.x + dl.y * dl.y) + (dl.z * dl.z + dl.w * dl.w)) * (1.f / 256.f);
        const float rs = rsqrtf(var + EPS);
        f32x4 z = dl * rs * lg + lb;
        z.x *= sigmoidf_(z.x); z.y *= sigmoidf_(z.y); z.z *= sigmoidf_(z.z); z.w *= sigmoidf_(z.w);
        v2u o; o.x = pk2(z.x, z.y); o.y = pk2(z.z, z.w);
        *(v2u*)(CO + (size_t)m * CONV_W + 4 * lane) = o;
    }
}
__device__ __forceinline__ float gelu_tanh(float y) {
    const float z = 0.7978845608028654f * (y + 0.044715f * y * y * y);
    const float th = 1.0f - 2.0f / (__expf(2.0f * z) + 1.0f);
    return 0.5f * y * (1.0f + th);
}
__device__ __forceinline__ void t1_ssm_scan(const Args& a, int l, int b, int g, int lane) {
    const bf16* U = (const bf16*)(a.out + DO_U); bf16* YG = (bf16*)(a.ws + WS_YG);
    const int lg = l * SSM_G + g, p = lane;
    const float lam_re = a.in[4][lg * SSM_P + p], lam_im = a.in[5][lg * SSM_P + p], dt = expf(a.in[6][lg]);
    const float mag = expf(lam_re * dt); float sn, cs; sincosf(lam_im * dt, &sn, &cs);
    const float ar = mag * cs, ai = mag * sn;
    const float nr = ar - 1.0f, ni = ai, den = lam_re * lam_re + lam_im * lam_im;
    const float cr = (nr * lam_re + ni * lam_im) / den, ci = (ni * lam_re - nr * lam_im) / den;
    float br[16], bi[16], cre[16], cim[16], dq[16];
#pragma unroll
    for (int h = 0; h < 16; ++h) {
        const float bre = a.in[7][((size_t)lg * SSM_P + p) * SSM_H + h], bim = a.in[8][((size_t)lg * SSM_P + p) * SSM_H + h];
        br[h] = cr * bre - ci * bim; bi[h] = cr * bim + ci * bre;
        cre[h] = a.in[9][((size_t)lg * SSM_H + h) * SSM_P + p]; cim[h] = a.in[10][((size_t)lg * SSM_H + h) * SSM_P + p];
        dq[h] = lane == 0 ? a.in[11][lg * SSM_H + h] : 0.f;
    }
    float xr = 0.f, xi = 0.f;
    const bf16* up = U + (size_t)b * SEQ * SSM_W + 16 * g;
    bf16* yp = YG + (size_t)b * SEQ * SSM_W + 16 * g + (lane >> 2);
    const bool b5 = (lane & 32) != 0, b4 = (lane & 16) != 0, b3 = (lane & 8) != 0, b2 = (lane & 4) != 0;
    v4u c0 = *(const v4u*)(up + (size_t)lane * SSM_W), c1 = *(const v4u*)(up + (size_t)lane * SSM_W + 8);
    for (int blk = 0; blk < SEQ / 64; ++blk) {
        v4u n0 = c0, n1 = c1;
        if (blk + 1 < SEQ / 64) { n0 = *(const v4u*)(up + (size_t)((blk + 1) * 64 + lane) * SSM_W); n1 = *(const v4u*)(up + (size_t)((blk + 1) * 64 + lane) * SSM_W + 8); }
#pragma unroll 2
        for (int j = 0; j < 64; ++j) {
            unsigned w[8];
            w[0] = __builtin_amdgcn_readlane(c0.x, j); w[1] = __builtin_amdgcn_readlane(c0.y, j); w[2] = __builtin_amdgcn_readlane(c0.z, j); w[3] = __builtin_amdgcn_readlane(c0.w, j);
            w[4] = __builtin_amdgcn_readlane(c1.x, j); w[5] = __builtin_amdgcn_readlane(c1.y, j); w[6] = __builtin_amdgcn_readlane(c1.z, j); w[7] = __builtin_amdgcn_readlane(c1.w, j);
            float u[16];
#pragma unroll
            for (int k = 0; k < 8; ++k) { u[2 * k] = bflo(w[k]); u[2 * k + 1] = bfhi(w[k]); }
            float bur = 0.f, bui = 0.f;
#pragma unroll
            for (int h = 0; h < 16; ++h) { bur += br[h] * u[h]; bui += bi[h] * u[h]; }
            const float nxr = ar * xr - ai * xi + bur, nxi = ar * xi + ai * xr + bui; xr = nxr; xi = nxi;
            float v[16];
#pragma unroll
            for (int h = 0; h < 16; ++h) v[h] = cre[h] * xr - cim[h] * xi + dq[h] * u[h];
            float w8[8], w4[4], w2[2];
#pragma unroll
            for (int i = 0; i < 8; ++i) { const float keep = b5 ? v[i + 8] : v[i], send = b5 ? v[i] : v[i + 8]; w8[i] = keep + __shfl_xor(send, 32); }
#pragma unroll
            for (int i = 0; i < 4; ++i) { const float keep = b4 ? w8[i + 4] : w8[i], send = b4 ? w8[i] : w8[i + 4]; w4[i] = keep + __shfl_xor(send, 16); }
#pragma unroll
            for (int i = 0; i < 2; ++i) { const float keep = b3 ? w4[i + 2] : w4[i], send = b3 ? w4[i] : w4[i + 2]; w2[i] = keep + __shfl_xor(send, 8); }
            float w1; { const float keep = b2 ? w2[1] : w2[0], send = b2 ? w2[0] : w2[1]; w1 = keep + __shfl_xor(send, 4); }
            w1 += __shfl_xor(w1, 2); w1 += __shfl_xor(w1, 1);
            if ((lane & 3) == 0) yp[(size_t)(blk * 64 + j) * SSM_W] = (bf16)f2bf(gelu_tanh(w1));
        }
        c0 = n0; c1 = n1;
    }
}

__device__ __forceinline__ void attn_naive_unit(const Args& a, int bh, int qb, int lane) {
    bf16* Q = (bf16*)(a.out + DO_Q); const bf16* Kb = (const bf16*)(a.out + DO_K); const bf16* Vb = (const bf16*)(a.out + DO_V);
    const float* Fh = (const float*)(a.ws + WS_FH) + (size_t)bh * SEQ;
    const int b = bh >> 3, h = bh & 7, i = qb * 32 + (lane >> 1), hf = lane & 1;
    bf16* qp = Q + ((size_t)b * SEQ + i) * ATT_W + h * HD + 32 * hf;
    float q[32], o[32];
#pragma unroll
    for (int c = 0; c < 4; ++c) { const v4u w = *(const v4u*)(qp + 8 * c); q[8 * c] = bflo(w.x); q[8 * c + 1] = bfhi(w.x); q[8 * c + 2] = bflo(w.y); q[8 * c + 3] = bfhi(w.y); q[8 * c + 4] = bflo(w.z); q[8 * c + 5] = bfhi(w.z); q[8 * c + 6] = bflo(w.w); q[8 * c + 7] = bfhi(w.w); }
#pragma unroll
    for (int d = 0; d < 32; ++d) o[d] = 0.f;
    const float Fi = Fh[i] * LOG2E; float mx = -INFINITY, lsum = 0.f;
    const int nk = qb * 32 + 32;
    const bf16* kp = Kb + (size_t)b * SEQ * ATT_W + h * HD + 32 * hf; const bf16* vp = Vb + (size_t)b * SEQ * ATT_W + h * HD + 32 * hf;
    for (int j = 0; j < nk; ++j) {
        float s = 0.f;
#pragma unroll
        for (int c = 0; c < 4; ++c) { const v4u w = *(const v4u*)(kp + (size_t)j * ATT_W + 8 * c);
            s += q[8 * c] * bflo(w.x) + q[8 * c + 1] * bfhi(w.x) + q[8 * c + 2] * bflo(w.y) + q[8 * c + 3] * bfhi(w.y) + q[8 * c + 4] * bflo(w.z) + q[8 * c + 5] * bfhi(w.z) + q[8 * c + 6] * bflo(w.w) + q[8 * c + 7] * bfhi(w.w); }
        s += __shfl_xor(s, 1);
        s += Fi - Fh[j] * LOG2E;
        if (j > i) s = -INFINITY;
        const float mn = fmaxf(mx, s), corr = __builtin_amdgcn_exp2f(mx - mn), pr = __builtin_amdgcn_exp2f(s - mn);
        mx = mn; lsum = lsum * corr + pr;
#pragma unroll
        for (int c = 0; c < 4; ++c) { const v4u w = *(const v4u*)(vp + (size_t)j * ATT_W + 8 * c);
            o[8 * c] = o[8 * c] * corr + pr * bflo(w.x); o[8 * c + 1] = o[8 * c + 1] * corr + pr * bfhi(w.x); o[8 * c + 2] = o[8 * c + 2] * corr + pr * bflo(w.y); o[8 * c + 3] = o[8 * c + 3] * corr + pr * bfhi(w.y);
            o[8 * c + 4] = o[8 * c + 4] * corr + pr * bflo(w.z); o[8 * c + 5] = o[8 * c + 5] * corr + pr * bfhi(w.z); o[8 * c + 6] = o[8 * c + 6] * corr + pr * bflo(w.w); o[8 * c + 7] = o[8 * c + 7] * corr + pr * bfhi(w.w); }
    }
    const float il = 1.0f / lsum;
#pragma unroll
    for (int c = 0; c < 4; ++c) { v4u w; w.x = pk2(o[8 * c] * il, o[8 * c + 1] * il); w.y = pk2(o[8 * c + 2] * il, o[8 * c + 3] * il); w.z = pk2(o[8 * c + 4] * il, o[8 * c + 5] * il); w.w = pk2(o[8 * c + 6] * il, o[8 * c + 7] * il); *(v4u*)(qp + 8 * c) = w; }
}
__device__ __forceinline__ void attn_naive(Frame& F, const Args& a) {
    for (int wt = F.gw; wt < BATCH * NH * 16; wt += F.NGW) {
        const int bh = wt >> 4, r = wt & 15;
        for (int ui = 0; ui < 8; ++ui) { const int pr_ = ui >> 1, qb = (ui & 1) ? (127 - 16 * pr_ - r) : (16 * pr_ + r); attn_naive_unit(a, bh, qb, F.lane); }
    }
}

__device__ __forceinline__ void moe_route(Frame& F, const Args& a, int l, int i) {
    const bf16* xb = (const bf16*)(a.ws + WS_XB); const float* ssq = (const float*)(a.ws + WS_SSQ);
    int* toke = (int*)(a.ws + WS_TOKE); float* tokw = (float*)(a.ws + WS_TOKW); int* cntw = (int*)(a.ws + WS_CNTW);
    const int lane = F.lane, k0 = 16 * lane;
    float wr[16][8];
#pragma unroll
    for (int j = 0; j < 16; ++j) { const float gk = a.in[21][l * D + k0 + j];
        const f32x4 w0 = *(const f32x4*)(a.in[25] + ((size_t)i * D + k0 + j) * NE), w1 = *(const f32x4*)(a.in[25] + ((size_t)i * D + k0 + j) * NE + 4);
        wr[j][0] = gk * w0.x; wr[j][1] = gk * w0.y; wr[j][2] = gk * w0.z; wr[j][3] = gk * w0.w; wr[j][4] = gk * w1.x; wr[j][5] = gk * w1.y; wr[j][6] = gk * w1.z; wr[j][7] = gk * w1.w; }
    float rb[8];
#pragma unroll
    for (int e = 0; e < 8; ++e) rb[e] = a.in[26][i * NE + e];
    const bool b5 = (lane & 32) != 0, b4 = (lane & 16) != 0, b3 = (lane & 8) != 0;
    for (int run = F.gw; run < M / 32; run += F.NGW) {
        int cnt[8];
#pragma unroll
        for (int e = 0; e < 8; ++e) cnt[e] = 0;
        for (int ti = 0; ti < 32; ++ti) {
            const int t = run * 32 + ti;
            const v4u x0 = *(const v4u*)(xb + (size_t)t * D + k0), x1 = *(const v4u*)(xb + (size_t)t * D + k0 + 8);
            float xv[16] = {bflo(x0.x), bfhi(x0.x), bflo(x0.y), bfhi(x0.y), bflo(x0.z), bfhi(x0.z), bflo(x0.w), bfhi(x0.w), bflo(x1.x), bfhi(x1.x), bflo(x1.y), bfhi(x1.y), bflo(x1.z), bfhi(x1.z), bflo(x1.w), bfhi(x1.w)};
            float v[8];
#pragma unroll
            for (int e = 0; e < 8; ++e) { float s = 0.f;
#pragma unroll
                for (int j = 0; j < 16; ++j) s += xv[j] * wr[j][e];
                v[e] = s; }
            float w4[4], w2[2];
#pragma unroll
            for (int q = 0; q < 4; ++q) { const float keep = b5 ? v[q + 4] : v[q], send = b5 ? v[q] : v[q + 4]; w4[q] = keep + __shfl_xor(send, 32); }
#pragma unroll
            for (int q = 0; q < 2; ++q) { const float keep = b4 ? w4[q + 2] : w4[q], send = b4 ? w4[q] : w4[q + 2]; w2[q] = keep + __shfl_xor(send, 16); }
            float w1; { const float keep = b3 ? w2[1] : w2[0], send = b3 ? w2[0] : w2[1]; w1 = keep + __shfl_xor(send, 8); }
            w1 += __shfl_xor(w1, 4); w1 += __shfl_xor(w1, 2); w1 += __shfl_xor(w1, 1);
            const float rstd = row_rstd(ssq, t);
            float lg[8];
#pragma unroll
            for (int e = 0; e < 8; ++e) lg[e] = __builtin_bit_cast(float, __builtin_amdgcn_readlane(__builtin_bit_cast(int, w1), 8 * e)) * rstd + rb[e];
            int e0 = 0; float l0 = lg[0];
#pragma unroll
            for (int e = 1; e < 8; ++e) if (lg[e] > l0) { l0 = lg[e]; e0 = e; }
            int e1 = -1; float l1 = -INFINITY;
#pragma unroll
            for (int e = 0; e < 8; ++e) if (e != e0 && lg[e] > l1) { l1 = lg[e]; e1 = e; }
            const float p0 = 1.0f / (1.0f + __expf(l1 - l0)), p1 = 1.0f - p0;
            if (lane == 0) { toke[t] = e0 | (e1 << 8); tokw[2 * t] = p0; tokw[2 * t + 1] = p1; }
#pragma unroll
            for (int e = 0; e < 8; ++e) cnt[e] += (e0 == e) + (e1 == e);
        }
        int cv = 0;
#pragma unroll
        for (int e = 0; e < 8; ++e) if (lane == e) cv = cnt[e];
        if (lane < 8) cntw[run * 8 + lane] = cv;
    }
}
__device__ __forceinline__ int wave_sum_i(int v) {
#pragma unroll
    for (int o = 1; o < 64; o <<= 1) v += __shfl_xor(v, o);
    return v;
}
__device__ __forceinline__ void moe_slots(Frame& F, const Args& a) {
    const bf16* xb = (const bf16*)(a.ws + WS_XB); const float* ssq = (const float*)(a.ws + WS_SSQ); bf16* xg = (bf16*)(a.ws + WS_XG);
    const int* toke = (const int*)(a.ws + WS_TOKE); const float* tokw = (const float*)(a.ws + WS_TOKW); const int* cntw = (const int*)(a.ws + WS_CNTW);
    int* meta = (int*)(a.ws + WS_META); int* rdest = (int*)(a.ws + WS_RDEST); float* rw = (float*)(a.ws + WS_RW); float* rrstd = (float*)(a.ws + WS_RRSTD);
    const int lane = F.lane;
    for (int run = F.gw; run < M / 32; run += F.NGW) {
        int pre[8], tot[8];
#pragma unroll
        for (int e = 0; e < 8; ++e) { pre[e] = 0; tot[e] = 0; }
        for (int r2 = lane; r2 < M / 32; r2 += 64) {
            const int4 c0 = *(const int4*)(cntw + r2 * 8), c1 = *(const int4*)(cntw + r2 * 8 + 4); const int f = r2 < run ? 1 : 0;
            tot[0] += c0.x; tot[1] += c0.y; tot[2] += c0.z; tot[3] += c0.w; tot[4] += c1.x; tot[5] += c1.y; tot[6] += c1.z; tot[7] += c1.w;
            pre[0] += f * c0.x; pre[1] += f * c0.y; pre[2] += f * c0.z; pre[3] += f * c0.w; pre[4] += f * c1.x; pre[5] += f * c1.y; pre[6] += f * c1.z; pre[7] += f * c1.w;
        }
        int seg[9]; seg[0] = 0;
#pragma unroll
        for (int e = 0; e < 8; ++e) { tot[e] = __builtin_amdgcn_readfirstlane(wave_sum_i(tot[e])); pre[e] = __builtin_amdgcn_readfirstlane(wave_sum_i(pre[e])); seg[e + 1] = seg[e] + ((tot[e] + 255) & ~255); }
        if (run == 0 && lane < 9) { int sv = 0;
#pragma unroll
            for (int e = 0; e < 9; ++e) if (lane == e) sv = seg[e] >> 8;
            meta[lane] = sv; }
        if (run < 8) {
#pragma unroll
            for (int e = 0; e < 8; ++e) if (run == e) { for (int r = tot[e] + lane; r < ((tot[e] + 255) & ~255); r += 64) { rdest[seg[e] + r] = -1; rw[seg[e] + r] = 0.f; rrstd[seg[e] + r] = 0.f; } }
        }
        int base[8];
#pragma unroll
        for (int e = 0; e < 8; ++e) base[e] = seg[e] + pre[e];
        for (int ti = 0; ti < 32; ++ti) {
            const int t = run * 32 + ti; const int ee = __builtin_amdgcn_readfirstlane(toke[t]); const int e0 = ee & 255, e1 = ee >> 8;
            int s0 = 0, s1 = 0;
#pragma unroll
            for (int e = 0; e < 8; ++e) { if (e0 == e) { s0 = base[e]; base[e] += 1; } if (e1 == e) { s1 = base[e]; base[e] += 1; } }
            if (lane == 0) { const float rstd = row_rstd(ssq, t); rdest[s0] = 2 * t; rdest[s1] = 2 * t + 1; rw[s0] = tokw[2 * t]; rw[s1] = tokw[2 * t + 1]; rrstd[s0] = rstd; rrstd[s1] = rstd; }
            const v4u x0 = *(const v4u*)(xb + (size_t)t * D + 16 * lane), x1 = *(const v4u*)(xb + (size_t)t * D + 16 * lane + 8);
            *(v4u*)(xg + (size_t)s0 * D + 16 * lane) = x0; *(v4u*)(xg + (size_t)s0 * D + 16 * lane + 8) = x1;
            *(v4u*)(xg + (size_t)s1 * D + 16 * lane) = x0; *(v4u*)(xg + (size_t)s1 * D + 16 * lane + 8) = x1;
        }
    }
}
__device__ __forceinline__ void moe_combine(Frame& F, const Args& a, bool last) {
    bf16* xb = (bf16*)(a.ws + WS_XB); float* ssq = (float*)(a.ws + WS_SSQ); const bf16* yb = (const bf16*)a.out; float* outp = (float*)a.out;
    const int lane = F.lane;
    for (int t = F.gw; t < M; t += F.NGW) {
        const v4u x0 = *(const v4u*)(xb + (size_t)t * D + 16 * lane), x1 = *(const v4u*)(xb + (size_t)t * D + 16 * lane + 8);
        const v4u y00 = *(const v4u*)(yb + (size_t)(2 * t) * D + 16 * lane), y01 = *(const v4u*)(yb + (size_t)(2 * t) * D + 16 * lane + 8);
        const v4u y10 = *(const v4u*)(yb + (size_t)(2 * t + 1) * D + 16 * lane), y11 = *(const v4u*)(yb + (size_t)(2 * t + 1) * D + 16 * lane + 8);
        A4 xa, xb_, xc, xd, t0, t1;
        unpack8(x0, xa, xb_); unpack8(x1, xc, xd);
        unpack8(y00, t0, t1); xa = xa + t0; xb_ = xb_ + t1; unpack8(y01, t0, t1); xc = xc + t0; xd = xd + t1;
        unpack8(y10, t0, t1); xa = xa + t0; xb_ = xb_ + t1; unpack8(y11, t0, t1); xc = xc + t0; xd = xd + t1;
        if (!last) {
            const v4u w0 = pack8(xa, xb_), w1 = pack8(xc, xd);
            *(v4u*)(xb + (size_t)t * D + 16 * lane) = w0; *(v4u*)(xb + (size_t)t * D + 16 * lane + 8) = w1;
            unpack8(w0, xa, xb_); unpack8(w1, xc, xd);
        }
        float ss = 0.f;
#pragma unroll
        for (int j = 0; j < 4; ++j) ss += xa[j] * xa[j] + xb_[j] * xb_[j] + xc[j] * xc[j] + xd[j] * xd[j];
        const float tot = wave_sum(ss);
        if (!last) { if (lane < 16) ssq[(size_t)t * 16 + lane] = lane == 0 ? tot : 0.f; }
        else {
            const float r = rsqrtf(tot * (1.0f / 1024.0f) + EPS); const f32x4* gf = (const f32x4*)(a.in[30] + 16 * lane); f32x4* op = (f32x4*)(outp + (size_t)t * D + 16 * lane);
            op[0] = xa * r * gf[0]; op[1] = xb_ * r * gf[1]; op[2] = xc * r * gf[2]; op[3] = xd * r * gf[3];
        }
    }
}
constexpr int SSM_T = 64, SSM_KA = 1152;
__device__ __forceinline__ void ssm_abar(const Args& a, int lg, int p, float& lam_re, float& lam_im, float& dt) { lam_re = a.in[4][lg * SSM_P + p]; lam_im = a.in[5][lg * SSM_P + p]; dt = expf(a.in[6][lg]); }
__device__ __forceinline__ void cpow(float lam_re, float lam_im, float dt, int tau, float& re, float& im) { const float mag = expf(lam_re * dt * (float)tau); float sn, cs; sincosf(lam_im * dt * (float)tau, &sn, &cs); re = mag * cs; im = mag * sn; }
__device__ __forceinline__ void ssm_tables(Frame& F, const Args& a) {
    float* APOW = (float*)(a.ws + WS_APOW); float* BBAR = (float*)(a.ws + WS_BBAR); float* KTAB = (float*)(a.ws + WS_KTAB);
    const int lane = F.lane, p = lane;
    const bool b5 = (lane & 32) != 0, b4 = (lane & 16) != 0, b3 = (lane & 8) != 0, b2 = (lane & 4) != 0;
    for (int task = F.gw; task < DEPTH * SSM_G * 65; task += F.NGW) {
        const int lg = task / 65, tau = task - lg * 65;
        float lam_re, lam_im, dt; ssm_abar(a, lg, p, lam_re, lam_im, dt);
        float pr, pi; cpow(lam_re, lam_im, dt, tau, pr, pi);
        *(f32x2*)(APOW + (((size_t)lg * 65 + tau) * SSM_P + p) * 2) = (f32x2){pr, pi};
        float ar, ai; cpow(lam_re, lam_im, dt, 1, ar, ai);
        const float nr = ar - 1.0f, ni = ai, den = lam_re * lam_re + lam_im * lam_im;
        const float cr = (nr * lam_re + ni * lam_im) / den, ci = (ni * lam_re - nr * lam_im) / den;
        float br[16], bi[16];
#pragma unroll
        for (int h = 0; h < 16; ++h) { const float bre = a.in[7][((size_t)lg * SSM_P + p) * SSM_H + h], bim = a.in[8][((size_t)lg * SSM_P + p) * SSM_H + h]; br[h] = cr * bre - ci * bim; bi[h] = cr * bim + ci * bre; }
        if (tau == 0) {
#pragma unroll
            for (int h = 0; h < 16; ++h) *(f32x2*)(BBAR + (((size_t)lg * SSM_P + p) * SSM_H + h) * 2) = (f32x2){br[h], bi[h]};
        }
        if (tau < 64) {
            for (int ho = 0; ho < 16; ++ho) {
                const float cre = a.in[9][((size_t)lg * SSM_H + ho) * SSM_P + p], cim = a.in[10][((size_t)lg * SSM_H + ho) * SSM_P + p];
                const float wr_ = cre * pr - cim * pi, wi_ = cre * pi + cim * pr;
                float v[16];
#pragma unroll
                for (int h = 0; h < 16; ++h) v[h] = wr_ * br[h] - wi_ * bi[h];
                float w8[8], w4[4], w2[2];
#pragma unroll
                for (int i = 0; i < 8; ++i) { const float keep = b5 ? v[i + 8] : v[i], send = b5 ? v[i] : v[i + 8]; w8[i] = keep + __shfl_xor(send, 32); }
#pragma unroll
                for (int i = 0; i < 4; ++i) { const float keep = b4 ? w8[i + 4] : w8[i], send = b4 ? w8[i] : w8[i + 4]; w4[i] = keep + __shfl_xor(send, 16); }
#pragma unroll
                for (int i = 0; i < 2; ++i) { const float keep = b3 ? w4[i + 2] : w4[i], send = b3 ? w4[i] : w4[i + 2]; w2[i] = keep + __shfl_xor(send, 8); }
                float w1; { const float keep = b2 ? w2[1] : w2[0], send = b2 ? w2[0] : w2[1]; w1 = keep + __shfl_xor(send, 4); }
                w1 += __shfl_xor(w1, 2); w1 += __shfl_xor(w1, 1);
                const int hi = lane >> 2;
                if (tau == 0 && hi == ho) w1 += a.in[11][lg * SSM_H + ho];
                if ((lane & 3) == 0) KTAB[(((size_t)lg * 64 + tau) * 16 + ho) * 16 + hi] = w1;
            }
        }
    }
}
__device__ __forceinline__ void ssm_gather_u(const Args& a, int chunk, int lane) {
    const bf16* U = (const bf16*)(a.out + DO_U); bf16* Ua = (bf16*)(a.ws + WS_UA);
    const int g = lane >> 2, o4 = (lane & 3) * 4;
    for (int j = 0; j < SSM_T; ++j) { const v2u w = *(const v2u*)(U + ((size_t)chunk * SSM_T + j) * SSM_W + 4 * lane);
        *(v2u*)(Ua + ((size_t)g * (M / SSM_T) + chunk) * SSM_KA + j * 16 + o4) = w; }
}
__device__ __forceinline__ void ssm_expand_mv(const Args& a, int l, int task, int lane) {
    const float* APOW = (const float*)(a.ws + WS_APOW); const float* KTAB = (const float*)(a.ws + WS_KTAB); bf16* MV = (bf16*)(a.ws + WS_MV);
    const int g = task >> 10, n = task & 1023, i = n >> 4, ho = n & 15, lg = l * SSM_G + g, j = lane;
    bf16* row = MV + (size_t)task * SSM_KA;
    v4u o0 = (v4u){0u, 0u, 0u, 0u}, o1 = o0;
    if (j <= i) { const f32x4* kt = (const f32x4*)(KTAB + (((size_t)lg * 64 + (i - j)) * 16 + ho) * 16); const f32x4 k0 = kt[0], k1 = kt[1], k2 = kt[2], k3 = kt[3];
        o0.x = pk2(k0.x, k0.y); o0.y = pk2(k0.z, k0.w); o0.z = pk2(k1.x, k1.y); o0.w = pk2(k1.z, k1.w); o1.x = pk2(k2.x, k2.y); o1.y = pk2(k2.z, k2.w); o1.z = pk2(k3.x, k3.y); o1.w = pk2(k3.z, k3.w); }
    *(v4u*)(row + j * 16) = o0; *(v4u*)(row + j * 16 + 8) = o1;
    const int p = lane; const f32x2 ap = *(const f32x2*)(APOW + (((size_t)lg * 65 + (i + 1)) * SSM_P + p) * 2);
    const float cre = a.in[9][((size_t)lg * SSM_H + ho) * SSM_P + p], cim = a.in[10][((size_t)lg * SSM_H + ho) * SSM_P + p];
    row[1024 + p] = (bf16)f2bf(cre * ap.x - cim * ap.y); row[1024 + 64 + p] = (bf16)f2bf(-(cre * ap.y + cim * ap.x));
}
__device__ __forceinline__ void ssm_expand_w(const Args& a, int l, int task, int lane) {
    const float* APOW = (const float*)(a.ws + WS_APOW); const float* BBAR = (const float*)(a.ws + WS_BBAR); bf16* WG = (bf16*)(a.ws + WS_WG);
    const int g = task >> 7, q = task & 127, p = q & 63, im = q >> 6, lg = l * SSM_G + g, j = lane;
    const f32x2 ap = *(const f32x2*)(APOW + (((size_t)lg * 65 + (63 - j)) * SSM_P + p) * 2);
    float v[16];
#pragma unroll
    for (int h = 0; h < 16; ++h) { const f32x2 bb = *(const f32x2*)(BBAR + (((size_t)lg * SSM_P + p) * SSM_H + h) * 2); v[h] = im ? (ap.x * bb.y + ap.y * bb.x) : (ap.x * bb.x - ap.y * bb.y); }
    bf16* row = WG + ((size_t)g * 256 + q) * 1024 + j * 16;
    v4u o0, o1; o0.x = pk2(v[0], v[1]); o0.y = pk2(v[2], v[3]); o0.z = pk2(v[4], v[5]); o0.w = pk2(v[6], v[7]); o1.x = pk2(v[8], v[9]); o1.y = pk2(v[10], v[11]); o1.z = pk2(v[12], v[13]); o1.w = pk2(v[14], v[15]);
    *(v4u*)row = o0; *(v4u*)(row + 8) = o1;
}
__device__ __forceinline__ void ssm_chunk_scan(const Args& a, int l, int b, int g, int lane) {
    const float* APOW = (const float*)(a.ws + WS_APOW); const float* S = (const float*)(a.ws + WS_SST); bf16* Ua = (bf16*)(a.ws + WS_UA);
    const int lg = l * SSM_G + g, p = lane; const f32x2 a64 = *(const f32x2*)(APOW + (((size_t)lg * 65 + 64) * SSM_P + p) * 2);
    float xr = 0.f, xi = 0.f; const size_t row0 = (size_t)g * (M / SSM_T) + (size_t)b * (SEQ / SSM_T);
    for (int cb = 0; cb < SEQ / SSM_T; cb += 16) {
        float sr[16], si[16];
#pragma unroll
        for (int c = 0; c < 16; ++c) { sr[c] = S[(row0 + cb + c) * 128 + p]; si[c] = S[(row0 + cb + c) * 128 + 64 + p]; }
#pragma unroll
        for (int c = 0; c < 16; ++c) { bf16* xrow = Ua + (row0 + cb + c) * SSM_KA + 1024;
            xrow[p] = (bf16)f2bf(xr); xrow[64 + p] = (bf16)f2bf(xi);
            const float nr = a64.x * xr - a64.y * xi + sr[c], ni = a64.x * xi + a64.y * xr + si[c]; xr = nr; xi = ni; }
    }
}
struct GroupOrder {
    pg8::StaticOrder so; int b_rows;
    __device__ __forceinline__ bool next(int i, pg8::Unit& u) const { if (!so.next(i, u)) return false; u.brow = (u.pm >> 2) * b_rows + u.pn * 256; return true; }
};
struct EpiSsmS {
    static constexpr bool PERM = true;
    float* S;
    __device__ __forceinline__ void operator()(const AccT& acc, const pg8::Unit& u, int wr, int wc, int fr, int fq) const {
        const int row0 = u.pm * 256 + wr * 64 + fr, cw = wc * 32 + 8 * fq;
#pragma unroll
        for (int ai = 0; ai < 2; ++ai)
#pragma unroll
            for (int m = 0; m < 4; ++m) { float* sp = S + (size_t)(row0 + ai * 128 + m * 16) * 128 + cw; *(A4*)sp = acc[ai][0][m][0]; *(A4*)(sp + 4) = acc[ai][0][m][1]; }
    }
};
struct EpiSsmY {
    static constexpr bool PERM = true;
    bf16* YGp;
    __device__ __forceinline__ void operator()(const AccT& acc, const pg8::Unit& u, int wr, int wc, int fr, int fq) const {
        const int row0 = u.pm * 256 + wr * 64 + fr, g = u.pm >> 2;
#pragma unroll
        for (int ai = 0; ai < 2; ++ai)
#pragma unroll
            for (int m = 0; m < 4; ++m) { const int chunk = (row0 + ai * 128 + m * 16) & 1023;
#pragma unroll
                for (int bj = 0; bj < 2; ++bj) { const int i = 16 * u.pn + 8 * bj + 2 * wc + (fq >> 1);
                    const A4 v0 = acc[ai][bj][m][0], v1 = acc[ai][bj][m][1];
                    v4u w; w.x = pk2(gelu_tanh(v0[0]), gelu_tanh(v0[1])); w.y = pk2(gelu_tanh(v0[2]), gelu_tanh(v0[3])); w.z = pk2(gelu_tanh(v1[0]), gelu_tanh(v1[1])); w.w = pk2(gelu_tanh(v1[2]), gelu_tanh(v1[3]));
                    *(v4u*)(YGp + ((size_t)chunk * SSM_T + i) * SSM_W + 16 * g + 8 * (fq & 1)) = w; } }
    }
};
#ifndef MK_N_LAUNCHES
#define MK_N_LAUNCHES 1
#endif
#ifndef SSM_FAST
#define SSM_FAST 1
#endif
constexpr int N_PHASES = 1 + 2 * (7 + 14) + (SSM_FAST ? 3 * DEPTH : 0);

__global__ void __launch_bounds__(NWAVES * 64, 2) fwd(Args args) {
    extern __shared__ __attribute__((aligned(16))) unsigned char lds[];
    Frame F;
    F.lds = (LAS unsigned char*)lds;
    F.MISC = (volatile LAS unsigned*)(F.lds + MISC_OFF);
    F.tid = threadIdx.x; F.lane = F.tid & 63; F.wave = __builtin_amdgcn_readfirstlane(F.tid >> 6);
    F.G = gridDim.x; F.gw = blockIdx.x * NWAVES + F.wave; F.NGW = F.G * NWAVES;
    unsigned char* ws = args.ws;
    F.ctl = (gu32*)(ws + WS_CTL);
    for (int u = F.tid; u < (LDS_BYTES - LDSCTL_OFF) / 4; u += NWAVES * 64) ((LAS unsigned*)(F.lds + LDSCTL_OFF))[u] = 0u;
    __syncthreads();
    XcdBarrier bar; bar.bar = (unsigned*)(F.ctl + CW_BAR); bar.x = 0; bar.st = nullptr;
    if (args.use_bar) bar = xcd_barrier_post((unsigned*)(F.ctl + CW_BAR), F.MISC + 8, F.wave);
    const int lo = args.ph_lo, hi = args.ph_hi; int ph = 0;
#ifndef MERGE_MASK
#define MERGE_MASK 7
#endif
#ifndef PHASE_MASK
#define PHASE_MASK 0xffffffffu
#endif
#define INP(k) ((lo <= ph && ph < hi) && ((PHASE_MASK >> (k)) & 1u))
#define OPQ() Frame Fp = F; { const int l_ = lane_id_fresh(); Fp.lane = l_; Fp.tid = (F.wave << 6) | l_; }
#define SEAM() do { if (lo <= ph && ph + 1 < hi) xcd_barrier(bar, F.wave); ++ph; } while (0)
#define BIDQ() ({ int b_ = (int)blockIdx.x; asm volatile("" : "+s"(b_)); b_; })
    LAS unsigned char* ring = F.lds + RING_OFF;
#define XB ((bf16*)(ws + WS_XB))
#define SSQ ((float*)(ws + WS_SSQ))
#define Qb ((bf16*)(args.out + DO_Q))
#define MRG ((bf16*)(args.out + DO_MERGED))
#define GATES ((bf16*)(ws + WS_GATES))
#define YG ((bf16*)(ws + WS_YG))
#define SSMO ((bf16*)(ws + WS_SSMO))
#define CONVO ((bf16*)(ws + WS_CONVO))

    if (INP(0)) { OPQ(); p0_prologue(Fp, args); if (SSM_FAST) ssm_tables(Fp, args); } SEAM();

    for (int l = 0; l < DEPTH; ++l) {
        unsigned char* wm = ws + WS_WMIX + (size_t)l * WMIX_STRIDE;
        if (INP(1)) {
            pg8::Gemm g{XB, (const bf16*)(wm + WM_IN), D, D, D}; pg8::StaticOrder S; S.init(M / 256, N_INP / 256, F.G, BIDQ());
            EpiInProj E{args.out, ws, l};
            pg8::gemm_phase<EpiInProj, pg8::StaticOrder, true, true>(ring, g, S, E, F.wave);
        } SEAM();
        if (INP(2)) {
            OPQ();
#if SSM_FAST
            {   const int gwl = Fp.gw, ngw = Fp.NGW;
                for (int bh = gwl; bh < BATCH * NH; bh += ngw) t1_cumsum(args, bh, Fp.lane);
                for (int c = gwl; c < M / SSM_T; c += ngw) ssm_gather_u(args, c, Fp.lane);
                for (int t = gwl; t < SSM_G * 1024; t += ngw) ssm_expand_mv(args, l, t, Fp.lane);
                for (int t = gwl; t < SSM_G * 128; t += ngw) ssm_expand_w(args, l, t, Fp.lane);
                for (int blk = gwl; blk < M / 32; blk += ngw) t1_conv(args, l, blk, Fp.lane);
                if (l & 1) cvt_moe_layer(args, l >> 1, l, (LAS float*)(F.lds + RING_OFF + F.wave * 16384), Fp.lane, gwl, ngw);
            }
#else
            if (F.wave == 0) { for (int unit = BIDQ(); unit < BATCH * SSM_G; unit += F.G) t1_ssm_scan(args, l, unit >> 4, unit & 15, Fp.lane); }
            else {
                const int gwl = BIDQ() * 7 + (F.wave - 1), ngw = F.G * 7;
                for (int bh = gwl; bh < BATCH * NH; bh += ngw) t1_cumsum(args, bh, Fp.lane);
                for (int blk = gwl; blk < M / 32; blk += ngw) t1_conv(args, l, blk, Fp.lane);
                if (l & 1) cvt_moe_layer(args, l >> 1, l, (LAS float*)(F.lds + RING_OFF + F.wave * 16384), Fp.lane, gwl, ngw);
            }
#endif
        } SEAM();
#if SSM_FAST
        if (INP(13)) {
            pg8::Gemm g{(const bf16*)(ws + WS_UA), (const bf16*)(ws + WS_WG), SSM_KA, 1024, 1024}; GroupOrder S; S.so.init(SSM_G * 4, 1, F.G, BIDQ()); S.b_rows = 256; EpiSsmS E{(float*)(ws + WS_SST)};
            pg8::gemm_phase<EpiSsmS, GroupOrder, true, true>(ring, g, S, E, F.wave);
        } SEAM();
        if (INP(14)) { OPQ(); for (int t = Fp.gw; t < BATCH * SSM_G; t += Fp.NGW) ssm_chunk_scan(args, l, t >> 4, t & 15, Fp.lane); } SEAM();
        if (INP(15)) {
            pg8::Gemm g{(const bf16*)(ws + WS_UA), (const bf16*)(ws + WS_MV), SSM_KA, SSM_KA, SSM_KA}; GroupOrder S; S.so.init(SSM_G * 4, 4, F.G, BIDQ()); S.b_rows = 1024; EpiSsmY E{YG};
            pg8::gemm_phase<EpiSsmY, GroupOrder, true, true>(ring, g, S, E, F.wave);
        } SEAM();
#endif
        if (INP(3)) {
            { pg8::Gemm g{YG, (const bf16*)(wm + WM_GLU), 256, 256, 256}; pg8::StaticOrder S; S.init(M / 256, 2, F.G, BIDQ()); EpiGluSsm E{SSMO};
              pg8::gemm_phase<EpiGluSsm, pg8::StaticOrder, true, true>(ring, g, S, E, F.wave); }
#if ATTN_FAST
            { const attn_body::AttnTensors AT{(const attn_body::bf16*)Qb, (const attn_body::bf16*)(args.out + DO_K), (const attn_body::bf16*)(args.out + DO_V), (attn_body::bf16*)Qb, (const float*)(ws + WS_FH)};
              const attn_body::StaticOrder SA((int)F.G, BIDQ());
              attn_body::attn_phase<attn_body::StaticOrder>((char*)lds + RING_OFF, AT, SA, F.wave); }
#else
            { OPQ(); attn_naive(Fp, args); }
#endif
        } SEAM();
        if (INP(4)) {
            pg8::StaticOrder S; S.init(M / 256, 4, F.G, BIDQ());
            if (MERGE_MASK & 1) { pg8::Gemm g{Qb, (const bf16*)(wm + WM_A), 512, 512, 512}; EpiMerge<0> E{GATES, MRG}; pg8::gemm_phase<EpiMerge<0>, pg8::StaticOrder, true, true>(ring, g, S, E, F.wave); }
            if (MERGE_MASK & 2) { pg8::Gemm g{SSMO, (const bf16*)(wm + WM_S), 256, 256, 256}; EpiMerge<1> E{GATES, MRG}; pg8::gemm_phase<EpiMerge<1>, pg8::StaticOrder, true, true>(ring, g, S, E, F.wave); }
            if (MERGE_MASK & 4) { pg8::Gemm g{CONVO, (const bf16*)(wm + WM_C), 256, 256, 256}; EpiMerge<2> E{GATES, MRG}; pg8::gemm_phase<EpiMerge<2>, pg8::StaticOrder, true, true>(ring, g, S, E, F.wave); }
        } SEAM();
        if (INP(5)) {
            pg8::Gemm g{MRG, (const bf16*)(wm + WM_O), D, D, D}; pg8::StaticOrder S; S.init(M / 256, 4, F.G, BIDQ()); EpiResid E{XB, SSQ};
            pg8::gemm_phase<EpiResid, pg8::StaticOrder, true, true>(ring, g, S, E, F.wave);
        } SEAM();
        if (!(l & 1)) {
            unsigned char* wd = ws + WS_WDENSE + (size_t)(l >> 1) * WDENSE_STRIDE; bf16* const HID = (bf16*)(ws + WS_HID);
            if (INP(6)) {
                pg8::Gemm g{XB, (const bf16*)(wd + WD_GU), D, D, D}; pg8::StaticOrder S; S.init(M / 256, 2 * D_FF / 256, F.G, BIDQ()); EpiSwiGlu<false> E{HID, D_FF, SSQ};
                pg8::gemm_phase<EpiSwiGlu<false>, pg8::StaticOrder, true, true>(ring, g, S, E, F.wave);
            } SEAM();
            if (INP(7)) {
                pg8::Gemm g{HID, (const bf16*)(wd + WD_D), D_FF, D_FF, D_FF}; pg8::StaticOrder S; S.init(M / 256, 4, F.G, BIDQ()); EpiResid E{XB, SSQ};
                pg8::gemm_phase<EpiResid, pg8::StaticOrder, true, true>(ring, g, S, E, F.wave);
            } SEAM();
        } else {
            if (INP(8)) { OPQ(); moe_route(Fp, args, l, l >> 1); } SEAM();
            if (INP(9)) { OPQ(); moe_slots(Fp, args); } SEAM();
            const int* meta = (const int*)(ws + WS_META);
            for (int ch = 0; ch < MOE_NCHUNK; ++ch) {
                if (INP(10)) {
                    const int total = meta[8], per = (total + MOE_NCHUNK - 1) / MOE_NCHUNK, tile0 = ch * per; int nM = total - tile0; nM = nM < 0 ? 0 : (nM > per ? per : nM);
                    pg8::Gemm g{(const bf16*)(ws + WS_XG), (const bf16*)(ws + WS_WMOE + WMOE_GU), D, D, D};
                    MoeOrder S; S.so.init(nM, 2 * D_FFE / 256, F.G, BIDQ()); S.tile0 = tile0; S.a_tile_off = tile0; S.b_rows = 2 * D_FFE;
                    S.s1 = meta[1]; S.s2 = meta[2]; S.s3 = meta[3]; S.s4 = meta[4]; S.s5 = meta[5]; S.s6 = meta[6]; S.s7 = meta[7];
                    EpiSwiGlu<true> E{(bf16*)(ws + WS_MHID), D_FFE, (const float*)(ws + WS_RRSTD) + (size_t)tile0 * 256};
                    pg8::gemm_phase<EpiSwiGlu<true>, MoeOrder, true, true>(ring, g, S, E, F.wave);
                } SEAM();
                if (INP(11)) {
                    const int total = meta[8], per = (total + MOE_NCHUNK - 1) / MOE_NCHUNK, tile0 = ch * per; int nM = total - tile0; nM = nM < 0 ? 0 : (nM > per ? per : nM);
                    pg8::Gemm g{(const bf16*)(ws + WS_MHID), (const bf16*)(ws + WS_WMOE + WMOE_D), D_FFE, D_FFE, D_FFE};
                    MoeOrder S; S.so.init(nM, 4, F.G, BIDQ()); S.tile0 = tile0; S.a_tile_off = 0; S.b_rows = D;
                    S.s1 = meta[1]; S.s2 = meta[2]; S.s3 = meta[3]; S.s4 = meta[4]; S.s5 = meta[5]; S.s6 = meta[6]; S.s7 = meta[7];
                    EpiMoeDown E{(bf16*)args.out, (const int*)(ws + WS_RDEST) + (size_t)tile0 * 256, (const float*)(ws + WS_RW) + (size_t)tile0 * 256};
                    pg8::gemm_phase<EpiMoeDown, MoeOrder, true, true>(ring, g, S, E, F.wave);
                } SEAM();
            }
            if (INP(12)) { OPQ(); moe_combine(Fp, args, l == DEPTH - 1); } SEAM();
        }
    }
#undef INP
#undef BIDQ
#undef OPQ
#undef SEAM
}

extern "C" void kernel_launch(void* const* d_in, const int* in_sizes, int n_in, void* d_out, int out_size, void* d_ws, size_t ws_size, hipStream_t stream) {
    static int grid = 0;
    if (grid == 0) {
        if (n_in != 31 || in_sizes[0] != M * D || out_size != M * D || ws_size < WS_END) { fprintf(stderr, "kernel_launch: unexpected shapes/workspace (n_in %d, ws %zu, need %zu); nothing launched\n", n_in, ws_size, (size_t)WS_END); grid = -1; return; }
        int dev = 0, cus = 0, per_cu = 0;
        if (hipGetDevice(&dev) != hipSuccess || hipDeviceGetAttribute(&cus, hipDeviceAttributeMultiprocessorCount, dev) != hipSuccess) { grid = -1; return; }
        if (hipFuncSetAttribute((const void*)fwd, hipFuncAttributeMaxDynamicSharedMemorySize, LDS_BYTES) != hipSuccess) { fprintf(stderr, "kernel_launch: hipFuncSetAttribute failed\n"); grid = -1; return; }
        if (hipOccupancyMaxActiveBlocksPerMultiprocessor(&per_cu, (const void*)fwd, NWAVES * 64, LDS_BYTES) != hipSuccess || per_cu < 1)
            fprintf(stderr, "kernel_launch: note: occupancy query reports %d workgroups per CU\n", per_cu);
        (void)hipGetLastError();
        grid = cus;
    }
    if (grid < 0) return;
    if (hipMemsetAsync((char*)d_ws + WS_CTL, 0, CTL_ZERO_BYTES, stream) != hipSuccess) return;
    Args a{};
    for (int i = 0; i < 31; ++i) a.in[i] = (const float*)d_in[i];
    a.out = (unsigned char*)d_out; a.ws = (unsigned char*)d_ws; a.pad = 0;
#if MK_N_LAUNCHES == 1
    a.ph_lo = 0; a.ph_hi = N_PHASES; a.use_bar = 1;
    hipLaunchKernelGGL(fwd, dim3(grid), dim3(NWAVES * 64), LDS_BYTES, stream, a);
#else
    for (int p = 0; p < N_PHASES; ++p) { a.ph_lo = p; a.ph_hi = p + 1; a.use_bar = 0; hipLaunchKernelGGL(fwd, dim3(grid), dim3(NWAVES * 64), LDS_BYTES, stream, a); }
#endif
}
```

```cpp
#include <hip/hip_runtime.h>
#include <cstdio>
#include <cstdint>
#include <hip/hip_bf16.h>
#include <cmath>
#ifndef ATTN_FAST
#define ATTN_FAST 1
#endif
#define MK_N_LAUNCHES 1
__device__ __forceinline__ int lane_id_fresh() { int l; asm volatile("v_mbcnt_lo_u32_b32 %0, -1, 0\n\tv_mbcnt_hi_u32_b32 %0, -1, %0" : "=v"(l)); return l; }
namespace pg8 {
#define PG8_LAS __attribute__((address_space(3)))
typedef unsigned short bf16_t;
typedef short bf16x8 __attribute__((ext_vector_type(8)));
typedef float f32x4 __attribute__((ext_vector_type(4)));
typedef float f32x2 __attribute__((ext_vector_type(2)));
typedef unsigned u32x4 __attribute__((ext_vector_type(4)));
constexpr int BM = 256, BK = 64, HALF = 128, HTB = HALF * BK * 2  , STAGE_BYTES = 8 * HTB, NXCD = 8, WGM = 4;

__host__ __device__ __forceinline__ int lds_byte(int r, int c) { const int st = (r >> 4) * 2 + (c >> 5), rr = r & 15, cc = c & 31, ob = rr * 64 + cc * 2; return st * 1024 + (ob ^ (((ob >> 9) & 1) << 5)); }
__host__ __device__ __forceinline__ void stage_rc(int b, int& R, int& C) { const int st = b / 1024, sb = b % 1024, swz = sb ^ (((sb >> 9) & 1) << 5); R = (st >> 1) * 16 + swz / 64; C = (st & 1) * 32 + (swz % 64) / 2; }
__host__ __device__ __forceinline__ int perm32(int rho) { const int n = rho >> 4, i = rho & 15; return 8 * (i >> 2) + 4 * n + (i & 3); }

struct Unit { int pm, pn, arow, brow; };
struct Gemm { const bf16_t* A; const bf16_t* Bt; int lda, ldb, K; const int* a_rows = nullptr; int a_kstep = 0; long a_tstride = 0; };

struct StaticOrder {
    int nM, nN, nwg, G, c, rev, pm0 = 0, wgm = WGM;
    __host__ __device__ void init(int nM_, int nN_, int G_, int c_, int rev_ = 0) { nM = nM_; nN = nN_; nwg = nM * nN; G = G_; c = c_; rev = rev_; }
    __host__ __device__ bool next(int i, Unit& u) const { return unit_of((long)i * G + c, u); }
    __host__ __device__ bool unit_of(long L, Unit& u) const {
        if (L >= nwg) return false;
        int wgid = (int)L; { const int q = nwg / NXCD, r = nwg % NXCD, xcd = wgid % NXCD, off = wgid / NXCD; wgid = (xcd < r ? xcd * (q + 1) : r * (q + 1) + (xcd - r) * q) + off; }
        const int nig = wgm * nN, gid = wgid / nig, fm = gid * wgm, gsz = (nM - fm) < wgm ? (nM - fm) : wgm;
        u.pm = fm + ((wgid % nig) % gsz); if (rev) u.pm = nM - 1 - u.pm; u.pm += pm0; u.pn = (wgid % nig) / gsz; u.arow = u.pm * BM; u.brow = u.pn * BM; return true;
    }
};

typedef float f32x8_t __attribute__((ext_vector_type(8)));
__device__ __forceinline__ f32x4 lo4(f32x8_t a) { return __builtin_shufflevector(a, a, 0, 1, 2, 3); }
__device__ __forceinline__ f32x4 hi4(f32x8_t a) { return __builtin_shufflevector(a, a, 4, 5, 6, 7); }
__device__ __forceinline__ f32x8_t set_lo4(f32x8_t a, f32x4 c) { return __builtin_shufflevector(__builtin_shufflevector(c, c, 0, 1, 2, 3, -1, -1, -1, -1), a, 0, 1, 2, 3, 12, 13, 14, 15); }
__device__ __forceinline__ f32x8_t set_hi4(f32x8_t a, f32x4 c) { return __builtin_shufflevector(a, __builtin_shufflevector(c, c, 0, 1, 2, 3, -1, -1, -1, -1), 0, 1, 2, 3, 8, 9, 10, 11); }
typedef int v4i_t __attribute__((ext_vector_type(4)));
typedef int v8i_t __attribute__((ext_vector_type(8)));
__device__ __forceinline__ v8i_t cat8(bf16x8 a, bf16x8 b) { return __builtin_shufflevector(__builtin_bit_cast(v4i_t, a), __builtin_bit_cast(v4i_t, b), 0, 1, 2, 3, 4, 5, 6, 7); }
__device__ __forceinline__ unsigned cvt_pk_bf16(float lo, float hi) { unsigned r; asm volatile("v_cvt_pk_bf16_f32 %0, %1, %2" : "=v"(r) : "v"(lo), "v"(hi)); return r; }

constexpr int GA_MAX_UNITS = 24, GA_TAB_OFF = STAGE_BYTES + 1024;
template <class Epi, class Sched, bool ALIGN_EPI = false, bool SP2 = false, bool GATHER_A = false, bool FP8 = false>
__device__ __forceinline__ void gemm_phase(PG8_LAS unsigned char* lds, const Gemm g, const Sched& S, const Epi& E, const int wave_id) {
    const int tid_ = lane_id_fresh() | (wave_id << 6);
    const int tid = tid_, wid = __builtin_amdgcn_readfirstlane(tid >> 6), lane = tid & 63, wr = wid >> 2, wc = wid & 3, fr = lane & 15, fq = lane >> 4;
    const char* gA = (const char*)g.A; const char* gB = (const char*)g.Bt; asm volatile("" : "+s"(gA), "+s"(gB));
    int K_ = g.K; asm volatile("" : "+s"(K_));
    const int nt = K_ / BK, lda = g.lda, ldb = g.ldb;
    unsigned voffA[2], voffB[2];
    int gaR[2], gaC[2];
#pragma unroll
    for (int i = 0; i < 2; ++i) { int R, C; stage_rc(tid * 16 + i * 8192, R, C); const int Rb = Epi::PERM ? ((R & ~31) + perm32(R & 31)) : R; gaR[i] = R; gaC[i] = C * 2;
        voffA[i] = (unsigned)(R * lda + C) * 2u; voffB[i] = (unsigned)(Rb * ldb + C) * 2u; }
    const size_t kstep = (size_t)(BK * 2);
    const size_t kstepA = g.a_kstep ? (size_t)g.a_kstep : kstep;
    const size_t hstepA = (size_t)HALF * lda * 2, hstepB = (size_t)HALF * ldb * 2;
    const unsigned ldsw = (unsigned)wid * 1024u;
    const int aoff = lds_byte(wr * 64 + fr, fq * 8), boff = lds_byte(wc * 32 + fr, fq * 8);
#define PG8_SA(b, h) (((b) * 2 + (h)) * HTB)
#define PG8_SB(b, h) ((4 + (b) * 2 + (h)) * HTB)
#define PG8_STAGE(bufoff, gbase, voff) do { _Pragma("unroll") for (int _i = 0; _i < 2; ++_i) \
        __builtin_amdgcn_global_load_lds((const unsigned*)((const char*)(gbase) + (voff)[_i]), (PG8_LAS unsigned*)(lds + (bufoff) + ldsw + _i * 8192), 16, 0, 0); } while (0)
#define PG8_STAGE_G(bufoff, h, kofs, sel) do { _Pragma("unroll") for (int _i = 0; _i < 2; ++_i) { const unsigned vo_ = (sel) ? nvA[h][_i] : cvA[h][_i]; \
        __builtin_amdgcn_global_load_lds((const unsigned*)(gA + (kofs) + vo_), (PG8_LAS unsigned*)(lds + (bufoff) + ldsw + _i * 8192), 16, 0, 0); } } while (0)
#define PG8_STAGE_A(bufoff, ptr, h, kofs, sel) do { if constexpr (GATHER_A) PG8_STAGE_G(bufoff, h, kofs, sel); else PG8_STAGE(bufoff, ptr, voffA); } while (0)
#define PG8_GA_VOFF(dst, ui_) do { _Pragma("unroll") for (int h_ = 0; h_ < 2; ++h_) _Pragma("unroll") for (int i_ = 0; i_ < 2; ++i_) \
        dst[h_][i_] = (unsigned)tabL[(ui_) * 256 + h_ * 128 + gaR[i_]] * (unsigned)(lda * 2) + (unsigned)gaC[i_]; } while (0)
#define PG8_LDA(dst, b, h) do { _Pragma("unroll") for (int m = 0; m < 4; ++m) _Pragma("unroll") for (int k = 0; k < 2; ++k) dst[m][k] = *(const PG8_LAS bf16x8*)(lds + PG8_SA(b, h) + aoff + m * 2048 + k * 1024); } while (0)
#define PG8_LDA_HI(dst, b, h) do { _Pragma("unroll") for (int m = 0; m < 2; ++m) _Pragma("unroll") for (int k = 0; k < 2; ++k) dst[m][k] = *(const PG8_LAS bf16x8*)(lds + PG8_SA(b, h) + aoff + (m + 2) * 2048 + k * 1024); } while (0)
#define PG8_MFMA8(accv, a8, b8) asm volatile("v_mfma_f32_16x16x128_f8f6f4 %0, %1, %2, %0" : "+v"(accv) : "v"(a8), "v"(b8))
#define PG8_MMA8(ai, bj, At, Bt, mh) do { _Pragma("unroll") for (int m = 0; m < 2; ++m) _Pragma("unroll") for (int n = 0; n < 2; ++n) { \
        const v8i_t a8_ = cat8(Bt[n][0], Bt[n][1]), b8_ = cat8(At[m][0], At[m][1]); PG8_MFMA8(acc[ai][bj][(mh) * 2 + m][n], a8_, b8_); } } while (0)
#define PG8_MMA_PAIR(ai, b, h) do { PG8_MMA(ai, 0, At, B0); PG8_MMA(ai, 1, At, B1); } while (0)
#define PG8_LDB(dst, b, h) do { _Pragma("unroll") for (int n = 0; n < 2; ++n) _Pragma("unroll") for (int k = 0; k < 2; ++k) dst[n][k] = *(const PG8_LAS bf16x8*)(lds + PG8_SB(b, h) + boff + n * 2048 + k * 1024); } while (0)
#define PG8_MMA(ai, bj, At, Bt) do { __builtin_amdgcn_s_setprio(1); if constexpr (FP8) { _Pragma("unroll") for (int m = 0; m < 4; ++m) _Pragma("unroll") for (int n = 0; n < 2; ++n) { \
        const v8i_t a8_ = cat8(Bt[n][0], Bt[n][1]), b8_ = cat8(At[m][0], At[m][1]); PG8_MFMA8(acc[ai][bj][m][n], a8_, b8_); } } \
        else { _Pragma("unroll") for (int m = 0; m < 4; ++m) _Pragma("unroll") for (int n = 0; n < 2; ++n) _Pragma("unroll") for (int k = 0; k < 2; ++k) \
        acc[ai][bj][m][n] = __builtin_amdgcn_mfma_f32_16x16x32_bf16(Bt[n][k], At[m][k], acc[ai][bj][m][n], 0, 0, 0); } __builtin_amdgcn_s_setprio(0); } while (0)
#define PG8_WAIT_V(n) asm volatile("s_waitcnt vmcnt(" #n ")" ::: "memory")
#define PG8_WAIT_L(n) asm volatile("s_waitcnt lgkmcnt(" #n ")" ::: "memory")
#define PG8_BAR __builtin_amdgcn_s_barrier()
#define PG8_SCHED __builtin_amdgcn_sched_barrier(0)
    Unit cur, nxt; int ui = 0;
    if (!S.next(0, cur)) return;
    f32x4 acc[2][2][4][2];
#pragma unroll
    for (int a = 0; a < 2; ++a)
#pragma unroll
        for (int b = 0; b < 2; ++b)
#pragma unroll
            for (int m = 0; m < 4; ++m)
                { _Pragma("unroll") for (int n = 0; n < 2; ++n) acc[a][b][m][n] = (f32x4){0.f, 0.f, 0.f, 0.f}; }
    bf16x8 At[4][2], B0[2][2], B1[2][2];
    static_assert(!GATHER_A || SP2, "GATHER_A is written for the SP2 loop");
    const PG8_LAS unsigned short* tabL = (const PG8_LAS unsigned short*)(lds + GA_TAB_OFF);
    unsigned cvA[2][2] = {{0u, 0u}, {0u, 0u}}, nvA[2][2] = {{0u, 0u}, {0u, 0u}};
    if constexpr (GATHER_A) {
        Unit uu;
        for (int q = 0; q < GA_MAX_UNITS && S.next(q, uu); ++q) if (tid < 256) { const int v = g.a_rows[uu.arow + tid]; ((PG8_LAS unsigned short*)(lds + GA_TAB_OFF))[q * 256 + tid] = (unsigned short)(v < 0 ? 0 : (v >> 1)); }
        asm volatile("s_waitcnt vmcnt(0) lgkmcnt(0)" ::: "memory"); PG8_BAR; asm volatile("" ::: "memory");
        PG8_GA_VOFF(cvA, 0);
    }
    const char* cA = gA + (g.a_tstride ? (size_t)(cur.arow >> 8) * (size_t)g.a_tstride : (size_t)cur.arow * lda * 2); const char* cB = gB + (size_t)cur.brow * ldb * 2;
    if constexpr (SP2) {
        PG8_STAGE(PG8_SB(0, 0), cB, voffB); PG8_STAGE(PG8_SB(0, 1), cB + hstepB, voffB); PG8_STAGE_A(PG8_SA(0, 0), cA, 0, (size_t)0, false); PG8_STAGE_A(PG8_SA(0, 1), cA + hstepA, 1, (size_t)0, false);
        if (wr == 1) PG8_BAR;
        PG8_WAIT_V(2); PG8_BAR;
        PG8_STAGE(PG8_SB(1, 0), cB + kstep, voffB); PG8_STAGE_A(PG8_SA(1, 0), cA + kstepA, 0, kstep, false); PG8_STAGE(PG8_SB(1, 1), cB + hstepB + kstep, voffB);
        PG8_WAIT_V(6); PG8_BAR;
    } else {
        PG8_STAGE(PG8_SB(0, 0), cB, voffB); PG8_STAGE(PG8_SA(0, 0), cA, voffA); PG8_STAGE(PG8_SB(0, 1), cB + hstepB, voffB); PG8_STAGE(PG8_SA(0, 1), cA + hstepA, voffA);
        if (wr == 1) PG8_BAR;
        PG8_WAIT_V(4); PG8_BAR;
        PG8_STAGE(PG8_SB(1, 0), cB + kstep, voffB); PG8_STAGE(PG8_SA(1, 0), cA + kstep, voffA); PG8_STAGE(PG8_SB(1, 1), cB + hstepB + kstep, voffB);
        PG8_WAIT_V(6); PG8_BAR;
    }
    for (;;) {
        const bool has_next = S.next(ui + 1, nxt);
        const char* nA = has_next ? gA + (g.a_tstride ? (size_t)(nxt.arow >> 8) * (size_t)g.a_tstride : (size_t)nxt.arow * lda * 2) : cA; const char* nB = has_next ? gB + (size_t)nxt.brow * ldb * 2 : cB;
        if constexpr (GATHER_A) { if (has_next) PG8_GA_VOFF(nvA, ui + 1); else { nvA[0][0] = cvA[0][0]; nvA[0][1] = cvA[0][1]; nvA[1][0] = cvA[1][0]; nvA[1][1] = cvA[1][1]; } }
        for (int t = 0; t < nt; t += 2) {
            if constexpr (Epi::HOOKS) { if (t == Epi::H1 || t == Epi::H2) E.mid(acc, cur, t, wr, wc, fr, fq); }
            const bool last = (t == nt - 2);
            const char* a1 = cA + (size_t)(t + 1) * kstepA;
            const char* a2 = last ? nA : cA + (size_t)(t + 2) * kstepA; const char* b2 = last ? nB : cB + (size_t)(t + 2) * kstep;
            const char* a3 = a2 + kstepA; const char* b3 = b2 + kstep;
            const size_t k1 = (size_t)(t + 1) * kstep, k2 = last ? (size_t)0 : (size_t)(t + 2) * kstep;
            if constexpr (SP2) {
            PG8_LDB(B0, 0, 0); PG8_LDB(B1, 0, 1); PG8_SCHED; PG8_LDA(At, 0, 0); PG8_STAGE_A(PG8_SA(1, 1), a1 + hstepA, 1, k1, false);
            PG8_WAIT_V(8); PG8_WAIT_L(0); PG8_BAR; PG8_MMA_PAIR(0, 0, 0); PG8_BAR; PG8_SCHED;
            PG8_LDA(At, 0, 1); PG8_STAGE(PG8_SB(0, 0), b2, voffB); PG8_STAGE(PG8_SB(0, 1), b2 + hstepB, voffB); PG8_STAGE_A(PG8_SA(0, 0), a2, 0, k2, last);
            PG8_WAIT_V(8); PG8_WAIT_L(0); PG8_BAR; PG8_MMA_PAIR(1, 0, 1); PG8_BAR; PG8_SCHED;
            PG8_LDB(B0, 1, 0); PG8_LDB(B1, 1, 1); PG8_SCHED; PG8_LDA(At, 1, 0); PG8_STAGE_A(PG8_SA(0, 1), a2 + hstepA, 1, k2, last);
            PG8_WAIT_V(8); PG8_WAIT_L(0); PG8_BAR; PG8_MMA_PAIR(0, 1, 0); PG8_BAR; PG8_SCHED;
            PG8_LDA(At, 1, 1); PG8_STAGE(PG8_SB(1, 0), b3, voffB); PG8_STAGE(PG8_SB(1, 1), b3 + hstepB, voffB); PG8_STAGE_A(PG8_SA(1, 0), a3, 0, k2 + kstep, last);
            PG8_WAIT_V(8); PG8_WAIT_L(0); PG8_BAR; PG8_MMA_PAIR(1, 1, 1); PG8_BAR; PG8_SCHED;
            } else {
            PG8_LDB(B0, 0, 0); PG8_SCHED; PG8_LDA(At, 0, 0); PG8_STAGE(PG8_SA(1, 1), a1 + hstepA, voffA);
            PG8_WAIT_L(8); PG8_BAR; PG8_WAIT_L(0); PG8_MMA(0, 0, At, B0); PG8_BAR; PG8_SCHED;
            PG8_LDB(B1, 0, 1); PG8_STAGE(PG8_SB(0, 0), b2, voffB);
            PG8_BAR; PG8_WAIT_L(0); PG8_MMA(0, 1, At, B1); PG8_BAR;
            PG8_LDA(At, 0, 1); PG8_STAGE(PG8_SA(0, 0), a2, voffA);
            PG8_BAR; PG8_WAIT_L(0); PG8_MMA(1, 0, At, B0); PG8_BAR; PG8_SCHED;
            PG8_STAGE(PG8_SB(0, 1), b2 + hstepB, voffB);
            PG8_WAIT_V(6); PG8_BAR; PG8_MMA(1, 1, At, B1); PG8_BAR;
            PG8_LDB(B0, 1, 0); PG8_SCHED; PG8_LDA(At, 1, 0); PG8_STAGE(PG8_SA(0, 1), a2 + hstepA, voffA);
            PG8_WAIT_L(8); PG8_BAR; PG8_WAIT_L(0); PG8_MMA(0, 0, At, B0); PG8_BAR; PG8_SCHED;
            PG8_LDB(B1, 1, 1); PG8_STAGE(PG8_SB(1, 0), b3, voffB);
            PG8_BAR; PG8_WAIT_L(0); PG8_MMA(0, 1, At, B1); PG8_BAR;
            PG8_LDA(At, 1, 1); PG8_STAGE(PG8_SA(1, 0), a3, voffA);
            PG8_BAR; PG8_WAIT_L(0); PG8_MMA(1, 0, At, B0); PG8_BAR; PG8_SCHED;
            PG8_STAGE(PG8_SB(1, 1), b3 + hstepB, voffB);
            PG8_WAIT_V(6); PG8_BAR; PG8_MMA(1, 1, At, B1); PG8_BAR;
            }
        }
        if constexpr (ALIGN_EPI) { if (wr == 0) PG8_BAR; }
        if constexpr (FP8) asm volatile("s_nop 15\n\ts_nop 15" ::: "memory");
        if constexpr (!Epi::AFTER_DRAIN) { E(acc, cur, wr, wc, fr, fq);
#ifdef PROBE_EPI2
            if constexpr (!Epi::RMW) { asm volatile("" ::: "memory"); E(acc, cur, wr, wc, fr, fq); }
#endif
        }
        if (!has_next) break;
#pragma unroll
        for (int a = 0; a < 2; ++a)
#pragma unroll
            for (int b = 0; b < 2; ++b)
#pragma unroll
                for (int m = 0; m < 4; ++m)
                    { _Pragma("unroll") for (int n = 0; n < 2; ++n) acc[a][b][m][n] = (f32x4){0.f, 0.f, 0.f, 0.f}; }
        cur = nxt; cA = nA; cB = nB; ++ui;
        if constexpr (GATHER_A) { cvA[0][0] = nvA[0][0]; cvA[0][1] = nvA[0][1]; cvA[1][0] = nvA[1][0]; cvA[1][1] = nvA[1][1]; }
        if constexpr (ALIGN_EPI) { if (wr == 1) PG8_BAR; }
    }
    PG8_WAIT_V(0);
    if constexpr (!ALIGN_EPI) { if (wr == 0) PG8_BAR; }
    PG8_BAR;
    if constexpr (Epi::AFTER_DRAIN) E.fused(acc, cur, wr, wc, fr, fq, lds, tid);
#undef PG8_SA
#undef PG8_SB
#undef PG8_STAGE
#undef PG8_STAGE_G
#undef PG8_STAGE_A
#undef PG8_GA_VOFF
#undef PG8_LDA
#undef PG8_LDB
#undef PG8_MMA
#undef PG8_WAIT_V
#undef PG8_WAIT_L
#undef PG8_BAR
#undef PG8_SCHED
}
}
constexpr int NWAVES = 8;
constexpr int BATCH = 16, SEQ = 4096, D = 1024, DEPTH = 4, M = BATCH * SEQ;
constexpr int NH = 8, HD = 64, ATT_W = 512, SSM_W = 256, SSM_G = 16, SSM_P = 64, SSM_H = 16, CONV_W = 256, CONV_K = 31;
constexpr int N_IN = 5384, N_INP = 5632, D_FF = 2816, NE = 8, D_FFE = 3584;
constexpr float EPS = 1e-6f;
constexpr float LOG2E = 1.4426950408889634f;
constexpr float QSCALE = 0.125f * LOG2E;
constexpr int MOE_ROWS_CAP = 133120;
constexpr int MOE_NCHUNK = 3, MOE_CHUNK_TILES_CAP = 174;

constexpr size_t MiB = 1u << 20;
constexpr size_t WS_CTL = 0, CTL_ZERO_BYTES = 1 * MiB;
constexpr size_t WS_BPERM = 1 * MiB;
constexpr size_t WS_TOKE = 2 * MiB;
constexpr size_t WS_TOKW = 3 * MiB;
constexpr size_t WS_CNTW = 4 * MiB;
constexpr size_t WS_META = 4 * MiB + 512 * 1024;
constexpr size_t WS_RDEST = 5 * MiB;
constexpr size_t WS_RW = 6 * MiB;
constexpr size_t WS_RRSTD = 7 * MiB;
constexpr size_t WS_WMIX = 16 * MiB, WMIX_STRIDE = 16 * MiB;
constexpr size_t WM_IN = 0, WM_GLU = 11 * MiB, WM_A = WM_GLU + 256 * 1024, WM_S = WM_A + 1 * MiB, WM_C = WM_S + 512 * 1024, WM_O = WM_C + 512 * 1024;
constexpr size_t WS_WDENSE = 80 * MiB, WDENSE_STRIDE = 16 * MiB + 512 * 1024;
constexpr size_t WD_GU = 0, WD_D = 11 * MiB;
constexpr size_t WS_WMOE = 113 * MiB;
constexpr size_t WMOE_GU = 0, WMOE_D = 112 * MiB;
constexpr size_t WS_XB = 281 * MiB;
constexpr size_t WS_SSQ = 409 * MiB;
constexpr size_t WS_LOGF = 413 * MiB;
constexpr size_t WS_FH = 415 * MiB;
constexpr size_t WS_BIG = 417 * MiB;
constexpr size_t WS_GATES = WS_BIG;
constexpr size_t WS_YG = WS_BIG + 384 * MiB;
constexpr size_t WS_BCAT = WS_YG + 32 * MiB;
constexpr size_t WS_CONVO = WS_BCAT + 96 * MiB;
constexpr size_t WS_HID = WS_BIG;
constexpr size_t WS_XG = WS_BIG;
constexpr size_t WS_XB8 = WS_BIG + 416 * MiB;
constexpr size_t WS_MHID = WS_BIG, MHID_BYTES = 153 * MiB;
constexpr size_t WS_UA = WS_BCAT + 128 * MiB;
constexpr size_t WS_MV = WS_UA + 36 * MiB;
constexpr size_t WS_WG = WS_MV + 36 * MiB;
constexpr size_t WS_APOW = 8 * MiB;
constexpr size_t WS_BBAR = 11 * MiB;
constexpr size_t WS_KTAB = 12 * MiB;
constexpr size_t WS_END = WS_WG + 8 * MiB;
static_assert(WS_MHID + 2 * MHID_BYTES <= WS_END, "ws map");
static_assert(WS_HID + 352 * MiB <= WS_END, "ws map");
constexpr size_t DO_Q = 0, DO_K = 64 * MiB, DO_V = 128 * MiB, DO_U = 192 * MiB, DO_HC = 224 * MiB, DO_MERGED = 64 * MiB;

constexpr int CW_TMO = 0, CW_CODE = 1;
constexpr int CW_BAR = 4096;

constexpr int RING_OFF = 0, RING_BYTES = 131072;
constexpr int LDSCTL_OFF = RING_BYTES, MISC_OFF = LDSCTL_OFF + 320;
constexpr int LDS_BYTES = 147456;

#define GAS __attribute__((address_space(1)))
#define LAS __attribute__((address_space(3)))
typedef unsigned short bf16;
typedef unsigned v4u __attribute__((ext_vector_type(4)));
typedef unsigned v2u __attribute__((ext_vector_type(2)));
typedef float f32x4 __attribute__((ext_vector_type(4)));
typedef float f32x2 __attribute__((ext_vector_type(2)));
typedef GAS unsigned gu32;
#define RLX_AGENT __ATOMIC_RELAXED, __HIP_MEMORY_SCOPE_AGENT
#define LDS_WAIT() asm volatile("s_waitcnt lgkmcnt(0)" ::: "memory")
#define VM_WAIT() asm volatile("s_waitcnt vmcnt(0)" ::: "memory")
__device__ __forceinline__ unsigned f2bf(float f) { unsigned u = __builtin_bit_cast(unsigned, f); return (u + 0x7fffu + ((u >> 16) & 1u)) >> 16; }
__device__ __forceinline__ unsigned pk2(float lo, float hi) { return pg8::cvt_pk_bf16(lo, hi); }
__device__ __forceinline__ float bflo(unsigned u) { return __builtin_bit_cast(float, u << 16); }
__device__ __forceinline__ float bfhi(unsigned u) { return __builtin_bit_cast(float, u & 0xffff0000u); }
__device__ __forceinline__ float bf1(bf16 h) { return __builtin_bit_cast(float, (unsigned)h << 16); }
__device__ __forceinline__ float sigmoidf_(float x) { return __builtin_amdgcn_rcpf(1.0f + __builtin_amdgcn_exp2f(-1.4426950408889634f * x)); }
__device__ __forceinline__ float wave_sum(float v) {
#pragma unroll
    for (int o = 1; o < 64; o <<= 1) v += __shfl_xor(v, o);
    return v;
}

#define XB_TMO      128
#define XB_XCNT(j)  (256  + 64 * (j))
#define XB_XSUB(j)  (1280 + 64 * (j))
#define XB_XGEN(j)  (2304 + 64 * (j))
#define XB_TOP      3328
#define XB_TOPGEN   3392
#define XCD_BAR_WORDS 3456
#define XB_SPIN_CAP (1u << 18)

__device__ __forceinline__ unsigned xb_ld(unsigned* p)              { return __hip_atomic_load(p, __ATOMIC_RELAXED, __HIP_MEMORY_SCOPE_AGENT); }
__device__ __forceinline__ unsigned xb_add(unsigned* p, unsigned v) { return __hip_atomic_fetch_add(p, v, __ATOMIC_RELAXED, __HIP_MEMORY_SCOPE_AGENT); }
__device__ __forceinline__ unsigned xb_xcc_id() { return (unsigned)__builtin_amdgcn_s_getreg((3 << 11) | 20) & 0xFu; }
#define XB_SPIN(cond, bar) do { unsigned _sp = 0; while (cond) { __builtin_amdgcn_s_sleep(1); \
    if ((++_sp & 255u) == 0u) { if (xb_ld(&(bar)[XB_TMO])) break; if (_sp > XB_SPIN_CAP) { atomicAdd(&(bar)[XB_TMO], 1u); break; } } } } while (0)

struct XcdBarrier {
    unsigned* bar; unsigned x;
    volatile LAS unsigned* st;
};
__device__ __forceinline__ bool xb_thread0(int wave_id) { return wave_id == 0 && lane_id_fresh() == 0; }
__device__ __forceinline__ XcdBarrier xcd_barrier_post(unsigned* bar, volatile LAS unsigned* st, int wave_id) {
    XcdBarrier b; b.bar = bar; b.x = xb_xcc_id(); b.st = st;
    if (xb_thread0(wave_id)) (void)xb_add(&bar[XB_XCNT(b.x)], 1u);
    return b;
}
__device__ __forceinline__ void xcd_barrier_complete(unsigned* bar, unsigned x, unsigned& nloc, unsigned& nx) {
    const unsigned G = gridDim.x * gridDim.y * gridDim.z;
    unsigned sum, cnt, mine, sp = 0u;
    for (;;) {
        sum = 0u; cnt = 0u; mine = 0u;
#pragma unroll
        for (unsigned j = 0; j < 16; ++j) { const unsigned c = xb_ld(&bar[XB_XCNT(j)]); sum += c; cnt += (c > 0u) ? 1u : 0u; mine = (j == x) ? c : mine; }
        if (sum == G) break;
        __builtin_amdgcn_s_sleep(1);
        if ((++sp & 255u) == 0u) { if (xb_ld(&bar[XB_TMO])) break; if (sp > XB_SPIN_CAP) { atomicAdd(&bar[XB_TMO], 1u); break; } }
    }
    nloc = mine > 0u ? mine : 1u; nx = cnt > 0u ? cnt : 1u;
}
__device__ __forceinline__ void xcd_barrier(const XcdBarrier& b, int wave_id) {
    asm volatile("s_waitcnt vmcnt(0)" ::: "memory");
    __syncthreads();
    if (xb_thread0(wave_id)) {
        unsigned* bar = b.bar;
        __builtin_amdgcn_s_waitcnt(0);
        unsigned nloc = b.st[0], nx = b.st[1];
        if (nloc == 0u) { xcd_barrier_complete(bar, b.x, nloc, nx); b.st[0] = nloc; b.st[1] = nx; }
        const unsigned old = xb_add(&bar[XB_XSUB(b.x)], 1u);
        const unsigned gen = old / nloc;
        if (old + 1u == (gen + 1u) * nloc) {
            __builtin_amdgcn_fence(__ATOMIC_RELEASE, "agent");
            asm volatile("s_waitcnt vmcnt(0)" ::: "memory");
            const unsigned og = xb_add(&bar[XB_TOP], 1u);
            const unsigned tg = og / nx;
            if (og + 1u == (tg + 1u) * nx) xb_add(&bar[XB_TOPGEN], 1u);
            else XB_SPIN(xb_ld(&bar[XB_TOPGEN]) == tg, bar);
            __builtin_amdgcn_fence(__ATOMIC_ACQUIRE, "agent");
            xb_add(&bar[XB_XGEN(b.x)], 1u);
            asm volatile("s_waitcnt vmcnt(0)" ::: "memory");
        } else {
            XB_SPIN(xb_ld(&bar[XB_XGEN(b.x)]) == gen, bar);
            __builtin_amdgcn_fence(__ATOMIC_ACQUIRE, "agent");
            asm volatile("s_waitcnt vmcnt(0)" ::: "memory");
        }
    }
    __syncthreads();
}


namespace attn_body {
using bf16=__hip_bfloat16;
using bf16x8=__attribute__((ext_vector_type(8)))short;
using s16x4=__attribute__((ext_vector_type(4)))short;
using f32x16=__attribute__((ext_vector_type(16)))float;
using u32x4=__attribute__((ext_vector_type(4)))unsigned;
using f32x4_t=__attribute__((ext_vector_type(4)))float;
constexpr int BATCH=16,NHEAD=8,SEQ=4096,D=64,DM=NHEAD*D;
constexpr int NW=8,QBLK=32,QB=QBLK*NW,KVBLK=64,NQB=SEQ/QB;
constexpr int ATTN_PITCH=DM, ATTN_UNIT_ROWS=QB, OPITCH=1024;
__device__ __forceinline__ int crow(int r,int hi){return (r&3)+8*(r>>2)+4*hi;}
#define SBAR() __builtin_amdgcn_sched_barrier(0)
__device__ __forceinline__ void cmask(f32x16&p0,f32x16&p1,int jb,int qrel,int hi){
  const float NEG=-INFINITY; int kb=64*jb+4*hi;
  #pragma unroll
  for(int r=0;r<16;++r){int kv=kb+(r&3)+8*(r>>2); if(kv>qrel)p0[r]=NEG; if(kv+32>qrel)p1[r]=NEG;}
}

constexpr int NSLOT=3, SLOTB=8192;
constexpr int LDS_K=0, LDS_V=NSLOT*SLOTB, LDS_WS=2*NSLOT*SLOTB, LDS_OST=LDS_WS+NW*64*4, LDS_KB=LDS_OST+NW*4096, LDS_BYTES=LDS_KB+SEQ*4;
constexpr float C2=0.125f*1.4426950408889634f;
__device__ __forceinline__ void glds16(const void*gsrc,unsigned lds_dst){unsigned keep;
  asm volatile("s_mov_b32 %0, m0\n\ts_mov_b32 m0, %2\n\ts_nop 0\n\tglobal_load_lds_dwordx4 %1, off\n\ts_mov_b32 m0, %0":"=&s"(keep):"v"(gsrc),"s"(lds_dst):"memory");}
__device__ __forceinline__ float max3f(float a,float b,float c){float r;asm("v_max3_f32 %0, %1, %2, %3":"=v"(r):"v"(a),"v"(b),"v"(c));return r;}
__device__ __forceinline__ float max2f(float a,float b){float r;asm("v_max_f32_e32 %0, %1, %2":"=v"(r):"v"(a),"v"(b));return r;}
__device__ __forceinline__ float fadd_s(float a,float b){float r;asm("v_add_f32_e32 %0, %1, %2":"=v"(r):"v"(a),"v"(b));return r;}
__device__ __forceinline__ float fsub_s(float a,float b){float r;asm("v_sub_f32_e32 %0, %1, %2":"=v"(r):"v"(a),"v"(b));return r;}
typedef float f32x2_t __attribute__((ext_vector_type(2))); typedef __bf16 bf16x2_t __attribute__((ext_vector_type(2)));
__device__ __forceinline__ unsigned cvtpk_s(float lo,float hi){f32x2_t v={lo,hi};bf16x2_t b=__builtin_convertvector(v,bf16x2_t);return __builtin_bit_cast(unsigned,b);}
#define WAIT_BAR(N) asm volatile("s_waitcnt vmcnt(" #N ") lgkmcnt(0)\n\ts_barrier":::"memory")

__device__ __forceinline__ void qkt(f32x16&p0,f32x16&p1,const char*Kslot,const bf16x8*qr,const f32x16&negm,int r32,int hi){
  const char*kb=Kslot+hi*1024+r32*16;
  #pragma unroll
  for(int d0=0;d0<4;++d0){
    const bf16x8 b0=*reinterpret_cast<const bf16x8*>(kb+d0*2048);
    const bf16x8 b1=*reinterpret_cast<const bf16x8*>(kb+d0*2048+512);
    if(d0==0){p0=__builtin_amdgcn_mfma_f32_32x32x16_bf16(b0,qr[0],negm,0,0,0);p1=__builtin_amdgcn_mfma_f32_32x32x16_bf16(b1,qr[0],negm,0,0,0);}
    else{p0=__builtin_amdgcn_mfma_f32_32x32x16_bf16(b0,qr[d0],p0,0,0,0);p1=__builtin_amdgcn_mfma_f32_32x32x16_bf16(b1,qr[d0],p1,0,0,0);}}
}
typedef __attribute__((address_space(3))) const char* lds_cptr;
typedef short v4i16_t __attribute__((ext_vector_type(4)));
__device__ __forceinline__ void kload8(bf16x8*kf,lds_cptr kp){
  kf[0]=*(const __attribute__((address_space(3))) bf16x8*)(kp);      kf[1]=*(const __attribute__((address_space(3))) bf16x8*)(kp+512);
  kf[2]=*(const __attribute__((address_space(3))) bf16x8*)(kp+2048); kf[3]=*(const __attribute__((address_space(3))) bf16x8*)(kp+2560);
  kf[4]=*(const __attribute__((address_space(3))) bf16x8*)(kp+4096); kf[5]=*(const __attribute__((address_space(3))) bf16x8*)(kp+4608);
  kf[6]=*(const __attribute__((address_space(3))) bf16x8*)(kp+6144); kf[7]=*(const __attribute__((address_space(3))) bf16x8*)(kp+6656);
}
__device__ __forceinline__ void kload2(bf16x8*kf,lds_cptr kp,int j){ kf[2*j]=*(const __attribute__((address_space(3))) bf16x8*)(kp+j*2048); kf[2*j+1]=*(const __attribute__((address_space(3))) bf16x8*)(kp+j*2048+512); }
__device__ __forceinline__ s16x4 vtr(lds_cptr p){ return __builtin_bit_cast(s16x4,__builtin_amdgcn_ds_read_tr16_b64_v4i16((__attribute__((address_space(3))) v4i16_t*)p)); }
__device__ __forceinline__ float rowmax(const f32x16&p0,const f32x16&p1){
  float a=max3f(p0[0],p0[1],p1[0]),b=max3f(p0[2],p0[3],p1[1]);a=max3f(a,p1[2],p1[3]);
  #pragma unroll
  for(int r=4;r<16;r+=4){a=max3f(a,p0[r],p0[r+1]);b=max3f(b,p0[r+2],p0[r+3]);a=max3f(a,p1[r],p1[r+1]);b=max3f(b,p1[r+2],p1[r+3]);}
  const float m=max2f(a,b);
  auto rr=__builtin_amdgcn_permlane32_swap(__float_as_uint(m),__float_as_uint(m),false,false);
  return max2f(__uint_as_float(rr[0]),__uint_as_float(rr[1]));
}
__device__ __forceinline__ void pv(f32x16*o,int vb,bf16x8 pa0,bf16x8 pa1,bf16x8 pa2,bf16x8 pa3){
  #pragma unroll
  for(int d0=0;d0<2;++d0){s16x4 lo[4],hi[4];
    #pragma unroll
    for(int ks=0;ks<4;++ks){
      asm volatile("ds_read_b64_tr_b16 %0,%1 offset:%c2":"=&v"(lo[ks]):"v"(vb),"i"(d0*4096+ks*1024):"memory");
      asm volatile("ds_read_b64_tr_b16 %0,%1 offset:%c2":"=&v"(hi[ks]):"v"(vb),"i"(d0*4096+ks*1024+512):"memory");}
    asm volatile("s_waitcnt lgkmcnt(0)":::"memory");SBAR();
    #define PK(k) (bf16x8){lo[k][0],lo[k][1],lo[k][2],lo[k][3],hi[k][0],hi[k][1],hi[k][2],hi[k][3]}
    o[d0]=__builtin_amdgcn_mfma_f32_32x32x16_bf16(pa0,PK(0),o[d0],0,0,0);
    o[d0]=__builtin_amdgcn_mfma_f32_32x32x16_bf16(pa1,PK(1),o[d0],0,0,0);
    o[d0]=__builtin_amdgcn_mfma_f32_32x32x16_bf16(pa2,PK(2),o[d0],0,0,0);
    o[d0]=__builtin_amdgcn_mfma_f32_32x32x16_bf16(pa3,PK(3),o[d0],0,0,0);
    #undef PK
  }
}

#ifndef ATTN_STORE16
#define ATTN_STORE16(p,v) (*(u32x4*)(p)=(v))
#endif
template<int THRL> __device__ __forceinline__ void attn_unit(int b,int h,int qb,const bf16*Q,const bf16*__restrict__ K,const bf16*__restrict__ V,bf16*O,const float*Fh,char*shm,const int wave_id){
  const int tid_=lane_id_fresh()|(wave_id<<6);
  const int tid=tid_,lane=tid&63,r32=lane&31,hi=lane>>5; const int wid=__builtin_amdgcn_readfirstlane(tid>>6);
  const long rowbase=(long)b*SEQ; const int q0=qb*QB;
  const bf16*Qw=Q+(rowbase+q0+wid*QBLK)*DM+h*D;
  const int NT0=(q0+QB)/KVBLK; int ts;
  { float bvl=0.f; if(lane<NT0) bvl=(Fh[q0]-Fh[lane*KVBLK+KVBLK-1])*1.4426950408889634f;
    const unsigned long long alive=__ballot(lane<NT0 && bvl>=-100.f);
    ts=alive?(int)__builtin_ctzll(alive):NT0; ts&=~1; if(ts>NT0-4)ts=NT0-4; ts=__builtin_amdgcn_readfirstlane(ts); }
  const bf16*Kh=K+(rowbase+(long)ts*KVBLK)*DM+h*D,*Vh=V+(rowbase+(long)ts*KVBLK)*DM+h*D;
  const lds_cptr shm3=(lds_cptr)shm;
  const unsigned lds0=(unsigned)(uintptr_t)shm;
  float*wsf=(float*)(shm+LDS_WS)+wid*64;
  const bf16*ksrc=Kh+(long)lane*DM+wid*8;
  const bf16*vsrc=Vh+(long)(16*(wid&3)+(lane>>2))*DM+(wid>>2)*32+(lane&3)*8;
  const unsigned kdst=lds0+LDS_K+wid*1024, vdst=lds0+LDS_V+wid*1024;
  #define DMA_K(t,slot) glds16(ksrc+(long)(t)*KVBLK*DM,(unsigned)__builtin_amdgcn_readfirstlane(kdst+(slot)))
  #define DMA_V(t,slot) glds16(vsrc+(long)(t)*KVBLK*DM,(unsigned)__builtin_amdgcn_readfirstlane(vdst+(slot)))
  const int vb0=(int)(lds0+LDS_V)+((lane>>4)&1)*32+(lane&3)*8+(4*hi+((lane&15)>>2))*64;
  const char*Kbase=shm+LDS_K; bf16x8 kf[8];
  const lds_cptr kp0=shm3+LDS_K+hi*1024+r32*16; const lds_cptr vp0=shm3+LDS_V+((lane>>4)&1)*32+(lane&3)*8+(4*hi+((lane&15)>>2))*64;
  const int NT=NT0-ts;
  DMA_K(0,0);DMA_V(0,0);DMA_K(1,SLOTB);
  bf16x8 qr[4];
  #pragma unroll
  for(int d0=0;d0<4;++d0)qr[d0]=*reinterpret_cast<const bf16x8*>(&Qw[(long)r32*DM+d0*16+hi*8]);
  { const float fref=Fh[q0]; __attribute__((address_space(3))) float* kbt=(__attribute__((address_space(3))) float*)(shm3+LDS_KB);
    float fv[SEQ/(NW*64)];
    #pragma unroll
    for(int i=0;i<SEQ/(NW*64);++i){ const int k=ts*KVBLK+tid+i*NW*64; fv[i]=(k<q0+QB)?Fh[k]:0.f; }
    #pragma unroll
    for(int i=0;i<SEQ/(NW*64);++i){ const int k=ts*KVBLK+tid+i*NW*64; if(k<q0+QB) kbt[k]=(fref-fv[i])*1.4426950408889634f; } }
  const __attribute__((address_space(3))) float* kbp=(const __attribute__((address_space(3))) float*)(shm3+LDS_KB)+ts*KVBLK+4*hi;
  #define BIAS(P0,P1,t) do{ const __attribute__((address_space(3))) float* kp_=kbp+(t)*KVBLK; \
    _Pragma("unroll") for(int j_=0;j_<4;++j_){ const f32x4_t b0_=*(const __attribute__((address_space(3))) f32x4_t*)(kp_+8*j_); const f32x4_t b1_=*(const __attribute__((address_space(3))) f32x4_t*)(kp_+32+8*j_); \
      P0[4*j_]+=b0_[0];P0[4*j_+1]+=b0_[1];P0[4*j_+2]+=b0_[2];P0[4*j_+3]+=b0_[3]; P1[4*j_]+=b1_[0];P1[4*j_+1]+=b1_[1];P1[4*j_+2]+=b1_[2];P1[4*j_+3]+=b1_[3]; } }while(0)
  float mhat=0.f,l_reg=0.f;f32x16 o[2];o[0]=f32x16{};o[1]=f32x16{};f32x16 negm=f32x16{};asm volatile("":"+v"(negm));
  const int qrel=wid*QBLK+r32;
  #define CMASK(P0,P1,t) do{int jb_=(t)-(NT-4); if(jb_>=0)cmask(P0,P1,jb_,qrel,hi);}while(0)
  bool resc=false;
  #define START(P0,P1) do{ const float rm=rowmax(P0,P1); resc=false; \
    { const float dl=max2f(rm,kbq); mhat=fadd_s(mhat,dl); \
      _Pragma("unroll") for(int r=0;r<16;++r){P0[r]=fsub_s(P0[r],dl);P1[r]=fsub_s(P1[r],dl);} \
      _Pragma("unroll") for(int r=0;r<16;++r)negm[r]=-mhat; asm volatile("":"+v"(negm)); } \
    _Pragma("unroll") for(int r=0;r<16;++r)P0[r]=__builtin_amdgcn_exp2f(P0[r]); }while(0)
  #define RESC() do{ if(resc){ asm volatile("s_waitcnt lgkmcnt(0)":::"memory"); \
      _Pragma("unroll") for(int d_=0;d_<2;++d_) _Pragma("unroll") for(int r=0;r<16;++r)o[d_][r]*=wsf[crow(r,hi)]; } }while(0)
  f32x16 pA0,pA1,pB0,pB1;
  int sl_prev=0,sl_cur=0,sl_next=SLOTB;
  #define ROT() do{sl_prev=sl_cur;sl_cur=sl_next;sl_next=(sl_next==(NSLOT-1)*SLOTB)?0:sl_next+SLOTB;}while(0)
  DMA_K(2,2*SLOTB);
  WAIT_BAR(3);
  const float kbq=*((const __attribute__((address_space(3))) float*)(shm3+LDS_KB)+q0+qrel)+4.0f;
  qkt(pA0,pA1,Kbase,qr,negm,r32,hi);asm volatile("s_nop 15\n\ts_nop 7":"+v"(pA0),"+v"(pA1));BIAS(pA0,pA1,0);CMASK(pA0,pA1,0);
  START(pA0,pA1);
  _Pragma("unroll") for(int r=0;r<16;++r)pA1[r]=__builtin_amdgcn_exp2f(pA1[r]);
  WAIT_BAR(0);
  DMA_K(3,0);DMA_V(1,SLOTB);
  ROT();
  kload8(kf,kp0+sl_cur);
  WAIT_BAR(2);
  s16x4 vlo[8],vhi[8]; u32x4 pw0,pw1,pw2,pw3;
  #define PKW(P,B) cvtpk_s(P[B],P[B+1])
  #define PAF(k) __builtin_bit_cast(bf16x8,pw##k)
  #define VFR(i) (bf16x8){vlo[i][0],vlo[i][1],vlo[i][2],vlo[i][3],vhi[i][0],vhi[i][1],vhi[i][2],vhi[i][3]}
  #define PIN(x) asm volatile("":"+v"(x))
  #define MX3(a,b,c) __builtin_fmaxf(__builtin_fmaxf((a),(b)),(c))
  #define GAPA(MF,A0,A1,A2,A3,W0,W1,PW) do{ MF; sacc+=A0; sacc+=A1; sacc+=A2; sacc+=A3; PIN(sacc); W0; W1; PIN(PW); SBAR(); }while(0)
  #define EX(v) __builtin_amdgcn_exp2f(v)
  #define GAPB(MF,X,B) do{ MF; X[B]=EX(X[B]); X[B+1]=EX(X[B+1]); X[B+2]=EX(X[B+2]); X[B+3]=EX(X[B+3]); PIN(X); SBAR(); }while(0)
  #define VRD(i) do{ vlo[i]=vtr(vp_+(((i)>>2)*4096+((i)&3)*1024)); vhi[i]=vtr(vp_+(((i)>>2)*4096+((i)&3)*1024+512)); }while(0)
  #define KRD(G,j) do{ if(G){ kload2(kf,kp0+sl_next,j); SBAR(); } }while(0)
  #define STEP(C0,C1,P0,P1,t,GK,GV,GL) do{ SBAR(); \
    const lds_cptr vp_=vp0+sl_prev; \
    VRD(0); SBAR(); float sacc=(P0[0]+P0[1]); \
    GAPA(C0=__builtin_amdgcn_mfma_f32_32x32x16_bf16(kf[0],qr[0],negm,0,0,0), P0[2],P0[3],P0[4],P0[5],     pw0[0]=PKW(P0,0), pw0[1]=PKW(P0,2), pw0); \
    VRD(4); SBAR(); GAPA(C1=__builtin_amdgcn_mfma_f32_32x32x16_bf16(kf[1],qr[0],negm,0,0,0), P0[6],P0[7],P0[8],P0[9],     pw0[2]=PKW(P0,4), pw0[3]=PKW(P0,6), pw0); \
    VRD(1); SBAR(); GAPA(C0=__builtin_amdgcn_mfma_f32_32x32x16_bf16(kf[2],qr[1],C0,0,0,0),   P0[10],P0[11],P0[12],P0[13], pw1[0]=PKW(P0,8), pw1[1]=PKW(P0,10), pw1); \
    VRD(5); SBAR(); GAPA(C1=__builtin_amdgcn_mfma_f32_32x32x16_bf16(kf[3],qr[1],C1,0,0,0),   P0[14],P0[15],P1[0],P1[1],   pw1[2]=PKW(P0,12),pw1[3]=PKW(P0,14), pw1); \
    VRD(2); SBAR(); GAPA(C0=__builtin_amdgcn_mfma_f32_32x32x16_bf16(kf[4],qr[2],C0,0,0,0),   P1[2],P1[3],P1[4],P1[5],     pw2[0]=PKW(P1,0), pw2[1]=PKW(P1,2), pw2); \
    VRD(6); SBAR(); GAPA(C1=__builtin_amdgcn_mfma_f32_32x32x16_bf16(kf[5],qr[2],C1,0,0,0),   P1[6],P1[7],P1[8],P1[9],     pw2[2]=PKW(P1,4), pw2[3]=PKW(P1,6), pw2); \
    VRD(3); SBAR(); GAPA(C0=__builtin_amdgcn_mfma_f32_32x32x16_bf16(kf[6],qr[3],C0,0,0,0),   P1[10],P1[11],P1[12],P1[13], pw3[0]=PKW(P1,8), pw3[1]=PKW(P1,10), pw3); \
    VRD(7); SBAR(); GAPA(C1=__builtin_amdgcn_mfma_f32_32x32x16_bf16(kf[7],qr[3],C1,0,0,0),   P1[14],P1[15],0.f,0.f,       pw3[2]=PKW(P1,12),pw3[3]=PKW(P1,14), pw3); \
    l_reg+=sacc; \
    if(GK){DMA_K((t)+3,sl_cur);} if(GV){DMA_V((t)+1,sl_next);} \
    BIAS(C0,C1,t); CMASK(C0,C1,t); \
    { float a=MX3(C0[0],C0[1],C1[0]),b=MX3(C0[2],C0[3],C1[1]); a=MX3(a,C1[2],C1[3]); \
      _Pragma("unroll") for(int r=4;r<16;r+=4){a=MX3(a,C0[r],C0[r+1]);b=MX3(b,C0[r+2],C0[r+3]);a=MX3(a,C1[r],C1[r+1]);b=MX3(b,C1[r+2],C1[r+3]);} \
      float rm=__builtin_fmaxf(a,b); { auto rr=__builtin_amdgcn_permlane32_swap(__float_as_uint(rm),__float_as_uint(rm),false,false); rm=__builtin_fmaxf(__uint_as_float(rr[0]),__uint_as_float(rr[1])); } \
      resc=false; \
      if(__builtin_expect(__any(rm>(float)THRL),0)){ const float dl=__builtin_fmaxf(rm,0.f); mhat+=dl; \
        _Pragma("unroll") for(int r=0;r<16;++r){C0[r]-=dl;C1[r]-=dl;} \
        _Pragma("unroll") for(int r=0;r<16;++r)negm[r]=-mhat; asm volatile("":"+v"(negm)); \
        const float f=__builtin_amdgcn_exp2f(-dl); l_reg*=f; if(hi==0)wsf[r32]=f; resc=true; } } \
    SBAR(); \
    GAPB(o[0]=__builtin_amdgcn_mfma_f32_32x32x16_bf16(PAF(0),VFR(0),o[0],0,0,0), C0,0); \
    GAPB(o[1]=__builtin_amdgcn_mfma_f32_32x32x16_bf16(PAF(0),VFR(4),o[1],0,0,0), C0,4); \
    KRD(GL,0); GAPB(o[0]=__builtin_amdgcn_mfma_f32_32x32x16_bf16(PAF(1),VFR(1),o[0],0,0,0), C0,8); \
    KRD(GL,1); GAPB(o[1]=__builtin_amdgcn_mfma_f32_32x32x16_bf16(PAF(1),VFR(5),o[1],0,0,0), C0,12); \
    KRD(GL,2); GAPB(o[0]=__builtin_amdgcn_mfma_f32_32x32x16_bf16(PAF(2),VFR(2),o[0],0,0,0), C1,0); \
    KRD(GL,3); GAPB(o[1]=__builtin_amdgcn_mfma_f32_32x32x16_bf16(PAF(2),VFR(6),o[1],0,0,0), C1,4); \
    GAPB(o[0]=__builtin_amdgcn_mfma_f32_32x32x16_bf16(PAF(3),VFR(3),o[0],0,0,0), C1,8); \
    GAPB(o[1]=__builtin_amdgcn_mfma_f32_32x32x16_bf16(PAF(3),VFR(7),o[1],0,0,0), C1,12); \
    }while(0)
  int t=1;
  #undef CMASK
  #define CMASK(P0,P1,t) do{}while(0)
  for(;t+5<NT;t+=2){
    STEP(pB0,pB1,pA0,pA1,t,true,true,true);     WAIT_BAR(2); RESC(); ROT();
    STEP(pA0,pA1,pB0,pB1,t+1,true,true,true);   WAIT_BAR(2); RESC(); ROT();
  }
  #undef CMASK
  #define CMASK(P0,P1,t) do{int jb_=(t)-(NT-4); if(jb_>=0)cmask(P0,P1,jb_,qrel,hi);}while(0)
  #define ENDW(tt) do{ if((tt)+3<NT){WAIT_BAR(2);} else if((tt)+2<NT){WAIT_BAR(1);} else {WAIT_BAR(0);} }while(0)
  for(;t+1<NT;t+=2){
    STEP(pB0,pB1,pA0,pA1,t,(t+3<NT),(t+1<NT),(t+1<NT));       ENDW(t);   RESC(); ROT();
    STEP(pA0,pA1,pB0,pB1,t+1,(t+4<NT),(t+2<NT),(t+2<NT));     ENDW(t+1); RESC(); ROT();
  }
  STEP(pB0,pB1,pA0,pA1,NT-1,false,false,false); RESC();
  { float sacc=pB0[0]+pB0[1]; _Pragma("unroll") for(int r=2;r<16;++r)sacc+=pB0[r]; _Pragma("unroll") for(int r=0;r<16;++r)sacc+=pB1[r]; l_reg+=sacc;
    pw0=(u32x4){PKW(pB0,0),PKW(pB0,2),PKW(pB0,4),PKW(pB0,6)};pw1=(u32x4){PKW(pB0,8),PKW(pB0,10),PKW(pB0,12),PKW(pB0,14)};pw2=(u32x4){PKW(pB1,0),PKW(pB1,2),PKW(pB1,4),PKW(pB1,6)};pw3=(u32x4){PKW(pB1,8),PKW(pB1,10),PKW(pB1,12),PKW(pB1,14)};
    SBAR(); pv(o,vb0+sl_cur,PAF(0),PAF(1),PAF(2),PAF(3)); }
  #undef PKW
  #undef PAF
  #undef VFR
  #undef PIN
  #undef MX3
  #undef GAPA
  #undef GAPB
  #undef EX
  #undef VRD
  #undef KRD
  #undef STEP
  #undef ENDW
  {auto rr=__builtin_amdgcn_permlane32_swap(__float_as_uint(l_reg),__float_as_uint(l_reg),false,false);l_reg=__uint_as_float(rr[0])+__uint_as_float(rr[1]);}
  if(hi==0)wsf[32+r32]=l_reg;asm volatile("s_waitcnt lgkmcnt(0)":::"memory");
  float rli[16];
  #pragma unroll
  for(int r=0;r<16;++r)rli[r]=__builtin_amdgcn_rcpf(wsf[32+crow(r,hi)]);
  bf16*Ow=O+(rowbase+q0+wid*QBLK)*OPITCH+h*D;
  { bf16*stg=(bf16*)(shm+LDS_OST)+wid*2048;
    #pragma unroll
    for(int r=0;r<16;++r){const int orow=crow(r,hi);
      #pragma unroll
      for(int d0=0;d0<2;++d0)stg[orow*64+d0*32+r32]=__float2bfloat16(o[d0][r]*rli[r]);}
    asm volatile("s_waitcnt lgkmcnt(0)":::"memory");
    #pragma unroll
    for(int i=0;i<4;++i){const int row=i*8+(lane>>3),ch=lane&7; const u32x4 v=*(const u32x4*)(stg+row*64+ch*8); ATTN_STORE16(Ow+(long)row*OPITCH+ch*8,v);} }
  asm volatile("s_waitcnt lgkmcnt(0)\n\ts_barrier":::"memory");
  #undef BIAS
  #undef DMA_K
  #undef DMA_V
  #undef CMASK
  #undef START
  #undef RESC
  #undef ROT
}
constexpr int ATTN_LDS_BYTES=LDS_BYTES;
struct AttnTensors { const bf16* Q; const bf16* K; const bf16* V; bf16* O; const float* Fh; };
struct AttnUnit { int bh; int qb; };
struct StaticOrder {
  int vcu,G;
  __device__ __forceinline__ explicit StaticOrder(int grid,int block):vcu((grid%8==0)?(block%8)*(grid/8)+block/8:block),G(grid){}
  __device__ __forceinline__ bool next(int i,AttnUnit&u)const{ const int L=(i>>3)*G+vcu; if(L>=BATCH*16)return false; const int hh=i&7,r=L&15,rot=(r+4*(hh>>1))&15; u.bh=(L>>4)*NHEAD+hh; u.qb=(hh&1)?15-rot:rot; return true; }
  __device__ __forceinline__ void a_ready(const AttnUnit&)const{}
  __device__ __forceinline__ void done(const AttnUnit&)const{}
};
template<class Sched,int THRL=8> __device__ __forceinline__ void attn_phase(char*lds,const AttnTensors&T,const Sched&S,const int wave_id){
  AttnUnit u;
  for(int i=0;S.next(i,u);++i){ S.a_ready(u); attn_unit<THRL>(u.bh/NHEAD,u.bh%NHEAD,u.qb,T.Q,T.K,T.V,T.O,T.Fh+(size_t)u.bh*SEQ,lds,wave_id); S.done(u); }
}
#undef SBAR
#undef WAIT_BAR
}
typedef pg8::f32x4 A4;
typedef A4 AccT[2][2][4][2];

__device__ __forceinline__ float row_rstd(const float* ssq, int row) {
    const f32x4* p = (const f32x4*)(ssq + (size_t)row * 16);
    const f32x4 a = p[0], b = p[1], c = p[2], d = p[3];
    const float s = (((a.x + a.y) + (a.z + a.w)) + ((b.x + b.y) + (b.z + b.w))) + (((c.x + c.y) + (c.z + c.w)) + ((d.x + d.y) + (d.z + d.w)));
    return rsqrtf(s * (1.0f / 1024.0f) + EPS);
}
__device__ __forceinline__ float row_rstd4(const float* ssq, int row, int fq) {
    const f32x4 a = ((const f32x4*)(ssq + (size_t)row * 16))[fq];
    float s = (a.x + a.y) + (a.z + a.w); s += __shfl_xor(s, 16); s += __shfl_xor(s, 32);
    return rsqrtf(s * (1.0f / 1024.0f) + EPS);
}
__device__ __forceinline__ v4u pack8(const A4& v0, const A4& v1) { v4u w; w.x = pk2(v0[0], v0[1]); w.y = pk2(v0[2], v0[3]); w.z = pk2(v1[0], v1[1]); w.w = pk2(v1[2], v1[3]); return w; }
__device__ __forceinline__ float clamp8(float v) { return __builtin_amdgcn_fmed3f(v, -448.0f, 448.0f); }
__device__ __forceinline__ unsigned pk4_fp8(float a, float b, float c, float d) { int w = __builtin_amdgcn_cvt_pk_fp8_f32(clamp8(a), clamp8(b), 0, false); w = __builtin_amdgcn_cvt_pk_fp8_f32(clamp8(c), clamp8(d), w, true); return (unsigned)w; }
__device__ __forceinline__ v2u pack8_fp8(const A4& v0, const A4& v1) { v2u w; w.x = pk4_fp8(v0[0], v0[1], v0[2], v0[3]); w.y = pk4_fp8(v1[0], v1[1], v1[2], v1[3]); return w; }
__device__ __forceinline__ void unpack8(const v4u w, A4& v0, A4& v1) { v0 = (A4){bflo(w.x), bfhi(w.x), bflo(w.y), bfhi(w.y)}; v1 = (A4){bflo(w.z), bfhi(w.z), bflo(w.w), bfhi(w.w)}; }
__device__ __forceinline__ A4 sig4(const A4& z) { return (A4){sigmoidf_(z[0]), sigmoidf_(z[1]), sigmoidf_(z[2]), sigmoidf_(z[3])}; }
__device__ __forceinline__ A4 ex4(const A4& z) { return (A4){__builtin_amdgcn_exp2f(z[0]), __builtin_amdgcn_exp2f(z[1]), __builtin_amdgcn_exp2f(z[2]), __builtin_amdgcn_exp2f(z[3])}; }
__device__ __forceinline__ A4 rc4(const A4& z) { return (A4){__builtin_amdgcn_rcpf(z[0]), __builtin_amdgcn_rcpf(z[1]), __builtin_amdgcn_rcpf(z[2]), __builtin_amdgcn_rcpf(z[3])}; }
__device__ __forceinline__ float logsig(float z) { return fminf(z, 0.f) - __logf(1.0f + __expf(-fabsf(z))); }

template <bool FP8 = false> struct EpiInProj {
    static constexpr bool PERM = true, AFTER_DRAIN = false, HOOKS = false, RMW = false;
    unsigned char* outb; unsigned char* wsb; int layer;
    __device__ __forceinline__ void operator()(const AccT& acc, const pg8::Unit& u, int wr, int wc, int fr, int fq) const {
        const int pn = u.pn, row0 = u.pm * 256 + wr * 64 + fr, cw = wc * 32 + 8 * fq;
        bf16* const Q = (bf16*)(outb + DO_Q); bf16* const K = (bf16*)(outb + DO_K); bf16* const V = (bf16*)(outb + DO_V); bf16* const U = (bf16*)(outb + DO_U); bf16* const HC = (bf16*)(outb + DO_HC);
        bf16* const G = (bf16*)(wsb + WS_GATES); float* const logf = (float*)(wsb + WS_LOGF); const float* const bias = (const float*)(wsb + WS_BPERM) + layer * N_INP; const float* const ssq = (const float*)(wsb + WS_SSQ);
#define IP_LOADS() float rs[2][4]; _Pragma("unroll") for (int ai = 0; ai < 2; ++ai) _Pragma("unroll") for (int m = 0; m < 4; ++m) rs[ai][m] = row_rstd4(ssq, row0 + ai * 128 + m * 16, fq) * (FP8 ? 0.03125f : 1.0f); \
        A4 bv[2][2]; _Pragma("unroll") for (int bj = 0; bj < 2; ++bj) _Pragma("unroll") for (int n = 0; n < 2; ++n) bv[bj][n] = *(const A4*)(bias + pn * 256 + bj * 128 + cw + 4 * n)
        if (pn == 7 || pn == 8) {
            IP_LOADS();
#pragma unroll
            for (int ai = 0; ai < 2; ++ai)
#pragma unroll
                for (int m = 0; m < 4; ++m) { const int row = row0 + ai * 128 + m * 16; const float r = rs[ai][m];
                    const A4 a0 = acc[ai][0][m][0] * r + bv[0][0], a1 = acc[ai][0][m][1] * r + bv[0][1], g0 = acc[ai][1][m][0] * r + bv[1][0], g1 = acc[ai][1][m][1] * r + bv[1][1];
                    *(v4u*)(HC + (size_t)row * 256 + (pn - 7) * 128 + cw) = pack8(a0 * sig4(g0), a1 * sig4(g1)); asm volatile("" ::: "memory"); }
        } else if (pn == 21) {
            if (wc == 0) {
                IP_LOADS();
                if (fq == 0) {
#pragma unroll
                for (int ai = 0; ai < 2; ++ai)
#pragma unroll
                    for (int m = 0; m < 4; ++m) { const int row = row0 + ai * 128 + m * 16; const float r = rs[ai][m];
                        const A4 z0 = acc[ai][0][m][0] * r + bv[0][0], z1 = acc[ai][0][m][1] * r + bv[0][1];
                        *(A4*)(logf + (size_t)row * 8) = (A4){logsig(z0[0]), logsig(z0[1]), logsig(z0[2]), logsig(z0[3])};
                        *(A4*)(logf + (size_t)row * 8 + 4) = (A4){logsig(z1[0]), logsig(z1[1]), logsig(z1[2]), logsig(z1[3])}; }
                }
            }
        } else {
            if (pn >= 9) {
                IP_LOADS();
                A4 bn[2][2];
#pragma unroll
                for (int bj = 0; bj < 2; ++bj)
#pragma unroll
                    for (int n = 0; n < 2; ++n) bn[bj][n] = bv[bj][n] * -LOG2E;
                const int gi = (pn - 9) >> 2, pq = (pn - 9) & 3, tix = ((wr * 4 + wc) << 6) | (fq << 4) | fr;
                v4u* gb = (v4u*)G + ((size_t)((gi * 256 + u.pm) * 4 + pq) * 16) * 512 + tix;
#pragma unroll
                for (int ai = 0; ai < 2; ++ai)
#pragma unroll
                    for (int m = 0; m < 4; ++m) { const float rn = rs[ai][m] * -LOG2E;
#pragma unroll
                        for (int bj = 0; bj < 2; ++bj) { A4 v0 = acc[ai][bj][m][0] * rn + bn[bj][0], v1 = acc[ai][bj][m][1] * rn + bn[bj][1];
                            v0 = rc4(ex4(__builtin_elementwise_min(v0, (A4){40.f, 40.f, 40.f, 40.f})) + 1.0f); v1 = rc4(ex4(__builtin_elementwise_min(v1, (A4){40.f, 40.f, 40.f, 40.f})) + 1.0f);
                            gb[(size_t)(((ai * 4 + m) * 2 + bj)) * 512] = pack8(v0, v1); } asm volatile("" ::: "memory"); }
            } else {
            bf16* base; int ld, col0; float sc = 1.f;
            if (pn < 6) { base = pn < 2 ? Q : (pn < 4 ? K : V); ld = 512; col0 = (pn & 1) * 256; sc = pn < 2 ? QSCALE : 1.f; }
            else { base = U; ld = 256; col0 = 0; }
            IP_LOADS();
#pragma unroll
            for (int ai = 0; ai < 2; ++ai)
#pragma unroll
                for (int m = 0; m < 4; ++m) { const int row = row0 + ai * 128 + m * 16; const float r = rs[ai][m]; bf16* rowp = base + (size_t)row * ld + col0 + cw;
#pragma unroll
                    for (int bj = 0; bj < 2; ++bj) { A4 v0 = acc[ai][bj][m][0] * r + bv[bj][0], v1 = acc[ai][bj][m][1] * r + bv[bj][1];
                        v0 = v0 * sc; v1 = v1 * sc;
                        if (pn == 6) { const int c = bj * 128 + cw;
                            *(v4u*)((bf16*)(wsb + WS_UA) + ((size_t)(c >> 4) * (M / 64) + (row >> 6)) * 1152 + (row & 63) * 16 + (c & 15)) = pack8(v0, v1); }
                        else *(v4u*)(rowp + bj * 128) = pack8(v0, v1); } asm volatile("" ::: "memory"); }
            }
        }
    }
};
#undef IP_LOADS
template <bool MOE, bool FP8 = false> struct EpiSwiGlu {
    static constexpr bool PERM = true, AFTER_DRAIN = false, HOOKS = false, RMW = false;
    bf16* Hd; int ldh; const float* rsrc;
    __device__ __forceinline__ void operator()(const AccT& acc, const pg8::Unit& u, int wr, int wc, int fr, int fq) const {
        const int row0 = u.pm * 256 + wr * 64 + fr, cw = wc * 32 + 8 * fq;
        float rs[2][4];
#pragma unroll
        for (int ai = 0; ai < 2; ++ai)
#pragma unroll
            for (int m = 0; m < 4; ++m) { const int row = row0 + ai * 128 + m * 16; rs[ai][m] = (MOE ? rsrc[row] : row_rstd4(rsrc, row, fq)) * (FP8 ? 0.03125f : 1.0f); }
#pragma unroll
        for (int ai = 0; ai < 2; ++ai)
#pragma unroll
            for (int m = 0; m < 4; ++m) { const int row = row0 + ai * 128 + m * 16; const float r = rs[ai][m];
                A4 o[2];
#pragma unroll
                for (int n = 0; n < 2; ++n) { const A4 s = rc4(ex4(acc[ai][0][m][n] * (r * -LOG2E)) + 1.0f); o[n] = (acc[ai][0][m][n] * acc[ai][1][m][n]) * (s * (r * r)); }
                if constexpr (FP8) *(v2u*)((unsigned char*)Hd + (((size_t)(row >> 8) * (ldh >> 7) + u.pn) * 256 + (row & 255)) * 128 + wc * 32 + 8 * fq) = pack8_fp8(o[0], o[1]);
                else *(v4u*)(Hd + (((size_t)(row >> 8) * (ldh >> 6) + (u.pn * 2 + (wc >> 1))) * 256 + (row & 255)) * 64 + (wc & 1) * 32 + 8 * fq) = pack8(o[0], o[1]);
                asm volatile("" ::: "memory"); }
    }
};
struct EpiGluSsm {
    static constexpr bool PERM = true, AFTER_DRAIN = false, HOOKS = false, RMW = false;
    bf16* O;
    __device__ __forceinline__ void operator()(const AccT& acc, const pg8::Unit& u, int wr, int wc, int fr, int fq) const {
        const int row0 = u.pm * 256 + wr * 64 + fr, cw = wc * 32 + 8 * fq;
#pragma unroll
        for (int ai = 0; ai < 2; ++ai)
#pragma unroll
            for (int m = 0; m < 4; ++m) { const int row = row0 + ai * 128 + m * 16;
                *(v4u*)(O + (size_t)row * 1024 + 512 + u.pn * 128 + cw) = pack8(acc[ai][0][m][0] * sig4(acc[ai][1][m][0]), acc[ai][0][m][1] * sig4(acc[ai][1][m][1])); }
    }
};
template <int I> struct EpiMerge {
    static constexpr bool PERM = true, AFTER_DRAIN = false, HOOKS = false, RMW = false;
    const bf16* G; bf16* Mg;
    __device__ __forceinline__ void operator()(const AccT& acc, const pg8::Unit& u, int wr, int wc, int fr, int fq) const {
        const int row0 = u.pm * 256 + wr * 64 + fr, col0 = u.pn * 256 + wc * 32 + 8 * fq;
        v4u gl[3][2], ol[3][2];
#define MG_LOAD(buf, grp) do { const int row_ = row0 + ((grp) >> 2) * 128 + ((grp) & 3) * 16; _Pragma("unroll") for (int bj = 0; bj < 2; ++bj) { \
            gl[buf][bj] = *(const v4u*)(G + (size_t)row_ * 3072 + I * 1024 + col0 + bj * 128); if (I > 0) ol[buf][bj] = *(const v4u*)(Mg + (size_t)row_ * 1024 + col0 + bj * 128); } } while (0)
        MG_LOAD(0, 0); MG_LOAD(1, 1);
#pragma unroll
        for (int grp = 0; grp < 8; ++grp) {
            if (grp + 2 < 8) MG_LOAD((grp + 2) % 3, grp + 2);
            asm volatile("" ::: "memory");
            const int ai = grp >> 2, m = grp & 3, row = row0 + ai * 128 + m * 16;
#pragma unroll
            for (int bj = 0; bj < 2; ++bj) { A4 g0, g1; unpack8(gl[grp % 3][bj], g0, g1);
                A4 v0 = g0 * acc[ai][bj][m][0], v1 = g1 * acc[ai][bj][m][1];
                if (I > 0) { A4 o0, o1; unpack8(ol[grp % 3][bj], o0, o1); v0 = v0 + o0; v1 = v1 + o1; }
                *(v4u*)(Mg + (size_t)row * 1024 + col0 + bj * 128) = pack8(v0, v1); }
        }
#undef MG_LOAD
    }
};
template <bool O8 = false> struct EpiMergeCat {
    static constexpr bool PERM = true, AFTER_DRAIN = false, HOOKS = true, RMW = false; static constexpr int H1 = 8, H2 = 12;
    const bf16* G; bf16* Mg;
    static __device__ __forceinline__ A4 rcp4(const A4& z) { return (A4){__builtin_amdgcn_rcpf(z[0]), __builtin_amdgcn_rcpf(z[1]), __builtin_amdgcn_rcpf(z[2]), __builtin_amdgcn_rcpf(z[3])}; }
    __device__ __forceinline__ void mid(AccT& acc, const pg8::Unit& u, int t, int wr, int wc, int fr, int fq) const {
        int fr_ = fr, fq_ = fq; asm volatile("" : "+v"(fr_), "+v"(fq_));
        const int s = (t == H1) ? 0 : 1, tix = ((wr * 4 + wc) << 6) | (fq_ << 4) | fr_;
        const v4u* ga_ = (const v4u*)G + ((size_t)((s * 256 + u.pm) * 4 + u.pn) * 16) * 512 + tix;
        const v4u* gb_ = ga_ + (size_t)256 * 4 * 16 * 512;
#pragma unroll
        for (int ai = 0; ai < 2; ++ai)
#pragma unroll
            for (int mp = 0; mp < 2; ++mp) {
                v4u ga[2][2], gb[2][2];
#pragma unroll
                for (int mm = 0; mm < 2; ++mm)
#pragma unroll
                    for (int bj = 0; bj < 2; ++bj) { const size_t o = (size_t)(((ai * 4 + 2 * mp + mm) * 2 + bj)) * 512; ga[mm][bj] = ga_[o]; gb[mm][bj] = gb_[o]; }
#pragma unroll
                for (int mm = 0; mm < 2; ++mm)
#pragma unroll
                    for (int bj = 0; bj < 2; ++bj) { A4 p0, p1, q0, q1; unpack8(ga[mm][bj], p0, p1); unpack8(gb[mm][bj], q0, q1);
                        acc[ai][bj][2 * mp + mm][0] = acc[ai][bj][2 * mp + mm][0] * (p0 * rcp4(q0)); acc[ai][bj][2 * mp + mm][1] = acc[ai][bj][2 * mp + mm][1] * (p1 * rcp4(q1)); }
                asm volatile("" ::: "memory");
            }
    }
    __device__ __forceinline__ void operator()(const AccT& acc, const pg8::Unit& u, int wr, int wc, int fr, int fq) const {
        const int row0 = u.pm * 256 + wr * 64 + fr, col0 = u.pn * 256 + wc * 32 + 8 * fq, tix = ((wr * 4 + wc) << 6) | (fq << 4) | fr;
        const v4u* g2 = (const v4u*)G + ((size_t)((2 * 256 + u.pm) * 4 + u.pn) * 16) * 512 + tix;
        v4u gl[3][2];
#define MC_LOAD(buf, grp) do { _Pragma("unroll") for (int bj = 0; bj < 2; ++bj) gl[buf][bj] = g2[(size_t)((grp) * 2 + bj) * 512]; } while (0)
        MC_LOAD(0, 0); MC_LOAD(1, 1);
#pragma unroll
        for (int grp = 0; grp < 8; ++grp) {
            if (grp + 2 < 8) MC_LOAD((grp + 2) % 3, grp + 2);
            asm volatile("" ::: "memory");
            const int ai = grp >> 2, m = grp & 3, row = row0 + ai * 128 + m * 16;
#pragma unroll
            for (int bj = 0; bj < 2; ++bj) { A4 g0, g1; unpack8(gl[grp % 3][bj], g0, g1);
                if constexpr (O8) *(v2u*)((unsigned char*)Mg + (size_t)row * 1024 + col0 + bj * 128) = pack8_fp8(g0 * acc[ai][bj][m][0], g1 * acc[ai][bj][m][1]);
                else *(v4u*)(Mg + (size_t)row * 1024 + col0 + bj * 128) = pack8(g0 * acc[ai][bj][m][0], g1 * acc[ai][bj][m][1]); }
        }
#undef MC_LOAD
    }
};
template <bool W8 = false, int SH = 0> struct EpiResid {
    static constexpr bool PERM = true, AFTER_DRAIN = false, HOOKS = false, RMW = true;
    bf16* X; float* ssq; unsigned char* X8;
    __device__ __forceinline__ void operator()(const AccT& acc, const pg8::Unit& u, int wr, int wc, int fr, int fq) const {
        const int row0 = u.pm * 256 + wr * 64 + fr, col0 = u.pn * 256 + wc * 32 + 8 * fq;
        v4u ol[3][2];
#define RS_LOAD(buf, grp) do { const int row_ = row0 + ((grp) >> 2) * 128 + ((grp) & 3) * 16; _Pragma("unroll") for (int bj = 0; bj < 2; ++bj) ol[buf][bj] = *(const v4u*)(X + (size_t)row_ * 1024 + col0 + bj * 128); } while (0)
        RS_LOAD(0, 0); RS_LOAD(1, 1);
#pragma unroll
        for (int grp = 0; grp < 8; ++grp) {
            if (grp + 2 < 8) RS_LOAD((grp + 2) % 3, grp + 2);
            asm volatile("" ::: "memory");
            const int ai = grp >> 2, m = grp & 3, row = row0 + ai * 128 + m * 16; float ss = 0.f;
#pragma unroll
            for (int bj = 0; bj < 2; ++bj) { A4 o0, o1; unpack8(ol[grp % 3][bj], o0, o1); o0 = o0 + acc[ai][bj][m][0] * (1.0f / (float)(1 << SH)); o1 = o1 + acc[ai][bj][m][1] * (1.0f / (float)(1 << SH));
                const v4u w = pack8(o0, o1); *(v4u*)(X + (size_t)row * 1024 + col0 + bj * 128) = w; unpack8(w, o0, o1);
                if constexpr (W8) *(v2u*)(X8 + (size_t)row * 1024 + col0 + bj * 128) = pack8_fp8(o0, o1);
                ss += (o0[0] * o0[0] + o0[1] * o0[1]) + (o0[2] * o0[2] + o0[3] * o0[3]) + (o1[0] * o1[0] + o1[1] * o1[1]) + (o1[2] * o1[2] + o1[3] * o1[3]); }
            ss += __shfl_xor(ss, 16); ss += __shfl_xor(ss, 32);
            if (fq == 0) ssq[(size_t)row * 16 + u.pn * 4 + wc] = ss;
        }
#undef RS_LOAD
    }
};
template <bool FP8 = false> struct EpiMoeDown {
    static constexpr bool PERM = true, AFTER_DRAIN = false, HOOKS = false, RMW = false;
    bf16* Y; const int* rdest; const float* rw;
    __device__ __forceinline__ void operator()(const AccT& acc, const pg8::Unit& u, int wr, int wc, int fr, int fq) const {
        const int row0 = u.pm * 256 + wr * 64 + fr, cw = wc * 32 + 8 * fq;
        int ds[2][4]; float wsv[2][4];
#pragma unroll
        for (int ai = 0; ai < 2; ++ai)
#pragma unroll
            for (int m = 0; m < 4; ++m) { const int row = row0 + ai * 128 + m * 16; ds[ai][m] = rdest[row]; wsv[ai][m] = rw[row] * (FP8 ? 0.015625f : 1.0f); }
#pragma unroll
        for (int ai = 0; ai < 2; ++ai)
#pragma unroll
            for (int m = 0; m < 4; ++m) { const int dest = ds[ai][m]; const float w = wsv[ai][m];
                if (dest >= 0) {
#pragma unroll
                    for (int bj = 0; bj < 2; ++bj) *(v4u*)(Y + (size_t)dest * 1024 + u.pn * 256 + bj * 128 + cw) = pack8(acc[ai][bj][m][0] * w, acc[ai][bj][m][1] * w); }
                asm volatile("" ::: "memory"); }
    }
};
struct MoeOrder {
    pg8::StaticOrder so; int tile0, a_tile_off, b_rows; int s1, s2, s3, s4, s5, s6, s7;
    int x = 0, nl = 0, c0 = 0; static constexpr int SK = 2;
    __device__ __forceinline__ void skew(int nwg_down) {
        const int G = so.G, r = nwg_down % G; nl = 0; x = 0; c0 = 0;
        if (r != 0 && so.nwg >= SK * (G - r)) { nl = G - r; c0 = r; x = (so.nwg - SK * nl) / G; }
    }
    __device__ __forceinline__ bool next(int i, pg8::Unit& u) const {
        long L;
        if (nl == 0) L = (long)i * so.G + so.c;
        else if (i < x) L = (long)i * so.G + so.c;
        else if (so.c >= c0) { if (i < x + SK) L = (long)x * so.G + (long)(i - x) * nl + (so.c - c0); else if (i == x + SK) L = (long)x * so.G + (long)SK * nl + so.c; else return false; }
        else { if (i == x) L = (long)x * so.G + (long)SK * nl + so.c; else return false; }
        if (!so.unit_of(L, u)) return false;
        const int gt = tile0 + u.pm;
        const int e = (gt >= s1) + (gt >= s2) + (gt >= s3) + (gt >= s4) + (gt >= s5) + (gt >= s6) + (gt >= s7);
        u.arow = (a_tile_off + u.pm) * 256; u.brow = e * b_rows + u.pn * 256; return true;
    }
};
struct Args { const float* in[31]; unsigned char* out; unsigned char* ws; int ph_lo, ph_hi, use_bar, pad; };
struct Frame {
    LAS unsigned char* lds;
    volatile LAS unsigned* MISC;
    gu32* ctl;
    int tid, lane, wave, G, gw, NGW;
};

__device__ __forceinline__ int inproj_dest(int n) {
    if (n < 1536) return n;
    if (n < 1544) return 5376 + (n - 1536);
    if (n < 1800) return 1536 + (n - 1544);
    if (n < 2056) { const int c = n - 1800; return 1792 + (c >> 7) * 256 + (c & 127); }
    if (n < 2312) { const int c = n - 2056; return 1792 + (c >> 7) * 256 + 128 + (c & 127); }
    return 2304 + (n - 2312);
}
__device__ __forceinline__ int inproj_src(int d) {
    if (d < 1536) return d;
    if (d < 1792) return 1544 + (d - 1536);
    if (d < 2304) { const int t = (d - 1792) >> 8, r = (d - 1792) & 255; return r < 128 ? 1800 + t * 128 + r : 2056 + t * 128 + (r - 128); }
    if (d < 5376) return 2312 + (d - 2304);
    return (d - 5376) < 8 ? 1536 + (d - 5376) : -1;
}
__device__ __forceinline__ int map_row(int kind, int off, int n) {
    if (kind == 0) return n + off;
    if (kind == 1) return (n >> 7) * 256 + (n & 127) + off;
    if (kind == 2) { const int j = n & 255; return (j >> 7) * 256 + (j & 127) + ((n >> 8) ? 128 : 0); }
    return inproj_dest(n);
}
#ifndef FP8_INPROJ_MASK
#define FP8_INPROJ_MASK 0xE
#endif
#define FP8_INPROJ(l_) (((FP8_INPROJ_MASK) >> (l_)) & 1)
#ifndef FP8_WO_MASK
#define FP8_WO_MASK 0xC
#endif
#define FP8_WO(l_) (((FP8_WO_MASK) >> (l_)) & 1)
#ifndef FP8_DENSE_I
#define FP8_DENSE_I 1
#endif
struct CvtDesc { const float* W; const float* gk; bf16* WT; int K, N, kind, off, item, ldt; float sc8; };
__device__ __forceinline__ CvtDesc cvt_moe_desc(const Args& a, int i, int l, int it) {
    const int e = it / 5376, r = it - e * 5376, kd = r / 1792, li = r - kd * 1792; const size_t wo = (size_t)(i * NE + e) * D * D_FFE;
    CvtDesc d; d.item = li;
    if (kd < 2) { d.W = (kd == 0 ? a.in[27] : a.in[28]) + wo; d.gk = a.in[21] + l * D; d.WT = (bf16*)(a.ws + WS_WMOE + WMOE_GU + (size_t)e * 7168 * D); d.K = D; d.N = D_FFE; d.kind = 1; d.off = kd * 128; d.ldt = D; d.sc8 = 32.0f; }
    else { d.W = a.in[29] + wo; d.gk = nullptr; d.WT = (bf16*)(a.ws + WS_WMOE + WMOE_D + (size_t)e * D * D_FFE); d.K = D_FFE; d.N = D; d.kind = 0; d.off = 0; d.ldt = D_FFE; d.sc8 = 64.0f; }
    return d;
}
__device__ __forceinline__ void cvt_load(const CvtDesc& d, int lane, f32x4 (&v)[8]) {
    const int nblk = (d.N + 31) >> 5, kb = d.item / nblk, nb = d.item - kb * nblk, k0 = 64 * kb, r8 = lane >> 3, n = 32 * nb + 4 * (lane & 7);
#pragma unroll
    for (int i = 0; i < 8; ++i) v[i] = (n < d.N) ? *(const f32x4*)(d.W + (size_t)(k0 + 8 * i + r8) * d.N + n) : (f32x4){0.f, 0.f, 0.f, 0.f};
}
__device__ __forceinline__ void cvt_store(const CvtDesc& d, LAS float* scr, int lane, const f32x4 (&v)[8]) {
    const int nblk = (d.N + 31) >> 5, kb = d.item / nblk, nb = d.item - kb * nblk, k0 = 64 * kb, n0 = 32 * nb, c = lane & 7, r8 = lane >> 3;
    f32x4 g0 = (f32x4){1.f, 1.f, 1.f, 1.f}, g1 = g0;
    if (d.gk) { g0 = *(const f32x4*)(d.gk + k0 + 8 * c); g1 = *(const f32x4*)(d.gk + k0 + 8 * c + 4); }
#pragma unroll
    for (int i = 0; i < 8; ++i) { LAS float* q = scr + (8 * i + r8) * 33 + 4 * c; q[0] = v[i].x; q[1] = v[i].y; q[2] = v[i].z; q[3] = v[i].w; }
    LDS_WAIT(); asm volatile("" ::: "memory");
#pragma unroll
    for (int j = 0; j < 4; ++j) { const int nl = (lane >> 3) + 8 * j; const int nn = n0 + nl; const LAS float* s = scr + (8 * c) * 33 + nl;
        if (nn < d.N) {
            if (d.sc8 != 0.0f) { const float q = d.sc8; v2u o; o.x = pk4_fp8(s[0 * 33] * g0.x * q, s[1 * 33] * g0.y * q, s[2 * 33] * g0.z * q, s[3 * 33] * g0.w * q); o.y = pk4_fp8(s[4 * 33] * g1.x * q, s[5 * 33] * g1.y * q, s[6 * 33] * g1.z * q, s[7 * 33] * g1.w * q);
                *(v2u*)((unsigned char*)d.WT + (size_t)map_row(d.kind, d.off, nn) * d.ldt + k0 + 8 * c) = o; }
            else { v4u o; o.x = pk2(s[0 * 33] * g0.x, s[1 * 33] * g0.y); o.y = pk2(s[2 * 33] * g0.z, s[3 * 33] * g0.w); o.z = pk2(s[4 * 33] * g1.x, s[5 * 33] * g1.y); o.w = pk2(s[6 * 33] * g1.z, s[7 * 33] * g1.w);
                *(v4u*)(d.WT + (size_t)map_row(d.kind, d.off, nn) * d.ldt + k0 + 8 * c) = o; } } }
    LDS_WAIT(); asm volatile("" ::: "memory");
}
__device__ __forceinline__ void cvt_moe_layer(const Args& a, int i, int l, LAS float* scr, int lane, int gwl, int ngw) {
    constexpr int TOTAL = NE * 3 * 1792;
    int it = gwl; if (it >= TOTAL) return;
    f32x4 va[8], vb[8];
    CvtDesc da = cvt_moe_desc(a, i, l, it), db = da; cvt_load(da, lane, va);
    for (;;) {
        const int itb = it + ngw; const bool hb = itb < TOTAL;
        if (hb) { db = cvt_moe_desc(a, i, l, itb); cvt_load(db, lane, vb); }
        cvt_store(da, scr, lane, va);
        if (!hb) break;
        it = itb + ngw; const bool ha = it < TOTAL;
        if (ha) { da = cvt_moe_desc(a, i, l, it); cvt_load(da, lane, va); }
        cvt_store(db, scr, lane, vb);
        if (!ha) break;
    }
}

__device__ __forceinline__ CvtDesc cvt_p0_desc(const Args& a, int it) {
    CvtDesc d; d.gk = nullptr; d.kind = 0; d.off = 0; d.sc8 = 0.0f;
    if (it < DEPTH * 3792) {
        const int l = it / 3792; int r = it - l * 3792; unsigned char* wm = a.ws + WS_WMIX + (size_t)l * WMIX_STRIDE;
        if (r < 2704) { d.W = a.in[2] + (size_t)l * D * N_IN; d.K = D; d.N = N_IN; d.gk = a.in[1] + l * D; d.WT = (bf16*)(wm + WM_IN); d.kind = 3; d.item = r; d.ldt = D; d.sc8 = FP8_INPROJ(l) ? 32.0f : 0.0f; return d; } r -= 2704;
        if (r < 64) { d.W = a.in[12] + (size_t)l * 256 * 512; d.K = 256; d.N = 512; d.WT = (bf16*)(wm + WM_GLU); d.kind = 2; d.item = r; d.ldt = 256; return d; } r -= 64;
        if (r < 256) { d.W = a.in[17] + (size_t)l * 512 * D; d.K = 512; d.N = D; d.WT = (bf16*)(wm + WM_A); d.item = r; d.ldt = 1024; return d; } r -= 256;
        if (r < 128) { d.W = a.in[18] + (size_t)l * 256 * D; d.K = 256; d.N = D; d.WT = (bf16*)(wm + WM_A) + 512; d.item = r; d.ldt = 1024; return d; } r -= 128;
        if (r < 128) { d.W = a.in[19] + (size_t)l * 256 * D; d.K = 256; d.N = D; d.WT = (bf16*)(wm + WM_A) + 768; d.item = r; d.ldt = 1024; return d; } r -= 128;
        d.W = a.in[20] + (size_t)l * D * D; d.K = D; d.N = D; d.WT = (bf16*)(wm + WM_O); d.item = r; d.ldt = D; d.sc8 = FP8_WO(l) ? 32.0f : 0.0f; return d;
    }
    it -= DEPTH * 3792; const int i = it / 4224; int r = it - i * 4224; unsigned char* wd = a.ws + WS_WDENSE + (size_t)i * WDENSE_STRIDE;
    if (r < 2816) { const int up = r >= 1408; d.W = (up ? a.in[23] : a.in[22]) + (size_t)i * D * D_FF; d.K = D; d.N = D_FF; d.gk = a.in[21] + (2 * i) * D; d.WT = (bf16*)(wd + WD_GU); d.kind = 1; d.off = up * 128; d.item = r - up * 1408; d.ldt = D; d.sc8 = (i == FP8_DENSE_I) ? 32.0f : 0.0f; return d; }
    d.W = a.in[24] + (size_t)i * D_FF * D; d.K = D_FF; d.N = D; d.WT = (bf16*)(wd + WD_D); d.item = r - 2816; d.ldt = D_FF; d.sc8 = (i == FP8_DENSE_I) ? 64.0f : 0.0f; return d;
}
__device__ __forceinline__ void p0_prologue(Frame& F, const Args& a) {
    LAS float* scr = (LAS float*)(F.lds + RING_OFF + F.wave * 16384);
    {   constexpr int TOTAL = DEPTH * 3792 + 2 * 4224;
        int it = F.gw;
        if (it < TOTAL) {
            f32x4 va[8], vb[8];
            CvtDesc da = cvt_p0_desc(a, it), db = da; cvt_load(da, F.lane, va);
            for (;;) {
                const int itb = it + F.NGW; const bool hb = itb < TOTAL;
                if (hb) { db = cvt_p0_desc(a, itb); cvt_load(db, F.lane, vb); }
                cvt_store(da, scr, F.lane, va);
                if (!hb) break;
                it = itb + F.NGW; const bool ha = it < TOTAL;
                if (ha) { da = cvt_p0_desc(a, it); cvt_load(da, F.lane, va); }
                cvt_store(db, scr, F.lane, vb);
                if (!ha) break;
            }
        }
    }
    for (int r = F.gw; r < DEPTH * 248; r += F.NGW) { const int l = r / 248, row = 5384 + (r - l * 248); unsigned char* wr_ = a.ws + WS_WMIX + (size_t)l * WMIX_STRIDE + WM_IN + (size_t)row * D * (FP8_INPROJ(l) ? 1 : 2);
        if (FP8_INPROJ(l)) *(v4u*)(wr_ + 16 * F.lane) = (v4u){0u, 0u, 0u, 0u}; else { *(v4u*)(wr_ + 32 * F.lane) = (v4u){0u, 0u, 0u, 0u}; *(v4u*)(wr_ + 32 * F.lane + 16) = (v4u){0u, 0u, 0u, 0u}; } }
    float* bperm = (float*)(a.ws + WS_BPERM);
    for (int idx = F.gw * 64 + F.lane; idx < DEPTH * N_INP; idx += F.NGW * 64) { const int l = idx / N_INP, d = idx - l * N_INP, n = inproj_src(d); bperm[idx] = n >= 0 ? a.in[3][l * N_IN + n] : 0.f; }
    bf16* xb = (bf16*)(a.ws + WS_XB); float* ssq = (float*)(a.ws + WS_SSQ);
    {   f32x4 nv[4]; int m = F.gw;
        if (m < M) { const f32x4* xr = (const f32x4*)(a.in[0] + (size_t)m * D) + F.lane;
#pragma unroll
            for (int j = 0; j < 4; ++j) nv[j] = xr[64 * j]; }
        for (; m < M; m += F.NGW) {
            f32x4 v[4];
#pragma unroll
            for (int j = 0; j < 4; ++j) v[j] = nv[j];
            if (m + F.NGW < M) { const f32x4* xr = (const f32x4*)(a.in[0] + (size_t)(m + F.NGW) * D) + F.lane;
#pragma unroll
                for (int j = 0; j < 4; ++j) nv[j] = xr[64 * j]; }
            float ss = 0.f;
#pragma unroll
            for (int j = 0; j < 4; ++j) { v2u w; w.x = pk2(v[j].x, v[j].y); w.y = pk2(v[j].z, v[j].w);
                *(v2u*)(xb + (size_t)m * D + 256 * j + 4 * F.lane) = w;
                const float a0 = bflo(w.x), a1 = bfhi(w.x), a2 = bflo(w.y), a3 = bfhi(w.y); ss += (a0 * a0 + a1 * a1) + (a2 * a2 + a3 * a3);
                *(unsigned*)(a.ws + WS_XB8 + (size_t)m * D + 256 * j + 4 * F.lane) = pk4_fp8(a0, a1, a2, a3); }
            const float tot = wave_sum(ss);
            if (F.lane < 16) ssq[(size_t)m * 16 + F.lane] = F.lane == 0 ? tot : 0.f;
        }
    }
}

__device__ __forceinline__ void t1_cumsum(const Args& a, int bh, int lane) {
    const float* logf = (const float*)(a.ws + WS_LOGF); float* Fh = (float*)(a.ws + WS_FH);
    const int b = bh >> 3, h = bh & 7; const float* p = logf + ((size_t)b * SEQ + lane) * 8 + h; float* o = Fh + (size_t)bh * SEQ + lane;
    float carry = 0.f;
    for (int blk = 0; blk < SEQ / 64; blk += 8) {
        float v[8];
#pragma unroll
        for (int q = 0; q < 8; ++q) v[q] = p[(size_t)(blk + q) * 64 * 8];
#pragma unroll
        for (int q = 0; q < 8; ++q) { float x = v[q];
#pragma unroll
            for (int s = 1; s < 64; s <<= 1) { const float t = __shfl_up(x, s); if (lane >= s) x += t; }
            x += carry; o[(blk + q) * 64] = x; carry = __builtin_bit_cast(float, __builtin_amdgcn_readlane(__builtin_bit_cast(int, x), 63)); }
    }
}
constexpr int CONV_TILE = 128, CONV_ROWS = CONV_TILE + CONV_K - 1;
__device__ __forceinline__ void t1_conv_tile(const Args& a, int l, int tile, LAS unsigned char* lds, int tid, int wave, int lane, const f32x4 (&cwt)[CONV_K], const f32x4 cb, const f32x4 lg, const f32x4 lb) {
    const bf16* HC = (const bf16*)(a.out + DO_HC); bf16* CO = (bf16*)(a.ws + WS_BCAT) + 768;
    const int t0 = tile * CONV_TILE, tl0 = t0 & (SEQ - 1);
    { v4u sv[10];
#pragma unroll
      for (int q = 0; q < 10; ++q) { const int pc = tid + q * NWAVES * 64, r = pc >> 5, c = pc & 31; sv[q] = (v4u){0u, 0u, 0u, 0u};
          if (pc < CONV_ROWS * 32 && tl0 + r - (CONV_K - 1) >= 0) sv[q] = *(const v4u*)(HC + (size_t)(t0 + r - (CONV_K - 1)) * CONV_W + 8 * c); }
#pragma unroll
      for (int q = 0; q < 10; ++q) { const int pc = tid + q * NWAVES * 64, r = pc >> 5, c = pc & 31; if (pc < CONV_ROWS * 32) *(LAS v4u*)(lds + r * 512 + c * 16) = sv[q]; } }
    __syncthreads();
    for (int i = 0; i < 16; ++i) {
        const int tr = wave * 16 + i;
        f32x4 y = cb;
#pragma unroll
        for (int k = 0; k < CONV_K; ++k) { const v2u hv = *(const LAS v2u*)(lds + (tr + k) * 512 + 8 * lane);
            y.x += cwt[k].x * bflo(hv.x); y.y += cwt[k].y * bfhi(hv.x); y.z += cwt[k].z * bflo(hv.y); y.w += cwt[k].w * bfhi(hv.y); }
        const float mu = wave_sum((y.x + y.y) + (y.z + y.w)) * (1.f / 256.f);
        const f32x4 dl = y - mu;
        const float var = wave_sum((dl.x * dl.x + dl.y * dl.y) + (dl.z * dl.z + dl.w * dl.w)) * (1.f / 256.f);
        const float rs = rsqrtf(var + EPS);
        f32x4 z = dl * rs * lg + lb;
        z.x *= sigmoidf_(z.x); z.y *= sigmoidf_(z.y); z.z *= sigmoidf_(z.z); z.w *= sigmoidf_(z.w);
        v2u o; o.x = pk2(z.x, z.y); o.y = pk2(z.z, z.w);
        *(v2u*)(CO + (size_t)(t0 + tr) * 1024 + 4 * lane) = o;
    }
    __syncthreads();
}
__device__ __forceinline__ void t1_conv_all(const Args& a, int l, int bid, int G, LAS unsigned char* lds, int tid, int wave, int lane) {
    f32x4 cwt[CONV_K];
#pragma unroll
    for (int k = 0; k < CONV_K; ++k) cwt[k] = *(const f32x4*)(a.in[13] + ((size_t)l * CONV_K + k) * CONV_W + 4 * lane);
    const f32x4 cb = *(const f32x4*)(a.in[14] + l * CONV_W + 4 * lane), lg = *(const f32x4*)(a.in[15] + l * CONV_W + 4 * lane), lb = *(const f32x4*)(a.in[16] + l * CONV_W + 4 * lane);
    for (int tile = bid; tile < M / CONV_TILE; tile += G) t1_conv_tile(a, l, tile, lds, tid, wave, lane, cwt, cb, lg, lb);
}
__device__ __forceinline__ float gelu_tanh(float y) {
    const float z = 0.7978845608028654f * (y + 0.044715f * y * y * y);
    const float th = 1.0f - 2.0f * __builtin_amdgcn_rcpf(__builtin_amdgcn_exp2f(2.885390081777927f * z) + 1.0f);
    return 0.5f * y * (1.0f + th);
}
__device__ __forceinline__ void moe_route(Frame& F, const Args& a, int l, int i) {
    const bf16* xb = (const bf16*)(a.ws + WS_XB); const float* ssq = (const float*)(a.ws + WS_SSQ);
    int* toke = (int*)(a.ws + WS_TOKE); float* tokw = (float*)(a.ws + WS_TOKW); int* cntw = (int*)(a.ws + WS_CNTW);
    const int lane = F.lane, k0 = 16 * lane;
    float wr[16][8];
#pragma unroll
    for (int j = 0; j < 16; ++j) { const float gk = a.in[21][l * D + k0 + j];
        const f32x4 w0 = *(const f32x4*)(a.in[25] + ((size_t)i * D + k0 + j) * NE), w1 = *(const f32x4*)(a.in[25] + ((size_t)i * D + k0 + j) * NE + 4);
        wr[j][0] = gk * w0.x; wr[j][1] = gk * w0.y; wr[j][2] = gk * w0.z; wr[j][3] = gk * w0.w; wr[j][4] = gk * w1.x; wr[j][5] = gk * w1.y; wr[j][6] = gk * w1.z; wr[j][7] = gk * w1.w; }
    float rb[8];
#pragma unroll
    for (int e = 0; e < 8; ++e) rb[e] = a.in[26][i * NE + e];
    const bool b5 = (lane & 32) != 0, b4 = (lane & 16) != 0, b3 = (lane & 8) != 0;
    for (int run = F.gw; run < M / 32; run += F.NGW) {
        int cnt[8];
#pragma unroll
        for (int e = 0; e < 8; ++e) cnt[e] = 0;
        const float rstd_l = row_rstd(ssq, run * 32 + (lane & 31));
        v4u x0n = *(const v4u*)(xb + (size_t)(run * 32) * D + k0), x1n = *(const v4u*)(xb + (size_t)(run * 32) * D + k0 + 8);
        for (int ti = 0; ti < 32; ++ti) {
            const int t = run * 32 + ti;
            const v4u x0 = x0n, x1 = x1n;
            if (ti + 1 < 32) { x0n = *(const v4u*)(xb + (size_t)(t + 1) * D + k0); x1n = *(const v4u*)(xb + (size_t)(t + 1) * D + k0 + 8); }
            float xv[16] = {bflo(x0.x), bfhi(x0.x), bflo(x0.y), bfhi(x0.y), bflo(x0.z), bfhi(x0.z), bflo(x0.w), bfhi(x0.w), bflo(x1.x), bfhi(x1.x), bflo(x1.y), bfhi(x1.y), bflo(x1.z), bfhi(x1.z), bflo(x1.w), bfhi(x1.w)};
            float v[8];
#pragma unroll
            for (int e = 0; e < 8; ++e) { float s = 0.f;
#pragma unroll
                for (int j = 0; j < 16; ++j) s += xv[j] * wr[j][e];
                v[e] = s; }
            float w4[4], w2[2];
#pragma unroll
            for (int q = 0; q < 4; ++q) { const float keep = b5 ? v[q + 4] : v[q], send = b5 ? v[q] : v[q + 4]; w4[q] = keep + __shfl_xor(send, 32); }
#pragma unroll
            for (int q = 0; q < 2; ++q) { const float keep = b4 ? w4[q + 2] : w4[q], send = b4 ? w4[q] : w4[q + 2]; w2[q] = keep + __shfl_xor(send, 16); }
            float w1; { const float keep = b3 ? w2[1] : w2[0], send = b3 ? w2[0] : w2[1]; w1 = keep + __shfl_xor(send, 8); }
            w1 += __shfl_xor(w1, 4); w1 += __shfl_xor(w1, 2); w1 += __shfl_xor(w1, 1);
            const float rstd = __builtin_bit_cast(float, __builtin_amdgcn_readlane(__builtin_bit_cast(int, rstd_l), ti));
            float lg[8];
#pragma unroll
            for (int e = 0; e < 8; ++e) lg[e] = __builtin_bit_cast(float, __builtin_amdgcn_readlane(__builtin_bit_cast(int, w1), 8 * e)) * rstd + rb[e];
            int e0 = 0; float l0 = lg[0];
#pragma unroll
            for (int e = 1; e < 8; ++e) if (lg[e] > l0) { l0 = lg[e]; e0 = e; }
            int e1 = (e0 == 0) ? 1 : 0; float l1 = -INFINITY;
#pragma unroll
            for (int e = 0; e < 8; ++e) if (e != e0 && lg[e] > l1) { l1 = lg[e]; e1 = e; }
            const float p0 = 1.0f / (1.0f + __expf(l1 - l0)), p1 = 1.0f - p0;
            if (lane == 0) { toke[t] = e0 | (e1 << 8); tokw[2 * t] = p0; tokw[2 * t + 1] = p1; }
#pragma unroll
            for (int e = 0; e < 8; ++e) cnt[e] += (e0 == e) + (e1 == e);
        }
        int cv = 0;
#pragma unroll
        for (int e = 0; e < 8; ++e) if (lane == e) cv = cnt[e];
        if (lane < 8) cntw[run * 8 + lane] = cv;
    }
}
__device__ __forceinline__ int wave_sum_i(int v) {
#pragma unroll
    for (int o = 1; o < 64; o <<= 1) v += __shfl_xor(v, o);
    return v;
}
__device__ __forceinline__ void moe_slots(Frame& F, const Args& a) {
    const bf16* xb = (const bf16*)(a.ws + WS_XB); const float* ssq = (const float*)(a.ws + WS_SSQ);
    const int* toke = (const int*)(a.ws + WS_TOKE); const float* tokw = (const float*)(a.ws + WS_TOKW); const int* cntw = (const int*)(a.ws + WS_CNTW);
    int* meta = (int*)(a.ws + WS_META); int* rdest = (int*)(a.ws + WS_RDEST); float* rw = (float*)(a.ws + WS_RW); float* rrstd = (float*)(a.ws + WS_RRSTD);
    const int lane = F.lane;
    for (int run = F.gw; run < M / 32; run += F.NGW) {
        int pre[8], tot[8];
#pragma unroll
        for (int e = 0; e < 8; ++e) { pre[e] = 0; tot[e] = 0; }
#pragma unroll 8
        for (int r2 = lane; r2 < M / 32; r2 += 64) {
            const int4 c0 = *(const int4*)(cntw + r2 * 8), c1 = *(const int4*)(cntw + r2 * 8 + 4); const int f = r2 < run ? 1 : 0;
            tot[0] += c0.x; tot[1] += c0.y; tot[2] += c0.z; tot[3] += c0.w; tot[4] += c1.x; tot[5] += c1.y; tot[6] += c1.z; tot[7] += c1.w;
            pre[0] += f * c0.x; pre[1] += f * c0.y; pre[2] += f * c0.z; pre[3] += f * c0.w; pre[4] += f * c1.x; pre[5] += f * c1.y; pre[6] += f * c1.z; pre[7] += f * c1.w;
        }
        int seg[9]; seg[0] = 0;
#pragma unroll
        for (int e = 0; e < 8; ++e) { tot[e] = __builtin_amdgcn_readfirstlane(wave_sum_i(tot[e])); pre[e] = __builtin_amdgcn_readfirstlane(wave_sum_i(pre[e])); seg[e + 1] = seg[e] + ((tot[e] + 255) & ~255); }
        if (run == 0 && lane < 9) { int sv = 0;
#pragma unroll
            for (int e = 0; e < 9; ++e) if (lane == e) sv = seg[e] >> 8;
            meta[lane] = sv; }
        if (run < 8) {
#pragma unroll
            for (int e = 0; e < 8; ++e) if (run == e) { for (int r = tot[e] + lane; r < ((tot[e] + 255) & ~255); r += 64) { rdest[seg[e] + r] = -1; rw[seg[e] + r] = 0.f; rrstd[seg[e] + r] = 0.f; } }
        }
        int base[8];
#pragma unroll
        for (int e = 0; e < 8; ++e) base[e] = seg[e] + pre[e];
        const int tl = run * 32 + (lane & 31);
        const int ee_l = toke[tl]; const float w0_l = tokw[2 * tl], w1_l = tokw[2 * tl + 1], rstd_l = row_rstd(ssq, tl);
        int s0_l = 0, s1_l = 0;
        for (int ti = 0; ti < 32; ++ti) {
            const int ee = __builtin_amdgcn_readlane(ee_l, ti); const int e0 = ee & 255, e1 = ee >> 8;
            int s0 = 0, s1 = 0;
#pragma unroll
            for (int e = 0; e < 8; ++e) { if (e0 == e) { s0 = base[e]; base[e] += 1; } if (e1 == e) { s1 = base[e]; base[e] += 1; } }
            if (lane == ti) { s0_l = s0; s1_l = s1; }
        }
        if (lane < 32) { rdest[s0_l] = 2 * tl; rdest[s1_l] = 2 * tl + 1; rw[s0_l] = w0_l; rw[s1_l] = w1_l; rrstd[s0_l] = rstd_l; rrstd[s1_l] = rstd_l; }
    }
}
__device__ __forceinline__ void moe_combine(Frame& F, const Args& a, bool last) {
    bf16* xb = (bf16*)(a.ws + WS_XB); float* ssq = (float*)(a.ws + WS_SSQ); const bf16* yb = (const bf16*)a.out; float* outp = (float*)a.out;
    const int lane = F.lane;
    v4u nx[6]; int tt = F.gw;
#define CMB_LOAD(dst, tok) do { const int t_ = (tok); dst[0] = *(const v4u*)(xb + (size_t)t_ * D + 16 * lane); dst[1] = *(const v4u*)(xb + (size_t)t_ * D + 16 * lane + 8); \
        dst[2] = *(const v4u*)(yb + (size_t)(2 * t_) * D + 16 * lane); dst[3] = *(const v4u*)(yb + (size_t)(2 * t_) * D + 16 * lane + 8); \
        dst[4] = *(const v4u*)(yb + (size_t)(2 * t_ + 1) * D + 16 * lane); dst[5] = *(const v4u*)(yb + (size_t)(2 * t_ + 1) * D + 16 * lane + 8); } while (0)
    if (tt < M) CMB_LOAD(nx, M - 1 - tt);
    for (; tt < M; tt += F.NGW) {
        const int t = M - 1 - tt;
        const v4u x0 = nx[0], x1 = nx[1], y00 = nx[2], y01 = nx[3], y10 = nx[4], y11 = nx[5];
        if (tt + F.NGW < M) CMB_LOAD(nx, M - 1 - (tt + F.NGW));
        A4 xa, xb_, xc, xd, t0, t1;
        unpack8(x0, xa, xb_); unpack8(x1, xc, xd);
        unpack8(y00, t0, t1); xa = xa + t0; xb_ = xb_ + t1; unpack8(y01, t0, t1); xc = xc + t0; xd = xd + t1;
        unpack8(y10, t0, t1); xa = xa + t0; xb_ = xb_ + t1; unpack8(y11, t0, t1); xc = xc + t0; xd = xd + t1;
        if (!last) {
            const v4u w0 = pack8(xa, xb_), w1 = pack8(xc, xd);
            *(v4u*)(xb + (size_t)t * D + 16 * lane) = w0; *(v4u*)(xb + (size_t)t * D + 16 * lane + 8) = w1;
            unpack8(w0, xa, xb_); unpack8(w1, xc, xd);
            { v4u o8; o8.x = pk4_fp8(xa[0], xa[1], xa[2], xa[3]); o8.y = pk4_fp8(xb_[0], xb_[1], xb_[2], xb_[3]); o8.z = pk4_fp8(xc[0], xc[1], xc[2], xc[3]); o8.w = pk4_fp8(xd[0], xd[1], xd[2], xd[3]); *(v4u*)(a.ws + WS_XB8 + (size_t)t * D + 16 * lane) = o8; }
        }
        float ss = 0.f;
#pragma unroll
        for (int j = 0; j < 4; ++j) ss += xa[j] * xa[j] + xb_[j] * xb_[j] + xc[j] * xc[j] + xd[j] * xd[j];
        const float tot = wave_sum(ss);
        if (!last) { if (lane < 16) ssq[(size_t)t * 16 + lane] = lane == 0 ? tot : 0.f; }
        else {
            const float r = rsqrtf(tot * (1.0f / 1024.0f) + EPS); const f32x4* gf = (const f32x4*)(a.in[30] + 16 * lane); f32x4* op = (f32x4*)(outp + (size_t)t * D + 16 * lane);
            op[0] = xa * r * gf[0]; op[1] = xb_ * r * gf[1]; op[2] = xc * r * gf[2]; op[3] = xd * r * gf[3];
        }
    }
#undef CMB_LOAD
}
constexpr int SSM_T = 64, SSM_KA = 1152;
__device__ __forceinline__ void ssm_abar(const Args& a, int lg, int p, float& lam_re, float& lam_im, float& dt) { lam_re = a.in[4][lg * SSM_P + p]; lam_im = a.in[5][lg * SSM_P + p]; dt = expf(a.in[6][lg]); }
__device__ __forceinline__ void cpow(float lam_re, float lam_im, float dt, int tau, float& re, float& im) { const float mag = expf(lam_re * dt * (float)tau); float sn, cs; sincosf(lam_im * dt * (float)tau, &sn, &cs); re = mag * cs; im = mag * sn; }
__device__ __forceinline__ void ssm_tables(Frame& F, const Args& a) {
    float* APOW = (float*)(a.ws + WS_APOW); float* BBAR = (float*)(a.ws + WS_BBAR); float* KTAB = (float*)(a.ws + WS_KTAB);
    const int lane = F.lane, p = lane;
    const bool b5 = (lane & 32) != 0, b4 = (lane & 16) != 0, b3 = (lane & 8) != 0, b2 = (lane & 4) != 0;
    for (int task = F.gw; task < DEPTH * SSM_G * 65; task += F.NGW) {
        const int lg = task / 65, tau = task - lg * 65;
        float lam_re, lam_im, dt; ssm_abar(a, lg, p, lam_re, lam_im, dt);
        float pr, pi; cpow(lam_re, lam_im, dt, tau, pr, pi);
        *(f32x2*)(APOW + (((size_t)lg * 65 + tau) * SSM_P + p) * 2) = (f32x2){pr, pi};
        float ar, ai; cpow(lam_re, lam_im, dt, 1, ar, ai);
        const float nr = ar - 1.0f, ni = ai, den = lam_re * lam_re + lam_im * lam_im;
        const float cr = (nr * lam_re + ni * lam_im) / den, ci = (ni * lam_re - nr * lam_im) / den;
        float br[16], bi[16];
#pragma unroll
        for (int h = 0; h < 16; ++h) { const float bre = a.in[7][((size_t)lg * SSM_P + p) * SSM_H + h], bim = a.in[8][((size_t)lg * SSM_P + p) * SSM_H + h]; br[h] = cr * bre - ci * bim; bi[h] = cr * bim + ci * bre; }
        if (tau == 0) {
#pragma unroll
            for (int h = 0; h < 16; ++h) *(f32x2*)(BBAR + (((size_t)lg * SSM_P + p) * SSM_H + h) * 2) = (f32x2){br[h], bi[h]};
        }
        if (tau < 64) {
            for (int ho = 0; ho < 16; ++ho) {
                const float cre = a.in[9][((size_t)lg * SSM_H + ho) * SSM_P + p], cim = a.in[10][((size_t)lg * SSM_H + ho) * SSM_P + p];
                const float wr_ = cre * pr - cim * pi, wi_ = cre * pi + cim * pr;
                float v[16];
#pragma unroll
                for (int h = 0; h < 16; ++h) v[h] = wr_ * br[h] - wi_ * bi[h];
                float w8[8], w4[4], w2[2];
#pragma unroll
                for (int i = 0; i < 8; ++i) { const float keep = b5 ? v[i + 8] : v[i], send = b5 ? v[i] : v[i + 8]; w8[i] = keep + __shfl_xor(send, 32); }
#pragma unroll
                for (int i = 0; i < 4; ++i) { const float keep = b4 ? w8[i + 4] : w8[i], send = b4 ? w8[i] : w8[i + 4]; w4[i] = keep + __shfl_xor(send, 16); }
#pragma unroll
                for (int i = 0; i < 2; ++i) { const float keep = b3 ? w4[i + 2] : w4[i], send = b3 ? w4[i] : w4[i + 2]; w2[i] = keep + __shfl_xor(send, 8); }
                float w1; { const float keep = b2 ? w2[1] : w2[0], send = b2 ? w2[0] : w2[1]; w1 = keep + __shfl_xor(send, 4); }
                w1 += __shfl_xor(w1, 2); w1 += __shfl_xor(w1, 1);
                const int hi = lane >> 2;
                if (tau == 0 && hi == ho) w1 += a.in[11][lg * SSM_H + ho];
                if ((lane & 3) == 0) KTAB[(((size_t)lg * 64 + tau) * 16 + ho) * 16 + hi] = w1;
            }
        }
    }
}
__device__ __forceinline__ void ssm_gather_u(const Args& a, int chunk, int lane) {
    const bf16* U = (const bf16*)(a.out + DO_U); bf16* Ua = (bf16*)(a.ws + WS_UA);
    const int g = lane >> 2, o4 = (lane & 3) * 4;
#pragma unroll 16
    for (int j = 0; j < SSM_T; ++j) { const v2u w = *(const v2u*)(U + ((size_t)chunk * SSM_T + j) * SSM_W + 4 * lane);
        *(v2u*)(Ua + ((size_t)g * (M / SSM_T) + chunk) * SSM_KA + j * 16 + o4) = w; }
}
__device__ __forceinline__ void ssm_expand_mv(const Args& a, int l, int task, int lane) {
    const float* APOW = (const float*)(a.ws + WS_APOW); const float* KTAB = (const float*)(a.ws + WS_KTAB); bf16* MV = (bf16*)(a.ws + WS_MV);
    const int g = task >> 10, n = task & 1023, i = n >> 4, ho = n & 15, lg = l * SSM_G + g, j = lane;
    bf16* row = MV + (size_t)task * SSM_KA;
    v4u o0 = (v4u){0u, 0u, 0u, 0u}, o1 = o0;
    if (j <= i) { const f32x4* kt = (const f32x4*)(KTAB + (((size_t)lg * 64 + (i - j)) * 16 + ho) * 16); const f32x4 k0 = kt[0], k1 = kt[1], k2 = kt[2], k3 = kt[3];
        o0.x = pk2(k0.x, k0.y); o0.y = pk2(k0.z, k0.w); o0.z = pk2(k1.x, k1.y); o0.w = pk2(k1.z, k1.w); o1.x = pk2(k2.x, k2.y); o1.y = pk2(k2.z, k2.w); o1.z = pk2(k3.x, k3.y); o1.w = pk2(k3.z, k3.w); }
    *(v4u*)(row + j * 16) = o0; *(v4u*)(row + j * 16 + 8) = o1;
    const int p = lane; const f32x2 ap = *(const f32x2*)(APOW + (((size_t)lg * 65 + (i + 1)) * SSM_P + p) * 2);
    const float cre = a.in[9][((size_t)lg * SSM_H + ho) * SSM_P + p], cim = a.in[10][((size_t)lg * SSM_H + ho) * SSM_P + p];
    row[1024 + p] = (bf16)f2bf(cre * ap.x - cim * ap.y); row[1024 + 64 + p] = (bf16)f2bf(-(cre * ap.y + cim * ap.x));
}
__device__ __forceinline__ void ssm_expand_w(const Args& a, int l, int task, int lane) {
    const float* APOW = (const float*)(a.ws + WS_APOW); const float* BBAR = (const float*)(a.ws + WS_BBAR); bf16* WG = (bf16*)(a.ws + WS_WG);
    const int g = task >> 7, q = task & 127, p = q & 63, im = q >> 6, lg = l * SSM_G + g, j = lane;
    { bf16* zr = WG + ((size_t)g * 256 + 128 + q) * 1024 + j * 16; *(v4u*)zr = (v4u){0u, 0u, 0u, 0u}; *(v4u*)(zr + 8) = (v4u){0u, 0u, 0u, 0u}; }
    const f32x2 ap = *(const f32x2*)(APOW + (((size_t)lg * 65 + (63 - j)) * SSM_P + p) * 2);
    float v[16];
#pragma unroll
    for (int h = 0; h < 16; ++h) { const f32x2 bb = *(const f32x2*)(BBAR + (((size_t)lg * SSM_P + p) * SSM_H + h) * 2); v[h] = im ? (ap.x * bb.y + ap.y * bb.x) : (ap.x * bb.x - ap.y * bb.y); }
    bf16* row = WG + ((size_t)g * 256 + q) * 1024 + j * 16;
    v4u o0, o1; o0.x = pk2(v[0], v[1]); o0.y = pk2(v[2], v[3]); o0.z = pk2(v[4], v[5]); o0.w = pk2(v[6], v[7]); o1.x = pk2(v[8], v[9]); o1.y = pk2(v[10], v[11]); o1.z = pk2(v[12], v[13]); o1.w = pk2(v[14], v[15]);
    *(v4u*)row = o0; *(v4u*)(row + 8) = o1;
}
struct GroupOrder {
    pg8::StaticOrder so; int b_rows;
    __device__ __forceinline__ bool next(int i, pg8::Unit& u) const { if (!so.next(i, u)) return false; u.brow = (u.pm >> 2) * b_rows + u.pn * 256; return true; }
};
struct EpiSsmScan {
    static constexpr bool PERM = true, AFTER_DRAIN = true, HOOKS = false, RMW = false;
    const float* APOW; bf16* Ua; int layer;
    __device__ __forceinline__ void fused(const AccT& acc, const pg8::Unit& u, int wr, int wc, int fr, int fq, PG8_LAS unsigned char* lds, int tid) const {
        PG8_LAS float* SL = (PG8_LAS float*)lds;
        const int rl0 = wr * 64 + fr, cw = wc * 32 + 8 * fq;
#pragma unroll
        for (int ai = 0; ai < 2; ++ai)
#pragma unroll
            for (int m = 0; m < 4; ++m) { PG8_LAS float* sp = SL + (rl0 + ai * 128 + m * 16) * 128 + cw; *(PG8_LAS A4*)sp = acc[ai][0][m][0]; *(PG8_LAS A4*)(sp + 4) = acc[ai][0][m][1]; }
        __syncthreads();
        if (tid < 256) {
            const int bl = tid >> 6, p = tid & 63, g = u.pm >> 2, lg = layer * SSM_G + g;
            const f32x2 a64 = *(const f32x2*)(APOW + (((size_t)lg * 65 + 64) * SSM_P + p) * 2);
            float xr = 0.f, xi = 0.f; bf16* xrow = Ua + ((size_t)u.pm * 256 + bl * 64) * SSM_KA + 1024 + p; const PG8_LAS float* sl = SL + (bl * 64) * 128 + p;
#pragma unroll 8
            for (int c = 0; c < 64; ++c) { const float sr = sl[c * 128], si = sl[c * 128 + 64];
                xrow[(size_t)c * SSM_KA] = (bf16)f2bf(xr); xrow[(size_t)c * SSM_KA + 64] = (bf16)f2bf(xi);
                const float nr = a64.x * xr - a64.y * xi + sr, ni = a64.x * xi + a64.y * xr + si; xr = nr; xi = ni; }
        }
        __syncthreads();
    }
};
struct EpiSsmY {
    static constexpr bool PERM = true, AFTER_DRAIN = false, HOOKS = false, RMW = false;
    bf16* YGp;
    __device__ __forceinline__ void operator()(const AccT& acc, const pg8::Unit& u, int wr, int wc, int fr, int fq) const {
        const int row0 = u.pm * 256 + wr * 64 + fr, g = u.pm >> 2;
#pragma unroll
        for (int ai = 0; ai < 2; ++ai)
#pragma unroll
            for (int m = 0; m < 4; ++m) { const int chunk = (row0 + ai * 128 + m * 16) & 1023;
#pragma unroll
                for (int bj = 0; bj < 2; ++bj) { const int i = 16 * u.pn + 8 * bj + 2 * wc + (fq >> 1);
                    const A4 v0 = acc[ai][bj][m][0], v1 = acc[ai][bj][m][1];
                    v4u w; w.x = pk2(gelu_tanh(v0[0]), gelu_tanh(v0[1])); w.y = pk2(gelu_tanh(v0[2]), gelu_tanh(v0[3])); w.z = pk2(gelu_tanh(v1[0]), gelu_tanh(v1[1])); w.w = pk2(gelu_tanh(v1[2]), gelu_tanh(v1[3]));
                    *(v4u*)(YGp + ((size_t)chunk * SSM_T + i) * SSM_W + 16 * g + 8 * (fq & 1)) = w; } }
    }
};
#ifndef MK_N_LAUNCHES
#define MK_N_LAUNCHES 1
#endif
#ifndef NARROW_WGM
#define NARROW_WGM 2
#endif
#ifndef SSM_FAST
#define SSM_FAST 1
#endif
constexpr int N_PHASES = 1 + 2 * (7 + (8 + MOE_NCHUNK + 1)) + (SSM_FAST ? 2 * DEPTH : 0);

__global__ void __launch_bounds__(NWAVES * 64, 2) fwd(Args args) {
    extern __shared__ __attribute__((aligned(16))) unsigned char lds[];
    Frame F;
    F.lds = (LAS unsigned char*)lds;
    F.MISC = (volatile LAS unsigned*)(F.lds + MISC_OFF);
    F.tid = threadIdx.x; F.lane = F.tid & 63; F.wave = __builtin_amdgcn_readfirstlane(F.tid >> 6);
    F.G = gridDim.x; F.gw = blockIdx.x * NWAVES + F.wave; F.NGW = F.G * NWAVES;
    unsigned char* ws = args.ws;
    F.ctl = (gu32*)(ws + WS_CTL);
    for (int u = F.tid; u < (LDS_BYTES - LDSCTL_OFF) / 4; u += NWAVES * 64) ((LAS unsigned*)(F.lds + LDSCTL_OFF))[u] = 0u;
    __syncthreads();
    XcdBarrier bar; bar.bar = (unsigned*)(F.ctl + CW_BAR); bar.x = 0; bar.st = nullptr;
    if (args.use_bar) bar = xcd_barrier_post((unsigned*)(F.ctl + CW_BAR), F.MISC + 8, F.wave);
    const int lo = args.ph_lo, hi = args.ph_hi; int ph = 0;
#ifndef MERGE_MASK
#define MERGE_MASK 7
#endif
#ifndef PHASE_MASK
#define PHASE_MASK 0xffffffffu
#endif
#define INP(k) ((lo <= ph && ph < hi) && ((PHASE_MASK >> (k)) & 1u))
#define OPQ() Frame Fp = F; { const int l_ = lane_id_fresh(); Fp.lane = l_; Fp.tid = (F.wave << 6) | l_; }
#ifdef PROBE_MASK
    unsigned long long tacc_ = 0ull, tst_ = 0ull;
#define PB_START(k) do { if ((PROBE_MASK >> (k)) & 1u) tst_ = __builtin_amdgcn_s_memrealtime(); } while (0)
#define PB_END(k) do { if ((PROBE_MASK >> (k)) & 1u) tacc_ += __builtin_amdgcn_s_memrealtime() - tst_; } while (0)
#else
#define PB_START(k) do {} while (0)
#define PB_END(k) do {} while (0)
#endif
#define SEAM() do { if (lo <= ph && ph + 1 < hi) xcd_barrier(bar, F.wave); ++ph; } while (0)
#define BIDQ() ({ int b_ = (int)blockIdx.x; asm volatile("" : "+s"(b_)); b_; })
    LAS unsigned char* ring = F.lds + RING_OFF;
#define XB ((bf16*)(ws + WS_XB))
#define SSQ ((float*)(ws + WS_SSQ))
#define Qb ((bf16*)(args.out + DO_Q))
#define MRG ((bf16*)(args.out + DO_MERGED))
#define GATES ((bf16*)(ws + WS_GATES))
#define YG ((bf16*)(ws + WS_YG))
#define BCAT ((bf16*)(ws + WS_BCAT))

    PB_START(0); if (INP(0)) { OPQ(); p0_prologue(Fp, args); if (SSM_FAST) ssm_tables(Fp, args); } SEAM(); PB_END(0);

    for (int l = 0; l < DEPTH; ++l) {
        unsigned char* wm = ws + WS_WMIX + (size_t)l * WMIX_STRIDE;
        PB_START(1); if (INP(1)) {
            if (FP8_INPROJ(l)) {
            pg8::Gemm g{(const bf16*)(ws + WS_XB8), (const bf16*)(wm + WM_IN), D / 2, D / 2, D / 2};   pg8::StaticOrder S; S.init(M / 256, N_INP / 256, F.G, BIDQ());
            EpiInProj<true> E{args.out, ws, l};
            pg8::gemm_phase<EpiInProj<true>, pg8::StaticOrder, true, true, false, true>(ring, g, S, E, F.wave);
            } else {
            pg8::Gemm g{XB, (const bf16*)(wm + WM_IN), D, D, D}; pg8::StaticOrder S; S.init(M / 256, N_INP / 256, F.G, BIDQ());
            EpiInProj<false> E{args.out, ws, l};
            pg8::gemm_phase<EpiInProj<false>, pg8::StaticOrder, true, true>(ring, g, S, E, F.wave);
            }
        } SEAM(); PB_END(1);
        PB_START(2); if (INP(2)) {
            OPQ();
#if SSM_FAST
            {
                const int gq = Fp.gw >> 4, gr = Fp.gw & 15, gwl = gq * 15 + (gr - 1), ngw = (Fp.NGW >> 4) * 15;
                if (gr == 0) { PB_START(16); for (int bh = gq; bh < BATCH * NH; bh += (Fp.NGW >> 4)) t1_cumsum(args, bh, Fp.lane); PB_END(16); }
                else {
                PB_START(19); for (int t = gwl; t < SSM_G * 128; t += ngw) ssm_expand_w(args, l, t, Fp.lane); PB_END(19);
#pragma unroll 4
                for (int t = gwl; t < SSM_G * 1024; t += ngw) ssm_expand_mv(args, l, t, Fp.lane);
                if (l & 1) cvt_moe_layer(args, l >> 1, l, (LAS float*)(F.lds + RING_OFF + F.wave * 16384), Fp.lane, gwl, ngw);
                }
                __syncthreads();
                PB_START(21); t1_conv_all(args, l, BIDQ(), F.G, ring, Fp.tid, F.wave, Fp.lane); PB_END(21);
            }
#endif
        } SEAM(); PB_END(2);
#if SSM_FAST
        PB_START(13); if (INP(13)) {
            pg8::Gemm g{(const bf16*)(ws + WS_UA), (const bf16*)(ws + WS_WG), SSM_KA, 1024, 1024}; GroupOrder S; S.so.init(SSM_G * 4, 1, F.G, BIDQ()); S.b_rows = 256; EpiSsmScan E{(const float*)(ws + WS_APOW), (bf16*)(ws + WS_UA), l};
            pg8::gemm_phase<EpiSsmScan, GroupOrder, true, true>(ring, g, S, E, F.wave);
        } SEAM(); PB_END(13);
        PB_START(15); if (INP(15)) {
            pg8::Gemm g{(const bf16*)(ws + WS_UA), (const bf16*)(ws + WS_MV), SSM_KA, SSM_KA, SSM_KA}; GroupOrder S; S.so.init(SSM_G * 4, 4, F.G, BIDQ()); S.b_rows = 1024; EpiSsmY E{YG};
            pg8::gemm_phase<EpiSsmY, GroupOrder, true, true>(ring, g, S, E, F.wave);
        } SEAM(); PB_END(15);
#endif
        PB_START(3); if (INP(3)) {
            { pg8::Gemm g{YG, (const bf16*)(wm + WM_GLU), 256, 256, 256}; pg8::StaticOrder S; S.init(M / 256, 2, F.G, BIDQ()); EpiGluSsm E{BCAT};
              pg8::gemm_phase<EpiGluSsm, pg8::StaticOrder, true, true>(ring, g, S, E, F.wave); }
#if ATTN_FAST
            { const attn_body::AttnTensors AT{(const attn_body::bf16*)Qb, (const attn_body::bf16*)(args.out + DO_K), (const attn_body::bf16*)(args.out + DO_V), (attn_body::bf16*)BCAT, (const float*)(ws + WS_FH)};
              const attn_body::StaticOrder SA((int)F.G, BIDQ());
              attn_body::attn_phase<attn_body::StaticOrder>((char*)lds + RING_OFF, AT, SA, F.wave); }
#endif
        } SEAM(); PB_END(3);
        PB_START(4); if (INP(4)) {
            pg8::StaticOrder S; S.init(M / 256, 4, F.G, BIDQ()); S.wgm = NARROW_WGM;
            pg8::Gemm g{BCAT, (const bf16*)(wm + WM_A), D, D, D};
            if (FP8_WO(l)) { EpiMergeCat<true> E{GATES, MRG}; pg8::gemm_phase<EpiMergeCat<true>, pg8::StaticOrder, true, true>(ring, g, S, E, F.wave); }
            else { EpiMergeCat<false> E{GATES, MRG}; pg8::gemm_phase<EpiMergeCat<false>, pg8::StaticOrder, true, true>(ring, g, S, E, F.wave); }
        } SEAM(); PB_END(4);
        PB_START(5); if (INP(5)) {
            pg8::StaticOrder S; S.init(M / 256, 4, F.G, BIDQ(), 1); S.wgm = NARROW_WGM;
            if (FP8_WO(l)) { pg8::Gemm g{MRG, (const bf16*)(wm + WM_O), D / 2, D / 2, D / 2};   EpiResid<true, 5> E{XB, SSQ, ws + WS_XB8}; pg8::gemm_phase<EpiResid<true, 5>, pg8::StaticOrder, true, true, false, true>(ring, g, S, E, F.wave); }
            else { pg8::Gemm g{MRG, (const bf16*)(wm + WM_O), D, D, D}; EpiResid<true, 0> E{XB, SSQ, ws + WS_XB8}; pg8::gemm_phase<EpiResid<true, 0>, pg8::StaticOrder, true, true>(ring, g, S, E, F.wave); }
        } SEAM(); PB_END(5);
        if (!(l & 1)) {
            unsigned char* wd = ws + WS_WDENSE + (size_t)(l >> 1) * WDENSE_STRIDE; bf16* const HID = (bf16*)(ws + WS_HID);
            PB_START(6); if (INP(6)) {
                if ((l >> 1) == FP8_DENSE_I) {
                pg8::Gemm g{(const bf16*)(ws + WS_XB8), (const bf16*)(wd + WD_GU), D / 2, D / 2, D / 2};   pg8::StaticOrder S; S.init(M / 256, 2 * D_FF / 256, F.G, BIDQ()); EpiSwiGlu<false, true> E{HID, D_FF, SSQ};
                pg8::gemm_phase<EpiSwiGlu<false, true>, pg8::StaticOrder, true, true, false, true>(ring, g, S, E, F.wave);
                } else {
                pg8::Gemm g{XB, (const bf16*)(wd + WD_GU), D, D, D}; pg8::StaticOrder S; S.init(M / 256, 2 * D_FF / 256, F.G, BIDQ()); EpiSwiGlu<false> E{HID, D_FF, SSQ};
                pg8::gemm_phase<EpiSwiGlu<false>, pg8::StaticOrder, true, true>(ring, g, S, E, F.wave);
                }
            } SEAM(); PB_END(6);
            PB_START(7); if (INP(7)) {
                if ((l >> 1) == FP8_DENSE_I) {
                pg8::Gemm g{HID, (const bf16*)(wd + WD_D), 64, D_FF / 2, D_FF / 2, nullptr, 256 * 128, (long)(D_FF / 128) * 256 * 128};   pg8::StaticOrder S; S.init(M / 256, 4, F.G, BIDQ(), 1); S.wgm = NARROW_WGM; EpiResid<true, 6> E{XB, SSQ, ws + WS_XB8};
                pg8::gemm_phase<EpiResid<true, 6>, pg8::StaticOrder, true, true, false, true>(ring, g, S, E, F.wave);
                } else {
                pg8::Gemm g{HID, (const bf16*)(wd + WD_D), 64, D_FF, D_FF, nullptr, 256 * 64 * 2, (long)(D_FF / 64) * 256 * 64 * 2};   pg8::StaticOrder S; S.init(M / 256, 4, F.G, BIDQ(), 1); S.wgm = NARROW_WGM; EpiResid<true, 0> E{XB, SSQ, ws + WS_XB8};
                pg8::gemm_phase<EpiResid<true, 0>, pg8::StaticOrder, true, true>(ring, g, S, E, F.wave);
                }
            } SEAM(); PB_END(7);
        } else {
            PB_START(8); if (INP(8)) { OPQ(); moe_route(Fp, args, l, l >> 1); } SEAM(); PB_END(8);
            PB_START(9); if (INP(9)) { OPQ(); moe_slots(Fp, args); } SEAM(); PB_END(9);
            const int* meta = (const int*)(ws + WS_META);
            for (int q = 0; q <= MOE_NCHUNK; ++q) {
                PB_START(10); if (INP(10)) {
                    const int total = meta[8], per = (total + MOE_NCHUNK - 1) / MOE_NCHUNK;
                    int nMd = 0;
                    if (q > 0) {
                        const int ch = q - 1, tile0 = ch * per; int nM = total - tile0; nM = nM < 0 ? 0 : (nM > per ? per : nM); nMd = nM;
                        pg8::Gemm g{(const bf16*)(ws + WS_MHID + (size_t)(ch & 1) * MHID_BYTES), (const bf16*)(ws + WS_WMOE + WMOE_D), 64, D_FFE / 2, D_FFE / 2, nullptr, 256 * 128, (long)(D_FFE / 128) * 256 * 128};
                        MoeOrder S; S.so.init(nM, 4, F.G, BIDQ(), 1); S.so.wgm = NARROW_WGM; S.tile0 = tile0; S.a_tile_off = 0; S.b_rows = D;
                        S.s1 = meta[1]; S.s2 = meta[2]; S.s3 = meta[3]; S.s4 = meta[4]; S.s5 = meta[5]; S.s6 = meta[6]; S.s7 = meta[7];
                        EpiMoeDown<true> E{(bf16*)args.out, (const int*)(ws + WS_RDEST) + (size_t)tile0 * 256, (const float*)(ws + WS_RW) + (size_t)tile0 * 256};
                        pg8::gemm_phase<EpiMoeDown<true>, MoeOrder, true, true, false, true>(ring, g, S, E, F.wave);
                    }
                    if (q < MOE_NCHUNK) {
                        const int ch = q, tile0 = ch * per; int nM = total - tile0; nM = nM < 0 ? 0 : (nM > per ? per : nM);
                        pg8::Gemm g{(const bf16*)(ws + WS_XB8), (const bf16*)(ws + WS_WMOE + WMOE_GU), D / 2, D / 2, D / 2, (const int*)(ws + WS_RDEST)};
                        MoeOrder S; S.so.init(nM, 2 * D_FFE / 256, F.G, BIDQ()); S.tile0 = tile0; S.a_tile_off = tile0; S.b_rows = 2 * D_FFE;
                        S.s1 = meta[1]; S.s2 = meta[2]; S.s3 = meta[3]; S.s4 = meta[4]; S.s5 = meta[5]; S.s6 = meta[6]; S.s7 = meta[7];
                        if (q > 0) S.skew(4 * nMd);
                        EpiSwiGlu<true, true> E{(bf16*)(ws + WS_MHID + (size_t)(ch & 1) * MHID_BYTES), D_FFE, (const float*)(ws + WS_RRSTD) + (size_t)tile0 * 256};
                        pg8::gemm_phase<EpiSwiGlu<true, true>, MoeOrder, true, true, true, true>(ring, g, S, E, F.wave);
                    }
                } SEAM(); PB_END(10);
            }
            PB_START(12); if (INP(12)) { OPQ(); moe_combine(Fp, args, l == DEPTH - 1); } SEAM(); PB_END(12);
        }
    }
#ifdef PROBE_MASK
    if (blockIdx.x == 0) { const unsigned long long t0_ = __builtin_amdgcn_s_memrealtime(); while (__builtin_amdgcn_s_memrealtime() - t0_ < tacc_) __builtin_amdgcn_s_sleep(8); }
#endif
#undef INP
#undef BIDQ
#undef OPQ
#undef SEAM
}

extern "C" void kernel_launch(void* const* d_in, const int* in_sizes, int n_in, void* d_out, int out_size, void* d_ws, size_t ws_size, hipStream_t stream) {
    static int grid = 0;
    if (grid == 0) {
        if (n_in != 31 || in_sizes[0] != M * D || out_size != M * D || ws_size < WS_END) { fprintf(stderr, "kernel_launch: unexpected shapes/workspace (n_in %d, ws %zu, need %zu); nothing launched\n", n_in, ws_size, (size_t)WS_END); grid = -1; return; }
        int dev = 0, cus = 0, per_cu = 0;
        if (hipGetDevice(&dev) != hipSuccess || hipDeviceGetAttribute(&cus, hipDeviceAttributeMultiprocessorCount, dev) != hipSuccess) { grid = -1; return; }
        if (hipFuncSetAttribute((const void*)fwd, hipFuncAttributeMaxDynamicSharedMemorySize, LDS_BYTES) != hipSuccess) { fprintf(stderr, "kernel_launch: hipFuncSetAttribute failed\n"); grid = -1; return; }
        if (hipOccupancyMaxActiveBlocksPerMultiprocessor(&per_cu, (const void*)fwd, NWAVES * 64, LDS_BYTES) != hipSuccess || per_cu < 1)
            fprintf(stderr, "kernel_launch: note: occupancy query reports %d workgroups per CU\n", per_cu);
        (void)hipGetLastError();
        grid = cus;
    }
    if (grid < 0) return;
    if (hipMemsetAsync((char*)d_ws + WS_CTL, 0, CTL_ZERO_BYTES, stream) != hipSuccess) return;
    Args a{};
    for (int i = 0; i < 31; ++i) a.in[i] = (const float*)d_in[i];
    a.out = (unsigned char*)d_out; a.ws = (unsigned char*)d_ws; a.pad = 0;
#if MK_N_LAUNCHES == 1
    a.ph_lo = 0; a.ph_hi = N_PHASES; a.use_bar = 1;
    hipLaunchKernelGGL(fwd, dim3(grid), dim3(NWAVES * 64), LDS_BYTES, stream, a);
#else
    for (int p = 0; p < N_PHASES; ++p) { a.ph_lo = p; a.ph_hi = p + 1; a.use_bar = 0; hipLaunchKernelGGL(fwd, dim3(grid), dim3(NWAVES * 64), LDS_BYTES, stream, a); }
#endif
}
```

```cpp
#include <hip/hip_runtime.h>
#include <cstdio>
#include <cstdint>
#include <hip/hip_bf16.h>
#include <cmath>
#ifndef ATTN_FAST
#define ATTN_FAST 1
#endif
#define MK_N_LAUNCHES 1
__device__ __forceinline__ int lane_id_fresh() { int l; asm volatile("v_mbcnt_lo_u32_b32 %0, -1, 0\n\tv_mbcnt_hi_u32_b32 %0, -1, %0" : "=v"(l)); return l; }
namespace pg8 {
#define PG8_LAS __attribute__((address_space(3)))
typedef unsigned short bf16_t;
typedef short bf16x8 __attribute__((ext_vector_type(8)));
typedef float f32x4 __attribute__((ext_vector_type(4)));
typedef float f32x2 __attribute__((ext_vector_type(2)));
typedef unsigned u32x4 __attribute__((ext_vector_type(4)));
constexpr int BM = 256, BK = 64, HALF = 128, HTB = HALF * BK * 2  , STAGE_BYTES = 8 * HTB, NXCD = 8, WGM = 4;

__host__ __device__ __forceinline__ int lds_byte(int r, int c) { const int st = (r >> 4) * 2 + (c >> 5), rr = r & 15, cc = c & 31, ob = rr * 64 + cc * 2; return st * 1024 + (ob ^ (((ob >> 9) & 1) << 5)); }
__host__ __device__ __forceinline__ void stage_rc(int b, int& R, int& C) { const int st = b / 1024, sb = b % 1024, swz = sb ^ (((sb >> 9) & 1) << 5); R = (st >> 1) * 16 + swz / 64; C = (st & 1) * 32 + (swz % 64) / 2; }
__host__ __device__ __forceinline__ int perm32(int rho) { const int n = rho >> 4, i = rho & 15; return 8 * (i >> 2) + 4 * n + (i & 3); }

struct Unit { int pm, pn, arow, brow; };
struct Gemm { const bf16_t* A; const bf16_t* Bt; int lda, ldb, K; const int* a_rows = nullptr; int a_kstep = 0; long a_tstride = 0; };

struct StaticOrder {
    int nM, nN, nwg, G, c, rev, pm0 = 0, wgm = WGM;
    __host__ __device__ void init(int nM_, int nN_, int G_, int c_, int rev_ = 0) { nM = nM_; nN = nN_; nwg = nM * nN; G = G_; c = c_; rev = rev_; }
    __host__ __device__ bool next(int i, Unit& u) const { return unit_of((long)i * G + c, u); }
    __host__ __device__ bool unit_of(long L, Unit& u) const {
        if (L >= nwg) return false;
        int wgid = (int)L; { const int q = nwg / NXCD, r = nwg % NXCD, xcd = wgid % NXCD, off = wgid / NXCD; wgid = (xcd < r ? xcd * (q + 1) : r * (q + 1) + (xcd - r) * q) + off; }
        const int nig = wgm * nN, gid = wgid / nig, fm = gid * wgm, gsz = (nM - fm) < wgm ? (nM - fm) : wgm;
        u.pm = fm + ((wgid % nig) % gsz); if (rev) u.pm = nM - 1 - u.pm; u.pm += pm0; u.pn = (wgid % nig) / gsz; u.arow = u.pm * BM; u.brow = u.pn * BM; return true;
    }
};

typedef float f32x8_t __attribute__((ext_vector_type(8)));
__device__ __forceinline__ f32x4 lo4(f32x8_t a) { return __builtin_shufflevector(a, a, 0, 1, 2, 3); }
__device__ __forceinline__ f32x4 hi4(f32x8_t a) { return __builtin_shufflevector(a, a, 4, 5, 6, 7); }
__device__ __forceinline__ f32x8_t set_lo4(f32x8_t a, f32x4 c) { return __builtin_shufflevector(__builtin_shufflevector(c, c, 0, 1, 2, 3, -1, -1, -1, -1), a, 0, 1, 2, 3, 12, 13, 14, 15); }
__device__ __forceinline__ f32x8_t set_hi4(f32x8_t a, f32x4 c) { return __builtin_shufflevector(a, __builtin_shufflevector(c, c, 0, 1, 2, 3, -1, -1, -1, -1), 0, 1, 2, 3, 8, 9, 10, 11); }
typedef int v4i_t __attribute__((ext_vector_type(4)));
typedef int v8i_t __attribute__((ext_vector_type(8)));
__device__ __forceinline__ v8i_t cat8(bf16x8 a, bf16x8 b) { return __builtin_shufflevector(__builtin_bit_cast(v4i_t, a), __builtin_bit_cast(v4i_t, b), 0, 1, 2, 3, 4, 5, 6, 7); }
__device__ __forceinline__ unsigned cvt_pk_bf16(float lo, float hi) { unsigned r; asm volatile("v_cvt_pk_bf16_f32 %0, %1, %2" : "=v"(r) : "v"(lo), "v"(hi)); return r; }

constexpr int GA_MAX_UNITS = 36, GA_TAB_OFF = STAGE_BYTES + 1024;
template <class Epi, class Sched, bool ALIGN_EPI = false, bool SP2 = false, bool GATHER_A = false, bool FP8 = false>
__device__ __forceinline__ void gemm_phase(PG8_LAS unsigned char* lds, const Gemm g, const Sched& S, const Epi& E, const int wave_id) {
    const int tid_ = lane_id_fresh() | (wave_id << 6);
    const int tid = tid_, wid = __builtin_amdgcn_readfirstlane(tid >> 6), lane = tid & 63, wr = wid >> 2, wc = wid & 3, fr = lane & 15, fq = lane >> 4;
    const char* gA = (const char*)g.A; const char* gB = (const char*)g.Bt; asm volatile("" : "+s"(gA), "+s"(gB));
    int K_ = g.K; asm volatile("" : "+s"(K_));
    const int nt = K_ / BK, lda = g.lda, ldb = g.ldb;
    unsigned voffA[2], voffB[2];
    int gaR[2], gaC[2];
#pragma unroll
    for (int i = 0; i < 2; ++i) { int R, C; stage_rc(tid * 16 + i * 8192, R, C); const int Rb = Epi::PERM ? ((R & ~31) + perm32(R & 31)) : R; gaR[i] = R; gaC[i] = C * 2;
        voffA[i] = (unsigned)(R * lda + C) * 2u; voffB[i] = (unsigned)(Rb * ldb + C) * 2u; }
    const size_t kstep = (size_t)(BK * 2);
    const size_t kstepA = g.a_kstep ? (size_t)g.a_kstep : kstep;
    const size_t hstepA = (size_t)HALF * lda * 2, hstepB = (size_t)HALF * ldb * 2;
    const unsigned ldsw = (unsigned)wid * 1024u;
    const int aoff = lds_byte(wr * 64 + fr, fq * 8), boff = lds_byte(wc * 32 + fr, fq * 8);
#define PG8_SA(b, h) (((b) * 2 + (h)) * HTB)
#define PG8_SB(b, h) ((4 + (b) * 2 + (h)) * HTB)
#define PG8_STAGE(bufoff, gbase, voff) do { _Pragma("unroll") for (int _i = 0; _i < 2; ++_i) \
        __builtin_amdgcn_global_load_lds((const unsigned*)((const char*)(gbase) + (voff)[_i]), (PG8_LAS unsigned*)(lds + (bufoff) + ldsw + _i * 8192), 16, 0, 0); } while (0)
#define PG8_STAGE_G(bufoff, h, kofs, sel) do { _Pragma("unroll") for (int _i = 0; _i < 2; ++_i) { const unsigned vo_ = (sel) ? nvA[h][_i] : cvA[h][_i]; \
        __builtin_amdgcn_global_load_lds((const unsigned*)(gA + (kofs) + vo_), (PG8_LAS unsigned*)(lds + (bufoff) + ldsw + _i * 8192), 16, 0, 0); } } while (0)
#define PG8_STAGE_A(bufoff, ptr, h, kofs, sel) do { if constexpr (GATHER_A) PG8_STAGE_G(bufoff, h, kofs, sel); else PG8_STAGE(bufoff, ptr, voffA); } while (0)
#define PG8_GA_VOFF(dst, ui_) do { _Pragma("unroll") for (int h_ = 0; h_ < 2; ++h_) _Pragma("unroll") for (int i_ = 0; i_ < 2; ++i_) \
        dst[h_][i_] = (unsigned)tabL[(ui_) * 256 + h_ * 128 + gaR[i_]] * (unsigned)(lda * 2) + (unsigned)gaC[i_]; } while (0)
#define PG8_LDA(dst, b, h) do { _Pragma("unroll") for (int m = 0; m < 4; ++m) _Pragma("unroll") for (int k = 0; k < 2; ++k) dst[m][k] = *(const PG8_LAS bf16x8*)(lds + PG8_SA(b, h) + aoff + m * 2048 + k * 1024); } while (0)
#define PG8_LDA_HI(dst, b, h) do { _Pragma("unroll") for (int m = 0; m < 2; ++m) _Pragma("unroll") for (int k = 0; k < 2; ++k) dst[m][k] = *(const PG8_LAS bf16x8*)(lds + PG8_SA(b, h) + aoff + (m + 2) * 2048 + k * 1024); } while (0)
#define PG8_MFMA8(accv, a8, b8) asm volatile("v_mfma_f32_16x16x128_f8f6f4 %0, %1, %2, %0" : "+v"(accv) : "v"(a8), "v"(b8))
#define PG8_MMA8(ai, bj, At, Bt, mh) do { _Pragma("unroll") for (int m = 0; m < 2; ++m) _Pragma("unroll") for (int n = 0; n < 2; ++n) { \
        const v8i_t a8_ = cat8(Bt[n][0], Bt[n][1]), b8_ = cat8(At[m][0], At[m][1]); PG8_MFMA8(acc[ai][bj][(mh) * 2 + m][n], a8_, b8_); } } while (0)
#define PG8_MMA_PAIR(ai, b, h) do { PG8_MMA(ai, 0, At, B0); PG8_MMA(ai, 1, At, B1); } while (0)
#define PG8_LDB(dst, b, h) do { _Pragma("unroll") for (int n = 0; n < 2; ++n) _Pragma("unroll") for (int k = 0; k < 2; ++k) dst[n][k] = *(const PG8_LAS bf16x8*)(lds + PG8_SB(b, h) + boff + n * 2048 + k * 1024); } while (0)
#define PG8_MMA(ai, bj, At, Bt) do { __builtin_amdgcn_s_setprio(1); if constexpr (FP8) { _Pragma("unroll") for (int m = 0; m < 4; ++m) _Pragma("unroll") for (int n = 0; n < 2; ++n) { \
        const v8i_t a8_ = cat8(Bt[n][0], Bt[n][1]), b8_ = cat8(At[m][0], At[m][1]); PG8_MFMA8(acc[ai][bj][m][n], a8_, b8_); } } \
        else { _Pragma("unroll") for (int m = 0; m < 4; ++m) _Pragma("unroll") for (int n = 0; n < 2; ++n) _Pragma("unroll") for (int k = 0; k < 2; ++k) \
        acc[ai][bj][m][n] = __builtin_amdgcn_mfma_f32_16x16x32_bf16(Bt[n][k], At[m][k], acc[ai][bj][m][n], 0, 0, 0); } __builtin_amdgcn_s_setprio(0); } while (0)
#define PG8_WAIT_V(n) asm volatile("s_waitcnt vmcnt(" #n ")" ::: "memory")
#define PG8_WAIT_L(n) asm volatile("s_waitcnt lgkmcnt(" #n ")" ::: "memory")
#define PG8_BAR __builtin_amdgcn_s_barrier()
#define PG8_SCHED __builtin_amdgcn_sched_barrier(0)
    Unit cur, nxt; int ui = 0;
    if (!S.next(0, cur)) return;
    f32x4 acc[2][2][4][2];
#pragma unroll
    for (int a = 0; a < 2; ++a)
#pragma unroll
        for (int b = 0; b < 2; ++b)
#pragma unroll
            for (int m = 0; m < 4; ++m)
                { _Pragma("unroll") for (int n = 0; n < 2; ++n) acc[a][b][m][n] = (f32x4){0.f, 0.f, 0.f, 0.f}; }
    bf16x8 At[4][2], B0[2][2], B1[2][2];
    static_assert(!GATHER_A || SP2, "GATHER_A is written for the SP2 loop");
    const PG8_LAS unsigned short* tabL = (const PG8_LAS unsigned short*)(lds + GA_TAB_OFF);
    unsigned cvA[2][2] = {{0u, 0u}, {0u, 0u}}, nvA[2][2] = {{0u, 0u}, {0u, 0u}};
    if constexpr (GATHER_A) {
        Unit uu;
        for (int q = 0; q < GA_MAX_UNITS && S.next(q, uu); ++q) if (tid < 256) { const int v = g.a_rows[uu.arow + tid]; ((PG8_LAS unsigned short*)(lds + GA_TAB_OFF))[q * 256 + tid] = (unsigned short)(v < 0 ? 0 : (v >> 1)); }
        asm volatile("s_waitcnt vmcnt(0) lgkmcnt(0)" ::: "memory"); PG8_BAR; asm volatile("" ::: "memory");
        PG8_GA_VOFF(cvA, 0);
    }
    const char* cA = gA + (g.a_tstride ? (size_t)(cur.arow >> 8) * (size_t)g.a_tstride : (size_t)cur.arow * lda * 2); const char* cB = gB + (size_t)cur.brow * ldb * 2;
    if constexpr (SP2) {
        PG8_STAGE(PG8_SB(0, 0), cB, voffB); PG8_STAGE(PG8_SB(0, 1), cB + hstepB, voffB); PG8_STAGE_A(PG8_SA(0, 0), cA, 0, (size_t)0, false); PG8_STAGE_A(PG8_SA(0, 1), cA + hstepA, 1, (size_t)0, false);
        if (wr == 1) PG8_BAR;
        PG8_WAIT_V(2); PG8_BAR;
        PG8_STAGE(PG8_SB(1, 0), cB + kstep, voffB); PG8_STAGE_A(PG8_SA(1, 0), cA + kstepA, 0, kstep, false); PG8_STAGE(PG8_SB(1, 1), cB + hstepB + kstep, voffB);
        PG8_WAIT_V(6); PG8_BAR;
    } else {
        PG8_STAGE(PG8_SB(0, 0), cB, voffB); PG8_STAGE(PG8_SA(0, 0), cA, voffA); PG8_STAGE(PG8_SB(0, 1), cB + hstepB, voffB); PG8_STAGE(PG8_SA(0, 1), cA + hstepA, voffA);
        if (wr == 1) PG8_BAR;
        PG8_WAIT_V(4); PG8_BAR;
        PG8_STAGE(PG8_SB(1, 0), cB + kstep, voffB); PG8_STAGE(PG8_SA(1, 0), cA + kstep, voffA); PG8_STAGE(PG8_SB(1, 1), cB + hstepB + kstep, voffB);
        PG8_WAIT_V(6); PG8_BAR;
    }
    for (;;) {
        const bool has_next = S.next(ui + 1, nxt);
        const char* nA = has_next ? gA + (g.a_tstride ? (size_t)(nxt.arow >> 8) * (size_t)g.a_tstride : (size_t)nxt.arow * lda * 2) : cA; const char* nB = has_next ? gB + (size_t)nxt.brow * ldb * 2 : cB;
        if constexpr (GATHER_A) { if (has_next) PG8_GA_VOFF(nvA, ui + 1); else { nvA[0][0] = cvA[0][0]; nvA[0][1] = cvA[0][1]; nvA[1][0] = cvA[1][0]; nvA[1][1] = cvA[1][1]; } }
        for (int t = 0; t < nt; t += 2) {
            if constexpr (Epi::HOOKS) { if (t == Epi::H1 || t == Epi::H2) E.mid(acc, cur, t, wr, wc, fr, fq); }
            const bool last = (t == nt - 2);
            const char* a1 = cA + (size_t)(t + 1) * kstepA;
            const char* a2 = last ? nA : cA + (size_t)(t + 2) * kstepA; const char* b2 = last ? nB : cB + (size_t)(t + 2) * kstep;
            const char* a3 = a2 + kstepA; const char* b3 = b2 + kstep;
            const size_t k1 = (size_t)(t + 1) * kstep, k2 = last ? (size_t)0 : (size_t)(t + 2) * kstep;
            if constexpr (SP2) {
            PG8_LDB(B0, 0, 0); PG8_LDB(B1, 0, 1); PG8_SCHED; PG8_LDA(At, 0, 0); PG8_STAGE_A(PG8_SA(1, 1), a1 + hstepA, 1, k1, false);
            PG8_WAIT_V(8); PG8_WAIT_L(0); PG8_BAR; PG8_MMA_PAIR(0, 0, 0); PG8_BAR; PG8_SCHED;
            PG8_LDA(At, 0, 1); PG8_STAGE(PG8_SB(0, 0), b2, voffB); PG8_STAGE(PG8_SB(0, 1), b2 + hstepB, voffB); PG8_STAGE_A(PG8_SA(0, 0), a2, 0, k2, last);
            PG8_WAIT_V(8); PG8_WAIT_L(0); PG8_BAR; PG8_MMA_PAIR(1, 0, 1); PG8_BAR; PG8_SCHED;
            PG8_LDB(B0, 1, 0); PG8_LDB(B1, 1, 1); PG8_SCHED; PG8_LDA(At, 1, 0); PG8_STAGE_A(PG8_SA(0, 1), a2 + hstepA, 1, k2, last);
            PG8_WAIT_V(8); PG8_WAIT_L(0); PG8_BAR; PG8_MMA_PAIR(0, 1, 0); PG8_BAR; PG8_SCHED;
            PG8_LDA(At, 1, 1); PG8_STAGE(PG8_SB(1, 0), b3, voffB); PG8_STAGE(PG8_SB(1, 1), b3 + hstepB, voffB); PG8_STAGE_A(PG8_SA(1, 0), a3, 0, k2 + kstep, last);
            PG8_WAIT_V(8); PG8_WAIT_L(0); PG8_BAR; PG8_MMA_PAIR(1, 1, 1); PG8_BAR; PG8_SCHED;
            } else {
            PG8_LDB(B0, 0, 0); PG8_SCHED; PG8_LDA(At, 0, 0); PG8_STAGE(PG8_SA(1, 1), a1 + hstepA, voffA);
            PG8_WAIT_L(8); PG8_BAR; PG8_WAIT_L(0); PG8_MMA(0, 0, At, B0); PG8_BAR; PG8_SCHED;
            PG8_LDB(B1, 0, 1); PG8_STAGE(PG8_SB(0, 0), b2, voffB);
            PG8_BAR; PG8_WAIT_L(0); PG8_MMA(0, 1, At, B1); PG8_BAR;
            PG8_LDA(At, 0, 1); PG8_STAGE(PG8_SA(0, 0), a2, voffA);
            PG8_BAR; PG8_WAIT_L(0); PG8_MMA(1, 0, At, B0); PG8_BAR; PG8_SCHED;
            PG8_STAGE(PG8_SB(0, 1), b2 + hstepB, voffB);
            PG8_WAIT_V(6); PG8_BAR; PG8_MMA(1, 1, At, B1); PG8_BAR;
            PG8_LDB(B0, 1, 0); PG8_SCHED; PG8_LDA(At, 1, 0); PG8_STAGE(PG8_SA(0, 1), a2 + hstepA, voffA);
            PG8_WAIT_L(8); PG8_BAR; PG8_WAIT_L(0); PG8_MMA(0, 0, At, B0); PG8_BAR; PG8_SCHED;
            PG8_LDB(B1, 1, 1); PG8_STAGE(PG8_SB(1, 0), b3, voffB);
            PG8_BAR; PG8_WAIT_L(0); PG8_MMA(0, 1, At, B1); PG8_BAR;
            PG8_LDA(At, 1, 1); PG8_STAGE(PG8_SA(1, 0), a3, voffA);
            PG8_BAR; PG8_WAIT_L(0); PG8_MMA(1, 0, At, B0); PG8_BAR; PG8_SCHED;
            PG8_STAGE(PG8_SB(1, 1), b3 + hstepB, voffB);
            PG8_WAIT_V(6); PG8_BAR; PG8_MMA(1, 1, At, B1); PG8_BAR;
            }
        }
        if constexpr (ALIGN_EPI) { if (wr == 0) PG8_BAR; }
        if constexpr (FP8) asm volatile("s_nop 15\n\ts_nop 15" ::: "memory");
        if constexpr (!Epi::AFTER_DRAIN) { E(acc, cur, wr, wc, fr, fq);
#ifdef PROBE_EPI2
            if constexpr (!Epi::RMW) { asm volatile("" ::: "memory"); E(acc, cur, wr, wc, fr, fq); }
#endif
        }
        if (!has_next) break;
#pragma unroll
        for (int a = 0; a < 2; ++a)
#pragma unroll
            for (int b = 0; b < 2; ++b)
#pragma unroll
                for (int m = 0; m < 4; ++m)
                    { _Pragma("unroll") for (int n = 0; n < 2; ++n) acc[a][b][m][n] = (f32x4){0.f, 0.f, 0.f, 0.f}; }
        cur = nxt; cA = nA; cB = nB; ++ui;
        if constexpr (GATHER_A) { cvA[0][0] = nvA[0][0]; cvA[0][1] = nvA[0][1]; cvA[1][0] = nvA[1][0]; cvA[1][1] = nvA[1][1]; }
        if constexpr (ALIGN_EPI) { if (wr == 1) PG8_BAR; }
    }
    PG8_WAIT_V(0);
    if constexpr (!ALIGN_EPI) { if (wr == 0) PG8_BAR; }
    PG8_BAR;
    if constexpr (Epi::AFTER_DRAIN) E.fused(acc, cur, wr, wc, fr, fq, lds, tid);
#undef PG8_SA
#undef PG8_SB
#undef PG8_STAGE
#undef PG8_STAGE_G
#undef PG8_STAGE_A
#undef PG8_GA_VOFF
#undef PG8_LDA
#undef PG8_LDB
#undef PG8_MMA
#undef PG8_WAIT_V
#undef PG8_WAIT_L
#undef PG8_BAR
#undef PG8_SCHED
}
}
constexpr int NWAVES = 8;
constexpr int BATCH = 16, SEQ = 4096, D = 1024, DEPTH = 4, M = BATCH * SEQ;
constexpr int NH = 8, HD = 64, ATT_W = 512, SSM_W = 256, SSM_G = 16, SSM_P = 64, SSM_H = 16, CONV_W = 256, CONV_K = 31;
constexpr int N_IN = 5384, N_INP = 5632, D_FF = 2816, NE = 8, D_FFE = 3584;
constexpr float EPS = 1e-6f;
constexpr float LOG2E = 1.4426950408889634f;
constexpr float QSCALE = 0.125f * LOG2E;
constexpr int MOE_ROWS_CAP = 133120;
constexpr int MOE_NCHUNK = 2, MOE_CHUNK_TILES_CAP = 264;

constexpr size_t MiB = 1u << 20;
constexpr size_t WS_CTL = 0, CTL_ZERO_BYTES = 1 * MiB;
constexpr size_t WS_BPERM = 1 * MiB;
constexpr size_t WS_TOKE = 2 * MiB;
constexpr size_t WS_TOKW = 3 * MiB;
constexpr size_t WS_CNTW = 4 * MiB;
constexpr size_t WS_META = 4 * MiB + 512 * 1024;
constexpr size_t WS_RDEST = 5 * MiB;
constexpr size_t WS_RW = 6 * MiB;
constexpr size_t WS_RRSTD = 7 * MiB;
constexpr size_t WS_WMIX = 16 * MiB, WMIX_STRIDE = 16 * MiB;
constexpr size_t WM_IN = 0, WM_GLU = 11 * MiB, WM_A = WM_GLU + 256 * 1024, WM_S = WM_A + 1 * MiB, WM_C = WM_S + 512 * 1024, WM_O = WM_C + 512 * 1024;
constexpr size_t WS_WDENSE = 80 * MiB, WDENSE_STRIDE = 16 * MiB + 512 * 1024;
constexpr size_t WD_GU = 0, WD_D = 11 * MiB;
constexpr size_t WS_WMOE = 113 * MiB;
constexpr size_t WMOE_GU = 0, WMOE_D = 112 * MiB;
constexpr size_t WS_XB = 281 * MiB;
constexpr size_t WS_SSQ = 409 * MiB;
constexpr size_t WS_LOGF = 413 * MiB;
constexpr size_t WS_FH = 415 * MiB;
constexpr size_t WS_BIG = 417 * MiB;
constexpr size_t WS_GATES = WS_BIG;
constexpr size_t WS_YG = WS_BIG + 384 * MiB;
constexpr size_t WS_BCAT = WS_YG + 32 * MiB;
constexpr size_t WS_CONVO = WS_BCAT + 96 * MiB;
constexpr size_t WS_HID = WS_BIG;
constexpr size_t WS_XG = WS_BIG;
constexpr size_t WS_XB8 = WS_BIG + 480 * MiB;
constexpr size_t WS_MHID = WS_BIG, MHID_BYTES = 232 * MiB;
constexpr size_t WS_UA = WS_BCAT + 128 * MiB;
constexpr size_t WS_MV = WS_UA + 36 * MiB;
constexpr size_t WS_WG = WS_MV + 36 * MiB;
constexpr size_t WS_APOW = 8 * MiB;
constexpr size_t WS_BBAR = 11 * MiB;
constexpr size_t WS_KTAB = 12 * MiB;
constexpr size_t WS_END = WS_WG + 8 * MiB;
static_assert(WS_MHID + 2 * MHID_BYTES <= WS_XB8, "ws map"); static_assert((size_t)MOE_CHUNK_TILES_CAP * 256 * 3584 <= MHID_BYTES, "ws map");
static_assert(WS_HID + 352 * MiB <= WS_END, "ws map");
constexpr size_t DO_Q = 0, DO_K = 64 * MiB, DO_V = 128 * MiB, DO_U = 192 * MiB, DO_HC = 224 * MiB, DO_MERGED = 64 * MiB;

constexpr int CW_TMO = 0, CW_CODE = 1;
constexpr int CW_BAR = 4096;

constexpr int RING_OFF = 0, RING_BYTES = 131072;
constexpr int LDSCTL_OFF = RING_BYTES, MISC_OFF = LDSCTL_OFF + 320;
constexpr int LDS_BYTES = 150528;
static_assert(pg8::GA_TAB_OFF + pg8::GA_MAX_UNITS * 512 <= LDS_BYTES, "LDS map");

#define GAS __attribute__((address_space(1)))
#define LAS __attribute__((address_space(3)))
typedef unsigned short bf16;
typedef unsigned v4u __attribute__((ext_vector_type(4)));
typedef unsigned v2u __attribute__((ext_vector_type(2)));
typedef float f32x4 __attribute__((ext_vector_type(4)));
typedef float f32x2 __attribute__((ext_vector_type(2)));
typedef GAS unsigned gu32;
#define RLX_AGENT __ATOMIC_RELAXED, __HIP_MEMORY_SCOPE_AGENT
#define LDS_WAIT() asm volatile("s_waitcnt lgkmcnt(0)" ::: "memory")
#define VM_WAIT() asm volatile("s_waitcnt vmcnt(0)" ::: "memory")
__device__ __forceinline__ unsigned f2bf(float f) { unsigned u = __builtin_bit_cast(unsigned, f); return (u + 0x7fffu + ((u >> 16) & 1u)) >> 16; }
__device__ __forceinline__ unsigned pk2(float lo, float hi) { return pg8::cvt_pk_bf16(lo, hi); }
__device__ __forceinline__ float bflo(unsigned u) { return __builtin_bit_cast(float, u << 16); }
__device__ __forceinline__ float bfhi(unsigned u) { return __builtin_bit_cast(float, u & 0xffff0000u); }
__device__ __forceinline__ float bf1(bf16 h) { return __builtin_bit_cast(float, (unsigned)h << 16); }
__device__ __forceinline__ float sigmoidf_(float x) { return __builtin_amdgcn_rcpf(1.0f + __builtin_amdgcn_exp2f(-1.4426950408889634f * x)); }
__device__ __forceinline__ float wave_sum(float v) {
#pragma unroll
    for (int o = 1; o < 64; o <<= 1) v += __shfl_xor(v, o);
    return v;
}

#define XB_TMO      128
#define XB_XCNT(j)  (256  + 64 * (j))
#define XB_XSUB(j)  (1280 + 64 * (j))
#define XB_XGEN(j)  (2304 + 64 * (j))
#define XB_TOP      3328
#define XB_TOPGEN   3392
#define XCD_BAR_WORDS 3456
#define XB_SPIN_CAP (1u << 18)

__device__ __forceinline__ unsigned xb_ld(unsigned* p)              { return __hip_atomic_load(p, __ATOMIC_RELAXED, __HIP_MEMORY_SCOPE_AGENT); }
__device__ __forceinline__ unsigned xb_add(unsigned* p, unsigned v) { return __hip_atomic_fetch_add(p, v, __ATOMIC_RELAXED, __HIP_MEMORY_SCOPE_AGENT); }
__device__ __forceinline__ unsigned xb_xcc_id() { return (unsigned)__builtin_amdgcn_s_getreg((3 << 11) | 20) & 0xFu; }
#define XB_SPIN(cond, bar) do { unsigned _sp = 0; while (cond) { __builtin_amdgcn_s_sleep(1); \
    if ((++_sp & 255u) == 0u) { if (xb_ld(&(bar)[XB_TMO])) break; if (_sp > XB_SPIN_CAP) { atomicAdd(&(bar)[XB_TMO], 1u); break; } } } } while (0)

struct XcdBarrier {
    unsigned* bar; unsigned x;
    volatile LAS unsigned* st;
};
__device__ __forceinline__ bool xb_thread0(int wave_id) { return wave_id == 0 && lane_id_fresh() == 0; }
__device__ __forceinline__ XcdBarrier xcd_barrier_post(unsigned* bar, volatile LAS unsigned* st, int wave_id) {
    XcdBarrier b; b.bar = bar; b.x = xb_xcc_id(); b.st = st;
    if (xb_thread0(wave_id)) (void)xb_add(&bar[XB_XCNT(b.x)], 1u);
    return b;
}
__device__ __forceinline__ void xcd_barrier_complete(unsigned* bar, unsigned x, unsigned& nloc, unsigned& nx) {
    const unsigned G = gridDim.x * gridDim.y * gridDim.z;
    unsigned sum, cnt, mine, sp = 0u;
    for (;;) {
        sum = 0u; cnt = 0u; mine = 0u;
#pragma unroll
        for (unsigned j = 0; j < 16; ++j) { const unsigned c = xb_ld(&bar[XB_XCNT(j)]); sum += c; cnt += (c > 0u) ? 1u : 0u; mine = (j == x) ? c : mine; }
        if (sum == G) break;
        __builtin_amdgcn_s_sleep(1);
        if ((++sp & 255u) == 0u) { if (xb_ld(&bar[XB_TMO])) break; if (sp > XB_SPIN_CAP) { atomicAdd(&bar[XB_TMO], 1u); break; } }
    }
    nloc = mine > 0u ? mine : 1u; nx = cnt > 0u ? cnt : 1u;
}
__device__ __forceinline__ void xcd_barrier(const XcdBarrier& b, int wave_id) {
    asm volatile("s_waitcnt vmcnt(0)" ::: "memory");
    __syncthreads();
    if (xb_thread0(wave_id)) {
        unsigned* bar = b.bar;
        __builtin_amdgcn_s_waitcnt(0);
        unsigned nloc = b.st[0], nx = b.st[1];
        if (nloc == 0u) { xcd_barrier_complete(bar, b.x, nloc, nx); b.st[0] = nloc; b.st[1] = nx; }
        const unsigned old = xb_add(&bar[XB_XSUB(b.x)], 1u);
        const unsigned gen = old / nloc;
        if (old + 1u == (gen + 1u) * nloc) {
            __builtin_amdgcn_fence(__ATOMIC_RELEASE, "agent");
            asm volatile("s_waitcnt vmcnt(0)" ::: "memory");
            const unsigned og = xb_add(&bar[XB_TOP], 1u);
            const unsigned tg = og / nx;
            if (og + 1u == (tg + 1u) * nx) xb_add(&bar[XB_TOPGEN], 1u);
            else XB_SPIN(xb_ld(&bar[XB_TOPGEN]) == tg, bar);
            __builtin_amdgcn_fence(__ATOMIC_ACQUIRE, "agent");
            xb_add(&bar[XB_XGEN(b.x)], 1u);
            asm volatile("s_waitcnt vmcnt(0)" ::: "memory");
        } else {
            XB_SPIN(xb_ld(&bar[XB_XGEN(b.x)]) == gen, bar);
            __builtin_amdgcn_fence(__ATOMIC_ACQUIRE, "agent");
            asm volatile("s_waitcnt vmcnt(0)" ::: "memory");
        }
    }
    __syncthreads();
}


namespace attn_body {
using bf16=__hip_bfloat16;
using bf16x8=__attribute__((ext_vector_type(8)))short;
using s16x4=__attribute__((ext_vector_type(4)))short;
using f32x16=__attribute__((ext_vector_type(16)))float;
using u32x4=__attribute__((ext_vector_type(4)))unsigned;
using f32x4_t=__attribute__((ext_vector_type(4)))float;
constexpr int BATCH=16,NHEAD=8,SEQ=4096,D=64,DM=NHEAD*D;
constexpr int NW=8,QBLK=32,QB=QBLK*NW,KVBLK=64,NQB=SEQ/QB;
constexpr int ATTN_PITCH=DM, ATTN_UNIT_ROWS=QB, OPITCH=1024;
__device__ __forceinline__ int crow(int r,int hi){return (r&3)+8*(r>>2)+4*hi;}
#define SBAR() __builtin_amdgcn_sched_barrier(0)
__device__ __forceinline__ void cmask(f32x16&p0,f32x16&p1,int jb,int qrel,int hi){
  const float NEG=-INFINITY; int kb=64*jb+4*hi;
  #pragma unroll
  for(int r=0;r<16;++r){int kv=kb+(r&3)+8*(r>>2); if(kv>qrel)p0[r]=NEG; if(kv+32>qrel)p1[r]=NEG;}
}

constexpr int NSLOT=3, SLOTB=8192;
constexpr int LDS_K=0, LDS_V=NSLOT*SLOTB, LDS_WS=2*NSLOT*SLOTB, LDS_OST=LDS_WS+NW*64*4, LDS_KB=LDS_OST+NW*4096, LDS_BYTES=LDS_KB+SEQ*4;
constexpr float C2=0.125f*1.4426950408889634f;
__device__ __forceinline__ void glds16(const void*gsrc,unsigned lds_dst){unsigned keep;
  asm volatile("s_mov_b32 %0, m0\n\ts_mov_b32 m0, %2\n\ts_nop 0\n\tglobal_load_lds_dwordx4 %1, off\n\ts_mov_b32 m0, %0":"=&s"(keep):"v"(gsrc),"s"(lds_dst):"memory");}
__device__ __forceinline__ float max3f(float a,float b,float c){float r;asm("v_max3_f32 %0, %1, %2, %3":"=v"(r):"v"(a),"v"(b),"v"(c));return r;}
__device__ __forceinline__ float max2f(float a,float b){float r;asm("v_max_f32_e32 %0, %1, %2":"=v"(r):"v"(a),"v"(b));return r;}
__device__ __forceinline__ float fadd_s(float a,float b){float r;asm("v_add_f32_e32 %0, %1, %2":"=v"(r):"v"(a),"v"(b));return r;}
__device__ __forceinline__ float fsub_s(float a,float b){float r;asm("v_sub_f32_e32 %0, %1, %2":"=v"(r):"v"(a),"v"(b));return r;}
typedef float f32x2_t __attribute__((ext_vector_type(2))); typedef __bf16 bf16x2_t __attribute__((ext_vector_type(2)));
__device__ __forceinline__ unsigned cvtpk_s(float lo,float hi){f32x2_t v={lo,hi};bf16x2_t b=__builtin_convertvector(v,bf16x2_t);return __builtin_bit_cast(unsigned,b);}
#define WAIT_BAR(N) asm volatile("s_waitcnt vmcnt(" #N ") lgkmcnt(0)\n\ts_barrier":::"memory")

__device__ __forceinline__ void qkt(f32x16&p0,f32x16&p1,const char*Kslot,const bf16x8*qr,const f32x16&negm,int r32,int hi){
  const char*kb=Kslot+hi*1024+r32*16;
  #pragma unroll
  for(int d0=0;d0<4;++d0){
    const bf16x8 b0=*reinterpret_cast<const bf16x8*>(kb+d0*2048);
    const bf16x8 b1=*reinterpret_cast<const bf16x8*>(kb+d0*2048+512);
    if(d0==0){p0=__builtin_amdgcn_mfma_f32_32x32x16_bf16(b0,qr[0],negm,0,0,0);p1=__builtin_amdgcn_mfma_f32_32x32x16_bf16(b1,qr[0],negm,0,0,0);}
    else{p0=__builtin_amdgcn_mfma_f32_32x32x16_bf16(b0,qr[d0],p0,0,0,0);p1=__builtin_amdgcn_mfma_f32_32x32x16_bf16(b1,qr[d0],p1,0,0,0);}}
}
typedef __attribute__((address_space(3))) const char* lds_cptr;
typedef short v4i16_t __attribute__((ext_vector_type(4)));
__device__ __forceinline__ void kload8(bf16x8*kf,lds_cptr kp){
  kf[0]=*(const __attribute__((address_space(3))) bf16x8*)(kp);      kf[1]=*(const __attribute__((address_space(3))) bf16x8*)(kp+512);
  kf[2]=*(const __attribute__((address_space(3))) bf16x8*)(kp+2048); kf[3]=*(const __attribute__((address_space(3))) bf16x8*)(kp+2560);
  kf[4]=*(const __attribute__((address_space(3))) bf16x8*)(kp+4096); kf[5]=*(const __attribute__((address_space(3))) bf16x8*)(kp+4608);
  kf[6]=*(const __attribute__((address_space(3))) bf16x8*)(kp+6144); kf[7]=*(const __attribute__((address_space(3))) bf16x8*)(kp+6656);
}
__device__ __forceinline__ void kload2(bf16x8*kf,lds_cptr kp,int j){ kf[2*j]=*(const __attribute__((address_space(3))) bf16x8*)(kp+j*2048); kf[2*j+1]=*(const __attribute__((address_space(3))) bf16x8*)(kp+j*2048+512); }
__device__ __forceinline__ s16x4 vtr(lds_cptr p){ return __builtin_bit_cast(s16x4,__builtin_amdgcn_ds_read_tr16_b64_v4i16((__attribute__((address_space(3))) v4i16_t*)p)); }
__device__ __forceinline__ float rowmax(const f32x16&p0,const f32x16&p1){
  float a=max3f(p0[0],p0[1],p1[0]),b=max3f(p0[2],p0[3],p1[1]);a=max3f(a,p1[2],p1[3]);
  #pragma unroll
  for(int r=4;r<16;r+=4){a=max3f(a,p0[r],p0[r+1]);b=max3f(b,p0[r+2],p0[r+3]);a=max3f(a,p1[r],p1[r+1]);b=max3f(b,p1[r+2],p1[r+3]);}
  const float m=max2f(a,b);
  auto rr=__builtin_amdgcn_permlane32_swap(__float_as_uint(m),__float_as_uint(m),false,false);
  return max2f(__uint_as_float(rr[0]),__uint_as_float(rr[1]));
}
__device__ __forceinline__ void pv(f32x16*o,int vb,bf16x8 pa0,bf16x8 pa1,bf16x8 pa2,bf16x8 pa3){
  #pragma unroll
  for(int d0=0;d0<2;++d0){s16x4 lo[4],hi[4];
    #pragma unroll
    for(int ks=0;ks<4;++ks){
      asm volatile("ds_read_b64_tr_b16 %0,%1 offset:%c2":"=&v"(lo[ks]):"v"(vb),"i"(d0*4096+ks*1024):"memory");
      asm volatile("ds_read_b64_tr_b16 %0,%1 offset:%c2":"=&v"(hi[ks]):"v"(vb),"i"(d0*4096+ks*1024+512):"memory");}
    asm volatile("s_waitcnt lgkmcnt(0)":::"memory");SBAR();
    #define PK(k) (bf16x8){lo[k][0],lo[k][1],lo[k][2],lo[k][3],hi[k][0],hi[k][1],hi[k][2],hi[k][3]}
    o[d0]=__builtin_amdgcn_mfma_f32_32x32x16_bf16(pa0,PK(0),o[d0],0,0,0);
    o[d0]=__builtin_amdgcn_mfma_f32_32x32x16_bf16(pa1,PK(1),o[d0],0,0,0);
    o[d0]=__builtin_amdgcn_mfma_f32_32x32x16_bf16(pa2,PK(2),o[d0],0,0,0);
    o[d0]=__builtin_amdgcn_mfma_f32_32x32x16_bf16(pa3,PK(3),o[d0],0,0,0);
    #undef PK
  }
}

#ifndef ATTN_STORE16
#define ATTN_STORE16(p,v) (*(u32x4*)(p)=(v))
#endif
template<int THRL> __device__ __forceinline__ void attn_unit(int b,int h,int qb,const bf16*Q,const bf16*__restrict__ K,const bf16*__restrict__ V,bf16*O,const float*Fh,char*shm,const int wave_id){
  const int tid_=lane_id_fresh()|(wave_id<<6);
  const int tid=tid_,lane=tid&63,r32=lane&31,hi=lane>>5; const int wid=__builtin_amdgcn_readfirstlane(tid>>6);
  const long rowbase=(long)b*SEQ; const int q0=qb*QB;
  const bf16*Qw=Q+(rowbase+q0+wid*QBLK)*DM+h*D;
  const int NT0=(q0+QB)/KVBLK; int ts;
  { float bvl=0.f; if(lane<NT0) bvl=(Fh[q0]-Fh[lane*KVBLK+KVBLK-1])*1.4426950408889634f;
    const unsigned long long alive=__ballot(lane<NT0 && bvl>=-100.f);
    ts=alive?(int)__builtin_ctzll(alive):NT0; ts&=~1; if(ts>NT0-4)ts=NT0-4; ts=__builtin_amdgcn_readfirstlane(ts); }
  const bf16*Kh=K+(rowbase+(long)ts*KVBLK)*DM+h*D,*Vh=V+(rowbase+(long)ts*KVBLK)*DM+h*D;
  const lds_cptr shm3=(lds_cptr)shm;
  const unsigned lds0=(unsigned)(uintptr_t)shm;
  float*wsf=(float*)(shm+LDS_WS)+wid*64;
  const bf16*ksrc=Kh+(long)lane*DM+wid*8;
  const bf16*vsrc=Vh+(long)(16*(wid&3)+(lane>>2))*DM+(wid>>2)*32+(lane&3)*8;
  const unsigned kdst=lds0+LDS_K+wid*1024, vdst=lds0+LDS_V+wid*1024;
  #define DMA_K(t,slot) glds16(ksrc+(long)(t)*KVBLK*DM,(unsigned)__builtin_amdgcn_readfirstlane(kdst+(slot)))
  #define DMA_V(t,slot) glds16(vsrc+(long)(t)*KVBLK*DM,(unsigned)__builtin_amdgcn_readfirstlane(vdst+(slot)))
  const int vb0=(int)(lds0+LDS_V)+((lane>>4)&1)*32+(lane&3)*8+(4*hi+((lane&15)>>2))*64;
  const char*Kbase=shm+LDS_K; bf16x8 kf[8];
  const lds_cptr kp0=shm3+LDS_K+hi*1024+r32*16; const lds_cptr vp0=shm3+LDS_V+((lane>>4)&1)*32+(lane&3)*8+(4*hi+((lane&15)>>2))*64;
  const int NT=NT0-ts;
  DMA_K(0,0);DMA_V(0,0);DMA_K(1,SLOTB);
  bf16x8 qr[4];
  #pragma unroll
  for(int d0=0;d0<4;++d0)qr[d0]=*reinterpret_cast<const bf16x8*>(&Qw[(long)r32*DM+d0*16+hi*8]);
  { const float fref=Fh[q0]; __attribute__((address_space(3))) float* kbt=(__attribute__((address_space(3))) float*)(shm3+LDS_KB);
    float fv[SEQ/(NW*64)];
    #pragma unroll
    for(int i=0;i<SEQ/(NW*64);++i){ const int k=ts*KVBLK+tid+i*NW*64; fv[i]=(k<q0+QB)?Fh[k]:0.f; }
    #pragma unroll
    for(int i=0;i<SEQ/(NW*64);++i){ const int k=ts*KVBLK+tid+i*NW*64; if(k<q0+QB) kbt[k]=(fref-fv[i])*1.4426950408889634f; } }
  const __attribute__((address_space(3))) float* kbp=(const __attribute__((address_space(3))) float*)(shm3+LDS_KB)+ts*KVBLK+4*hi;
  #define BIAS(P0,P1,t) do{ const __attribute__((address_space(3))) float* kp_=kbp+(t)*KVBLK; \
    _Pragma("unroll") for(int j_=0;j_<4;++j_){ const f32x4_t b0_=*(const __attribute__((address_space(3))) f32x4_t*)(kp_+8*j_); const f32x4_t b1_=*(const __attribute__((address_space(3))) f32x4_t*)(kp_+32+8*j_); \
      P0[4*j_]+=b0_[0];P0[4*j_+1]+=b0_[1];P0[4*j_+2]+=b0_[2];P0[4*j_+3]+=b0_[3]; P1[4*j_]+=b1_[0];P1[4*j_+1]+=b1_[1];P1[4*j_+2]+=b1_[2];P1[4*j_+3]+=b1_[3]; } }while(0)
  float mhat=0.f,l_reg=0.f;f32x16 o[2];o[0]=f32x16{};o[1]=f32x16{};f32x16 negm=f32x16{};asm volatile("":"+v"(negm));
  const int qrel=wid*QBLK+r32;
  #define CMASK(P0,P1,t) do{int jb_=(t)-(NT-4); if(jb_>=0)cmask(P0,P1,jb_,qrel,hi);}while(0)
  bool resc=false;
  #define START(P0,P1) do{ const float rm=rowmax(P0,P1); resc=false; \
    { const float dl=max2f(rm,kbq); mhat=fadd_s(mhat,dl); \
      _Pragma("unroll") for(int r=0;r<16;++r){P0[r]=fsub_s(P0[r],dl);P1[r]=fsub_s(P1[r],dl);} \
      _Pragma("unroll") for(int r=0;r<16;++r)negm[r]=-mhat; asm volatile("":"+v"(negm)); } \
    _Pragma("unroll") for(int r=0;r<16;++r)P0[r]=__builtin_amdgcn_exp2f(P0[r]); }while(0)
  #define RESC() do{ if(resc){ asm volatile("s_waitcnt lgkmcnt(0)":::"memory"); \
      _Pragma("unroll") for(int d_=0;d_<2;++d_) _Pragma("unroll") for(int r=0;r<16;++r)o[d_][r]*=wsf[crow(r,hi)]; } }while(0)
  f32x16 pA0,pA1,pB0,pB1;
  int sl_prev=0,sl_cur=0,sl_next=SLOTB;
  #define ROT() do{sl_prev=sl_cur;sl_cur=sl_next;sl_next=(sl_next==(NSLOT-1)*SLOTB)?0:sl_next+SLOTB;}while(0)
  DMA_K(2,2*SLOTB);
  WAIT_BAR(3);
  const float kbq=*((const __attribute__((address_space(3))) float*)(shm3+LDS_KB)+q0+qrel)+4.0f;
  qkt(pA0,pA1,Kbase,qr,negm,r32,hi);asm volatile("s_nop 15\n\ts_nop 7":"+v"(pA0),"+v"(pA1));BIAS(pA0,pA1,0);CMASK(pA0,pA1,0);
  START(pA0,pA1);
  _Pragma("unroll") for(int r=0;r<16;++r)pA1[r]=__builtin_amdgcn_exp2f(pA1[r]);
  WAIT_BAR(0);
  DMA_K(3,0);DMA_V(1,SLOTB);
  ROT();
  kload8(kf,kp0+sl_cur);
  WAIT_BAR(2);
  s16x4 vlo[8],vhi[8]; u32x4 pw0,pw1,pw2,pw3;
  #define PKW(P,B) cvtpk_s(P[B],P[B+1])
  #define PAF(k) __builtin_bit_cast(bf16x8,pw##k)
  #define VFR(i) (bf16x8){vlo[i][0],vlo[i][1],vlo[i][2],vlo[i][3],vhi[i][0],vhi[i][1],vhi[i][2],vhi[i][3]}
  #define PIN(x) asm volatile("":"+v"(x))
  #define MX3(a,b,c) __builtin_fmaxf(__builtin_fmaxf((a),(b)),(c))
  #define GAPA(MF,A0,A1,A2,A3,W0,W1,PW) do{ MF; sacc+=A0; sacc+=A1; sacc+=A2; sacc+=A3; PIN(sacc); W0; W1; PIN(PW); SBAR(); }while(0)
  #define EX(v) __builtin_amdgcn_exp2f(v)
  #define GAPB(MF,X,B) do{ MF; X[B]=EX(X[B]); X[B+1]=EX(X[B+1]); X[B+2]=EX(X[B+2]); X[B+3]=EX(X[B+3]); PIN(X); SBAR(); }while(0)
  #define VRD(i) do{ vlo[i]=vtr(vp_+(((i)>>2)*4096+((i)&3)*1024)); vhi[i]=vtr(vp_+(((i)>>2)*4096+((i)&3)*1024+512)); }while(0)
  #define KRD(G,j) do{ if(G){ kload2(kf,kp0+sl_next,j); SBAR(); } }while(0)
  #define STEP(C0,C1,P0,P1,t,GK,GV,GL) do{ SBAR(); \
    const lds_cptr vp_=vp0+sl_prev; \
    VRD(0); SBAR(); float sacc=(P0[0]+P0[1]); \
    GAPA(C0=__builtin_amdgcn_mfma_f32_32x32x16_bf16(kf[0],qr[0],negm,0,0,0), P0[2],P0[3],P0[4],P0[5],     pw0[0]=PKW(P0,0), pw0[1]=PKW(P0,2), pw0); \
    VRD(4); SBAR(); GAPA(C1=__builtin_amdgcn_mfma_f32_32x32x16_bf16(kf[1],qr[0],negm,0,0,0), P0[6],P0[7],P0[8],P0[9],     pw0[2]=PKW(P0,4), pw0[3]=PKW(P0,6), pw0); \
    VRD(1); SBAR(); GAPA(C0=__builtin_amdgcn_mfma_f32_32x32x16_bf16(kf[2],qr[1],C0,0,0,0),   P0[10],P0[11],P0[12],P0[13], pw1[0]=PKW(P0,8), pw1[1]=PKW(P0,10), pw1); \
    VRD(5); SBAR(); GAPA(C1=__builtin_amdgcn_mfma_f32_32x32x16_bf16(kf[3],qr[1],C1,0,0,0),   P0[14],P0[15],P1[0],P1[1],   pw1[2]=PKW(P0,12),pw1[3]=PKW(P0,14), pw1); \
    VRD(2); SBAR(); GAPA(C0=__builtin_amdgcn_mfma_f32_32x32x16_bf16(kf[4],qr[2],C0,0,0,0),   P1[2],P1[3],P1[4],P1[5],     pw2[0]=PKW(P1,0), pw2[1]=PKW(P1,2), pw2); \
    VRD(6); SBAR(); GAPA(C1=__builtin_amdgcn_mfma_f32_32x32x16_bf16(kf[5],qr[2],C1,0,0,0),   P1[6],P1[7],P1[8],P1[9],     pw2[2]=PKW(P1,4), pw2[3]=PKW(P1,6), pw2); \
    VRD(3); SBAR(); GAPA(C0=__builtin_amdgcn_mfma_f32_32x32x16_bf16(kf[6],qr[3],C0,0,0,0),   P1[10],P1[11],P1[12],P1[13], pw3[0]=PKW(P1,8), pw3[1]=PKW(P1,10), pw3); \
    VRD(7); SBAR(); GAPA(C1=__builtin_amdgcn_mfma_f32_32x32x16_bf16(kf[7],qr[3],C1,0,0,0),   P1[14],P1[15],0.f,0.f,       pw3[2]=PKW(P1,12),pw3[3]=PKW(P1,14), pw3); \
    l_reg+=sacc; \
    if(GK){DMA_K((t)+3,sl_cur);} if(GV){DMA_V((t)+1,sl_next);} \
    BIAS(C0,C1,t); CMASK(C0,C1,t); \
    { float a=MX3(C0[0],C0[1],C1[0]),b=MX3(C0[2],C0[3],C1[1]); a=MX3(a,C1[2],C1[3]); \
      _Pragma("unroll") for(int r=4;r<16;r+=4){a=MX3(a,C0[r],C0[r+1]);b=MX3(b,C0[r+2],C0[r+3]);a=MX3(a,C1[r],C1[r+1]);b=MX3(b,C1[r+2],C1[r+3]);} \
      float rm=__builtin_fmaxf(a,b); { auto rr=__builtin_amdgcn_permlane32_swap(__float_as_uint(rm),__float_as_uint(rm),false,false); rm=__builtin_fmaxf(__uint_as_float(rr[0]),__uint_as_float(rr[1])); } \
      resc=false; \
      if(__builtin_expect(__any(rm>(float)THRL),0)){ const float dl=__builtin_fmaxf(rm,0.f); mhat+=dl; \
        _Pragma("unroll") for(int r=0;r<16;++r){C0[r]-=dl;C1[r]-=dl;} \
        _Pragma("unroll") for(int r=0;r<16;++r)negm[r]=-mhat; asm volatile("":"+v"(negm)); \
        const float f=__builtin_amdgcn_exp2f(-dl); l_reg*=f; if(hi==0)wsf[r32]=f; resc=true; } } \
    SBAR(); \
    GAPB(o[0]=__builtin_amdgcn_mfma_f32_32x32x16_bf16(PAF(0),VFR(0),o[0],0,0,0), C0,0); \
    GAPB(o[1]=__builtin_amdgcn_mfma_f32_32x32x16_bf16(PAF(0),VFR(4),o[1],0,0,0), C0,4); \
    KRD(GL,0); GAPB(o[0]=__builtin_amdgcn_mfma_f32_32x32x16_bf16(PAF(1),VFR(1),o[0],0,0,0), C0,8); \
    KRD(GL,1); GAPB(o[1]=__builtin_amdgcn_mfma_f32_32x32x16_bf16(PAF(1),VFR(5),o[1],0,0,0), C0,12); \
    KRD(GL,2); GAPB(o[0]=__builtin_amdgcn_mfma_f32_32x32x16_bf16(PAF(2),VFR(2),o[0],0,0,0), C1,0); \
    KRD(GL,3); GAPB(o[1]=__builtin_amdgcn_mfma_f32_32x32x16_bf16(PAF(2),VFR(6),o[1],0,0,0), C1,4); \
    GAPB(o[0]=__builtin_amdgcn_mfma_f32_32x32x16_bf16(PAF(3),VFR(3),o[0],0,0,0), C1,8); \
    GAPB(o[1]=__builtin_amdgcn_mfma_f32_32x32x16_bf16(PAF(3),VFR(7),o[1],0,0,0), C1,12); \
    }while(0)
  int t=1;
  #undef CMASK
  #define CMASK(P0,P1,t) do{}while(0)
  for(;t+5<NT;t+=2){
    STEP(pB0,pB1,pA0,pA1,t,true,true,true);     WAIT_BAR(2); RESC(); ROT();
    STEP(pA0,pA1,pB0,pB1,t+1,true,true,true);   WAIT_BAR(2); RESC(); ROT();
  }
  #undef CMASK
  #define CMASK(P0,P1,t) do{int jb_=(t)-(NT-4); if(jb_>=0)cmask(P0,P1,jb_,qrel,hi);}while(0)
  #define ENDW(tt) do{ if((tt)+3<NT){WAIT_BAR(2);} else if((tt)+2<NT){WAIT_BAR(1);} else {WAIT_BAR(0);} }while(0)
  for(;t+1<NT;t+=2){
    STEP(pB0,pB1,pA0,pA1,t,(t+3<NT),(t+1<NT),(t+1<NT));       ENDW(t);   RESC(); ROT();
    STEP(pA0,pA1,pB0,pB1,t+1,(t+4<NT),(t+2<NT),(t+2<NT));     ENDW(t+1); RESC(); ROT();
  }
  STEP(pB0,pB1,pA0,pA1,NT-1,false,false,false); RESC();
  { float sacc=pB0[0]+pB0[1]; _Pragma("unroll") for(int r=2;r<16;++r)sacc+=pB0[r]; _Pragma("unroll") for(int r=0;r<16;++r)sacc+=pB1[r]; l_reg+=sacc;
    pw0=(u32x4){PKW(pB0,0),PKW(pB0,2),PKW(pB0,4),PKW(pB0,6)};pw1=(u32x4){PKW(pB0,8),PKW(pB0,10),PKW(pB0,12),PKW(pB0,14)};pw2=(u32x4){PKW(pB1,0),PKW(pB1,2),PKW(pB1,4),PKW(pB1,6)};pw3=(u32x4){PKW(pB1,8),PKW(pB1,10),PKW(pB1,12),PKW(pB1,14)};
    SBAR(); pv(o,vb0+sl_cur,PAF(0),PAF(1),PAF(2),PAF(3)); }
  #undef PKW
  #undef PAF
  #undef VFR
  #undef PIN
  #undef MX3
  #undef GAPA
  #undef GAPB
  #undef EX
  #undef VRD
  #undef KRD
  #undef STEP
  #undef ENDW
  {auto rr=__builtin_amdgcn_permlane32_swap(__float_as_uint(l_reg),__float_as_uint(l_reg),false,false);l_reg=__uint_as_float(rr[0])+__uint_as_float(rr[1]);}
  if(hi==0)wsf[32+r32]=l_reg;asm volatile("s_waitcnt lgkmcnt(0)":::"memory");
  float rli[16];
  #pragma unroll
  for(int r=0;r<16;++r)rli[r]=__builtin_amdgcn_rcpf(wsf[32+crow(r,hi)]);
  bf16*Ow=O+(rowbase+q0+wid*QBLK)*OPITCH+h*D;
  { bf16*stg=(bf16*)(shm+LDS_OST)+wid*2048;
    #pragma unroll
    for(int r=0;r<16;++r){const int orow=crow(r,hi);
      #pragma unroll
      for(int d0=0;d0<2;++d0)stg[orow*64+d0*32+r32]=__float2bfloat16(o[d0][r]*rli[r]);}
    asm volatile("s_waitcnt lgkmcnt(0)":::"memory");
    #pragma unroll
    for(int i=0;i<4;++i){const int row=i*8+(lane>>3),ch=lane&7; const u32x4 v=*(const u32x4*)(stg+row*64+ch*8); ATTN_STORE16(Ow+(long)row*OPITCH+ch*8,v);} }
  asm volatile("s_waitcnt lgkmcnt(0)\n\ts_barrier":::"memory");
  #undef BIAS
  #undef DMA_K
  #undef DMA_V
  #undef CMASK
  #undef START
  #undef RESC
  #undef ROT
}
constexpr int ATTN_LDS_BYTES=LDS_BYTES;
struct AttnTensors { const bf16* Q; const bf16* K; const bf16* V; bf16* O; const float* Fh; };
struct AttnUnit { int bh; int qb; };
struct StaticOrder {
  int vcu,G;
  __device__ __forceinline__ explicit StaticOrder(int grid,int block):vcu((grid%8==0)?(block%8)*(grid/8)+block/8:block),G(grid){}
  __device__ __forceinline__ bool next(int i,AttnUnit&u)const{ const int L=(i>>3)*G+vcu; if(L>=BATCH*16)return false; const int hh=i&7,r=L&15,rot=(r+4*(hh>>1))&15; u.bh=(L>>4)*NHEAD+hh; u.qb=(hh&1)?15-rot:rot; return true; }
  __device__ __forceinline__ void a_ready(const AttnUnit&)const{}
  __device__ __forceinline__ void done(const AttnUnit&)const{}
};
template<class Sched,int THRL=8> __device__ __forceinline__ void attn_phase(char*lds,const AttnTensors&T,const Sched&S,const int wave_id){
  AttnUnit u;
  for(int i=0;S.next(i,u);++i){ S.a_ready(u); attn_unit<THRL>(u.bh/NHEAD,u.bh%NHEAD,u.qb,T.Q,T.K,T.V,T.O,T.Fh+(size_t)u.bh*SEQ,lds,wave_id); S.done(u); }
}
#undef SBAR
#undef WAIT_BAR
}
typedef pg8::f32x4 A4;
typedef A4 AccT[2][2][4][2];

__device__ __forceinline__ float row_rstd(const float* ssq, int row) {
    const f32x4* p = (const f32x4*)(ssq + (size_t)row * 16);
    const f32x4 a = p[0], b = p[1], c = p[2], d = p[3];
    const float s = (((a.x + a.y) + (a.z + a.w)) + ((b.x + b.y) + (b.z + b.w))) + (((c.x + c.y) + (c.z + c.w)) + ((d.x + d.y) + (d.z + d.w)));
    return rsqrtf(s * (1.0f / 1024.0f) + EPS);
}
__device__ __forceinline__ float row_rstd4(const float* ssq, int row, int fq) {
    const f32x4 a = ((const f32x4*)(ssq + (size_t)row * 16))[fq];
    float s = (a.x + a.y) + (a.z + a.w); s += __shfl_xor(s, 16); s += __shfl_xor(s, 32);
    return rsqrtf(s * (1.0f / 1024.0f) + EPS);
}
__device__ __forceinline__ v4u pack8(const A4& v0, const A4& v1) { v4u w; w.x = pk2(v0[0], v0[1]); w.y = pk2(v0[2], v0[3]); w.z = pk2(v1[0], v1[1]); w.w = pk2(v1[2], v1[3]); return w; }
__device__ __forceinline__ float clamp8(float v) { return __builtin_amdgcn_fmed3f(v, -448.0f, 448.0f); }
__device__ __forceinline__ unsigned pk4_fp8(float a, float b, float c, float d) { int w = __builtin_amdgcn_cvt_pk_fp8_f32(clamp8(a), clamp8(b), 0, false); w = __builtin_amdgcn_cvt_pk_fp8_f32(clamp8(c), clamp8(d), w, true); return (unsigned)w; }
__device__ __forceinline__ v2u pack8_fp8(const A4& v0, const A4& v1) { v2u w; w.x = pk4_fp8(v0[0], v0[1], v0[2], v0[3]); w.y = pk4_fp8(v1[0], v1[1], v1[2], v1[3]); return w; }
__device__ __forceinline__ void unpack8(const v4u w, A4& v0, A4& v1) { v0 = (A4){bflo(w.x), bfhi(w.x), bflo(w.y), bfhi(w.y)}; v1 = (A4){bflo(w.z), bfhi(w.z), bflo(w.w), bfhi(w.w)}; }
__device__ __forceinline__ A4 sig4(const A4& z) { return (A4){sigmoidf_(z[0]), sigmoidf_(z[1]), sigmoidf_(z[2]), sigmoidf_(z[3])}; }
__device__ __forceinline__ A4 ex4(const A4& z) { return (A4){__builtin_amdgcn_exp2f(z[0]), __builtin_amdgcn_exp2f(z[1]), __builtin_amdgcn_exp2f(z[2]), __builtin_amdgcn_exp2f(z[3])}; }
__device__ __forceinline__ A4 rc4(const A4& z) { return (A4){__builtin_amdgcn_rcpf(z[0]), __builtin_amdgcn_rcpf(z[1]), __builtin_amdgcn_rcpf(z[2]), __builtin_amdgcn_rcpf(z[3])}; }
__device__ __forceinline__ float logsig(float z) { return fminf(z, 0.f) - __logf(1.0f + __expf(-fabsf(z))); }

template <bool FP8 = false> struct EpiInProj {
    static constexpr bool PERM = true, AFTER_DRAIN = false, HOOKS = false, RMW = false;
    unsigned char* outb; unsigned char* wsb; int layer;
    __device__ __forceinline__ void operator()(const AccT& acc, const pg8::Unit& u, int wr, int wc, int fr, int fq) const {
        const int pn = u.pn, row0 = u.pm * 256 + wr * 64 + fr, cw = wc * 32 + 8 * fq;
        bf16* const Q = (bf16*)(outb + DO_Q); bf16* const K = (bf16*)(outb + DO_K); bf16* const V = (bf16*)(outb + DO_V); bf16* const U = (bf16*)(outb + DO_U); bf16* const HC = (bf16*)(outb + DO_HC);
        bf16* const G = (bf16*)(wsb + WS_GATES); float* const logf = (float*)(wsb + WS_LOGF); const float* const bias = (const float*)(wsb + WS_BPERM) + layer * N_INP; const float* const ssq = (const float*)(wsb + WS_SSQ);
#define IP_LOADS() float rs[2][4]; _Pragma("unroll") for (int ai = 0; ai < 2; ++ai) _Pragma("unroll") for (int m = 0; m < 4; ++m) rs[ai][m] = row_rstd4(ssq, row0 + ai * 128 + m * 16, fq) * (FP8 ? 0.03125f : 1.0f); \
        A4 bv[2][2]; _Pragma("unroll") for (int bj = 0; bj < 2; ++bj) _Pragma("unroll") for (int n = 0; n < 2; ++n) bv[bj][n] = *(const A4*)(bias + pn * 256 + bj * 128 + cw + 4 * n)
        if (pn == 7 || pn == 8) {
            IP_LOADS();
#pragma unroll
            for (int ai = 0; ai < 2; ++ai)
#pragma unroll
                for (int m = 0; m < 4; ++m) { const int row = row0 + ai * 128 + m * 16; const float r = rs[ai][m];
                    const A4 a0 = acc[ai][0][m][0] * r + bv[0][0], a1 = acc[ai][0][m][1] * r + bv[0][1], g0 = acc[ai][1][m][0] * r + bv[1][0], g1 = acc[ai][1][m][1] * r + bv[1][1];
                    *(v4u*)(HC + (size_t)row * 256 + (pn - 7) * 128 + cw) = pack8(a0 * sig4(g0), a1 * sig4(g1)); asm volatile("" ::: "memory"); }
        } else if (pn == 21) {
            if (wc == 0) {
                IP_LOADS();
                if (fq == 0) {
#pragma unroll
                for (int ai = 0; ai < 2; ++ai)
#pragma unroll
                    for (int m = 0; m < 4; ++m) { const int row = row0 + ai * 128 + m * 16; const float r = rs[ai][m];
                        const A4 z0 = acc[ai][0][m][0] * r + bv[0][0], z1 = acc[ai][0][m][1] * r + bv[0][1];
                        *(A4*)(logf + (size_t)row * 8) = (A4){logsig(z0[0]), logsig(z0[1]), logsig(z0[2]), logsig(z0[3])};
                        *(A4*)(logf + (size_t)row * 8 + 4) = (A4){logsig(z1[0]), logsig(z1[1]), logsig(z1[2]), logsig(z1[3])}; }
                }
            }
        } else {
            if (pn >= 9) {
                IP_LOADS();
                A4 bn[2][2];
#pragma unroll
                for (int bj = 0; bj < 2; ++bj)
#pragma unroll
                    for (int n = 0; n < 2; ++n) bn[bj][n] = bv[bj][n] * -LOG2E;
                const int gi = (pn - 9) >> 2, pq = (pn - 9) & 3, tix = ((wr * 4 + wc) << 6) | (fq << 4) | fr;
                v4u* gb = (v4u*)G + ((size_t)((gi * 256 + u.pm) * 4 + pq) * 16) * 512 + tix;
#pragma unroll
                for (int ai = 0; ai < 2; ++ai)
#pragma unroll
                    for (int m = 0; m < 4; ++m) { const float rn = rs[ai][m] * -LOG2E;
#pragma unroll
                        for (int bj = 0; bj < 2; ++bj) { A4 v0 = acc[ai][bj][m][0] * rn + bn[bj][0], v1 = acc[ai][bj][m][1] * rn + bn[bj][1];
                            v0 = rc4(ex4(__builtin_elementwise_min(v0, (A4){40.f, 40.f, 40.f, 40.f})) + 1.0f); v1 = rc4(ex4(__builtin_elementwise_min(v1, (A4){40.f, 40.f, 40.f, 40.f})) + 1.0f);
                            gb[(size_t)(((ai * 4 + m) * 2 + bj)) * 512] = pack8(v0, v1); } asm volatile("" ::: "memory"); }
            } else {
            bf16* base; int ld, col0; float sc = 1.f;
            if (pn < 6) { base = pn < 2 ? Q : (pn < 4 ? K : V); ld = 512; col0 = (pn & 1) * 256; sc = pn < 2 ? QSCALE : 1.f; }
            else { base = U; ld = 256; col0 = 0; }
            IP_LOADS();
#pragma unroll
            for (int ai = 0; ai < 2; ++ai)
#pragma unroll
                for (int m = 0; m < 4; ++m) { const int row = row0 + ai * 128 + m * 16; const float r = rs[ai][m]; bf16* rowp = base + (size_t)row * ld + col0 + cw;
#pragma unroll
                    for (int bj = 0; bj < 2; ++bj) { A4 v0 = acc[ai][bj][m][0] * r + bv[bj][0], v1 = acc[ai][bj][m][1] * r + bv[bj][1];
                        v0 = v0 * sc; v1 = v1 * sc;
                        if (pn == 6) { const int c = bj * 128 + cw;
                            *(v4u*)((bf16*)(wsb + WS_UA) + ((size_t)(c >> 4) * (M / 64) + (row >> 6)) * 1152 + (row & 63) * 16 + (c & 15)) = pack8(v0, v1); }
                        else *(v4u*)(rowp + bj * 128) = pack8(v0, v1); } asm volatile("" ::: "memory"); }
            }
        }
    }
};
#undef IP_LOADS
template <bool MOE, bool FP8 = false> struct EpiSwiGlu {
    static constexpr bool PERM = true, AFTER_DRAIN = false, HOOKS = false, RMW = false;
    bf16* Hd; int ldh; const float* rsrc;
    __device__ __forceinline__ void operator()(const AccT& acc, const pg8::Unit& u, int wr, int wc, int fr, int fq) const {
        const int row0 = u.pm * 256 + wr * 64 + fr, cw = wc * 32 + 8 * fq;
        float rs[2][4];
#pragma unroll
        for (int ai = 0; ai < 2; ++ai)
#pragma unroll
            for (int m = 0; m < 4; ++m) { const int row = row0 + ai * 128 + m * 16; rs[ai][m] = (MOE ? rsrc[row] : row_rstd4(rsrc, row, fq)) * (FP8 ? 0.03125f : 1.0f); }
#pragma unroll
        for (int ai = 0; ai < 2; ++ai)
#pragma unroll
            for (int m = 0; m < 4; ++m) { const int row = row0 + ai * 128 + m * 16; const float r = rs[ai][m];
                A4 o[2];
#pragma unroll
                for (int n = 0; n < 2; ++n) { const A4 s = rc4(ex4(acc[ai][0][m][n] * (r * -LOG2E)) + 1.0f); o[n] = (acc[ai][0][m][n] * acc[ai][1][m][n]) * (s * (r * r)); }
                if constexpr (FP8) *(v2u*)((unsigned char*)Hd + (((size_t)(row >> 8) * (ldh >> 7) + u.pn) * 256 + (row & 255)) * 128 + wc * 32 + 8 * fq) = pack8_fp8(o[0], o[1]);
                else *(v4u*)(Hd + (((size_t)(row >> 8) * (ldh >> 6) + (u.pn * 2 + (wc >> 1))) * 256 + (row & 255)) * 64 + (wc & 1) * 32 + 8 * fq) = pack8(o[0], o[1]);
                asm volatile("" ::: "memory"); }
    }
};
struct EpiGluSsm {
    static constexpr bool PERM = true, AFTER_DRAIN = false, HOOKS = false, RMW = false;
    bf16* O;
    __device__ __forceinline__ void operator()(const AccT& acc, const pg8::Unit& u, int wr, int wc, int fr, int fq) const {
        const int row0 = u.pm * 256 + wr * 64 + fr, cw = wc * 32 + 8 * fq;
#pragma unroll
        for (int ai = 0; ai < 2; ++ai)
#pragma unroll
            for (int m = 0; m < 4; ++m) { const int row = row0 + ai * 128 + m * 16;
                *(v4u*)(O + (size_t)row * 1024 + 512 + u.pn * 128 + cw) = pack8(acc[ai][0][m][0] * sig4(acc[ai][1][m][0]), acc[ai][0][m][1] * sig4(acc[ai][1][m][1])); }
    }
};
template <int I> struct EpiMerge {
    static constexpr bool PERM = true, AFTER_DRAIN = false, HOOKS = false, RMW = false;
    const bf16* G; bf16* Mg;
    __device__ __forceinline__ void operator()(const AccT& acc, const pg8::Unit& u, int wr, int wc, int fr, int fq) const {
        const int row0 = u.pm * 256 + wr * 64 + fr, col0 = u.pn * 256 + wc * 32 + 8 * fq;
        v4u gl[3][2], ol[3][2];
#define MG_LOAD(buf, grp) do { const int row_ = row0 + ((grp) >> 2) * 128 + ((grp) & 3) * 16; _Pragma("unroll") for (int bj = 0; bj < 2; ++bj) { \
            gl[buf][bj] = *(const v4u*)(G + (size_t)row_ * 3072 + I * 1024 + col0 + bj * 128); if (I > 0) ol[buf][bj] = *(const v4u*)(Mg + (size_t)row_ * 1024 + col0 + bj * 128); } } while (0)
        MG_LOAD(0, 0); MG_LOAD(1, 1);
#pragma unroll
        for (int grp = 0; grp < 8; ++grp) {
            if (grp + 2 < 8) MG_LOAD((grp + 2) % 3, grp + 2);
            asm volatile("" ::: "memory");
            const int ai = grp >> 2, m = grp & 3, row = row0 + ai * 128 + m * 16;
#pragma unroll
            for (int bj = 0; bj < 2; ++bj) { A4 g0, g1; unpack8(gl[grp % 3][bj], g0, g1);
                A4 v0 = g0 * acc[ai][bj][m][0], v1 = g1 * acc[ai][bj][m][1];
                if (I > 0) { A4 o0, o1; unpack8(ol[grp % 3][bj], o0, o1); v0 = v0 + o0; v1 = v1 + o1; }
                *(v4u*)(Mg + (size_t)row * 1024 + col0 + bj * 128) = pack8(v0, v1); }
        }
#undef MG_LOAD
    }
};
template <bool O8 = false> struct EpiMergeCat {
    static constexpr bool PERM = true, AFTER_DRAIN = false, HOOKS = true, RMW = false; static constexpr int H1 = 8, H2 = 12;
    const bf16* G; bf16* Mg;
    static __device__ __forceinline__ A4 rcp4(const A4& z) { return (A4){__builtin_amdgcn_rcpf(z[0]), __builtin_amdgcn_rcpf(z[1]), __builtin_amdgcn_rcpf(z[2]), __builtin_amdgcn_rcpf(z[3])}; }
    __device__ __forceinline__ void mid(AccT& acc, const pg8::Unit& u, int t, int wr, int wc, int fr, int fq) const {
        int fr_ = fr, fq_ = fq; asm volatile("" : "+v"(fr_), "+v"(fq_));
        const int s = (t == H1) ? 0 : 1, tix = ((wr * 4 + wc) << 6) | (fq_ << 4) | fr_;
        const v4u* ga_ = (const v4u*)G + ((size_t)((s * 256 + u.pm) * 4 + u.pn) * 16) * 512 + tix;
        const v4u* gb_ = ga_ + (size_t)256 * 4 * 16 * 512;
#pragma unroll
        for (int ai = 0; ai < 2; ++ai)
#pragma unroll
            for (int mp = 0; mp < 2; ++mp) {
                v4u ga[2][2], gb[2][2];
#pragma unroll
                for (int mm = 0; mm < 2; ++mm)
#pragma unroll
                    for (int bj = 0; bj < 2; ++bj) { const size_t o = (size_t)(((ai * 4 + 2 * mp + mm) * 2 + bj)) * 512; ga[mm][bj] = ga_[o]; gb[mm][bj] = gb_[o]; }
#pragma unroll
                for (int mm = 0; mm < 2; ++mm)
#pragma unroll
                    for (int bj = 0; bj < 2; ++bj) { A4 p0, p1, q0, q1; unpack8(ga[mm][bj], p0, p1); unpack8(gb[mm][bj], q0, q1);
                        acc[ai][bj][2 * mp + mm][0] = acc[ai][bj][2 * mp + mm][0] * (p0 * rcp4(q0)); acc[ai][bj][2 * mp + mm][1] = acc[ai][bj][2 * mp + mm][1] * (p1 * rcp4(q1)); }
                asm volatile("" ::: "memory");
            }
    }
    __device__ __forceinline__ void operator()(const AccT& acc, const pg8::Unit& u, int wr, int wc, int fr, int fq) const {
        const int row0 = u.pm * 256 + wr * 64 + fr, col0 = u.pn * 256 + wc * 32 + 8 * fq, tix = ((wr * 4 + wc) << 6) | (fq << 4) | fr;
        const v4u* g2 = (const v4u*)G + ((size_t)((2 * 256 + u.pm) * 4 + u.pn) * 16) * 512 + tix;
        v4u gl[3][2];
#define MC_LOAD(buf, grp) do { _Pragma("unroll") for (int bj = 0; bj < 2; ++bj) gl[buf][bj] = g2[(size_t)((grp) * 2 + bj) * 512]; } while (0)
        MC_LOAD(0, 0); MC_LOAD(1, 1);
#pragma unroll
        for (int grp = 0; grp < 8; ++grp) {
            if (grp + 2 < 8) MC_LOAD((grp + 2) % 3, grp + 2);
            asm volatile("" ::: "memory");
            const int ai = grp >> 2, m = grp & 3, row = row0 + ai * 128 + m * 16;
#pragma unroll
            for (int bj = 0; bj < 2; ++bj) { A4 g0, g1; unpack8(gl[grp % 3][bj], g0, g1);
                if constexpr (O8) *(v2u*)((unsigned char*)Mg + (size_t)row * 1024 + col0 + bj * 128) = pack8_fp8(g0 * acc[ai][bj][m][0], g1 * acc[ai][bj][m][1]);
                else *(v4u*)(Mg + (size_t)row * 1024 + col0 + bj * 128) = pack8(g0 * acc[ai][bj][m][0], g1 * acc[ai][bj][m][1]); }
        }
#undef MC_LOAD
    }
};
template <bool W8 = false, int SH = 0> struct EpiResid {
    static constexpr bool PERM = true, AFTER_DRAIN = false, HOOKS = false, RMW = true;
    bf16* X; float* ssq; unsigned char* X8;
    __device__ __forceinline__ void operator()(const AccT& acc, const pg8::Unit& u, int wr, int wc, int fr, int fq) const {
        const int row0 = u.pm * 256 + wr * 64 + fr, col0 = u.pn * 256 + wc * 32 + 8 * fq;
        v4u ol[3][2];
#define RS_LOAD(buf, grp) do { const int row_ = row0 + ((grp) >> 2) * 128 + ((grp) & 3) * 16; _Pragma("unroll") for (int bj = 0; bj < 2; ++bj) ol[buf][bj] = *(const v4u*)(X + (size_t)row_ * 1024 + col0 + bj * 128); } while (0)
        RS_LOAD(0, 0); RS_LOAD(1, 1);
#pragma unroll
        for (int grp = 0; grp < 8; ++grp) {
            if (grp + 2 < 8) RS_LOAD((grp + 2) % 3, grp + 2);
            asm volatile("" ::: "memory");
            const int ai = grp >> 2, m = grp & 3, row = row0 + ai * 128 + m * 16; float ss = 0.f;
#pragma unroll
            for (int bj = 0; bj < 2; ++bj) { A4 o0, o1; unpack8(ol[grp % 3][bj], o0, o1); o0 = o0 + acc[ai][bj][m][0] * (1.0f / (float)(1 << SH)); o1 = o1 + acc[ai][bj][m][1] * (1.0f / (float)(1 << SH));
                const v4u w = pack8(o0, o1); *(v4u*)(X + (size_t)row * 1024 + col0 + bj * 128) = w; unpack8(w, o0, o1);
                if constexpr (W8) *(v2u*)(X8 + (size_t)row * 1024 + col0 + bj * 128) = pack8_fp8(o0, o1);
                ss += (o0[0] * o0[0] + o0[1] * o0[1]) + (o0[2] * o0[2] + o0[3] * o0[3]) + (o1[0] * o1[0] + o1[1] * o1[1]) + (o1[2] * o1[2] + o1[3] * o1[3]); }
            ss += __shfl_xor(ss, 16); ss += __shfl_xor(ss, 32);
            if (fq == 0) ssq[(size_t)row * 16 + u.pn * 4 + wc] = ss;
        }
#undef RS_LOAD
    }
};
template <bool FP8 = false> struct EpiMoeDown {
    static constexpr bool PERM = true, AFTER_DRAIN = false, HOOKS = false, RMW = false;
    bf16* Y; const int* rdest; const float* rw;
    __device__ __forceinline__ void operator()(const AccT& acc, const pg8::Unit& u, int wr, int wc, int fr, int fq) const {
        const int row0 = u.pm * 256 + wr * 64 + fr, cw = wc * 32 + 8 * fq;
        int ds[2][4]; float wsv[2][4];
#pragma unroll
        for (int ai = 0; ai < 2; ++ai)
#pragma unroll
            for (int m = 0; m < 4; ++m) { const int row = row0 + ai * 128 + m * 16; ds[ai][m] = rdest[row]; wsv[ai][m] = rw[row] * (FP8 ? 0.015625f : 1.0f); }
#pragma unroll
        for (int ai = 0; ai < 2; ++ai)
#pragma unroll
            for (int m = 0; m < 4; ++m) { const int dest = ds[ai][m]; const float w = wsv[ai][m];
                if (dest >= 0) {
#pragma unroll
                    for (int bj = 0; bj < 2; ++bj) *(v4u*)(Y + (size_t)dest * 1024 + u.pn * 256 + bj * 128 + cw) = pack8(acc[ai][bj][m][0] * w, acc[ai][bj][m][1] * w); }
                asm volatile("" ::: "memory"); }
    }
};
struct MoeOrder {
    pg8::StaticOrder so; int tile0, a_tile_off, b_rows; int s1, s2, s3, s4, s5, s6, s7;
    int x = 0, nl = 0, c0 = 0; static constexpr int SK = 3;
    __device__ __forceinline__ void skew(int nwg_down) {
        const int G = so.G, r = nwg_down % G; nl = 0; x = 0; c0 = 0;
        if (r != 0 && so.nwg >= SK * (G - r)) { nl = G - r; c0 = r; x = (so.nwg - SK * nl) / G; }
    }
    __device__ __forceinline__ bool next(int i, pg8::Unit& u) const {
        long L;
        if (nl == 0) L = (long)i * so.G + so.c;
        else if (i < x) L = (long)i * so.G + so.c;
        else if (so.c >= c0) { if (i < x + SK) L = (long)x * so.G + (long)(i - x) * nl + (so.c - c0); else if (i == x + SK) L = (long)x * so.G + (long)SK * nl + so.c; else return false; }
        else { if (i == x) L = (long)x * so.G + (long)SK * nl + so.c; else return false; }
        if (!so.unit_of(L, u)) return false;
        const int gt = tile0 + u.pm;
        const int e = (gt >= s1) + (gt >= s2) + (gt >= s3) + (gt >= s4) + (gt >= s5) + (gt >= s6) + (gt >= s7);
        u.arow = (a_tile_off + u.pm) * 256; u.brow = e * b_rows + u.pn * 256; return true;
    }
};
struct Args { const float* in[31]; unsigned char* out; unsigned char* ws; int ph_lo, ph_hi, use_bar, pad; };
struct Frame {
    LAS unsigned char* lds;
    volatile LAS unsigned* MISC;
    gu32* ctl;
    int tid, lane, wave, G, gw, NGW;
};

__device__ __forceinline__ int inproj_dest(int n) {
    if (n < 1536) return n;
    if (n < 1544) return 5376 + (n - 1536);
    if (n < 1800) return 1536 + (n - 1544);
    if (n < 2056) { const int c = n - 1800; return 1792 + (c >> 7) * 256 + (c & 127); }
    if (n < 2312) { const int c = n - 2056; return 1792 + (c >> 7) * 256 + 128 + (c & 127); }
    return 2304 + (n - 2312);
}
__device__ __forceinline__ int inproj_src(int d) {
    if (d < 1536) return d;
    if (d < 1792) return 1544 + (d - 1536);
    if (d < 2304) { const int t = (d - 1792) >> 8, r = (d - 1792) & 255; return r < 128 ? 1800 + t * 128 + r : 2056 + t * 128 + (r - 128); }
    if (d < 5376) return 2312 + (d - 2304);
    return (d - 5376) < 8 ? 1536 + (d - 5376) : -1;
}
__device__ __forceinline__ int map_row(int kind, int off, int n) {
    if (kind == 0) return n + off;
    if (kind == 1) return (n >> 7) * 256 + (n & 127) + off;
    if (kind == 2) { const int j = n & 255; return (j >> 7) * 256 + (j & 127) + ((n >> 8) ? 128 : 0); }
    return inproj_dest(n);
}
#ifndef FP8_INPROJ_MASK
#define FP8_INPROJ_MASK 0xE
#endif
#define FP8_INPROJ(l_) (((FP8_INPROJ_MASK) >> (l_)) & 1)
#ifndef FP8_WO_MASK
#define FP8_WO_MASK 0xC
#endif
#define FP8_WO(l_) (((FP8_WO_MASK) >> (l_)) & 1)
#ifndef FP8_DENSE_I
#define FP8_DENSE_I 1
#endif
struct CvtDesc { const float* W; const float* gk; bf16* WT; int K, N, kind, off, item, ldt; float sc8; };
__device__ __forceinline__ CvtDesc cvt_moe_desc(const Args& a, int i, int l, int it) {
    const int e = it / 5376, r = it - e * 5376, kd = r / 1792, li = r - kd * 1792; const size_t wo = (size_t)(i * NE + e) * D * D_FFE;
    CvtDesc d; d.item = li;
    if (kd < 2) { d.W = (kd == 0 ? a.in[27] : a.in[28]) + wo; d.gk = a.in[21] + l * D; d.WT = (bf16*)(a.ws + WS_WMOE + WMOE_GU + (size_t)e * 7168 * D); d.K = D; d.N = D_FFE; d.kind = 1; d.off = kd * 128; d.ldt = D; d.sc8 = 32.0f; }
    else { d.W = a.in[29] + wo; d.gk = nullptr; d.WT = (bf16*)(a.ws + WS_WMOE + WMOE_D + (size_t)e * D * D_FFE); d.K = D_FFE; d.N = D; d.kind = 0; d.off = 0; d.ldt = D_FFE; d.sc8 = 64.0f; }
    return d;
}
__device__ __forceinline__ void cvt_load(const CvtDesc& d, int lane, f32x4 (&v)[8]) {
    const int nblk = (d.N + 31) >> 5, kb = d.item / nblk, nb = d.item - kb * nblk, k0 = 64 * kb, r8 = lane >> 3, n = 32 * nb + 4 * (lane & 7);
#pragma unroll
    for (int i = 0; i < 8; ++i) v[i] = (n < d.N) ? *(const f32x4*)(d.W + (size_t)(k0 + 8 * i + r8) * d.N + n) : (f32x4){0.f, 0.f, 0.f, 0.f};
}
__device__ __forceinline__ void cvt_store(const CvtDesc& d, LAS float* scr, int lane, const f32x4 (&v)[8]) {
    const int nblk = (d.N + 31) >> 5, kb = d.item / nblk, nb = d.item - kb * nblk, k0 = 64 * kb, n0 = 32 * nb, c = lane & 7, r8 = lane >> 3;
    f32x4 g0 = (f32x4){1.f, 1.f, 1.f, 1.f}, g1 = g0;
    if (d.gk) { g0 = *(const f32x4*)(d.gk + k0 + 8 * c); g1 = *(const f32x4*)(d.gk + k0 + 8 * c + 4); }
#pragma unroll
    for (int i = 0; i < 8; ++i) { LAS float* q = scr + (8 * i + r8) * 33 + 4 * c; q[0] = v[i].x; q[1] = v[i].y; q[2] = v[i].z; q[3] = v[i].w; }
    LDS_WAIT(); asm volatile("" ::: "memory");
#pragma unroll
    for (int j = 0; j < 4; ++j) { const int nl = (lane >> 3) + 8 * j; const int nn = n0 + nl; const LAS float* s = scr + (8 * c) * 33 + nl;
        if (nn < d.N) {
            if (d.sc8 != 0.0f) { const float q = d.sc8; v2u o; o.x = pk4_fp8(s[0 * 33] * g0.x * q, s[1 * 33] * g0.y * q, s[2 * 33] * g0.z * q, s[3 * 33] * g0.w * q); o.y = pk4_fp8(s[4 * 33] * g1.x * q, s[5 * 33] * g1.y * q, s[6 * 33] * g1.z * q, s[7 * 33] * g1.w * q);
                *(v2u*)((unsigned char*)d.WT + (size_t)map_row(d.kind, d.off, nn) * d.ldt + k0 + 8 * c) = o; }
            else { v4u o; o.x = pk2(s[0 * 33] * g0.x, s[1 * 33] * g0.y); o.y = pk2(s[2 * 33] * g0.z, s[3 * 33] * g0.w); o.z = pk2(s[4 * 33] * g1.x, s[5 * 33] * g1.y); o.w = pk2(s[6 * 33] * g1.z, s[7 * 33] * g1.w);
                *(v4u*)(d.WT + (size_t)map_row(d.kind, d.off, nn) * d.ldt + k0 + 8 * c) = o; } } }
    LDS_WAIT(); asm volatile("" ::: "memory");
}
__device__ __forceinline__ void cvt_moe_layer(const Args& a, int i, int l, LAS float* scr, int lane, int gwl, int ngw) {
    constexpr int TOTAL = NE * 3 * 1792;
    int it = gwl; if (it >= TOTAL) return;
    f32x4 va[8], vb[8];
    CvtDesc da = cvt_moe_desc(a, i, l, it), db = da; cvt_load(da, lane, va);
    for (;;) {
        const int itb = it + ngw; const bool hb = itb < TOTAL;
        if (hb) { db = cvt_moe_desc(a, i, l, itb); cvt_load(db, lane, vb); }
        cvt_store(da, scr, lane, va);
        if (!hb) break;
        it = itb + ngw; const bool ha = it < TOTAL;
        if (ha) { da = cvt_moe_desc(a, i, l, it); cvt_load(da, lane, va); }
        cvt_store(db, scr, lane, vb);
        if (!ha) break;
    }
}

__device__ __forceinline__ CvtDesc cvt_p0_desc(const Args& a, int it) {
    CvtDesc d; d.gk = nullptr; d.kind = 0; d.off = 0; d.sc8 = 0.0f;
    if (it < DEPTH * 3792) {
        const int l = it / 3792; int r = it - l * 3792; unsigned char* wm = a.ws + WS_WMIX + (size_t)l * WMIX_STRIDE;
        if (r < 2704) { d.W = a.in[2] + (size_t)l * D * N_IN; d.K = D; d.N = N_IN; d.gk = a.in[1] + l * D; d.WT = (bf16*)(wm + WM_IN); d.kind = 3; d.item = r; d.ldt = D; d.sc8 = FP8_INPROJ(l) ? 32.0f : 0.0f; return d; } r -= 2704;
        if (r < 64) { d.W = a.in[12] + (size_t)l * 256 * 512; d.K = 256; d.N = 512; d.WT = (bf16*)(wm + WM_GLU); d.kind = 2; d.item = r; d.ldt = 256; return d; } r -= 64;
        if (r < 256) { d.W = a.in[17] + (size_t)l * 512 * D; d.K = 512; d.N = D; d.WT = (bf16*)(wm + WM_A); d.item = r; d.ldt = 1024; return d; } r -= 256;
        if (r < 128) { d.W = a.in[18] + (size_t)l * 256 * D; d.K = 256; d.N = D; d.WT = (bf16*)(wm + WM_A) + 512; d.item = r; d.ldt = 1024; return d; } r -= 128;
        if (r < 128) { d.W = a.in[19] + (size_t)l * 256 * D; d.K = 256; d.N = D; d.WT = (bf16*)(wm + WM_A) + 768; d.item = r; d.ldt = 1024; return d; } r -= 128;
        d.W = a.in[20] + (size_t)l * D * D; d.K = D; d.N = D; d.WT = (bf16*)(wm + WM_O); d.item = r; d.ldt = D; d.sc8 = FP8_WO(l) ? 32.0f : 0.0f; return d;
    }
    it -= DEPTH * 3792; const int i = it / 4224; int r = it - i * 4224; unsigned char* wd = a.ws + WS_WDENSE + (size_t)i * WDENSE_STRIDE;
    if (r < 2816) { const int up = r >= 1408; d.W = (up ? a.in[23] : a.in[22]) + (size_t)i * D * D_FF; d.K = D; d.N = D_FF; d.gk = a.in[21] + (2 * i) * D; d.WT = (bf16*)(wd + WD_GU); d.kind = 1; d.off = up * 128; d.item = r - up * 1408; d.ldt = D; d.sc8 = (i == FP8_DENSE_I) ? 32.0f : 0.0f; return d; }
    d.W = a.in[24] + (size_t)i * D_FF * D; d.K = D_FF; d.N = D; d.WT = (bf16*)(wd + WD_D); d.item = r - 2816; d.ldt = D_FF; d.sc8 = (i == FP8_DENSE_I) ? 64.0f : 0.0f; return d;
}
__device__ __forceinline__ void p0_prologue(Frame& F, const Args& a) {
    LAS float* scr = (LAS float*)(F.lds + RING_OFF + F.wave * 16384);
    {   constexpr int TOTAL = DEPTH * 3792 + 2 * 4224;
        int it = F.gw;
        if (it < TOTAL) {
            f32x4 va[8], vb[8];
            CvtDesc da = cvt_p0_desc(a, it), db = da; cvt_load(da, F.lane, va);
            for (;;) {
                const int itb = it + F.NGW; const bool hb = itb < TOTAL;
                if (hb) { db = cvt_p0_desc(a, itb); cvt_load(db, F.lane, vb); }
                cvt_store(da, scr, F.lane, va);
                if (!hb) break;
                it = itb + F.NGW; const bool ha = it < TOTAL;
                if (ha) { da = cvt_p0_desc(a, it); cvt_load(da, F.lane, va); }
                cvt_store(db, scr, F.lane, vb);
                if (!ha) break;
            }
        }
    }
    for (int r = F.gw; r < DEPTH * 248; r += F.NGW) { const int l = r / 248, row = 5384 + (r - l * 248); unsigned char* wr_ = a.ws + WS_WMIX + (size_t)l * WMIX_STRIDE + WM_IN + (size_t)row * D * (FP8_INPROJ(l) ? 1 : 2);
        if (FP8_INPROJ(l)) *(v4u*)(wr_ + 16 * F.lane) = (v4u){0u, 0u, 0u, 0u}; else { *(v4u*)(wr_ + 32 * F.lane) = (v4u){0u, 0u, 0u, 0u}; *(v4u*)(wr_ + 32 * F.lane + 16) = (v4u){0u, 0u, 0u, 0u}; } }
    float* bperm = (float*)(a.ws + WS_BPERM);
    for (int idx = F.gw * 64 + F.lane; idx < DEPTH * N_INP; idx += F.NGW * 64) { const int l = idx / N_INP, d = idx - l * N_INP, n = inproj_src(d); bperm[idx] = n >= 0 ? a.in[3][l * N_IN + n] : 0.f; }
    bf16* xb = (bf16*)(a.ws + WS_XB); float* ssq = (float*)(a.ws + WS_SSQ);
    {   f32x4 nv[4]; int m = F.gw;
        if (m < M) { const f32x4* xr = (const f32x4*)(a.in[0] + (size_t)m * D) + F.lane;
#pragma unroll
            for (int j = 0; j < 4; ++j) nv[j] = xr[64 * j]; }
        for (; m < M; m += F.NGW) {
            f32x4 v[4];
#pragma unroll
            for (int j = 0; j < 4; ++j) v[j] = nv[j];
            if (m + F.NGW < M) { const f32x4* xr = (const f32x4*)(a.in[0] + (size_t)(m + F.NGW) * D) + F.lane;
#pragma unroll
                for (int j = 0; j < 4; ++j) nv[j] = xr[64 * j]; }
            float ss = 0.f;
#pragma unroll
            for (int j = 0; j < 4; ++j) { v2u w; w.x = pk2(v[j].x, v[j].y); w.y = pk2(v[j].z, v[j].w);
                *(v2u*)(xb + (size_t)m * D + 256 * j + 4 * F.lane) = w;
                const float a0 = bflo(w.x), a1 = bfhi(w.x), a2 = bflo(w.y), a3 = bfhi(w.y); ss += (a0 * a0 + a1 * a1) + (a2 * a2 + a3 * a3);
                *(unsigned*)(a.ws + WS_XB8 + (size_t)m * D + 256 * j + 4 * F.lane) = pk4_fp8(a0, a1, a2, a3); }
            const float tot = wave_sum(ss);
            if (F.lane < 16) ssq[(size_t)m * 16 + F.lane] = F.lane == 0 ? tot : 0.f;
        }
    }
}

__device__ __forceinline__ void t1_cumsum(const Args& a, int bh, int lane) {
    const float* logf = (const float*)(a.ws + WS_LOGF); float* Fh = (float*)(a.ws + WS_FH);
    const int b = bh >> 3, h = bh & 7; const float* p = logf + ((size_t)b * SEQ + lane) * 8 + h; float* o = Fh + (size_t)bh * SEQ + lane;
    float carry = 0.f;
    for (int blk = 0; blk < SEQ / 64; blk += 8) {
        float v[8];
#pragma unroll
        for (int q = 0; q < 8; ++q) v[q] = p[(size_t)(blk + q) * 64 * 8];
#pragma unroll
        for (int q = 0; q < 8; ++q) { float x = v[q];
#pragma unroll
            for (int s = 1; s < 64; s <<= 1) { const float t = __shfl_up(x, s); if (lane >= s) x += t; }
            x += carry; o[(blk + q) * 64] = x; carry = __builtin_bit_cast(float, __builtin_amdgcn_readlane(__builtin_bit_cast(int, x), 63)); }
    }
}
constexpr int CONV_TILE = 128, CONV_ROWS = CONV_TILE + CONV_K - 1;
__device__ __forceinline__ void t1_conv_tile(const Args& a, int l, int tile, LAS unsigned char* lds, int tid, int wave, int lane, const f32x4 (&cwt)[CONV_K], const f32x4 cb, const f32x4 lg, const f32x4 lb) {
    const bf16* HC = (const bf16*)(a.out + DO_HC); bf16* CO = (bf16*)(a.ws + WS_BCAT) + 768;
    const int t0 = tile * CONV_TILE, tl0 = t0 & (SEQ - 1);
    { v4u sv[10];
#pragma unroll
      for (int q = 0; q < 10; ++q) { const int pc = tid + q * NWAVES * 64, r = pc >> 5, c = pc & 31; sv[q] = (v4u){0u, 0u, 0u, 0u};
          if (pc < CONV_ROWS * 32 && tl0 + r - (CONV_K - 1) >= 0) sv[q] = *(const v4u*)(HC + (size_t)(t0 + r - (CONV_K - 1)) * CONV_W + 8 * c); }
#pragma unroll
      for (int q = 0; q < 10; ++q) { const int pc = tid + q * NWAVES * 64, r = pc >> 5, c = pc & 31; if (pc < CONV_ROWS * 32) *(LAS v4u*)(lds + r * 512 + c * 16) = sv[q]; } }
    __syncthreads();
    for (int i = 0; i < 16; ++i) {
        const int tr = wave * 16 + i;
        f32x4 y = cb;
#pragma unroll
        for (int k = 0; k < CONV_K; ++k) { const v2u hv = *(const LAS v2u*)(lds + (tr + k) * 512 + 8 * lane);
            y.x += cwt[k].x * bflo(hv.x); y.y += cwt[k].y * bfhi(hv.x); y.z += cwt[k].z * bflo(hv.y); y.w += cwt[k].w * bfhi(hv.y); }
        const float mu = wave_sum((y.x + y.y) + (y.z + y.w)) * (1.f / 256.f);
        const f32x4 dl = y - mu;
        const float var = wave_sum((dl.x * dl.x + dl.y * dl.y) + (dl.z * dl.z + dl.w * dl.w)) * (1.f / 256.f);
        const float rs = rsqrtf(var + EPS);
        f32x4 z = dl * rs * lg + lb;
        z.x *= sigmoidf_(z.x); z.y *= sigmoidf_(z.y); z.z *= sigmoidf_(z.z); z.w *= sigmoidf_(z.w);
        v2u o; o.x = pk2(z.x, z.y); o.y = pk2(z.z, z.w);
        *(v2u*)(CO + (size_t)(t0 + tr) * 1024 + 4 * lane) = o;
    }
    __syncthreads();
}
__device__ __forceinline__ void t1_conv_all(const Args& a, int l, int bid, int G, LAS unsigned char* lds, int tid, int wave, int lane) {
    f32x4 cwt[CONV_K];
#pragma unroll
    for (int k = 0; k < CONV_K; ++k) cwt[k] = *(const f32x4*)(a.in[13] + ((size_t)l * CONV_K + k) * CONV_W + 4 * lane);
    const f32x4 cb = *(const f32x4*)(a.in[14] + l * CONV_W + 4 * lane), lg = *(const f32x4*)(a.in[15] + l * CONV_W + 4 * lane), lb = *(const f32x4*)(a.in[16] + l * CONV_W + 4 * lane);
    for (int tile = bid; tile < M / CONV_TILE; tile += G) t1_conv_tile(a, l, tile, lds, tid, wave, lane, cwt, cb, lg, lb);
}
__device__ __forceinline__ float gelu_tanh(float y) {
    const float z = 0.7978845608028654f * (y + 0.044715f * y * y * y);
    const float th = 1.0f - 2.0f * __builtin_amdgcn_rcpf(__builtin_amdgcn_exp2f(2.885390081777927f * z) + 1.0f);
    return 0.5f * y * (1.0f + th);
}
__device__ __forceinline__ void moe_route(Frame& F, const Args& a, int l, int i) {
    const bf16* xb = (const bf16*)(a.ws + WS_XB); const float* ssq = (const float*)(a.ws + WS_SSQ);
    int* toke = (int*)(a.ws + WS_TOKE); float* tokw = (float*)(a.ws + WS_TOKW); int* cntw = (int*)(a.ws + WS_CNTW);
    const int lane = F.lane, k0 = 16 * lane;
    float wr[16][8];
#pragma unroll
    for (int j = 0; j < 16; ++j) { const float gk = a.in[21][l * D + k0 + j];
        const f32x4 w0 = *(const f32x4*)(a.in[25] + ((size_t)i * D + k0 + j) * NE), w1 = *(const f32x4*)(a.in[25] + ((size_t)i * D + k0 + j) * NE + 4);
        wr[j][0] = gk * w0.x; wr[j][1] = gk * w0.y; wr[j][2] = gk * w0.z; wr[j][3] = gk * w0.w; wr[j][4] = gk * w1.x; wr[j][5] = gk * w1.y; wr[j][6] = gk * w1.z; wr[j][7] = gk * w1.w; }
    float rb[8];
#pragma unroll
    for (int e = 0; e < 8; ++e) rb[e] = a.in[26][i * NE + e];
    const bool b5 = (lane & 32) != 0, b4 = (lane & 16) != 0, b3 = (lane & 8) != 0;
    for (int run = F.gw; run < M / 32; run += F.NGW) {
        int cnt[8];
#pragma unroll
        for (int e = 0; e < 8; ++e) cnt[e] = 0;
        const float rstd_l = row_rstd(ssq, run * 32 + (lane & 31));
        v4u x0n = *(const v4u*)(xb + (size_t)(run * 32) * D + k0), x1n = *(const v4u*)(xb + (size_t)(run * 32) * D + k0 + 8);
        for (int ti = 0; ti < 32; ++ti) {
            const int t = run * 32 + ti;
            const v4u x0 = x0n, x1 = x1n;
            if (ti + 1 < 32) { x0n = *(const v4u*)(xb + (size_t)(t + 1) * D + k0); x1n = *(const v4u*)(xb + (size_t)(t + 1) * D + k0 + 8); }
            float xv[16] = {bflo(x0.x), bfhi(x0.x), bflo(x0.y), bfhi(x0.y), bflo(x0.z), bfhi(x0.z), bflo(x0.w), bfhi(x0.w), bflo(x1.x), bfhi(x1.x), bflo(x1.y), bfhi(x1.y), bflo(x1.z), bfhi(x1.z), bflo(x1.w), bfhi(x1.w)};
            float v[8];
#pragma unroll
            for (int e = 0; e < 8; ++e) { float s = 0.f;
#pragma unroll
                for (int j = 0; j < 16; ++j) s += xv[j] * wr[j][e];
                v[e] = s; }
            float w4[4], w2[2];
#pragma unroll
            for (int q = 0; q < 4; ++q) { const float keep = b5 ? v[q + 4] : v[q], send = b5 ? v[q] : v[q + 4]; w4[q] = keep + __shfl_xor(send, 32); }
#pragma unroll
            for (int q = 0; q < 2; ++q) { const float keep = b4 ? w4[q + 2] : w4[q], send = b4 ? w4[q] : w4[q + 2]; w2[q] = keep + __shfl_xor(send, 16); }
            float w1; { const float keep = b3 ? w2[1] : w2[0], send = b3 ? w2[0] : w2[1]; w1 = keep + __shfl_xor(send, 8); }
            w1 += __shfl_xor(w1, 4); w1 += __shfl_xor(w1, 2); w1 += __shfl_xor(w1, 1);
            const float rstd = __builtin_bit_cast(float, __builtin_amdgcn_readlane(__builtin_bit_cast(int, rstd_l), ti));
            float lg[8];
#pragma unroll
            for (int e = 0; e < 8; ++e) lg[e] = __builtin_bit_cast(float, __builtin_amdgcn_readlane(__builtin_bit_cast(int, w1), 8 * e)) * rstd + rb[e];
            int e0 = 0; float l0 = lg[0];
#pragma unroll
            for (int e = 1; e < 8; ++e) if (lg[e] > l0) { l0 = lg[e]; e0 = e; }
            int e1 = (e0 == 0) ? 1 : 0; float l1 = -INFINITY;
#pragma unroll
            for (int e = 0; e < 8; ++e) if (e != e0 && lg[e] > l1) { l1 = lg[e]; e1 = e; }
            const float p0 = 1.0f / (1.0f + __expf(l1 - l0)), p1 = 1.0f - p0;
            if (lane == 0) { toke[t] = e0 | (e1 << 8); tokw[2 * t] = p0; tokw[2 * t + 1] = p1; }
#pragma unroll
            for (int e = 0; e < 8; ++e) cnt[e] += (e0 == e) + (e1 == e);
        }
        int cv = 0;
#pragma unroll
        for (int e = 0; e < 8; ++e) if (lane == e) cv = cnt[e];
        if (lane < 8) cntw[run * 8 + lane] = cv;
    }
}
__device__ __forceinline__ int wave_sum_i(int v) {
#pragma unroll
    for (int o = 1; o < 64; o <<= 1) v += __shfl_xor(v, o);
    return v;
}
__device__ __forceinline__ void moe_slots(Frame& F, const Args& a) {
    const bf16* xb = (const bf16*)(a.ws + WS_XB); const float* ssq = (const float*)(a.ws + WS_SSQ);
    const int* toke = (const int*)(a.ws + WS_TOKE); const float* tokw = (const float*)(a.ws + WS_TOKW); const int* cntw = (const int*)(a.ws + WS_CNTW);
    int* meta = (int*)(a.ws + WS_META); int* rdest = (int*)(a.ws + WS_RDEST); float* rw = (float*)(a.ws + WS_RW); float* rrstd = (float*)(a.ws + WS_RRSTD);
    const int lane = F.lane;
    for (int run = F.gw; run < M / 32; run += F.NGW) {
        int pre[8], tot[8];
#pragma unroll
        for (int e = 0; e < 8; ++e) { pre[e] = 0; tot[e] = 0; }
#pragma unroll 8
        for (int r2 = lane; r2 < M / 32; r2 += 64) {
            const int4 c0 = *(const int4*)(cntw + r2 * 8), c1 = *(const int4*)(cntw + r2 * 8 + 4); const int f = r2 < run ? 1 : 0;
            tot[0] += c0.x; tot[1] += c0.y; tot[2] += c0.z; tot[3] += c0.w; tot[4] += c1.x; tot[5] += c1.y; tot[6] += c1.z; tot[7] += c1.w;
            pre[0] += f * c0.x; pre[1] += f * c0.y; pre[2] += f * c0.z; pre[3] += f * c0.w; pre[4] += f * c1.x; pre[5] += f * c1.y; pre[6] += f * c1.z; pre[7] += f * c1.w;
        }
        int seg[9]; seg[0] = 0;
#pragma unroll
        for (int e = 0; e < 8; ++e) { tot[e] = __builtin_amdgcn_readfirstlane(wave_sum_i(tot[e])); pre[e] = __builtin_amdgcn_readfirstlane(wave_sum_i(pre[e])); seg[e + 1] = seg[e] + ((tot[e] + 255) & ~255); }
        if (run == 0 && lane < 9) { int sv = 0;
#pragma unroll
            for (int e = 0; e < 9; ++e) if (lane == e) sv = seg[e] >> 8;
            meta[lane] = sv; }
        if (run < 8) {
#pragma unroll
            for (int e = 0; e < 8; ++e) if (run == e) { for (int r = tot[e] + lane; r < ((tot[e] + 255) & ~255); r += 64) { rdest[seg[e] + r] = -1; rw[seg[e] + r] = 0.f; rrstd[seg[e] + r] = 0.f; } }
        }
        int base[8];
#pragma unroll
        for (int e = 0; e < 8; ++e) base[e] = seg[e] + pre[e];
        const int tl = run * 32 + (lane & 31);
        const int ee_l = toke[tl]; const float w0_l = tokw[2 * tl], w1_l = tokw[2 * tl + 1], rstd_l = row_rstd(ssq, tl);
        int s0_l = 0, s1_l = 0;
        for (int ti = 0; ti < 32; ++ti) {
            const int ee = __builtin_amdgcn_readlane(ee_l, ti); const int e0 = ee & 255, e1 = ee >> 8;
            int s0 = 0, s1 = 0;
#pragma unroll
            for (int e = 0; e < 8; ++e) { if (e0 == e) { s0 = base[e]; base[e] += 1; } if (e1 == e) { s1 = base[e]; base[e] += 1; } }
            if (lane == ti) { s0_l = s0; s1_l = s1; }
        }
        if (lane < 32) { rdest[s0_l] = 2 * tl; rdest[s1_l] = 2 * tl + 1; rw[s0_l] = w0_l; rw[s1_l] = w1_l; rrstd[s0_l] = rstd_l; rrstd[s1_l] = rstd_l; }
    }
}
__device__ __forceinline__ void moe_combine(Frame& F, const Args& a, bool last) {
    bf16* xb = (bf16*)(a.ws + WS_XB); float* ssq = (float*)(a.ws + WS_SSQ); const bf16* yb = (const bf16*)a.out; float* outp = (float*)a.out;
    const int lane = F.lane;
    v4u nx[6]; int tt = F.gw;
#define CMB_LOAD(dst, tok) do { const int t_ = (tok); dst[0] = *(const v4u*)(xb + (size_t)t_ * D + 16 * lane); dst[1] = *(const v4u*)(xb + (size_t)t_ * D + 16 * lane + 8); \
        dst[2] = *(const v4u*)(yb + (size_t)(2 * t_) * D + 16 * lane); dst[3] = *(const v4u*)(yb + (size_t)(2 * t_) * D + 16 * lane + 8); \
        dst[4] = *(const v4u*)(yb + (size_t)(2 * t_ + 1) * D + 16 * lane); dst[5] = *(const v4u*)(yb + (size_t)(2 * t_ + 1) * D + 16 * lane + 8); } while (0)
    if (tt < M) CMB_LOAD(nx, M - 1 - tt);
    for (; tt < M; tt += F.NGW) {
        const int t = M - 1 - tt;
        const v4u x0 = nx[0], x1 = nx[1], y00 = nx[2], y01 = nx[3], y10 = nx[4], y11 = nx[5];
        if (tt + F.NGW < M) CMB_LOAD(nx, M - 1 - (tt + F.NGW));
        A4 xa, xb_, xc, xd, t0, t1;
        unpack8(x0, xa, xb_); unpack8(x1, xc, xd);
        unpack8(y00, t0, t1); xa = xa + t0; xb_ = xb_ + t1; unpack8(y01, t0, t1); xc = xc + t0; xd = xd + t1;
        unpack8(y10, t0, t1); xa = xa + t0; xb_ = xb_ + t1; unpack8(y11, t0, t1); xc = xc + t0; xd = xd + t1;
        if (!last) {
            const v4u w0 = pack8(xa, xb_), w1 = pack8(xc, xd);
            *(v4u*)(xb + (size_t)t * D + 16 * lane) = w0; *(v4u*)(xb + (size_t)t * D + 16 * lane + 8) = w1;
            unpack8(w0, xa, xb_); unpack8(w1, xc, xd);
            { v4u o8; o8.x = pk4_fp8(xa[0], xa[1], xa[2], xa[3]); o8.y = pk4_fp8(xb_[0], xb_[1], xb_[2], xb_[3]); o8.z = pk4_fp8(xc[0], xc[1], xc[2], xc[3]); o8.w = pk4_fp8(xd[0], xd[1], xd[2], xd[3]); *(v4u*)(a.ws + WS_XB8 + (size_t)t * D + 16 * lane) = o8; }
        }
        float ss = 0.f;
#pragma unroll
        for (int j = 0; j < 4; ++j) ss += xa[j] * xa[j] + xb_[j] * xb_[j] + xc[j] * xc[j] + xd[j] * xd[j];
        const float tot = wave_sum(ss);
        if (!last) { if (lane < 16) ssq[(size_t)t * 16 + lane] = lane == 0 ? tot : 0.f; }
        else {
            const float r = rsqrtf(tot * (1.0f / 1024.0f) + EPS); const f32x4* gf = (const f32x4*)(a.in[30] + 16 * lane); f32x4* op = (f32x4*)(outp + (size_t)t * D + 16 * lane);
            op[0] = xa * r * gf[0]; op[1] = xb_ * r * gf[1]; op[2] = xc * r * gf[2]; op[3] = xd * r * gf[3];
        }
    }
#undef CMB_LOAD
}
constexpr int SSM_T = 64, SSM_KA = 1152;
__device__ __forceinline__ void ssm_abar(const Args& a, int lg, int p, float& lam_re, float& lam_im, float& dt) { lam_re = a.in[4][lg * SSM_P + p]; lam_im = a.in[5][lg * SSM_P + p]; dt = expf(a.in[6][lg]); }
__device__ __forceinline__ void cpow(float lam_re, float lam_im, float dt, int tau, float& re, float& im) { const float mag = expf(lam_re * dt * (float)tau); float sn, cs; sincosf(lam_im * dt * (float)tau, &sn, &cs); re = mag * cs; im = mag * sn; }
__device__ __forceinline__ void ssm_tables(Frame& F, const Args& a) {
    float* APOW = (float*)(a.ws + WS_APOW); float* BBAR = (float*)(a.ws + WS_BBAR); float* KTAB = (float*)(a.ws + WS_KTAB);
    const int lane = F.lane, p = lane;
    const bool b5 = (lane & 32) != 0, b4 = (lane & 16) != 0, b3 = (lane & 8) != 0, b2 = (lane & 4) != 0;
    for (int task = F.gw; task < DEPTH * SSM_G * 65; task += F.NGW) {
        const int lg = task / 65, tau = task - lg * 65;
        float lam_re, lam_im, dt; ssm_abar(a, lg, p, lam_re, lam_im, dt);
        float pr, pi; cpow(lam_re, lam_im, dt, tau, pr, pi);
        *(f32x2*)(APOW + (((size_t)lg * 65 + tau) * SSM_P + p) * 2) = (f32x2){pr, pi};
        float ar, ai; cpow(lam_re, lam_im, dt, 1, ar, ai);
        const float nr = ar - 1.0f, ni = ai, den = lam_re * lam_re + lam_im * lam_im;
        const float cr = (nr * lam_re + ni * lam_im) / den, ci = (ni * lam_re - nr * lam_im) / den;
        float br[16], bi[16];
#pragma unroll
        for (int h = 0; h < 16; ++h) { const float bre = a.in[7][((size_t)lg * SSM_P + p) * SSM_H + h], bim = a.in[8][((size_t)lg * SSM_P + p) * SSM_H + h]; br[h] = cr * bre - ci * bim; bi[h] = cr * bim + ci * bre; }
        if (tau == 0) {
#pragma unroll
            for (int h = 0; h < 16; ++h) *(f32x2*)(BBAR + (((size_t)lg * SSM_P + p) * SSM_H + h) * 2) = (f32x2){br[h], bi[h]};
        }
        if (tau < 64) {
            for (int ho = 0; ho < 16; ++ho) {
                const float cre = a.in[9][((size_t)lg * SSM_H + ho) * SSM_P + p], cim = a.in[10][((size_t)lg * SSM_H + ho) * SSM_P + p];
                const float wr_ = cre * pr - cim * pi, wi_ = cre * pi + cim * pr;
                float v[16];
#pragma unroll
                for (int h = 0; h < 16; ++h) v[h] = wr_ * br[h] - wi_ * bi[h];
                float w8[8], w4[4], w2[2];
#pragma unroll
                for (int i = 0; i < 8; ++i) { const float keep = b5 ? v[i + 8] : v[i], send = b5 ? v[i] : v[i + 8]; w8[i] = keep + __shfl_xor(send, 32); }
#pragma unroll
                for (int i = 0; i < 4; ++i) { const float keep = b4 ? w8[i + 4] : w8[i], send = b4 ? w8[i] : w8[i + 4]; w4[i] = keep + __shfl_xor(send, 16); }
#pragma unroll
                for (int i = 0; i < 2; ++i) { const float keep = b3 ? w4[i + 2] : w4[i], send = b3 ? w4[i] : w4[i + 2]; w2[i] = keep + __shfl_xor(send, 8); }
                float w1; { const float keep = b2 ? w2[1] : w2[0], send = b2 ? w2[0] : w2[1]; w1 = keep + __shfl_xor(send, 4); }
                w1 += __shfl_xor(w1, 2); w1 += __shfl_xor(w1, 1);
                const int hi = lane >> 2;
                if (tau == 0 && hi == ho) w1 += a.in[11][lg * SSM_H + ho];
                if ((lane & 3) == 0) KTAB[(((size_t)lg * 64 + tau) * 16 + ho) * 16 + hi] = w1;
            }
        }
    }
}
__device__ __forceinline__ void ssm_gather_u(const Args& a, int chunk, int lane) {
    const bf16* U = (const bf16*)(a.out + DO_U); bf16* Ua = (bf16*)(a.ws + WS_UA);
    const int g = lane >> 2, o4 = (lane & 3) * 4;
#pragma unroll 16
    for (int j = 0; j < SSM_T; ++j) { const v2u w = *(const v2u*)(U + ((size_t)chunk * SSM_T + j) * SSM_W + 4 * lane);
        *(v2u*)(Ua + ((size_t)g * (M / SSM_T) + chunk) * SSM_KA + j * 16 + o4) = w; }
}
__device__ __forceinline__ void ssm_expand_mv(const Args& a, int l, int task, int lane) {
    const float* APOW = (const float*)(a.ws + WS_APOW); const float* KTAB = (const float*)(a.ws + WS_KTAB); bf16* MV = (bf16*)(a.ws + WS_MV);
    const int g = task >> 10, n = task & 1023, i = n >> 4, ho = n & 15, lg = l * SSM_G + g, j = lane;
    bf16* row = MV + (size_t)task * SSM_KA;
    v4u o0 = (v4u){0u, 0u, 0u, 0u}, o1 = o0;
    if (j <= i) { const f32x4* kt = (const f32x4*)(KTAB + (((size_t)lg * 64 + (i - j)) * 16 + ho) * 16); const f32x4 k0 = kt[0], k1 = kt[1], k2 = kt[2], k3 = kt[3];
        o0.x = pk2(k0.x, k0.y); o0.y = pk2(k0.z, k0.w); o0.z = pk2(k1.x, k1.y); o0.w = pk2(k1.z, k1.w); o1.x = pk2(k2.x, k2.y); o1.y = pk2(k2.z, k2.w); o1.z = pk2(k3.x, k3.y); o1.w = pk2(k3.z, k3.w); }
    *(v4u*)(row + j * 16) = o0; *(v4u*)(row + j * 16 + 8) = o1;
    const int p = lane; const f32x2 ap = *(const f32x2*)(APOW + (((size_t)lg * 65 + (i + 1)) * SSM_P + p) * 2);
    const float cre = a.in[9][((size_t)lg * SSM_H + ho) * SSM_P + p], cim = a.in[10][((size_t)lg * SSM_H + ho) * SSM_P + p];
    row[1024 + p] = (bf16)f2bf(cre * ap.x - cim * ap.y); row[1024 + 64 + p] = (bf16)f2bf(-(cre * ap.y + cim * ap.x));
}
__device__ __forceinline__ void ssm_expand_w(const Args& a, int l, int task, int lane) {
    const float* APOW = (const float*)(a.ws + WS_APOW); const float* BBAR = (const float*)(a.ws + WS_BBAR); bf16* WG = (bf16*)(a.ws + WS_WG);
    const int g = task >> 7, q = task & 127, p = q & 63, im = q >> 6, lg = l * SSM_G + g, j = lane;
    { bf16* zr = WG + ((size_t)g * 256 + 128 + q) * 1024 + j * 16; *(v4u*)zr = (v4u){0u, 0u, 0u, 0u}; *(v4u*)(zr + 8) = (v4u){0u, 0u, 0u, 0u}; }
    const f32x2 ap = *(const f32x2*)(APOW + (((size_t)lg * 65 + (63 - j)) * SSM_P + p) * 2);
    float v[16];
#pragma unroll
    for (int h = 0; h < 16; ++h) { const f32x2 bb = *(const f32x2*)(BBAR + (((size_t)lg * SSM_P + p) * SSM_H + h) * 2); v[h] = im ? (ap.x * bb.y + ap.y * bb.x) : (ap.x * bb.x - ap.y * bb.y); }
    bf16* row = WG + ((size_t)g * 256 + q) * 1024 + j * 16;
    v4u o0, o1; o0.x = pk2(v[0], v[1]); o0.y = pk2(v[2], v[3]); o0.z = pk2(v[4], v[5]); o0.w = pk2(v[6], v[7]); o1.x = pk2(v[8], v[9]); o1.y = pk2(v[10], v[11]); o1.z = pk2(v[12], v[13]); o1.w = pk2(v[14], v[15]);
    *(v4u*)row = o0; *(v4u*)(row + 8) = o1;
}
struct GroupOrder {
    pg8::StaticOrder so; int b_rows;
    __device__ __forceinline__ bool next(int i, pg8::Unit& u) const { if (!so.next(i, u)) return false; u.brow = (u.pm >> 2) * b_rows + u.pn * 256; return true; }
};
struct EpiSsmScan {
    static constexpr bool PERM = true, AFTER_DRAIN = true, HOOKS = false, RMW = false;
    const float* APOW; bf16* Ua; int layer;
    __device__ __forceinline__ void fused(const AccT& acc, const pg8::Unit& u, int wr, int wc, int fr, int fq, PG8_LAS unsigned char* lds, int tid) const {
        PG8_LAS float* SL = (PG8_LAS float*)lds;
        const int rl0 = wr * 64 + fr, cw = wc * 32 + 8 * fq;
#pragma unroll
        for (int ai = 0; ai < 2; ++ai)
#pragma unroll
            for (int m = 0; m < 4; ++m) { PG8_LAS float* sp = SL + (rl0 + ai * 128 + m * 16) * 128 + cw; *(PG8_LAS A4*)sp = acc[ai][0][m][0]; *(PG8_LAS A4*)(sp + 4) = acc[ai][0][m][1]; }
        __syncthreads();
        if (tid < 256) {
            const int bl = tid >> 6, p = tid & 63, g = u.pm >> 2, lg = layer * SSM_G + g;
            const f32x2 a64 = *(const f32x2*)(APOW + (((size_t)lg * 65 + 64) * SSM_P + p) * 2);
            float xr = 0.f, xi = 0.f; bf16* xrow = Ua + ((size_t)u.pm * 256 + bl * 64) * SSM_KA + 1024 + p; const PG8_LAS float* sl = SL + (bl * 64) * 128 + p;
#pragma unroll 8
            for (int c = 0; c < 64; ++c) { const float sr = sl[c * 128], si = sl[c * 128 + 64];
                xrow[(size_t)c * SSM_KA] = (bf16)f2bf(xr); xrow[(size_t)c * SSM_KA + 64] = (bf16)f2bf(xi);
                const float nr = a64.x * xr - a64.y * xi + sr, ni = a64.x * xi + a64.y * xr + si; xr = nr; xi = ni; }
        }
        __syncthreads();
    }
};
struct EpiSsmY {
    static constexpr bool PERM = true, AFTER_DRAIN = false, HOOKS = false, RMW = false;
    bf16* YGp;
    __device__ __forceinline__ void operator()(const AccT& acc, const pg8::Unit& u, int wr, int wc, int fr, int fq) const {
        const int row0 = u.pm * 256 + wr * 64 + fr, g = u.pm >> 2;
#pragma unroll
        for (int ai = 0; ai < 2; ++ai)
#pragma unroll
            for (int m = 0; m < 4; ++m) { const int chunk = (row0 + ai * 128 + m * 16) & 1023;
#pragma unroll
                for (int bj = 0; bj < 2; ++bj) { const int i = 16 * u.pn + 8 * bj + 2 * wc + (fq >> 1);
                    const A4 v0 = acc[ai][bj][m][0], v1 = acc[ai][bj][m][1];
                    v4u w; w.x = pk2(gelu_tanh(v0[0]), gelu_tanh(v0[1])); w.y = pk2(gelu_tanh(v0[2]), gelu_tanh(v0[3])); w.z = pk2(gelu_tanh(v1[0]), gelu_tanh(v1[1])); w.w = pk2(gelu_tanh(v1[2]), gelu_tanh(v1[3]));
                    *(v4u*)(YGp + ((size_t)chunk * SSM_T + i) * SSM_W + 16 * g + 8 * (fq & 1)) = w; } }
    }
};
#ifndef MK_N_LAUNCHES
#define MK_N_LAUNCHES 1
#endif
#ifndef NARROW_WGM
#define NARROW_WGM 2
#endif
#ifndef SSM_FAST
#define SSM_FAST 1
#endif
constexpr int N_PHASES = 1 + 2 * (7 + (8 + MOE_NCHUNK + 1)) + (SSM_FAST ? 2 * DEPTH : 0);

__global__ void __launch_bounds__(NWAVES * 64, 2) fwd(Args args) {
    extern __shared__ __attribute__((aligned(16))) unsigned char lds[];
    Frame F;
    F.lds = (LAS unsigned char*)lds;
    F.MISC = (volatile LAS unsigned*)(F.lds + MISC_OFF);
    F.tid = threadIdx.x; F.lane = F.tid & 63; F.wave = __builtin_amdgcn_readfirstlane(F.tid >> 6);
    F.G = gridDim.x; F.gw = blockIdx.x * NWAVES + F.wave; F.NGW = F.G * NWAVES;
    unsigned char* ws = args.ws;
    F.ctl = (gu32*)(ws + WS_CTL);
    for (int u = F.tid; u < (LDS_BYTES - LDSCTL_OFF) / 4; u += NWAVES * 64) ((LAS unsigned*)(F.lds + LDSCTL_OFF))[u] = 0u;
    __syncthreads();
    XcdBarrier bar; bar.bar = (unsigned*)(F.ctl + CW_BAR); bar.x = 0; bar.st = nullptr;
    if (args.use_bar) bar = xcd_barrier_post((unsigned*)(F.ctl + CW_BAR), F.MISC + 8, F.wave);
    const int lo = args.ph_lo, hi = args.ph_hi; int ph = 0;
#ifndef MERGE_MASK
#define MERGE_MASK 7
#endif
#ifndef PHASE_MASK
#define PHASE_MASK 0xffffffffu
#endif
#define INP(k) ((lo <= ph && ph < hi) && ((PHASE_MASK >> (k)) & 1u))
#define OPQ() Frame Fp = F; { const int l_ = lane_id_fresh(); Fp.lane = l_; Fp.tid = (F.wave << 6) | l_; }
#ifdef PROBE_MASK
    unsigned long long tacc_ = 0ull, tst_ = 0ull;
#define PB_START(k) do { if ((PROBE_MASK >> (k)) & 1u) tst_ = __builtin_amdgcn_s_memrealtime(); } while (0)
#define PB_END(k) do { if ((PROBE_MASK >> (k)) & 1u) tacc_ += __builtin_amdgcn_s_memrealtime() - tst_; } while (0)
#else
#define PB_START(k) do {} while (0)
#define PB_END(k) do {} while (0)
#endif
#define SEAM() do { if (lo <= ph && ph + 1 < hi) xcd_barrier(bar, F.wave); ++ph; } while (0)
#define BIDQ() ({ int b_ = (int)blockIdx.x; asm volatile("" : "+s"(b_)); b_; })
    LAS unsigned char* ring = F.lds + RING_OFF;
#define XB ((bf16*)(ws + WS_XB))
#define SSQ ((float*)(ws + WS_SSQ))
#define Qb ((bf16*)(args.out + DO_Q))
#define MRG ((bf16*)(args.out + DO_MERGED))
#define GATES ((bf16*)(ws + WS_GATES))
#define YG ((bf16*)(ws + WS_YG))
#define BCAT ((bf16*)(ws + WS_BCAT))

    PB_START(0); if (INP(0)) { OPQ(); p0_prologue(Fp, args); if (SSM_FAST) ssm_tables(Fp, args); } SEAM(); PB_END(0);

    for (int l = 0; l < DEPTH; ++l) {
        unsigned char* wm = ws + WS_WMIX + (size_t)l * WMIX_STRIDE;
        PB_START(1); if (INP(1)) {
            if (FP8_INPROJ(l)) {
            pg8::Gemm g{(const bf16*)(ws + WS_XB8), (const bf16*)(wm + WM_IN), D / 2, D / 2, D / 2};   pg8::StaticOrder S; S.init(M / 256, N_INP / 256, F.G, BIDQ());
            EpiInProj<true> E{args.out, ws, l};
            pg8::gemm_phase<EpiInProj<true>, pg8::StaticOrder, true, true, false, true>(ring, g, S, E, F.wave);
            } else {
            pg8::Gemm g{XB, (const bf16*)(wm + WM_IN), D, D, D}; pg8::StaticOrder S; S.init(M / 256, N_INP / 256, F.G, BIDQ());
            EpiInProj<false> E{args.out, ws, l};
            pg8::gemm_phase<EpiInProj<false>, pg8::StaticOrder, true, true>(ring, g, S, E, F.wave);
            }
        } SEAM(); PB_END(1);
        PB_START(2); if (INP(2)) {
            OPQ();
#if SSM_FAST
            {
                const int gq = Fp.gw >> 4, gr = Fp.gw & 15, gwl = gq * 15 + (gr - 1), ngw = (Fp.NGW >> 4) * 15;
                if (gr == 0) { PB_START(16); for (int bh = gq; bh < BATCH * NH; bh += (Fp.NGW >> 4)) t1_cumsum(args, bh, Fp.lane); PB_END(16); }
                else {
                PB_START(19); for (int t = gwl; t < SSM_G * 128; t += ngw) ssm_expand_w(args, l, t, Fp.lane); PB_END(19);
#pragma unroll 4
                for (int t = gwl; t < SSM_G * 1024; t += ngw) ssm_expand_mv(args, l, t, Fp.lane);
                if (l & 1) cvt_moe_layer(args, l >> 1, l, (LAS float*)(F.lds + RING_OFF + F.wave * 16384), Fp.lane, gwl, ngw);
                }
                __syncthreads();
                PB_START(21); t1_conv_all(args, l, BIDQ(), F.G, ring, Fp.tid, F.wave, Fp.lane); PB_END(21);
            }
#endif
        } SEAM(); PB_END(2);
#if SSM_FAST
        PB_START(13); if (INP(13)) {
            pg8::Gemm g{(const bf16*)(ws + WS_UA), (const bf16*)(ws + WS_WG), SSM_KA, 1024, 1024}; GroupOrder S; S.so.init(SSM_G * 4, 1, F.G, BIDQ()); S.b_rows = 256; EpiSsmScan E{(const float*)(ws + WS_APOW), (bf16*)(ws + WS_UA), l};
            pg8::gemm_phase<EpiSsmScan, GroupOrder, true, true>(ring, g, S, E, F.wave);
        } SEAM(); PB_END(13);
        PB_START(15); if (INP(15)) {
            pg8::Gemm g{(const bf16*)(ws + WS_UA), (const bf16*)(ws + WS_MV), SSM_KA, SSM_KA, SSM_KA}; GroupOrder S; S.so.init(SSM_G * 4, 4, F.G, BIDQ()); S.b_rows = 1024; EpiSsmY E{YG};
            pg8::gemm_phase<EpiSsmY, GroupOrder, true, true>(ring, g, S, E, F.wave);
        } SEAM(); PB_END(15);
#endif
        PB_START(3); if (INP(3)) {
            { pg8::Gemm g{YG, (const bf16*)(wm + WM_GLU), 256, 256, 256}; pg8::StaticOrder S; S.init(M / 256, 2, F.G, BIDQ()); EpiGluSsm E{BCAT};
              pg8::gemm_phase<EpiGluSsm, pg8::StaticOrder, true, true>(ring, g, S, E, F.wave); }
#if ATTN_FAST
            { const attn_body::AttnTensors AT{(const attn_body::bf16*)Qb, (const attn_body::bf16*)(args.out + DO_K), (const attn_body::bf16*)(args.out + DO_V), (attn_body::bf16*)BCAT, (const float*)(ws + WS_FH)};
              const attn_body::StaticOrder SA((int)F.G, BIDQ());
              attn_body::attn_phase<attn_body::StaticOrder>((char*)lds + RING_OFF, AT, SA, F.wave); }
#endif
        } SEAM(); PB_END(3);
        PB_START(4); if (INP(4)) {
            pg8::StaticOrder S; S.init(M / 256, 4, F.G, BIDQ()); S.wgm = NARROW_WGM;
            pg8::Gemm g{BCAT, (const bf16*)(wm + WM_A), D, D, D};
            if (FP8_WO(l)) { EpiMergeCat<true> E{GATES, MRG}; pg8::gemm_phase<EpiMergeCat<true>, pg8::StaticOrder, true, true>(ring, g, S, E, F.wave); }
            else { EpiMergeCat<false> E{GATES, MRG}; pg8::gemm_phase<EpiMergeCat<false>, pg8::StaticOrder, true, true>(ring, g, S, E, F.wave); }
        } SEAM(); PB_END(4);
        PB_START(5); if (INP(5)) {
            pg8::StaticOrder S; S.init(M / 256, 4, F.G, BIDQ(), 1); S.wgm = NARROW_WGM;
            if (FP8_WO(l)) { pg8::Gemm g{MRG, (const bf16*)(wm + WM_O), D / 2, D / 2, D / 2};   EpiResid<true, 5> E{XB, SSQ, ws + WS_XB8}; pg8::gemm_phase<EpiResid<true, 5>, pg8::StaticOrder, true, true, false, true>(ring, g, S, E, F.wave); }
            else { pg8::Gemm g{MRG, (const bf16*)(wm + WM_O), D, D, D}; EpiResid<true, 0> E{XB, SSQ, ws + WS_XB8}; pg8::gemm_phase<EpiResid<true, 0>, pg8::StaticOrder, true, true>(ring, g, S, E, F.wave); }
        } SEAM(); PB_END(5);
        if (!(l & 1)) {
            unsigned char* wd = ws + WS_WDENSE + (size_t)(l >> 1) * WDENSE_STRIDE; bf16* const HID = (bf16*)(ws + WS_HID);
            PB_START(6); if (INP(6)) {
                if ((l >> 1) == FP8_DENSE_I) {
                pg8::Gemm g{(const bf16*)(ws + WS_XB8), (const bf16*)(wd + WD_GU), D / 2, D / 2, D / 2};   pg8::StaticOrder S; S.init(M / 256, 2 * D_FF / 256, F.G, BIDQ()); EpiSwiGlu<false, true> E{HID, D_FF, SSQ};
                pg8::gemm_phase<EpiSwiGlu<false, true>, pg8::StaticOrder, true, true, false, true>(ring, g, S, E, F.wave);
                } else {
                pg8::Gemm g{XB, (const bf16*)(wd + WD_GU), D, D, D}; pg8::StaticOrder S; S.init(M / 256, 2 * D_FF / 256, F.G, BIDQ()); EpiSwiGlu<false> E{HID, D_FF, SSQ};
                pg8::gemm_phase<EpiSwiGlu<false>, pg8::StaticOrder, true, true>(ring, g, S, E, F.wave);
                }
            } SEAM(); PB_END(6);
            PB_START(7); if (INP(7)) {
                if ((l >> 1) == FP8_DENSE_I) {
                pg8::Gemm g{HID, (const bf16*)(wd + WD_D), 64, D_FF / 2, D_FF / 2, nullptr, 256 * 128, (long)(D_FF / 128) * 256 * 128};   pg8::StaticOrder S; S.init(M / 256, 4, F.G, BIDQ(), 1); S.wgm = NARROW_WGM; EpiResid<true, 6> E{XB, SSQ, ws + WS_XB8};
                pg8::gemm_phase<EpiResid<true, 6>, pg8::StaticOrder, true, true, false, true>(ring, g, S, E, F.wave);
                } else {
                pg8::Gemm g{HID, (const bf16*)(wd + WD_D), 64, D_FF, D_FF, nullptr, 256 * 64 * 2, (long)(D_FF / 64) * 256 * 64 * 2};   pg8::StaticOrder S; S.init(M / 256, 4, F.G, BIDQ(), 1); S.wgm = NARROW_WGM; EpiResid<true, 0> E{XB, SSQ, ws + WS_XB8};
                pg8::gemm_phase<EpiResid<true, 0>, pg8::StaticOrder, true, true>(ring, g, S, E, F.wave);
                }
            } SEAM(); PB_END(7);
        } else {
            PB_START(8); if (INP(8)) { OPQ(); moe_route(Fp, args, l, l >> 1); } SEAM(); PB_END(8);
            PB_START(9); if (INP(9)) { OPQ(); moe_slots(Fp, args); } SEAM(); PB_END(9);
            const int* meta = (const int*)(ws + WS_META);
            for (int q = 0; q <= MOE_NCHUNK; ++q) {
                PB_START(10); if (INP(10)) {
                    const int total = meta[8], per = (total + MOE_NCHUNK - 1) / MOE_NCHUNK;
                    auto bnd = [&](int c) -> int { if (c <= 0) return 0; if (c >= MOE_NCHUNK) return total; if (MOE_NCHUNK == 2) return total > 256 ? total - 256 : total; return c * per < total ? c * per : total; };
                    int nMd = 0;
                    if (q > 0) {
                        const int ch = q - 1, tile0 = bnd(ch); const int nM = bnd(ch + 1) - tile0; nMd = nM;
                        pg8::Gemm g{(const bf16*)(ws + WS_MHID + (size_t)(ch & 1) * MHID_BYTES), (const bf16*)(ws + WS_WMOE + WMOE_D), 64, D_FFE / 2, D_FFE / 2, nullptr, 256 * 128, (long)(D_FFE / 128) * 256 * 128};
                        MoeOrder S; S.so.init(nM, 4, F.G, BIDQ(), 1); S.so.wgm = NARROW_WGM; S.tile0 = tile0; S.a_tile_off = 0; S.b_rows = D;
                        S.s1 = meta[1]; S.s2 = meta[2]; S.s3 = meta[3]; S.s4 = meta[4]; S.s5 = meta[5]; S.s6 = meta[6]; S.s7 = meta[7];
                        EpiMoeDown<true> E{(bf16*)args.out, (const int*)(ws + WS_RDEST) + (size_t)tile0 * 256, (const float*)(ws + WS_RW) + (size_t)tile0 * 256};
                        pg8::gemm_phase<EpiMoeDown<true>, MoeOrder, true, true, false, true>(ring, g, S, E, F.wave);
                    }
                    if (q < MOE_NCHUNK) {
                        const int ch = q, tile0 = bnd(ch); const int nM = bnd(ch + 1) - tile0;
                        pg8::Gemm g{(const bf16*)(ws + WS_XB8), (const bf16*)(ws + WS_WMOE + WMOE_GU), D / 2, D / 2, D / 2, (const int*)(ws + WS_RDEST)};
                        MoeOrder S; S.so.init(nM, 2 * D_FFE / 256, F.G, BIDQ()); S.tile0 = tile0; S.a_tile_off = tile0; S.b_rows = 2 * D_FFE;
                        S.s1 = meta[1]; S.s2 = meta[2]; S.s3 = meta[3]; S.s4 = meta[4]; S.s5 = meta[5]; S.s6 = meta[6]; S.s7 = meta[7];
                        if (q > 0) S.skew(4 * nMd);
                        EpiSwiGlu<true, true> E{(bf16*)(ws + WS_MHID + (size_t)(ch & 1) * MHID_BYTES), D_FFE, (const float*)(ws + WS_RRSTD) + (size_t)tile0 * 256};
                        pg8::gemm_phase<EpiSwiGlu<true, true>, MoeOrder, true, true, true, true>(ring, g, S, E, F.wave);
                    }
                } SEAM(); PB_END(10);
            }
            PB_START(12); if (INP(12)) { OPQ(); moe_combine(Fp, args, l == DEPTH - 1); } SEAM(); PB_END(12);
        }
    }
#ifdef PROBE_MASK
    if (blockIdx.x == 0) { const unsigned long long t0_ = __builtin_amdgcn_s_memrealtime(); while (__builtin_amdgcn_s_memrealtime() - t0_ < tacc_) __builtin_amdgcn_s_sleep(8); }
#endif
#undef INP
#undef BIDQ
#undef OPQ
#undef SEAM
}

extern "C" void kernel_launch(void* const* d_in, const int* in_sizes, int n_in, void* d_out, int out_size, void* d_ws, size_t ws_size, hipStream_t stream) {
    static int grid = 0;
    if (grid == 0) {
        if (n_in != 31 || in_sizes[0] != M * D || out_size != M * D || ws_size < WS_END) { fprintf(stderr, "kernel_launch: unexpected shapes/workspace (n_in %d, ws %zu, need %zu); nothing launched\n", n_in, ws_size, (size_t)WS_END); grid = -1; return; }
        int dev = 0, cus = 0, per_cu = 0;
        if (hipGetDevice(&dev) != hipSuccess || hipDeviceGetAttribute(&cus, hipDeviceAttributeMultiprocessorCount, dev) != hipSuccess) { grid = -1; return; }
        if (hipFuncSetAttribute((const void*)fwd, hipFuncAttributeMaxDynamicSharedMemorySize, LDS_BYTES) != hipSuccess) { fprintf(stderr, "kernel_launch: hipFuncSetAttribute failed\n"); grid = -1; return; }
        if (hipOccupancyMaxActiveBlocksPerMultiprocessor(&per_cu, (const void*)fwd, NWAVES * 64, LDS_BYTES) != hipSuccess || per_cu < 1)
            fprintf(stderr, "kernel_launch: note: occupancy query reports %d workgroups per CU\n", per_cu);
        (void)hipGetLastError();
        grid = cus;
    }
    if (grid < 0) return;
    if (hipMemsetAsync((char*)d_ws + WS_CTL, 0, CTL_ZERO_BYTES, stream) != hipSuccess) return;
    Args a{};
    for (int i = 0; i < 31; ++i) a.in[i] = (const float*)d_in[i];
    a.out = (unsigned char*)d_out; a.ws = (unsigned char*)d_ws; a.pad = 0;
#if MK_N_LAUNCHES == 1
    a.ph_lo = 0; a.ph_hi = N_PHASES; a.use_bar = 1;
    hipLaunchKernelGGL(fwd, dim3(grid), dim3(NWAVES * 64), LDS_BYTES, stream, a);
#else
    for (int p = 0; p < N_PHASES; ++p) { a.ph_lo = p; a.ph_hi = p + 1; a.use_bar = 0; hipLaunchKernelGGL(fwd, dim3(grid), dim3(NWAVES * 64), LDS_BYTES, stream, a); }
#endif
}
```

```cpp
#include <hip/hip_runtime.h>
#include <cstdio>
#include <cstdint>
#include <hip/hip_bf16.h>
#include <cmath>
#ifndef ATTN_FAST
#define ATTN_FAST 1
#endif
#define MK_N_LAUNCHES 1
__device__ __forceinline__ int lane_id_fresh() { int l; asm volatile("v_mbcnt_lo_u32_b32 %0, -1, 0\n\tv_mbcnt_hi_u32_b32 %0, -1, %0" : "=v"(l)); return l; }
namespace pg8 {
#define PG8_LAS __attribute__((address_space(3)))
typedef unsigned short bf16_t;
typedef short bf16x8 __attribute__((ext_vector_type(8)));
typedef float f32x4 __attribute__((ext_vector_type(4)));
typedef float f32x2 __attribute__((ext_vector_type(2)));
typedef unsigned u32x4 __attribute__((ext_vector_type(4)));
constexpr int BM = 256, BK = 64, HALF = 128, HTB = HALF * BK * 2  , STAGE_BYTES = 8 * HTB, NXCD = 8, WGM = 4;

__host__ __device__ __forceinline__ int lds_byte(int r, int c) { const int st = (r >> 4) * 2 + (c >> 5), rr = r & 15, cc = c & 31, ob = rr * 64 + cc * 2; return st * 1024 + (ob ^ (((ob >> 9) & 1) << 5)); }
__host__ __device__ __forceinline__ void stage_rc(int b, int& R, int& C) { const int st = b / 1024, sb = b % 1024, swz = sb ^ (((sb >> 9) & 1) << 5); R = (st >> 1) * 16 + swz / 64; C = (st & 1) * 32 + (swz % 64) / 2; }
__host__ __device__ __forceinline__ int perm32(int rho) { const int n = rho >> 4, i = rho & 15; return 8 * (i >> 2) + 4 * n + (i & 3); }

struct Unit { int pm, pn, arow, brow; };
struct Gemm { const bf16_t* A; const bf16_t* Bt; int lda, ldb, K; const int* a_rows = nullptr; int a_kstep = 0; long a_tstride = 0; };

struct StaticOrder {
    int nM, nN, nwg, G, c, rev, pm0 = 0, wgm = WGM;
    __host__ __device__ void init(int nM_, int nN_, int G_, int c_, int rev_ = 0) { nM = nM_; nN = nN_; nwg = nM * nN; G = G_; c = c_; rev = rev_; }
    __host__ __device__ bool next(int i, Unit& u) const { return unit_of((long)i * G + c, u); }
    __host__ __device__ bool unit_of(long L, Unit& u) const {
        if (L >= nwg) return false;
        int wgid = (int)L; { const int q = nwg / NXCD, r = nwg % NXCD, xcd = wgid % NXCD, off = wgid / NXCD; wgid = (xcd < r ? xcd * (q + 1) : r * (q + 1) + (xcd - r) * q) + off; }
        const int nig = wgm * nN, gid = wgid / nig, fm = gid * wgm, gsz = (nM - fm) < wgm ? (nM - fm) : wgm;
        u.pm = fm + ((wgid % nig) % gsz); if (rev) u.pm = nM - 1 - u.pm; u.pm += pm0; u.pn = (wgid % nig) / gsz; u.arow = u.pm * BM; u.brow = u.pn * BM; return true;
    }
};

typedef float f32x8_t __attribute__((ext_vector_type(8)));
__device__ __forceinline__ f32x4 lo4(f32x8_t a) { return __builtin_shufflevector(a, a, 0, 1, 2, 3); }
__device__ __forceinline__ f32x4 hi4(f32x8_t a) { return __builtin_shufflevector(a, a, 4, 5, 6, 7); }
__device__ __forceinline__ f32x8_t set_lo4(f32x8_t a, f32x4 c) { return __builtin_shufflevector(__builtin_shufflevector(c, c, 0, 1, 2, 3, -1, -1, -1, -1), a, 0, 1, 2, 3, 12, 13, 14, 15); }
__device__ __forceinline__ f32x8_t set_hi4(f32x8_t a, f32x4 c) { return __builtin_shufflevector(a, __builtin_shufflevector(c, c, 0, 1, 2, 3, -1, -1, -1, -1), 0, 1, 2, 3, 8, 9, 10, 11); }
typedef int v4i_t __attribute__((ext_vector_type(4)));
typedef int v8i_t __attribute__((ext_vector_type(8)));
__device__ __forceinline__ v8i_t cat8(bf16x8 a, bf16x8 b) { return __builtin_shufflevector(__builtin_bit_cast(v4i_t, a), __builtin_bit_cast(v4i_t, b), 0, 1, 2, 3, 4, 5, 6, 7); }
__device__ __forceinline__ unsigned cvt_pk_bf16(float lo, float hi) { unsigned r; asm volatile("v_cvt_pk_bf16_f32 %0, %1, %2" : "=v"(r) : "v"(lo), "v"(hi)); return r; }

constexpr int GA_MAX_UNITS = 36, GA_TAB_OFF = STAGE_BYTES + 1024;
template <class Epi, class Sched, bool ALIGN_EPI = false, bool SP2 = false, bool GATHER_A = false, bool FP8 = false>
__device__ __forceinline__ void gemm_phase(PG8_LAS unsigned char* lds, const Gemm g, const Sched& S, const Epi& E, const int wave_id) {
    const int tid_ = lane_id_fresh() | (wave_id << 6);
    const int tid = tid_, wid = __builtin_amdgcn_readfirstlane(tid >> 6), lane = tid & 63, wr = wid >> 2, wc = wid & 3, fr = lane & 15, fq = lane >> 4;
    const char* gA = (const char*)g.A; const char* gB = (const char*)g.Bt; asm volatile("" : "+s"(gA), "+s"(gB));
    int K_ = g.K; asm volatile("" : "+s"(K_));
    const int nt = K_ / BK, lda = g.lda, ldb = g.ldb;
    unsigned voffA[2], voffB[2];
    int gaR[2], gaC[2];
#pragma unroll
    for (int i = 0; i < 2; ++i) { int R, C; stage_rc(tid * 16 + i * 8192, R, C); const int Rb = Epi::PERM ? ((R & ~31) + perm32(R & 31)) : R; gaR[i] = R; gaC[i] = C * 2;
        voffA[i] = (unsigned)(R * lda + C) * 2u; voffB[i] = (unsigned)(Rb * ldb + C) * 2u; }
    const size_t kstep = (size_t)(BK * 2);
    const size_t kstepA = g.a_kstep ? (size_t)g.a_kstep : kstep;
    const size_t hstepA = (size_t)HALF * lda * 2, hstepB = (size_t)HALF * ldb * 2;
    const unsigned ldsw = (unsigned)wid * 1024u;
    const int aoff = lds_byte(wr * 64 + fr, fq * 8), boff = lds_byte(wc * 32 + fr, fq * 8);
#define PG8_SA(b, h) (((b) * 2 + (h)) * HTB)
#define PG8_SB(b, h) ((4 + (b) * 2 + (h)) * HTB)
#define PG8_STAGE(bufoff, gbase, voff) do { _Pragma("unroll") for (int _i = 0; _i < 2; ++_i) \
        __builtin_amdgcn_global_load_lds((const unsigned*)((const char*)(gbase) + (voff)[_i]), (PG8_LAS unsigned*)(lds + (bufoff) + ldsw + _i * 8192), 16, 0, 0); } while (0)
#define PG8_STAGE_G(bufoff, h, kofs, sel) do { _Pragma("unroll") for (int _i = 0; _i < 2; ++_i) { const unsigned vo_ = (sel) ? nvA[h][_i] : cvA[h][_i]; \
        __builtin_amdgcn_global_load_lds((const unsigned*)(gA + (kofs) + vo_), (PG8_LAS unsigned*)(lds + (bufoff) + ldsw + _i * 8192), 16, 0, 0); } } while (0)
#define PG8_STAGE_A(bufoff, ptr, h, kofs, sel) do { if constexpr (GATHER_A) PG8_STAGE_G(bufoff, h, kofs, sel); else PG8_STAGE(bufoff, ptr, voffA); } while (0)
#define PG8_GA_VOFF(dst, ui_) do { _Pragma("unroll") for (int h_ = 0; h_ < 2; ++h_) _Pragma("unroll") for (int i_ = 0; i_ < 2; ++i_) \
        dst[h_][i_] = (unsigned)tabL[(ui_) * 256 + h_ * 128 + gaR[i_]] * (unsigned)(lda * 2) + (unsigned)gaC[i_]; } while (0)
#define PG8_LDA(dst, b, h) do { _Pragma("unroll") for (int m = 0; m < 4; ++m) _Pragma("unroll") for (int k = 0; k < 2; ++k) dst[m][k] = *(const PG8_LAS bf16x8*)(lds + PG8_SA(b, h) + aoff + m * 2048 + k * 1024); } while (0)
#define PG8_LDA_HI(dst, b, h) do { _Pragma("unroll") for (int m = 0; m < 2; ++m) _Pragma("unroll") for (int k = 0; k < 2; ++k) dst[m][k] = *(const PG8_LAS bf16x8*)(lds + PG8_SA(b, h) + aoff + (m + 2) * 2048 + k * 1024); } while (0)
#define PG8_MFMA8(accv, a8, b8) asm volatile("v_mfma_f32_16x16x128_f8f6f4 %0, %1, %2, %0" : "+v"(accv) : "v"(a8), "v"(b8))
#define PG8_MMA8(ai, bj, At, Bt, mh) do { _Pragma("unroll") for (int m = 0; m < 2; ++m) _Pragma("unroll") for (int n = 0; n < 2; ++n) { \
        const v8i_t a8_ = cat8(Bt[n][0], Bt[n][1]), b8_ = cat8(At[m][0], At[m][1]); PG8_MFMA8(acc[ai][bj][(mh) * 2 + m][n], a8_, b8_); } } while (0)
#define PG8_MMA_PAIR(ai, b, h) do { PG8_MMA(ai, 0, At, B0); PG8_MMA(ai, 1, At, B1); } while (0)
#define PG8_LDB(dst, b, h) do { _Pragma("unroll") for (int n = 0; n < 2; ++n) _Pragma("unroll") for (int k = 0; k < 2; ++k) dst[n][k] = *(const PG8_LAS bf16x8*)(lds + PG8_SB(b, h) + boff + n * 2048 + k * 1024); } while (0)
#define PG8_MMA(ai, bj, At, Bt) do { __builtin_amdgcn_s_setprio(1); if constexpr (FP8) { _Pragma("unroll") for (int m = 0; m < 4; ++m) _Pragma("unroll") for (int n = 0; n < 2; ++n) { \
        const v8i_t a8_ = cat8(Bt[n][0], Bt[n][1]), b8_ = cat8(At[m][0], At[m][1]); PG8_MFMA8(acc[ai][bj][m][n], a8_, b8_); } } \
        else { _Pragma("unroll") for (int m = 0; m < 4; ++m) _Pragma("unroll") for (int n = 0; n < 2; ++n) _Pragma("unroll") for (int k = 0; k < 2; ++k) \
        acc[ai][bj][m][n] = __builtin_amdgcn_mfma_f32_16x16x32_bf16(Bt[n][k], At[m][k], acc[ai][bj][m][n], 0, 0, 0); } __builtin_amdgcn_s_setprio(0); } while (0)
#define PG8_WAIT_V(n) asm volatile("s_waitcnt vmcnt(" #n ")" ::: "memory")
#define PG8_WAIT_L(n) asm volatile("s_waitcnt lgkmcnt(" #n ")" ::: "memory")
#define PG8_BAR __builtin_amdgcn_s_barrier()
#define PG8_SCHED __builtin_amdgcn_sched_barrier(0)
    Unit cur, nxt; int ui = 0;
    if (!S.next(0, cur)) return;
    f32x4 acc[2][2][4][2];
#pragma unroll
    for (int a = 0; a < 2; ++a)
#pragma unroll
        for (int b = 0; b < 2; ++b)
#pragma unroll
            for (int m = 0; m < 4; ++m)
                { _Pragma("unroll") for (int n = 0; n < 2; ++n) acc[a][b][m][n] = (f32x4){0.f, 0.f, 0.f, 0.f}; }
    bf16x8 At[4][2], B0[2][2], B1[2][2];
    static_assert(!GATHER_A || SP2, "GATHER_A is written for the SP2 loop");
    const PG8_LAS unsigned short* tabL = (const PG8_LAS unsigned short*)(lds + GA_TAB_OFF);
    unsigned cvA[2][2] = {{0u, 0u}, {0u, 0u}}, nvA[2][2] = {{0u, 0u}, {0u, 0u}};
    if constexpr (GATHER_A) {
        Unit uu;
        for (int q = 0; q < GA_MAX_UNITS && S.next(q, uu); ++q) if (tid < 256) { const int v = g.a_rows[uu.arow + tid]; ((PG8_LAS unsigned short*)(lds + GA_TAB_OFF))[q * 256 + tid] = (unsigned short)(v < 0 ? 0 : (v >> 1)); }
        asm volatile("s_waitcnt vmcnt(0) lgkmcnt(0)" ::: "memory"); PG8_BAR; asm volatile("" ::: "memory");
        PG8_GA_VOFF(cvA, 0);
    }
    const char* cA = gA + (g.a_tstride ? (size_t)(cur.arow >> 8) * (size_t)g.a_tstride : (size_t)cur.arow * lda * 2); const char* cB = gB + (size_t)cur.brow * ldb * 2;
    if constexpr (SP2) {
        PG8_STAGE(PG8_SB(0, 0), cB, voffB); PG8_STAGE(PG8_SB(0, 1), cB + hstepB, voffB); PG8_STAGE_A(PG8_SA(0, 0), cA, 0, (size_t)0, false); PG8_STAGE_A(PG8_SA(0, 1), cA + hstepA, 1, (size_t)0, false);
        if (wr == 1) PG8_BAR;
        PG8_WAIT_V(2); PG8_BAR;
        PG8_STAGE(PG8_SB(1, 0), cB + kstep, voffB); PG8_STAGE_A(PG8_SA(1, 0), cA + kstepA, 0, kstep, false); PG8_STAGE(PG8_SB(1, 1), cB + hstepB + kstep, voffB);
        PG8_WAIT_V(6); PG8_BAR;
    } else {
        PG8_STAGE(PG8_SB(0, 0), cB, voffB); PG8_STAGE(PG8_SA(0, 0), cA, voffA); PG8_STAGE(PG8_SB(0, 1), cB + hstepB, voffB); PG8_STAGE(PG8_SA(0, 1), cA + hstepA, voffA);
        if (wr == 1) PG8_BAR;
        PG8_WAIT_V(4); PG8_BAR;
        PG8_STAGE(PG8_SB(1, 0), cB + kstep, voffB); PG8_STAGE(PG8_SA(1, 0), cA + kstep, voffA); PG8_STAGE(PG8_SB(1, 1), cB + hstepB + kstep, voffB);
        PG8_WAIT_V(6); PG8_BAR;
    }
    for (;;) {
        const bool has_next = S.next(ui + 1, nxt);
        const char* nA = has_next ? gA + (g.a_tstride ? (size_t)(nxt.arow >> 8) * (size_t)g.a_tstride : (size_t)nxt.arow * lda * 2) : cA; const char* nB = has_next ? gB + (size_t)nxt.brow * ldb * 2 : cB;
        if constexpr (GATHER_A) { if (has_next) PG8_GA_VOFF(nvA, ui + 1); else { nvA[0][0] = cvA[0][0]; nvA[0][1] = cvA[0][1]; nvA[1][0] = cvA[1][0]; nvA[1][1] = cvA[1][1]; } }
        for (int t = 0; t < nt; t += 2) {
            if constexpr (Epi::HOOKS) { if (t == Epi::H1 || t == Epi::H2) E.mid(acc, cur, t, wr, wc, fr, fq); }
            const bool last = (t == nt - 2);
            const char* a1 = cA + (size_t)(t + 1) * kstepA;
            const char* a2 = last ? nA : cA + (size_t)(t + 2) * kstepA; const char* b2 = last ? nB : cB + (size_t)(t + 2) * kstep;
            const char* a3 = a2 + kstepA; const char* b3 = b2 + kstep;
            const size_t k1 = (size_t)(t + 1) * kstep, k2 = last ? (size_t)0 : (size_t)(t + 2) * kstep;
            if constexpr (SP2) {
            PG8_LDB(B0, 0, 0); PG8_LDB(B1, 0, 1); PG8_SCHED; PG8_LDA(At, 0, 0); PG8_STAGE_A(PG8_SA(1, 1), a1 + hstepA, 1, k1, false);
            PG8_WAIT_V(8); PG8_WAIT_L(0); PG8_BAR; PG8_MMA_PAIR(0, 0, 0); PG8_BAR; PG8_SCHED;
            PG8_LDA(At, 0, 1); PG8_STAGE(PG8_SB(0, 0), b2, voffB); PG8_STAGE(PG8_SB(0, 1), b2 + hstepB, voffB); PG8_STAGE_A(PG8_SA(0, 0), a2, 0, k2, last);
            PG8_WAIT_V(8); PG8_WAIT_L(0); PG8_BAR; PG8_MMA_PAIR(1, 0, 1); PG8_BAR; PG8_SCHED;
            PG8_LDB(B0, 1, 0); PG8_LDB(B1, 1, 1); PG8_SCHED; PG8_LDA(At, 1, 0); PG8_STAGE_A(PG8_SA(0, 1), a2 + hstepA, 1, k2, last);
            PG8_WAIT_V(8); PG8_WAIT_L(0); PG8_BAR; PG8_MMA_PAIR(0, 1, 0); PG8_BAR; PG8_SCHED;
            PG8_LDA(At, 1, 1); PG8_STAGE(PG8_SB(1, 0), b3, voffB); PG8_STAGE(PG8_SB(1, 1), b3 + hstepB, voffB); PG8_STAGE_A(PG8_SA(1, 0), a3, 0, k2 + kstep, last);
            PG8_WAIT_V(8); PG8_WAIT_L(0); PG8_BAR; PG8_MMA_PAIR(1, 1, 1); PG8_BAR; PG8_SCHED;
            } else {
            PG8_LDB(B0, 0, 0); PG8_SCHED; PG8_LDA(At, 0, 0); PG8_STAGE(PG8_SA(1, 1), a1 + hstepA, voffA);
            PG8_WAIT_L(8); PG8_BAR; PG8_WAIT_L(0); PG8_MMA(0, 0, At, B0); PG8_BAR; PG8_SCHED;
            PG8_LDB(B1, 0, 1); PG8_STAGE(PG8_SB(0, 0), b2, voffB);
            PG8_BAR; PG8_WAIT_L(0); PG8_MMA(0, 1, At, B1); PG8_BAR;
            PG8_LDA(At, 0, 1); PG8_STAGE(PG8_SA(0, 0), a2, voffA);
            PG8_BAR; PG8_WAIT_L(0); PG8_MMA(1, 0, At, B0); PG8_BAR; PG8_SCHED;
            PG8_STAGE(PG8_SB(0, 1), b2 + hstepB, voffB);
            PG8_WAIT_V(6); PG8_BAR; PG8_MMA(1, 1, At, B1); PG8_BAR;
            PG8_LDB(B0, 1, 0); PG8_SCHED; PG8_LDA(At, 1, 0); PG8_STAGE(PG8_SA(0, 1), a2 + hstepA, voffA);
            PG8_WAIT_L(8); PG8_BAR; PG8_WAIT_L(0); PG8_MMA(0, 0, At, B0); PG8_BAR; PG8_SCHED;
            PG8_LDB(B1, 1, 1); PG8_STAGE(PG8_SB(1, 0), b3, voffB);
            PG8_BAR; PG8_WAIT_L(0); PG8_MMA(0, 1, At, B1); PG8_BAR;
            PG8_LDA(At, 1, 1); PG8_STAGE(PG8_SA(1, 0), a3, voffA);
            PG8_BAR; PG8_WAIT_L(0); PG8_MMA(1, 0, At, B0); PG8_BAR; PG8_SCHED;
            PG8_STAGE(PG8_SB(1, 1), b3 + hstepB, voffB);
            PG8_WAIT_V(6); PG8_BAR; PG8_MMA(1, 1, At, B1); PG8_BAR;
            }
        }
        if constexpr (ALIGN_EPI) { if (wr == 0) PG8_BAR; }
        if constexpr (FP8) asm volatile("s_nop 15\n\ts_nop 15" ::: "memory");
        if constexpr (!Epi::AFTER_DRAIN) { E(acc, cur, wr, wc, fr, fq);
#ifdef PROBE_EPI2
            if constexpr (!Epi::RMW) { asm volatile("" ::: "memory"); E(acc, cur, wr, wc, fr, fq); }
#endif
        }
        if (!has_next) break;
#pragma unroll
        for (int a = 0; a < 2; ++a)
#pragma unroll
            for (int b = 0; b < 2; ++b)
#pragma unroll
                for (int m = 0; m < 4; ++m)
                    { _Pragma("unroll") for (int n = 0; n < 2; ++n) acc[a][b][m][n] = (f32x4){0.f, 0.f, 0.f, 0.f}; }
        cur = nxt; cA = nA; cB = nB; ++ui;
        if constexpr (GATHER_A) { cvA[0][0] = nvA[0][0]; cvA[0][1] = nvA[0][1]; cvA[1][0] = nvA[1][0]; cvA[1][1] = nvA[1][1]; }
        if constexpr (ALIGN_EPI) { if (wr == 1) PG8_BAR; }
    }
    PG8_WAIT_V(0);
    if constexpr (!ALIGN_EPI) { if (wr == 0) PG8_BAR; }
    PG8_BAR;
    if constexpr (Epi::AFTER_DRAIN) E.fused(acc, cur, wr, wc, fr, fq, lds, tid);
#undef PG8_SA
#undef PG8_SB
#undef PG8_STAGE
#undef PG8_STAGE_G
#undef PG8_STAGE_A
#undef PG8_GA_VOFF
#undef PG8_LDA
#undef PG8_LDB
#undef PG8_MMA
#undef PG8_WAIT_V
#undef PG8_WAIT_L
#undef PG8_BAR
#undef PG8_SCHED
}
}
constexpr int NWAVES = 8;
constexpr int BATCH = 16, SEQ = 4096, D = 1024, DEPTH = 4, M = BATCH * SEQ;
constexpr int NH = 8, HD = 64, ATT_W = 512, SSM_W = 256, SSM_G = 16, SSM_P = 64, SSM_H = 16, CONV_W = 256, CONV_K = 31;
constexpr int N_IN = 5384, N_INP = 5632, D_FF = 2816, NE = 8, D_FFE = 3584;
constexpr float EPS = 1e-6f;
constexpr float LOG2E = 1.4426950408889634f;
constexpr float QSCALE = 0.125f * LOG2E;
constexpr int MOE_ROWS_CAP = 133120;
constexpr int MOE_NCHUNK = 2, MOE_CHUNK_TILES_CAP = 264;

constexpr size_t MiB = 1u << 20;
constexpr size_t WS_CTL = 0, CTL_ZERO_BYTES = 1 * MiB;
constexpr size_t WS_BPERM = 1 * MiB;
constexpr size_t WS_TOKE = 2 * MiB;
constexpr size_t WS_TOKW = 3 * MiB;
constexpr size_t WS_CNTW = 4 * MiB;
constexpr size_t WS_META = 4 * MiB + 512 * 1024;
constexpr size_t WS_RDEST = 5 * MiB;
constexpr size_t WS_RW = 6 * MiB;
constexpr size_t WS_RRSTD = 7 * MiB;
constexpr size_t WS_WMIX = 16 * MiB, WMIX_STRIDE = 16 * MiB;
constexpr size_t WM_IN = 0, WM_GLU = 11 * MiB, WM_A = WM_GLU + 256 * 1024, WM_S = WM_A + 1 * MiB, WM_C = WM_S + 512 * 1024, WM_O = WM_C + 512 * 1024;
constexpr size_t WS_WDENSE = 80 * MiB, WDENSE_STRIDE = 16 * MiB + 512 * 1024;
constexpr size_t WD_GU = 0, WD_D = 11 * MiB;
constexpr size_t WS_WMOE = 113 * MiB;
constexpr size_t WMOE_GU = 0, WMOE_D = 112 * MiB;
constexpr size_t WS_XB = 281 * MiB;
constexpr size_t WS_SSQ = 409 * MiB;
constexpr size_t WS_LOGF = 413 * MiB;
constexpr size_t WS_FH = 415 * MiB;
constexpr size_t WS_BIG = 417 * MiB;
constexpr size_t WS_GATES = WS_BIG;
constexpr size_t WS_YG = WS_BIG + 384 * MiB;
constexpr size_t WS_BCAT = WS_YG + 32 * MiB;
constexpr size_t WS_CONVO = WS_BCAT + 96 * MiB;
constexpr size_t WS_HID = WS_BIG;
constexpr size_t WS_XG = WS_BIG;
constexpr size_t WS_XB8 = WS_BIG + 480 * MiB;
constexpr size_t WS_MHID = WS_BIG, MHID_BYTES = 232 * MiB;
constexpr size_t WS_UA = WS_BCAT + 128 * MiB;
constexpr size_t WS_MV = WS_UA + 36 * MiB;
constexpr size_t WS_WG = WS_MV + 36 * MiB;
constexpr size_t WS_APOW = 8 * MiB;
constexpr size_t WS_BBAR = 11 * MiB;
constexpr size_t WS_KTAB = 12 * MiB;
constexpr size_t WS_END = WS_WG + 8 * MiB;
static_assert(WS_MHID + 2 * MHID_BYTES <= WS_XB8, "ws map"); static_assert((size_t)MOE_CHUNK_TILES_CAP * 256 * 3584 <= MHID_BYTES, "ws map");
static_assert(WS_HID + 352 * MiB <= WS_END, "ws map");
constexpr size_t DO_Q = 0, DO_K = 64 * MiB, DO_V = 128 * MiB, DO_U = 192 * MiB, DO_HC = 224 * MiB, DO_MERGED = 64 * MiB;

constexpr int CW_TMO = 0, CW_CODE = 1;
constexpr int CW_BAR = 4096;

constexpr int RING_OFF = 0, RING_BYTES = 131072;
constexpr int LDSCTL_OFF = RING_BYTES, MISC_OFF = LDSCTL_OFF + 320;
constexpr int LDS_BYTES = 150528;
static_assert(pg8::GA_TAB_OFF + pg8::GA_MAX_UNITS * 512 <= LDS_BYTES, "LDS map");

#define GAS __attribute__((address_space(1)))
#define LAS __attribute__((address_space(3)))
typedef unsigned short bf16;
typedef unsigned v4u __attribute__((ext_vector_type(4)));
typedef unsigned v2u __attribute__((ext_vector_type(2)));
typedef float f32x4 __attribute__((ext_vector_type(4)));
typedef float f32x2 __attribute__((ext_vector_type(2)));
typedef GAS unsigned gu32;
#define RLX_AGENT __ATOMIC_RELAXED, __HIP_MEMORY_SCOPE_AGENT
#define LDS_WAIT() asm volatile("s_waitcnt lgkmcnt(0)" ::: "memory")
#define VM_WAIT() asm volatile("s_waitcnt vmcnt(0)" ::: "memory")
__device__ __forceinline__ unsigned f2bf(float f) { unsigned u = __builtin_bit_cast(unsigned, f); return (u + 0x7fffu + ((u >> 16) & 1u)) >> 16; }
__device__ __forceinline__ unsigned pk2(float lo, float hi) { return pg8::cvt_pk_bf16(lo, hi); }
__device__ __forceinline__ float bflo(unsigned u) { return __builtin_bit_cast(float, u << 16); }
__device__ __forceinline__ float bfhi(unsigned u) { return __builtin_bit_cast(float, u & 0xffff0000u); }
__device__ __forceinline__ float bf1(bf16 h) { return __builtin_bit_cast(float, (unsigned)h << 16); }
__device__ __forceinline__ float sigmoidf_(float x) { return __builtin_amdgcn_rcpf(1.0f + __builtin_amdgcn_exp2f(-1.4426950408889634f * x)); }
__device__ __forceinline__ float wave_sum(float v) {
#pragma unroll
    for (int o = 1; o < 64; o <<= 1) v += __shfl_xor(v, o);
    return v;
}

#define XB_TMO      128
#define XB_XCNT(j)  (256  + 64 * (j))
#define XB_XSUB(j)  (1280 + 64 * (j))
#define XB_XGEN(j)  (2304 + 64 * (j))
#define XB_TOP      3328
#define XB_TOPGEN   3392
#define XCD_BAR_WORDS 3456
#define XB_SPIN_CAP (1u << 18)

__device__ __forceinline__ unsigned xb_ld(unsigned* p)              { return __hip_atomic_load(p, __ATOMIC_RELAXED, __HIP_MEMORY_SCOPE_AGENT); }
__device__ __forceinline__ unsigned xb_add(unsigned* p, unsigned v) { return __hip_atomic_fetch_add(p, v, __ATOMIC_RELAXED, __HIP_MEMORY_SCOPE_AGENT); }
__device__ __forceinline__ unsigned xb_xcc_id() { return (unsigned)__builtin_amdgcn_s_getreg((3 << 11) | 20) & 0xFu; }
#define XB_SPIN(cond, bar) do { unsigned _sp = 0; while (cond) { __builtin_amdgcn_s_sleep(1); \
    if ((++_sp & 255u) == 0u) { if (xb_ld(&(bar)[XB_TMO])) break; if (_sp > XB_SPIN_CAP) { atomicAdd(&(bar)[XB_TMO], 1u); break; } } } } while (0)

struct XcdBarrier {
    unsigned* bar; unsigned x;
    volatile LAS unsigned* st;
};
__device__ __forceinline__ bool xb_thread0(int wave_id) { return wave_id == 0 && lane_id_fresh() == 0; }
__device__ __forceinline__ XcdBarrier xcd_barrier_post(unsigned* bar, volatile LAS unsigned* st, int wave_id) {
    XcdBarrier b; b.bar = bar; b.x = xb_xcc_id(); b.st = st;
    if (xb_thread0(wave_id)) (void)xb_add(&bar[XB_XCNT(b.x)], 1u);
    return b;
}
__device__ __forceinline__ void xcd_barrier_complete(unsigned* bar, unsigned x, unsigned& nloc, unsigned& nx) {
    const unsigned G = gridDim.x * gridDim.y * gridDim.z;
    unsigned sum, cnt, mine, sp = 0u;
    for (;;) {
        sum = 0u; cnt = 0u; mine = 0u;
#pragma unroll
        for (unsigned j = 0; j < 16; ++j) { const unsigned c = xb_ld(&bar[XB_XCNT(j)]); sum += c; cnt += (c > 0u) ? 1u : 0u; mine = (j == x) ? c : mine; }
        if (sum == G) break;
        __builtin_amdgcn_s_sleep(1);
        if ((++sp & 255u) == 0u) { if (xb_ld(&bar[XB_TMO])) break; if (sp > XB_SPIN_CAP) { atomicAdd(&bar[XB_TMO], 1u); break; } }
    }
    nloc = mine > 0u ? mine : 1u; nx = cnt > 0u ? cnt : 1u;
}
__device__ __forceinline__ void xcd_barrier(const XcdBarrier& b, int wave_id) {
    asm volatile("s_waitcnt vmcnt(0)" ::: "memory");
    __syncthreads();
    if (xb_thread0(wave_id)) {
        unsigned* bar = b.bar;
        __builtin_amdgcn_s_waitcnt(0);
        unsigned nloc = b.st[0], nx = b.st[1];
        if (nloc == 0u) { xcd_barrier_complete(bar, b.x, nloc, nx); b.st[0] = nloc; b.st[1] = nx; }
        const unsigned old = xb_add(&bar[XB_XSUB(b.x)], 1u);
        const unsigned gen = old / nloc;
        if (old + 1u == (gen + 1u) * nloc) {
            __builtin_amdgcn_fence(__ATOMIC_RELEASE, "agent");
            asm volatile("s_waitcnt vmcnt(0)" ::: "memory");
            const unsigned og = xb_add(&bar[XB_TOP], 1u);
            const unsigned tg = og / nx;
            if (og + 1u == (tg + 1u) * nx) xb_add(&bar[XB_TOPGEN], 1u);
            else XB_SPIN(xb_ld(&bar[XB_TOPGEN]) == tg, bar);
            __builtin_amdgcn_fence(__ATOMIC_ACQUIRE, "agent");
            xb_add(&bar[XB_XGEN(b.x)], 1u);
            asm volatile("s_waitcnt vmcnt(0)" ::: "memory");
        } else {
            XB_SPIN(xb_ld(&bar[XB_XGEN(b.x)]) == gen, bar);
            __builtin_amdgcn_fence(__ATOMIC_ACQUIRE, "agent");
            asm volatile("s_waitcnt vmcnt(0)" ::: "memory");
        }
    }
    __syncthreads();
}


namespace attn_body {
using bf16=__hip_bfloat16;
using bf16x8=__attribute__((ext_vector_type(8)))short;
using s16x4=__attribute__((ext_vector_type(4)))short;
using f32x16=__attribute__((ext_vector_type(16)))float;
using u32x4=__attribute__((ext_vector_type(4)))unsigned;
using f32x4_t=__attribute__((ext_vector_type(4)))float;
constexpr int BATCH=16,NHEAD=8,SEQ=4096,D=64,DM=NHEAD*D;
constexpr int NW=8,QBLK=32,QB=QBLK*NW,KVBLK=64,NQB=SEQ/QB;
constexpr int ATTN_PITCH=DM, ATTN_UNIT_ROWS=QB, OPITCH=1024;
__device__ __forceinline__ int crow(int r,int hi){return (r&3)+8*(r>>2)+4*hi;}
#define SBAR() __builtin_amdgcn_sched_barrier(0)
__device__ __forceinline__ void cmask(f32x16&p0,f32x16&p1,int jb,int qrel,int hi){
  const float NEG=-INFINITY; int kb=64*jb+4*hi;
  #pragma unroll
  for(int r=0;r<16;++r){int kv=kb+(r&3)+8*(r>>2); if(kv>qrel)p0[r]=NEG; if(kv+32>qrel)p1[r]=NEG;}
}

constexpr int NSLOT=3, SLOTB=8192;
constexpr int LDS_K=0, LDS_V=NSLOT*SLOTB, LDS_WS=2*NSLOT*SLOTB, LDS_OST=LDS_WS+NW*64*4, LDS_KB=LDS_OST+NW*4096, LDS_BYTES=LDS_KB+SEQ*4;
constexpr float C2=0.125f*1.4426950408889634f;
__device__ __forceinline__ void glds16(const void*gsrc,unsigned lds_dst){unsigned keep;
  asm volatile("s_mov_b32 %0, m0\n\ts_mov_b32 m0, %2\n\ts_nop 0\n\tglobal_load_lds_dwordx4 %1, off\n\ts_mov_b32 m0, %0":"=&s"(keep):"v"(gsrc),"s"(lds_dst):"memory");}
__device__ __forceinline__ float max3f(float a,float b,float c){float r;asm("v_max3_f32 %0, %1, %2, %3":"=v"(r):"v"(a),"v"(b),"v"(c));return r;}
__device__ __forceinline__ float max2f(float a,float b){float r;asm("v_max_f32_e32 %0, %1, %2":"=v"(r):"v"(a),"v"(b));return r;}
__device__ __forceinline__ float fadd_s(float a,float b){float r;asm("v_add_f32_e32 %0, %1, %2":"=v"(r):"v"(a),"v"(b));return r;}
__device__ __forceinline__ float fsub_s(float a,float b){float r;asm("v_sub_f32_e32 %0, %1, %2":"=v"(r):"v"(a),"v"(b));return r;}
typedef float f32x2_t __attribute__((ext_vector_type(2))); typedef __bf16 bf16x2_t __attribute__((ext_vector_type(2)));
__device__ __forceinline__ unsigned cvtpk_s(float lo,float hi){f32x2_t v={lo,hi};bf16x2_t b=__builtin_convertvector(v,bf16x2_t);return __builtin_bit_cast(unsigned,b);}
#define WAIT_BAR(N) asm volatile("s_waitcnt vmcnt(" #N ") lgkmcnt(0)\n\ts_barrier":::"memory")

__device__ __forceinline__ void qkt(f32x16&p0,f32x16&p1,const char*Kslot,const bf16x8*qr,const f32x16&negm,int r32,int hi){
  const char*kb=Kslot+hi*1024+r32*16;
  #pragma unroll
  for(int d0=0;d0<4;++d0){
    const bf16x8 b0=*reinterpret_cast<const bf16x8*>(kb+d0*2048);
    const bf16x8 b1=*reinterpret_cast<const bf16x8*>(kb+d0*2048+512);
    if(d0==0){p0=__builtin_amdgcn_mfma_f32_32x32x16_bf16(b0,qr[0],negm,0,0,0);p1=__builtin_amdgcn_mfma_f32_32x32x16_bf16(b1,qr[0],negm,0,0,0);}
    else{p0=__builtin_amdgcn_mfma_f32_32x32x16_bf16(b0,qr[d0],p0,0,0,0);p1=__builtin_amdgcn_mfma_f32_32x32x16_bf16(b1,qr[d0],p1,0,0,0);}}
}
typedef __attribute__((address_space(3))) const char* lds_cptr;
typedef short v4i16_t __attribute__((ext_vector_type(4)));
__device__ __forceinline__ void kload8(bf16x8*kf,lds_cptr kp){
  kf[0]=*(const __attribute__((address_space(3))) bf16x8*)(kp);      kf[1]=*(const __attribute__((address_space(3))) bf16x8*)(kp+512);
  kf[2]=*(const __attribute__((address_space(3))) bf16x8*)(kp+2048); kf[3]=*(const __attribute__((address_space(3))) bf16x8*)(kp+2560);
  kf[4]=*(const __attribute__((address_space(3))) bf16x8*)(kp+4096); kf[5]=*(const __attribute__((address_space(3))) bf16x8*)(kp+4608);
  kf[6]=*(const __attribute__((address_space(3))) bf16x8*)(kp+6144); kf[7]=*(const __attribute__((address_space(3))) bf16x8*)(kp+6656);
}
__device__ __forceinline__ void kload2(bf16x8*kf,lds_cptr kp,int j){ kf[2*j]=*(const __attribute__((address_space(3))) bf16x8*)(kp+j*2048); kf[2*j+1]=*(const __attribute__((address_space(3))) bf16x8*)(kp+j*2048+512); }
__device__ __forceinline__ s16x4 vtr(lds_cptr p){ return __builtin_bit_cast(s16x4,__builtin_amdgcn_ds_read_tr16_b64_v4i16((__attribute__((address_space(3))) v4i16_t*)p)); }
__device__ __forceinline__ float rowmax(const f32x16&p0,const f32x16&p1){
  float a=max3f(p0[0],p0[1],p1[0]),b=max3f(p0[2],p0[3],p1[1]);a=max3f(a,p1[2],p1[3]);
  #pragma unroll
  for(int r=4;r<16;r+=4){a=max3f(a,p0[r],p0[r+1]);b=max3f(b,p0[r+2],p0[r+3]);a=max3f(a,p1[r],p1[r+1]);b=max3f(b,p1[r+2],p1[r+3]);}
  const float m=max2f(a,b);
  auto rr=__builtin_amdgcn_permlane32_swap(__float_as_uint(m),__float_as_uint(m),false,false);
  return max2f(__uint_as_float(rr[0]),__uint_as_float(rr[1]));
}
__device__ __forceinline__ void pv(f32x16*o,int vb,bf16x8 pa0,bf16x8 pa1,bf16x8 pa2,bf16x8 pa3){
  #pragma unroll
  for(int d0=0;d0<2;++d0){s16x4 lo[4],hi[4];
    #pragma unroll
    for(int ks=0;ks<4;++ks){
      asm volatile("ds_read_b64_tr_b16 %0,%1 offset:%c2":"=&v"(lo[ks]):"v"(vb),"i"(d0*4096+ks*1024):"memory");
      asm volatile("ds_read_b64_tr_b16 %0,%1 offset:%c2":"=&v"(hi[ks]):"v"(vb),"i"(d0*4096+ks*1024+512):"memory");}
    asm volatile("s_waitcnt lgkmcnt(0)":::"memory");SBAR();
    #define PK(k) (bf16x8){lo[k][0],lo[k][1],lo[k][2],lo[k][3],hi[k][0],hi[k][1],hi[k][2],hi[k][3]}
    o[d0]=__builtin_amdgcn_mfma_f32_32x32x16_bf16(pa0,PK(0),o[d0],0,0,0);
    o[d0]=__builtin_amdgcn_mfma_f32_32x32x16_bf16(pa1,PK(1),o[d0],0,0,0);
    o[d0]=__builtin_amdgcn_mfma_f32_32x32x16_bf16(pa2,PK(2),o[d0],0,0,0);
    o[d0]=__builtin_amdgcn_mfma_f32_32x32x16_bf16(pa3,PK(3),o[d0],0,0,0);
    #undef PK
  }
}

#ifndef ATTN_STORE16
#define ATTN_STORE16(p,v) (*(u32x4*)(p)=(v))
#endif
template<int THRL> __device__ __forceinline__ void attn_unit(int b,int h,int qb,const bf16*Q,const bf16*__restrict__ K,const bf16*__restrict__ V,bf16*O,const float*Fh,char*shm,const int wave_id){
  const int tid_=lane_id_fresh()|(wave_id<<6);
  const int tid=tid_,lane=tid&63,r32=lane&31,hi=lane>>5; const int wid=__builtin_amdgcn_readfirstlane(tid>>6);
  const long rowbase=(long)b*SEQ; const int q0=qb*QB;
  const bf16*Qw=Q+(rowbase+q0+wid*QBLK)*DM+h*D;
  const int NT0=(q0+QB)/KVBLK; int ts;
  { float bvl=0.f; if(lane<NT0) bvl=(Fh[q0]-Fh[lane*KVBLK+KVBLK-1])*1.4426950408889634f;
    const unsigned long long alive=__ballot(lane<NT0 && bvl>=-100.f);
    ts=alive?(int)__builtin_ctzll(alive):NT0; ts&=~1; if(ts>NT0-4)ts=NT0-4; ts=__builtin_amdgcn_readfirstlane(ts); }
  const bf16*Kh=K+(rowbase+(long)ts*KVBLK)*DM+h*D,*Vh=V+(rowbase+(long)ts*KVBLK)*DM+h*D;
  const lds_cptr shm3=(lds_cptr)shm;
  const unsigned lds0=(unsigned)(uintptr_t)shm;
  float*wsf=(float*)(shm+LDS_WS)+wid*64;
  const bf16*ksrc=Kh+(long)lane*DM+wid*8;
  const bf16*vsrc=Vh+(long)(16*(wid&3)+(lane>>2))*DM+(wid>>2)*32+(lane&3)*8;
  const unsigned kdst=lds0+LDS_K+wid*1024, vdst=lds0+LDS_V+wid*1024;
  #define DMA_K(t,slot) glds16(ksrc+(long)(t)*KVBLK*DM,(unsigned)__builtin_amdgcn_readfirstlane(kdst+(slot)))
  #define DMA_V(t,slot) glds16(vsrc+(long)(t)*KVBLK*DM,(unsigned)__builtin_amdgcn_readfirstlane(vdst+(slot)))
  const int vb0=(int)(lds0+LDS_V)+((lane>>4)&1)*32+(lane&3)*8+(4*hi+((lane&15)>>2))*64;
  const char*Kbase=shm+LDS_K; bf16x8 kf[8];
  const lds_cptr kp0=shm3+LDS_K+hi*1024+r32*16; const lds_cptr vp0=shm3+LDS_V+((lane>>4)&1)*32+(lane&3)*8+(4*hi+((lane&15)>>2))*64;
  const int NT=NT0-ts;
  DMA_K(0,0);DMA_V(0,0);DMA_K(1,SLOTB);
  bf16x8 qr[4];
  #pragma unroll
  for(int d0=0;d0<4;++d0)qr[d0]=*reinterpret_cast<const bf16x8*>(&Qw[(long)r32*DM+d0*16+hi*8]);
  { const float fref=Fh[q0]; __attribute__((address_space(3))) float* kbt=(__attribute__((address_space(3))) float*)(shm3+LDS_KB);
    float fv[SEQ/(NW*64)];
    #pragma unroll
    for(int i=0;i<SEQ/(NW*64);++i){ const int k=ts*KVBLK+tid+i*NW*64; fv[i]=(k<q0+QB)?Fh[k]:0.f; }
    #pragma unroll
    for(int i=0;i<SEQ/(NW*64);++i){ const int k=ts*KVBLK+tid+i*NW*64; if(k<q0+QB) kbt[k]=(fref-fv[i])*1.4426950408889634f; } }
  const __attribute__((address_space(3))) float* kbp=(const __attribute__((address_space(3))) float*)(shm3+LDS_KB)+ts*KVBLK+4*hi;
  #define BIAS(P0,P1,t) do{ const __attribute__((address_space(3))) float* kp_=kbp+(t)*KVBLK; \
    _Pragma("unroll") for(int j_=0;j_<4;++j_){ const f32x4_t b0_=*(const __attribute__((address_space(3))) f32x4_t*)(kp_+8*j_); const f32x4_t b1_=*(const __attribute__((address_space(3))) f32x4_t*)(kp_+32+8*j_); \
      P0[4*j_]+=b0_[0];P0[4*j_+1]+=b0_[1];P0[4*j_+2]+=b0_[2];P0[4*j_+3]+=b0_[3]; P1[4*j_]+=b1_[0];P1[4*j_+1]+=b1_[1];P1[4*j_+2]+=b1_[2];P1[4*j_+3]+=b1_[3]; } }while(0)
  float mhat=0.f,l_reg=0.f;f32x16 o[2];o[0]=f32x16{};o[1]=f32x16{};f32x16 negm=f32x16{};asm volatile("":"+v"(negm));
  const int qrel=wid*QBLK+r32;
  #define CMASK(P0,P1,t) do{int jb_=(t)-(NT-4); if(jb_>=0)cmask(P0,P1,jb_,qrel,hi);}while(0)
  bool resc=false;
  #define START(P0,P1) do{ const float rm=rowmax(P0,P1); resc=false; \
    { const float dl=max2f(rm,kbq); mhat=fadd_s(mhat,dl); \
      _Pragma("unroll") for(int r=0;r<16;++r){P0[r]=fsub_s(P0[r],dl);P1[r]=fsub_s(P1[r],dl);} \
      _Pragma("unroll") for(int r=0;r<16;++r)negm[r]=-mhat; asm volatile("":"+v"(negm)); } \
    _Pragma("unroll") for(int r=0;r<16;++r)P0[r]=__builtin_amdgcn_exp2f(P0[r]); }while(0)
  #define RESC() do{ if(resc){ asm volatile("s_waitcnt lgkmcnt(0)":::"memory"); \
      _Pragma("unroll") for(int d_=0;d_<2;++d_) _Pragma("unroll") for(int r=0;r<16;++r)o[d_][r]*=wsf[crow(r,hi)]; } }while(0)
  f32x16 pA0,pA1,pB0,pB1;
  int sl_prev=0,sl_cur=0,sl_next=SLOTB;
  #define ROT() do{sl_prev=sl_cur;sl_cur=sl_next;sl_next=(sl_next==(NSLOT-1)*SLOTB)?0:sl_next+SLOTB;}while(0)
  DMA_K(2,2*SLOTB);
  WAIT_BAR(3);
  const float kbq=*((const __attribute__((address_space(3))) float*)(shm3+LDS_KB)+q0+qrel)+4.0f;
  qkt(pA0,pA1,Kbase,qr,negm,r32,hi);asm volatile("s_nop 15\n\ts_nop 7":"+v"(pA0),"+v"(pA1));BIAS(pA0,pA1,0);CMASK(pA0,pA1,0);
  START(pA0,pA1);
  _Pragma("unroll") for(int r=0;r<16;++r)pA1[r]=__builtin_amdgcn_exp2f(pA1[r]);
  WAIT_BAR(0);
  DMA_K(3,0);DMA_V(1,SLOTB);
  ROT();
  kload8(kf,kp0+sl_cur);
  WAIT_BAR(2);
  s16x4 vlo[8],vhi[8]; u32x4 pw0,pw1,pw2,pw3;
  #define PKW(P,B) cvtpk_s(P[B],P[B+1])
  #define PAF(k) __builtin_bit_cast(bf16x8,pw##k)
  #define VFR(i) (bf16x8){vlo[i][0],vlo[i][1],vlo[i][2],vlo[i][3],vhi[i][0],vhi[i][1],vhi[i][2],vhi[i][3]}
  #define PIN(x) asm volatile("":"+v"(x))
  #define MX3(a,b,c) __builtin_fmaxf(__builtin_fmaxf((a),(b)),(c))
  #define GAPA(MF,A0,A1,A2,A3,W0,W1,PW) do{ MF; sacc+=A0; sacc+=A1; sacc+=A2; sacc+=A3; PIN(sacc); W0; W1; PIN(PW); SBAR(); }while(0)
  #define EX(v) __builtin_amdgcn_exp2f(v)
  #define GAPB(MF,X,B) do{ MF; X[B]=EX(X[B]); X[B+1]=EX(X[B+1]); X[B+2]=EX(X[B+2]); X[B+3]=EX(X[B+3]); PIN(X); SBAR(); }while(0)
  #define VRD(i) do{ vlo[i]=vtr(vp_+(((i)>>2)*4096+((i)&3)*1024)); vhi[i]=vtr(vp_+(((i)>>2)*4096+((i)&3)*1024+512)); }while(0)
  #define KRD(G,j) do{ if(G){ kload2(kf,kp0+sl_next,j); SBAR(); } }while(0)
  #define STEP(C0,C1,P0,P1,t,GK,GV,GL) do{ SBAR(); \
    const lds_cptr vp_=vp0+sl_prev; \
    VRD(0); SBAR(); float sacc=(P0[0]+P0[1]); \
    GAPA(C0=__builtin_amdgcn_mfma_f32_32x32x16_bf16(kf[0],qr[0],negm,0,0,0), P0[2],P0[3],P0[4],P0[5],     pw0[0]=PKW(P0,0), pw0[1]=PKW(P0,2), pw0); \
    VRD(4); SBAR(); GAPA(C1=__builtin_amdgcn_mfma_f32_32x32x16_bf16(kf[1],qr[0],negm,0,0,0), P0[6],P0[7],P0[8],P0[9],     pw0[2]=PKW(P0,4), pw0[3]=PKW(P0,6), pw0); \
    VRD(1); SBAR(); GAPA(C0=__builtin_amdgcn_mfma_f32_32x32x16_bf16(kf[2],qr[1],C0,0,0,0),   P0[10],P0[11],P0[12],P0[13], pw1[0]=PKW(P0,8), pw1[1]=PKW(P0,10), pw1); \
    VRD(5); SBAR(); GAPA(C1=__builtin_amdgcn_mfma_f32_32x32x16_bf16(kf[3],qr[1],C1,0,0,0),   P0[14],P0[15],P1[0],P1[1],   pw1[2]=PKW(P0,12),pw1[3]=PKW(P0,14), pw1); \
    VRD(2); SBAR(); GAPA(C0=__builtin_amdgcn_mfma_f32_32x32x16_bf16(kf[4],qr[2],C0,0,0,0),   P1[2],P1[3],P1[4],P1[5],     pw2[0]=PKW(P1,0), pw2[1]=PKW(P1,2), pw2); \
    VRD(6); SBAR(); GAPA(C1=__builtin_amdgcn_mfma_f32_32x32x16_bf16(kf[5],qr[2],C1,0,0,0),   P1[6],P1[7],P1[8],P1[9],     pw2[2]=PKW(P1,4), pw2[3]=PKW(P1,6), pw2); \
    VRD(3); SBAR(); GAPA(C0=__builtin_amdgcn_mfma_f32_32x32x16_bf16(kf[6],qr[3],C0,0,0,0),   P1[10],P1[11],P1[12],P1[13], pw3[0]=PKW(P1,8), pw3[1]=PKW(P1,10), pw3); \
    VRD(7); SBAR(); GAPA(C1=__builtin_amdgcn_mfma_f32_32x32x16_bf16(kf[7],qr[3],C1,0,0,0),   P1[14],P1[15],0.f,0.f,       pw3[2]=PKW(P1,12),pw3[3]=PKW(P1,14), pw3); \
    l_reg+=sacc; \
    if(GK){DMA_K((t)+3,sl_cur);} if(GV){DMA_V((t)+1,sl_next);} \
    BIAS(C0,C1,t); CMASK(C0,C1,t); \
    { float a=MX3(C0[0],C0[1],C1[0]),b=MX3(C0[2],C0[3],C1[1]); a=MX3(a,C1[2],C1[3]); \
      _Pragma("unroll") for(int r=4;r<16;r+=4){a=MX3(a,C0[r],C0[r+1]);b=MX3(b,C0[r+2],C0[r+3]);a=MX3(a,C1[r],C1[r+1]);b=MX3(b,C1[r+2],C1[r+3]);} \
      float rm=__builtin_fmaxf(a,b); { auto rr=__builtin_amdgcn_permlane32_swap(__float_as_uint(rm),__float_as_uint(rm),false,false); rm=__builtin_fmaxf(__uint_as_float(rr[0]),__uint_as_float(rr[1])); } \
      resc=false; \
      if(__builtin_expect(__any(rm>(float)THRL),0)){ const float dl=__builtin_fmaxf(rm,0.f); mhat+=dl; \
        _Pragma("unroll") for(int r=0;r<16;++r){C0[r]-=dl;C1[r]-=dl;} \
        _Pragma("unroll") for(int r=0;r<16;++r)negm[r]=-mhat; asm volatile("":"+v"(negm)); \
        const float f=__builtin_amdgcn_exp2f(-dl); l_reg*=f; if(hi==0)wsf[r32]=f; resc=true; } } \
    SBAR(); \
    GAPB(o[0]=__builtin_amdgcn_mfma_f32_32x32x16_bf16(PAF(0),VFR(0),o[0],0,0,0), C0,0); \
    GAPB(o[1]=__builtin_amdgcn_mfma_f32_32x32x16_bf16(PAF(0),VFR(4),o[1],0,0,0), C0,4); \
    KRD(GL,0); GAPB(o[0]=__builtin_amdgcn_mfma_f32_32x32x16_bf16(PAF(1),VFR(1),o[0],0,0,0), C0,8); \
    KRD(GL,1); GAPB(o[1]=__builtin_amdgcn_mfma_f32_32x32x16_bf16(PAF(1),VFR(5),o[1],0,0,0), C0,12); \
    KRD(GL,2); GAPB(o[0]=__builtin_amdgcn_mfma_f32_32x32x16_bf16(PAF(2),VFR(2),o[0],0,0,0), C1,0); \
    KRD(GL,3); GAPB(o[1]=__builtin_amdgcn_mfma_f32_32x32x16_bf16(PAF(2),VFR(6),o[1],0,0,0), C1,4); \
    GAPB(o[0]=__builtin_amdgcn_mfma_f32_32x32x16_bf16(PAF(3),VFR(3),o[0],0,0,0), C1,8); \
    GAPB(o[1]=__builtin_amdgcn_mfma_f32_32x32x16_bf16(PAF(3),VFR(7),o[1],0,0,0), C1,12); \
    }while(0)
  int t=1;
  #undef CMASK
  #define CMASK(P0,P1,t) do{}while(0)
  for(;t+5<NT;t+=2){
    STEP(pB0,pB1,pA0,pA1,t,true,true,true);     WAIT_BAR(2); RESC(); ROT();
    STEP(pA0,pA1,pB0,pB1,t+1,true,true,true);   WAIT_BAR(2); RESC(); ROT();
  }
  #undef CMASK
  #define CMASK(P0,P1,t) do{int jb_=(t)-(NT-4); if(jb_>=0)cmask(P0,P1,jb_,qrel,hi);}while(0)
  #define ENDW(tt) do{ if((tt)+3<NT){WAIT_BAR(2);} else if((tt)+2<NT){WAIT_BAR(1);} else {WAIT_BAR(0);} }while(0)
  for(;t+1<NT;t+=2){
    STEP(pB0,pB1,pA0,pA1,t,(t+3<NT),(t+1<NT),(t+1<NT));       ENDW(t);   RESC(); ROT();
    STEP(pA0,pA1,pB0,pB1,t+1,(t+4<NT),(t+2<NT),(t+2<NT));     ENDW(t+1); RESC(); ROT();
  }
  STEP(pB0,pB1,pA0,pA1,NT-1,false,false,false); RESC();
  { float sacc=pB0[0]+pB0[1]; _Pragma("unroll") for(int r=2;r<16;++r)sacc+=pB0[r]; _Pragma("unroll") for(int r=0;r<16;++r)sacc+=pB1[r]; l_reg+=sacc;
    pw0=(u32x4){PKW(pB0,0),PKW(pB0,2),PKW(pB0,4),PKW(pB0,6)};pw1=(u32x4){PKW(pB0,8),PKW(pB0,10),PKW(pB0,12),PKW(pB0,14)};pw2=(u32x4){PKW(pB1,0),PKW(pB1,2),PKW(pB1,4),PKW(pB1,6)};pw3=(u32x4){PKW(pB1,8),PKW(pB1,10),PKW(pB1,12),PKW(pB1,14)};
    SBAR(); pv(o,vb0+sl_cur,PAF(0),PAF(1),PAF(2),PAF(3)); }
  #undef PKW
  #undef PAF
  #undef VFR
  #undef PIN
  #undef MX3
  #undef GAPA
  #undef GAPB
  #undef EX
  #undef VRD
  #undef KRD
  #undef STEP
  #undef ENDW
  {auto rr=__builtin_amdgcn_permlane32_swap(__float_as_uint(l_reg),__float_as_uint(l_reg),false,false);l_reg=__uint_as_float(rr[0])+__uint_as_float(rr[1]);}
  if(hi==0)wsf[32+r32]=l_reg;asm volatile("s_waitcnt lgkmcnt(0)":::"memory");
  float rli[16];
  #pragma unroll
  for(int r=0;r<16;++r)rli[r]=__builtin_amdgcn_rcpf(wsf[32+crow(r,hi)]);
  bf16*Ow=O+(rowbase+q0+wid*QBLK)*OPITCH+h*D;
  { bf16*stg=(bf16*)(shm+LDS_OST)+wid*2048;
    #pragma unroll
    for(int r=0;r<16;++r){const int orow=crow(r,hi);
      #pragma unroll
      for(int d0=0;d0<2;++d0)stg[orow*64+d0*32+r32]=__float2bfloat16(o[d0][r]*rli[r]);}
    asm volatile("s_waitcnt lgkmcnt(0)":::"memory");
    #pragma unroll
    for(int i=0;i<4;++i){const int row=i*8+(lane>>3),ch=lane&7; const u32x4 v=*(const u32x4*)(stg+row*64+ch*8); ATTN_STORE16(Ow+(long)row*OPITCH+ch*8,v);} }
  asm volatile("s_waitcnt lgkmcnt(0)\n\ts_barrier":::"memory");
  #undef BIAS
  #undef DMA_K
  #undef DMA_V
  #undef CMASK
  #undef START
  #undef RESC
  #undef ROT
}
constexpr int ATTN_LDS_BYTES=LDS_BYTES;
struct AttnTensors { const bf16* Q; const bf16* K; const bf16* V; bf16* O; const float* Fh; };
struct AttnUnit { int bh; int qb; };
struct StaticOrder {
  int vcu,G;
  __device__ __forceinline__ explicit StaticOrder(int grid,int block):vcu((grid%8==0)?(block%8)*(grid/8)+block/8:block),G(grid){}
  __device__ __forceinline__ bool next(int i,AttnUnit&u)const{ const int L=(i>>3)*G+vcu; if(L>=BATCH*16)return false; const int hh=i&7,r=L&15,rot=(r+4*(hh>>1))&15; u.bh=(L>>4)*NHEAD+hh; u.qb=(hh&1)?15-rot:rot; return true; }
  __device__ __forceinline__ void a_ready(const AttnUnit&)const{}
  __device__ __forceinline__ void done(const AttnUnit&)const{}
};
template<class Sched,int THRL=8> __device__ __forceinline__ void attn_phase(char*lds,const AttnTensors&T,const Sched&S,const int wave_id){
  AttnUnit u;
  for(int i=0;S.next(i,u);++i){ S.a_ready(u); attn_unit<THRL>(u.bh/NHEAD,u.bh%NHEAD,u.qb,T.Q,T.K,T.V,T.O,T.Fh+(size_t)u.bh*SEQ,lds,wave_id); S.done(u); }
}
#undef SBAR
#undef WAIT_BAR
}
typedef pg8::f32x4 A4;
typedef A4 AccT[2][2][4][2];

__device__ __forceinline__ float row_rstd(const float* ssq, int row) {
    const f32x4* p = (const f32x4*)(ssq + (size_t)row * 16);
    const f32x4 a = p[0], b = p[1], c = p[2], d = p[3];
    const float s = (((a.x + a.y) + (a.z + a.w)) + ((b.x + b.y) + (b.z + b.w))) + (((c.x + c.y) + (c.z + c.w)) + ((d.x + d.y) + (d.z + d.w)));
    return rsqrtf(s * (1.0f / 1024.0f) + EPS);
}
__device__ __forceinline__ float row_rstd4(const float* ssq, int row, int fq) {
    const f32x4 a = ((const f32x4*)(ssq + (size_t)row * 16))[fq];
    float s = (a.x + a.y) + (a.z + a.w); s += __shfl_xor(s, 16); s += __shfl_xor(s, 32);
    return rsqrtf(s * (1.0f / 1024.0f) + EPS);
}
__device__ __forceinline__ v4u pack8(const A4& v0, const A4& v1) { v4u w; w.x = pk2(v0[0], v0[1]); w.y = pk2(v0[2], v0[3]); w.z = pk2(v1[0], v1[1]); w.w = pk2(v1[2], v1[3]); return w; }
__device__ __forceinline__ float clamp8(float v) { return __builtin_amdgcn_fmed3f(v, -448.0f, 448.0f); }
__device__ __forceinline__ unsigned pk4_fp8(float a, float b, float c, float d) { int w = __builtin_amdgcn_cvt_pk_fp8_f32(clamp8(a), clamp8(b), 0, false); w = __builtin_amdgcn_cvt_pk_fp8_f32(clamp8(c), clamp8(d), w, true); return (unsigned)w; }
__device__ __forceinline__ v2u pack8_fp8(const A4& v0, const A4& v1) { v2u w; w.x = pk4_fp8(v0[0], v0[1], v0[2], v0[3]); w.y = pk4_fp8(v1[0], v1[1], v1[2], v1[3]); return w; }
__device__ __forceinline__ void unpack8(const v4u w, A4& v0, A4& v1) { v0 = (A4){bflo(w.x), bfhi(w.x), bflo(w.y), bfhi(w.y)}; v1 = (A4){bflo(w.z), bfhi(w.z), bflo(w.w), bfhi(w.w)}; }
__device__ __forceinline__ A4 sig4(const A4& z) { return (A4){sigmoidf_(z[0]), sigmoidf_(z[1]), sigmoidf_(z[2]), sigmoidf_(z[3])}; }
__device__ __forceinline__ A4 ex4(const A4& z) { return (A4){__builtin_amdgcn_exp2f(z[0]), __builtin_amdgcn_exp2f(z[1]), __builtin_amdgcn_exp2f(z[2]), __builtin_amdgcn_exp2f(z[3])}; }
__device__ __forceinline__ A4 rc4(const A4& z) { return (A4){__builtin_amdgcn_rcpf(z[0]), __builtin_amdgcn_rcpf(z[1]), __builtin_amdgcn_rcpf(z[2]), __builtin_amdgcn_rcpf(z[3])}; }
__device__ __forceinline__ float logsig(float z) { return fminf(z, 0.f) - __logf(1.0f + __expf(-fabsf(z))); }

template <bool FP8 = false> struct EpiInProj {
    static constexpr bool PERM = true, AFTER_DRAIN = false, HOOKS = false, RMW = false;
    unsigned char* outb; unsigned char* wsb; int layer;
    __device__ __forceinline__ void operator()(const AccT& acc, const pg8::Unit& u, int wr, int wc, int fr, int fq) const {
        const int pn = u.pn, row0 = u.pm * 256 + wr * 64 + fr, cw = wc * 32 + 8 * fq;
        bf16* const Q = (bf16*)(outb + DO_Q); bf16* const K = (bf16*)(outb + DO_K); bf16* const V = (bf16*)(outb + DO_V); bf16* const U = (bf16*)(outb + DO_U); bf16* const HC = (bf16*)(outb + DO_HC);
        bf16* const G = (bf16*)(wsb + WS_GATES); float* const logf = (float*)(wsb + WS_LOGF); const float* const bias = (const float*)(wsb + WS_BPERM) + layer * N_INP; const float* const ssq = (const float*)(wsb + WS_SSQ);
#define IP_LOADS() float rs[2][4]; _Pragma("unroll") for (int ai = 0; ai < 2; ++ai) _Pragma("unroll") for (int m = 0; m < 4; ++m) rs[ai][m] = row_rstd4(ssq, row0 + ai * 128 + m * 16, fq) * (FP8 ? 0.03125f : 1.0f); \
        A4 bv[2][2]; _Pragma("unroll") for (int bj = 0; bj < 2; ++bj) _Pragma("unroll") for (int n = 0; n < 2; ++n) bv[bj][n] = *(const A4*)(bias + pn * 256 + bj * 128 + cw + 4 * n)
        if (pn == 7 || pn == 8) {
            IP_LOADS();
#pragma unroll
            for (int ai = 0; ai < 2; ++ai)
#pragma unroll
                for (int m = 0; m < 4; ++m) { const int row = row0 + ai * 128 + m * 16; const float r = rs[ai][m];
                    const A4 a0 = acc[ai][0][m][0] * r + bv[0][0], a1 = acc[ai][0][m][1] * r + bv[0][1], g0 = acc[ai][1][m][0] * r + bv[1][0], g1 = acc[ai][1][m][1] * r + bv[1][1];
                    *(v4u*)(HC + (size_t)row * 256 + (pn - 7) * 128 + cw) = pack8(a0 * sig4(g0), a1 * sig4(g1)); asm volatile("" ::: "memory"); }
        } else if (pn == 21) {
            if (wc == 0) {
                IP_LOADS();
                if (fq == 0) {
#pragma unroll
                for (int ai = 0; ai < 2; ++ai)
#pragma unroll
                    for (int m = 0; m < 4; ++m) { const int row = row0 + ai * 128 + m * 16; const float r = rs[ai][m];
                        const A4 z0 = acc[ai][0][m][0] * r + bv[0][0], z1 = acc[ai][0][m][1] * r + bv[0][1];
                        *(A4*)(logf + (size_t)row * 8) = (A4){logsig(z0[0]), logsig(z0[1]), logsig(z0[2]), logsig(z0[3])};
                        *(A4*)(logf + (size_t)row * 8 + 4) = (A4){logsig(z1[0]), logsig(z1[1]), logsig(z1[2]), logsig(z1[3])}; }
                }
            }
        } else {
            if (pn >= 9) {
                IP_LOADS();
                A4 bn[2][2];
#pragma unroll
                for (int bj = 0; bj < 2; ++bj)
#pragma unroll
                    for (int n = 0; n < 2; ++n) bn[bj][n] = bv[bj][n] * -LOG2E;
                const int gi = (pn - 9) >> 2, pq = (pn - 9) & 3, tix = ((wr * 4 + wc) << 6) | (fq << 4) | fr;
                v4u* gb = (v4u*)G + ((size_t)((gi * 256 + u.pm) * 4 + pq) * 16) * 512 + tix;
#pragma unroll
                for (int ai = 0; ai < 2; ++ai)
#pragma unroll
                    for (int m = 0; m < 4; ++m) { const float rn = rs[ai][m] * -LOG2E;
#pragma unroll
                        for (int bj = 0; bj < 2; ++bj) { A4 v0 = acc[ai][bj][m][0] * rn + bn[bj][0], v1 = acc[ai][bj][m][1] * rn + bn[bj][1];
                            v0 = rc4(ex4(__builtin_elementwise_min(v0, (A4){40.f, 40.f, 40.f, 40.f})) + 1.0f); v1 = rc4(ex4(__builtin_elementwise_min(v1, (A4){40.f, 40.f, 40.f, 40.f})) + 1.0f);
                            gb[(size_t)(((ai * 4 + m) * 2 + bj)) * 512] = pack8(v0, v1); } asm volatile("" ::: "memory"); }
            } else {
            bf16* base; int ld, col0; float sc = 1.f;
            if (pn < 6) { base = pn < 2 ? Q : (pn < 4 ? K : V); ld = 512; col0 = (pn & 1) * 256; sc = pn < 2 ? QSCALE : 1.f; }
            else { base = U; ld = 256; col0 = 0; }
            IP_LOADS();
#pragma unroll
            for (int ai = 0; ai < 2; ++ai)
#pragma unroll
                for (int m = 0; m < 4; ++m) { const int row = row0 + ai * 128 + m * 16; const float r = rs[ai][m]; bf16* rowp = base + (size_t)row * ld + col0 + cw;
#pragma unroll
                    for (int bj = 0; bj < 2; ++bj) { A4 v0 = acc[ai][bj][m][0] * r + bv[bj][0], v1 = acc[ai][bj][m][1] * r + bv[bj][1];
                        v0 = v0 * sc; v1 = v1 * sc;
                        if (pn == 6) { const int c = bj * 128 + cw;
                            *(v4u*)((bf16*)(wsb + WS_UA) + ((size_t)(c >> 4) * (M / 64) + (row >> 6)) * 1152 + (row & 63) * 16 + (c & 15)) = pack8(v0, v1); }
                        else *(v4u*)(rowp + bj * 128) = pack8(v0, v1); } asm volatile("" ::: "memory"); }
            }
        }
    }
};
#undef IP_LOADS
template <bool MOE, bool FP8 = false> struct EpiSwiGlu {
    static constexpr bool PERM = true, AFTER_DRAIN = false, HOOKS = false, RMW = false;
    bf16* Hd; int ldh; const float* rsrc;
    __device__ __forceinline__ void operator()(const AccT& acc, const pg8::Unit& u, int wr, int wc, int fr, int fq) const {
        const int row0 = u.pm * 256 + wr * 64 + fr, cw = wc * 32 + 8 * fq;
        float rs[2][4];
#pragma unroll
        for (int ai = 0; ai < 2; ++ai)
#pragma unroll
            for (int m = 0; m < 4; ++m) { const int row = row0 + ai * 128 + m * 16; rs[ai][m] = (MOE ? rsrc[row] : row_rstd4(rsrc, row, fq)) * (FP8 ? 0.03125f : 1.0f); }
#pragma unroll
        for (int ai = 0; ai < 2; ++ai)
#pragma unroll
            for (int m = 0; m < 4; ++m) { const int row = row0 + ai * 128 + m * 16; const float r = rs[ai][m];
                A4 o[2];
#pragma unroll
                for (int n = 0; n < 2; ++n) { const A4 s = rc4(ex4(acc[ai][0][m][n] * (r * -LOG2E)) + 1.0f); o[n] = (acc[ai][0][m][n] * acc[ai][1][m][n]) * (s * (r * r)); }
                if constexpr (FP8) *(v2u*)((unsigned char*)Hd + (((size_t)(row >> 8) * (ldh >> 7) + u.pn) * 256 + (row & 255)) * 128 + wc * 32 + 8 * fq) = pack8_fp8(o[0], o[1]);
                else *(v4u*)(Hd + (((size_t)(row >> 8) * (ldh >> 6) + (u.pn * 2 + (wc >> 1))) * 256 + (row & 255)) * 64 + (wc & 1) * 32 + 8 * fq) = pack8(o[0], o[1]);
                asm volatile("" ::: "memory"); }
    }
};
struct EpiGluSsm {
    static constexpr bool PERM = true, AFTER_DRAIN = false, HOOKS = false, RMW = false;
    bf16* O;
    __device__ __forceinline__ void operator()(const AccT& acc, const pg8::Unit& u, int wr, int wc, int fr, int fq) const {
        const int row0 = u.pm * 256 + wr * 64 + fr, cw = wc * 32 + 8 * fq;
#pragma unroll
        for (int ai = 0; ai < 2; ++ai)
#pragma unroll
            for (int m = 0; m < 4; ++m) { const int row = row0 + ai * 128 + m * 16;
                *(v4u*)(O + (size_t)row * 1024 + 512 + u.pn * 128 + cw) = pack8(acc[ai][0][m][0] * sig4(acc[ai][1][m][0]), acc[ai][0][m][1] * sig4(acc[ai][1][m][1])); }
    }
};
template <int I> struct EpiMerge {
    static constexpr bool PERM = true, AFTER_DRAIN = false, HOOKS = false, RMW = false;
    const bf16* G; bf16* Mg;
    __device__ __forceinline__ void operator()(const AccT& acc, const pg8::Unit& u, int wr, int wc, int fr, int fq) const {
        const int row0 = u.pm * 256 + wr * 64 + fr, col0 = u.pn * 256 + wc * 32 + 8 * fq;
        v4u gl[3][2], ol[3][2];
#define MG_LOAD(buf, grp) do { const int row_ = row0 + ((grp) >> 2) * 128 + ((grp) & 3) * 16; _Pragma("unroll") for (int bj = 0; bj < 2; ++bj) { \
            gl[buf][bj] = *(const v4u*)(G + (size_t)row_ * 3072 + I * 1024 + col0 + bj * 128); if (I > 0) ol[buf][bj] = *(const v4u*)(Mg + (size_t)row_ * 1024 + col0 + bj * 128); } } while (0)
        MG_LOAD(0, 0); MG_LOAD(1, 1);
#pragma unroll
        for (int grp = 0; grp < 8; ++grp) {
            if (grp + 2 < 8) MG_LOAD((grp + 2) % 3, grp + 2);
            asm volatile("" ::: "memory");
            const int ai = grp >> 2, m = grp & 3, row = row0 + ai * 128 + m * 16;
#pragma unroll
            for (int bj = 0; bj < 2; ++bj) { A4 g0, g1; unpack8(gl[grp % 3][bj], g0, g1);
                A4 v0 = g0 * acc[ai][bj][m][0], v1 = g1 * acc[ai][bj][m][1];
                if (I > 0) { A4 o0, o1; unpack8(ol[grp % 3][bj], o0, o1); v0 = v0 + o0; v1 = v1 + o1; }
                *(v4u*)(Mg + (size_t)row * 1024 + col0 + bj * 128) = pack8(v0, v1); }
        }
#undef MG_LOAD
    }
};
template <bool O8 = false> struct EpiMergeCat {
    static constexpr bool PERM = true, AFTER_DRAIN = false, HOOKS = true, RMW = false; static constexpr int H1 = 8, H2 = 12;
    const bf16* G; bf16* Mg;
    static __device__ __forceinline__ A4 rcp4(const A4& z) { return (A4){__builtin_amdgcn_rcpf(z[0]), __builtin_amdgcn_rcpf(z[1]), __builtin_amdgcn_rcpf(z[2]), __builtin_amdgcn_rcpf(z[3])}; }
    __device__ __forceinline__ void mid(AccT& acc, const pg8::Unit& u, int t, int wr, int wc, int fr, int fq) const {
        int fr_ = fr, fq_ = fq; asm volatile("" : "+v"(fr_), "+v"(fq_));
        const int s = (t == H1) ? 0 : 1, tix = ((wr * 4 + wc) << 6) | (fq_ << 4) | fr_;
        const v4u* ga_ = (const v4u*)G + ((size_t)((s * 256 + u.pm) * 4 + u.pn) * 16) * 512 + tix;
        const v4u* gb_ = ga_ + (size_t)256 * 4 * 16 * 512;
#pragma unroll
        for (int ai = 0; ai < 2; ++ai)
#pragma unroll
            for (int mp = 0; mp < 2; ++mp) {
                v4u ga[2][2], gb[2][2];
#pragma unroll
                for (int mm = 0; mm < 2; ++mm)
#pragma unroll
                    for (int bj = 0; bj < 2; ++bj) { const size_t o = (size_t)(((ai * 4 + 2 * mp + mm) * 2 + bj)) * 512; ga[mm][bj] = ga_[o]; gb[mm][bj] = gb_[o]; }
#pragma unroll
                for (int mm = 0; mm < 2; ++mm)
#pragma unroll
                    for (int bj = 0; bj < 2; ++bj) { A4 p0, p1, q0, q1; unpack8(ga[mm][bj], p0, p1); unpack8(gb[mm][bj], q0, q1);
                        acc[ai][bj][2 * mp + mm][0] = acc[ai][bj][2 * mp + mm][0] * (p0 * rcp4(q0)); acc[ai][bj][2 * mp + mm][1] = acc[ai][bj][2 * mp + mm][1] * (p1 * rcp4(q1)); }
                asm volatile("" ::: "memory");
            }
    }
    __device__ __forceinline__ void operator()(const AccT& acc, const pg8::Unit& u, int wr, int wc, int fr, int fq) const {
        const int row0 = u.pm * 256 + wr * 64 + fr, col0 = u.pn * 256 + wc * 32 + 8 * fq, tix = ((wr * 4 + wc) << 6) | (fq << 4) | fr;
        const v4u* g2 = (const v4u*)G + ((size_t)((2 * 256 + u.pm) * 4 + u.pn) * 16) * 512 + tix;
        v4u gl[3][2];
#define MC_LOAD(buf, grp) do { _Pragma("unroll") for (int bj = 0; bj < 2; ++bj) gl[buf][bj] = g2[(size_t)((grp) * 2 + bj) * 512]; } while (0)
        MC_LOAD(0, 0); MC_LOAD(1, 1);
#pragma unroll
        for (int grp = 0; grp < 8; ++grp) {
            if (grp + 2 < 8) MC_LOAD((grp + 2) % 3, grp + 2);
            asm volatile("" ::: "memory");
            const int ai = grp >> 2, m = grp & 3, row = row0 + ai * 128 + m * 16;
#pragma unroll
            for (int bj = 0; bj < 2; ++bj) { A4 g0, g1; unpack8(gl[grp % 3][bj], g0, g1);
                if constexpr (O8) *(v2u*)((unsigned char*)Mg + (size_t)row * 1024 + col0 + bj * 128) = pack8_fp8(g0 * acc[ai][bj][m][0], g1 * acc[ai][bj][m][1]);
                else *(v4u*)(Mg + (size_t)row * 1024 + col0 + bj * 128) = pack8(g0 * acc[ai][bj][m][0], g1 * acc[ai][bj][m][1]); }
        }
#undef MC_LOAD
    }
};
template <bool W8 = false, int SH = 0> struct EpiResid {
    static constexpr bool PERM = true, AFTER_DRAIN = false, HOOKS = false, RMW = true;
    bf16* X; float* ssq; unsigned char* X8;
    __device__ __forceinline__ void operator()(const AccT& acc, const pg8::Unit& u, int wr, int wc, int fr, int fq) const {
        const int row0 = u.pm * 256 + wr * 64 + fr, col0 = u.pn * 256 + wc * 32 + 8 * fq;
        v4u ol[3][2];
#define RS_LOAD(buf, grp) do { const int row_ = row0 + ((grp) >> 2) * 128 + ((grp) & 3) * 16; _Pragma("unroll") for (int bj = 0; bj < 2; ++bj) ol[buf][bj] = *(const v4u*)(X + (size_t)row_ * 1024 + col0 + bj * 128); } while (0)
        RS_LOAD(0, 0); RS_LOAD(1, 1);
#pragma unroll
        for (int grp = 0; grp < 8; ++grp) {
            if (grp + 2 < 8) RS_LOAD((grp + 2) % 3, grp + 2);
            asm volatile("" ::: "memory");
            const int ai = grp >> 2, m = grp & 3, row = row0 + ai * 128 + m * 16; float ss = 0.f;
#pragma unroll
            for (int bj = 0; bj < 2; ++bj) { A4 o0, o1; unpack8(ol[grp % 3][bj], o0, o1); o0 = o0 + acc[ai][bj][m][0] * (1.0f / (float)(1 << SH)); o1 = o1 + acc[ai][bj][m][1] * (1.0f / (float)(1 << SH));
                const v4u w = pack8(o0, o1); *(v4u*)(X + (size_t)row * 1024 + col0 + bj * 128) = w; unpack8(w, o0, o1);
                if constexpr (W8) *(v2u*)(X8 + (size_t)row * 1024 + col0 + bj * 128) = pack8_fp8(o0, o1);
                ss += (o0[0] * o0[0] + o0[1] * o0[1]) + (o0[2] * o0[2] + o0[3] * o0[3]) + (o1[0] * o1[0] + o1[1] * o1[1]) + (o1[2] * o1[2] + o1[3] * o1[3]); }
            ss += __shfl_xor(ss, 16); ss += __shfl_xor(ss, 32);
            if (fq == 0) ssq[(size_t)row * 16 + u.pn * 4 + wc] = ss;
        }
#undef RS_LOAD
    }
};
template <bool FP8 = false> struct EpiMoeDown {
    static constexpr bool PERM = true, AFTER_DRAIN = false, HOOKS = false, RMW = false;
    bf16* Y; const int* rdest; const float* rw;
    __device__ __forceinline__ void operator()(const AccT& acc, const pg8::Unit& u, int wr, int wc, int fr, int fq) const {
        const int row0 = u.pm * 256 + wr * 64 + fr, cw = wc * 32 + 8 * fq;
        int ds[2][4]; float wsv[2][4];
#pragma unroll
        for (int ai = 0; ai < 2; ++ai)
#pragma unroll
            for (int m = 0; m < 4; ++m) { const int row = row0 + ai * 128 + m * 16; ds[ai][m] = rdest[row]; wsv[ai][m] = rw[row] * (FP8 ? 0.015625f : 1.0f); }
#pragma unroll
        for (int ai = 0; ai < 2; ++ai)
#pragma unroll
            for (int m = 0; m < 4; ++m) { const int dest = ds[ai][m]; const float w = wsv[ai][m];
                if (dest >= 0) {
#pragma unroll
                    for (int bj = 0; bj < 2; ++bj) *(v4u*)(Y + (size_t)dest * 1024 + u.pn * 256 + bj * 128 + cw) = pack8(acc[ai][bj][m][0] * w, acc[ai][bj][m][1] * w); }
                asm volatile("" ::: "memory"); }
    }
};
struct MoeOrder {
    pg8::StaticOrder so; int tile0, a_tile_off, b_rows; int s1, s2, s3, s4, s5, s6, s7;
    int x = 0, nl = 0, c0 = 0; static constexpr int SK = 3;
    __device__ __forceinline__ void skew(int nwg_down) {
        const int G = so.G, r = nwg_down % G; nl = 0; x = 0; c0 = 0;
        if (r != 0 && so.nwg >= SK * (G - r)) { nl = G - r; c0 = r; x = (so.nwg - SK * nl) / G; }
    }
    __device__ __forceinline__ bool next(int i, pg8::Unit& u) const {
        long L;
        if (nl == 0) L = (long)i * so.G + so.c;
        else if (i < x) L = (long)i * so.G + so.c;
        else if (so.c >= c0) { if (i < x + SK) L = (long)x * so.G + (long)(i - x) * nl + (so.c - c0); else if (i == x + SK) L = (long)x * so.G + (long)SK * nl + so.c; else return false; }
        else { if (i == x) L = (long)x * so.G + (long)SK * nl + so.c; else return false; }
        if (!so.unit_of(L, u)) return false;
        const int gt = tile0 + u.pm;
        const int e = (gt >= s1) + (gt >= s2) + (gt >= s3) + (gt >= s4) + (gt >= s5) + (gt >= s6) + (gt >= s7);
        u.arow = (a_tile_off + u.pm) * 256; u.brow = e * b_rows + u.pn * 256; return true;
    }
};
struct Args { const float* in[31]; unsigned char* out; unsigned char* ws; int ph_lo, ph_hi, use_bar, pad; };
struct Frame {
    LAS unsigned char* lds;
    volatile LAS unsigned* MISC;
    gu32* ctl;
    int tid, lane, wave, G, gw, NGW;
};

__device__ __forceinline__ int inproj_dest(int n) {
    if (n < 1536) return n;
    if (n < 1544) return 5376 + (n - 1536);
    if (n < 1800) return 1536 + (n - 1544);
    if (n < 2056) { const int c = n - 1800; return 1792 + (c >> 7) * 256 + (c & 127); }
    if (n < 2312) { const int c = n - 2056; return 1792 + (c >> 7) * 256 + 128 + (c & 127); }
    return 2304 + (n - 2312);
}
__device__ __forceinline__ int inproj_src(int d) {
    if (d < 1536) return d;
    if (d < 1792) return 1544 + (d - 1536);
    if (d < 2304) { const int t = (d - 1792) >> 8, r = (d - 1792) & 255; return r < 128 ? 1800 + t * 128 + r : 2056 + t * 128 + (r - 128); }
    if (d < 5376) return 2312 + (d - 2304);
    return (d - 5376) < 8 ? 1536 + (d - 5376) : -1;
}
__device__ __forceinline__ int map_row(int kind, int off, int n) {
    if (kind == 0) return n + off;
    if (kind == 1) return (n >> 7) * 256 + (n & 127) + off;
    if (kind == 2) { const int j = n & 255; return (j >> 7) * 256 + (j & 127) + ((n >> 8) ? 128 : 0); }
    return inproj_dest(n);
}
#ifndef FP8_INPROJ_MASK
#define FP8_INPROJ_MASK 0xF
#endif
#define FP8_INPROJ(l_) (((FP8_INPROJ_MASK) >> (l_)) & 1)
#ifndef FP8_WO_MASK
#define FP8_WO_MASK 0xC
#endif
#define FP8_WO(l_) (((FP8_WO_MASK) >> (l_)) & 1)
#ifndef FP8_DENSE_I
#define FP8_DENSE_I 1
#endif
struct CvtDesc { const float* W; const float* gk; bf16* WT; int K, N, kind, off, item, ldt; float sc8; };
__device__ __forceinline__ CvtDesc cvt_moe_desc(const Args& a, int i, int l, int it) {
    const int e = it / 5376, r = it - e * 5376, kd = r / 1792, li = r - kd * 1792; const size_t wo = (size_t)(i * NE + e) * D * D_FFE;
    CvtDesc d; d.item = li;
    if (kd < 2) { d.W = (kd == 0 ? a.in[27] : a.in[28]) + wo; d.gk = a.in[21] + l * D; d.WT = (bf16*)(a.ws + WS_WMOE + WMOE_GU + (size_t)e * 7168 * D); d.K = D; d.N = D_FFE; d.kind = 1; d.off = kd * 128; d.ldt = D; d.sc8 = 32.0f; }
    else { d.W = a.in[29] + wo; d.gk = nullptr; d.WT = (bf16*)(a.ws + WS_WMOE + WMOE_D + (size_t)e * D * D_FFE); d.K = D_FFE; d.N = D; d.kind = 0; d.off = 0; d.ldt = D_FFE; d.sc8 = 64.0f; }
    return d;
}
__device__ __forceinline__ void cvt_load(const CvtDesc& d, int lane, f32x4 (&v)[8]) {
    const int nblk = (d.N + 31) >> 5, kb = d.item / nblk, nb = d.item - kb * nblk, k0 = 64 * kb, r8 = lane >> 3, n = 32 * nb + 4 * (lane & 7);
#pragma unroll
    for (int i = 0; i < 8; ++i) v[i] = (n < d.N) ? *(const f32x4*)(d.W + (size_t)(k0 + 8 * i + r8) * d.N + n) : (f32x4){0.f, 0.f, 0.f, 0.f};
}
__device__ __forceinline__ void cvt_store(const CvtDesc& d, LAS float* scr, int lane, const f32x4 (&v)[8]) {
    const int nblk = (d.N + 31) >> 5, kb = d.item / nblk, nb = d.item - kb * nblk, k0 = 64 * kb, n0 = 32 * nb, c = lane & 7, r8 = lane >> 3;
    f32x4 g0 = (f32x4){1.f, 1.f, 1.f, 1.f}, g1 = g0;
    if (d.gk) { g0 = *(const f32x4*)(d.gk + k0 + 8 * c); g1 = *(const f32x4*)(d.gk + k0 + 8 * c + 4); }
#pragma unroll
    for (int i = 0; i < 8; ++i) { LAS float* q = scr + (8 * i + r8) * 33 + 4 * c; q[0] = v[i].x; q[1] = v[i].y; q[2] = v[i].z; q[3] = v[i].w; }
    LDS_WAIT(); asm volatile("" ::: "memory");
#pragma unroll
    for (int j = 0; j < 4; ++j) { const int nl = (lane >> 3) + 8 * j; const int nn = n0 + nl; const LAS float* s = scr + (8 * c) * 33 + nl;
        if (nn < d.N) {
            if (d.sc8 != 0.0f) { const float q = d.sc8; v2u o; o.x = pk4_fp8(s[0 * 33] * g0.x * q, s[1 * 33] * g0.y * q, s[2 * 33] * g0.z * q, s[3 * 33] * g0.w * q); o.y = pk4_fp8(s[4 * 33] * g1.x * q, s[5 * 33] * g1.y * q, s[6 * 33] * g1.z * q, s[7 * 33] * g1.w * q);
                *(v2u*)((unsigned char*)d.WT + (size_t)map_row(d.kind, d.off, nn) * d.ldt + k0 + 8 * c) = o; }
            else { v4u o; o.x = pk2(s[0 * 33] * g0.x, s[1 * 33] * g0.y); o.y = pk2(s[2 * 33] * g0.z, s[3 * 33] * g0.w); o.z = pk2(s[4 * 33] * g1.x, s[5 * 33] * g1.y); o.w = pk2(s[6 * 33] * g1.z, s[7 * 33] * g1.w);
                *(v4u*)(d.WT + (size_t)map_row(d.kind, d.off, nn) * d.ldt + k0 + 8 * c) = o; } } }
    LDS_WAIT(); asm volatile("" ::: "memory");
}
__device__ __forceinline__ void cvt_moe_layer(const Args& a, int i, int l, LAS float* scr, int lane, int gwl, int ngw) {
    constexpr int TOTAL = NE * 3 * 1792;
    int it = gwl; if (it >= TOTAL) return;
    f32x4 va[8], vb[8];
    CvtDesc da = cvt_moe_desc(a, i, l, it), db = da; cvt_load(da, lane, va);
    for (;;) {
        const int itb = it + ngw; const bool hb = itb < TOTAL;
        if (hb) { db = cvt_moe_desc(a, i, l, itb); cvt_load(db, lane, vb); }
        cvt_store(da, scr, lane, va);
        if (!hb) break;
        it = itb + ngw; const bool ha = it < TOTAL;
        if (ha) { da = cvt_moe_desc(a, i, l, it); cvt_load(da, lane, va); }
        cvt_store(db, scr, lane, vb);
        if (!ha) break;
    }
}

__device__ __forceinline__ CvtDesc cvt_p0_desc(const Args& a, int it) {
    CvtDesc d; d.gk = nullptr; d.kind = 0; d.off = 0; d.sc8 = 0.0f;
    if (it < DEPTH * 3792) {
        const int l = it / 3792; int r = it - l * 3792; unsigned char* wm = a.ws + WS_WMIX + (size_t)l * WMIX_STRIDE;
        if (r < 2704) { d.W = a.in[2] + (size_t)l * D * N_IN; d.K = D; d.N = N_IN; d.gk = a.in[1] + l * D; d.WT = (bf16*)(wm + WM_IN); d.kind = 3; d.item = r; d.ldt = D; d.sc8 = FP8_INPROJ(l) ? 32.0f : 0.0f; return d; } r -= 2704;
        if (r < 64) { d.W = a.in[12] + (size_t)l * 256 * 512; d.K = 256; d.N = 512; d.WT = (bf16*)(wm + WM_GLU); d.kind = 2; d.item = r; d.ldt = 256; return d; } r -= 64;
        if (r < 256) { d.W = a.in[17] + (size_t)l * 512 * D; d.K = 512; d.N = D; d.WT = (bf16*)(wm + WM_A); d.item = r; d.ldt = 1024; return d; } r -= 256;
        if (r < 128) { d.W = a.in[18] + (size_t)l * 256 * D; d.K = 256; d.N = D; d.WT = (bf16*)(wm + WM_A) + 512; d.item = r; d.ldt = 1024; return d; } r -= 128;
        if (r < 128) { d.W = a.in[19] + (size_t)l * 256 * D; d.K = 256; d.N = D; d.WT = (bf16*)(wm + WM_A) + 768; d.item = r; d.ldt = 1024; return d; } r -= 128;
        d.W = a.in[20] + (size_t)l * D * D; d.K = D; d.N = D; d.WT = (bf16*)(wm + WM_O); d.item = r; d.ldt = D; d.sc8 = FP8_WO(l) ? 32.0f : 0.0f; return d;
    }
    it -= DEPTH * 3792; const int i = it / 4224; int r = it - i * 4224; unsigned char* wd = a.ws + WS_WDENSE + (size_t)i * WDENSE_STRIDE;
    if (r < 2816) { const int up = r >= 1408; d.W = (up ? a.in[23] : a.in[22]) + (size_t)i * D * D_FF; d.K = D; d.N = D_FF; d.gk = a.in[21] + (2 * i) * D; d.WT = (bf16*)(wd + WD_GU); d.kind = 1; d.off = up * 128; d.item = r - up * 1408; d.ldt = D; d.sc8 = (i == FP8_DENSE_I) ? 32.0f : 0.0f; return d; }
    d.W = a.in[24] + (size_t)i * D_FF * D; d.K = D_FF; d.N = D; d.WT = (bf16*)(wd + WD_D); d.item = r - 2816; d.ldt = D_FF; d.sc8 = (i == FP8_DENSE_I) ? 64.0f : 0.0f; return d;
}
__device__ __forceinline__ void p0_prologue(Frame& F, const Args& a) {
    LAS float* scr = (LAS float*)(F.lds + RING_OFF + F.wave * 16384);
    {   constexpr int TOTAL = DEPTH * 3792 + 2 * 4224;
        int it = F.gw;
        if (it < TOTAL) {
            f32x4 va[8], vb[8];
            CvtDesc da = cvt_p0_desc(a, it), db = da; cvt_load(da, F.lane, va);
            for (;;) {
                const int itb = it + F.NGW; const bool hb = itb < TOTAL;
                if (hb) { db = cvt_p0_desc(a, itb); cvt_load(db, F.lane, vb); }
                cvt_store(da, scr, F.lane, va);
                if (!hb) break;
                it = itb + F.NGW; const bool ha = it < TOTAL;
                if (ha) { da = cvt_p0_desc(a, it); cvt_load(da, F.lane, va); }
                cvt_store(db, scr, F.lane, vb);
                if (!ha) break;
            }
        }
    }
    for (int r = F.gw; r < DEPTH * 248; r += F.NGW) { const int l = r / 248, row = 5384 + (r - l * 248); unsigned char* wr_ = a.ws + WS_WMIX + (size_t)l * WMIX_STRIDE + WM_IN + (size_t)row * D * (FP8_INPROJ(l) ? 1 : 2);
        if (FP8_INPROJ(l)) *(v4u*)(wr_ + 16 * F.lane) = (v4u){0u, 0u, 0u, 0u}; else { *(v4u*)(wr_ + 32 * F.lane) = (v4u){0u, 0u, 0u, 0u}; *(v4u*)(wr_ + 32 * F.lane + 16) = (v4u){0u, 0u, 0u, 0u}; } }
    float* bperm = (float*)(a.ws + WS_BPERM);
    for (int idx = F.gw * 64 + F.lane; idx < DEPTH * N_INP; idx += F.NGW * 64) { const int l = idx / N_INP, d = idx - l * N_INP, n = inproj_src(d); bperm[idx] = n >= 0 ? a.in[3][l * N_IN + n] : 0.f; }
    bf16* xb = (bf16*)(a.ws + WS_XB); float* ssq = (float*)(a.ws + WS_SSQ);
    {   f32x4 nv[4]; int m = F.gw;
        if (m < M) { const f32x4* xr = (const f32x4*)(a.in[0] + (size_t)m * D) + F.lane;
#pragma unroll
            for (int j = 0; j < 4; ++j) nv[j] = xr[64 * j]; }
        for (; m < M; m += F.NGW) {
            f32x4 v[4];
#pragma unroll
            for (int j = 0; j < 4; ++j) v[j] = nv[j];
            if (m + F.NGW < M) { const f32x4* xr = (const f32x4*)(a.in[0] + (size_t)(m + F.NGW) * D) + F.lane;
#pragma unroll
                for (int j = 0; j < 4; ++j) nv[j] = xr[64 * j]; }
            float ss = 0.f;
#pragma unroll
            for (int j = 0; j < 4; ++j) { v2u w; w.x = pk2(v[j].x, v[j].y); w.y = pk2(v[j].z, v[j].w);
                *(v2u*)(xb + (size_t)m * D + 256 * j + 4 * F.lane) = w;
                const float a0 = bflo(w.x), a1 = bfhi(w.x), a2 = bflo(w.y), a3 = bfhi(w.y); ss += (a0 * a0 + a1 * a1) + (a2 * a2 + a3 * a3);
                *(unsigned*)(a.ws + WS_XB8 + (size_t)m * D + 256 * j + 4 * F.lane) = pk4_fp8(a0, a1, a2, a3); }
            const float tot = wave_sum(ss);
            if (F.lane < 16) ssq[(size_t)m * 16 + F.lane] = F.lane == 0 ? tot : 0.f;
        }
    }
}

__device__ __forceinline__ void t1_cumsum(const Args& a, int bh, int lane) {
    const float* logf = (const float*)(a.ws + WS_LOGF); float* Fh = (float*)(a.ws + WS_FH);
    const int b = bh >> 3, h = bh & 7; const float* p = logf + ((size_t)b * SEQ + lane) * 8 + h; float* o = Fh + (size_t)bh * SEQ + lane;
    float carry = 0.f;
    for (int blk = 0; blk < SEQ / 64; blk += 8) {
        float v[8];
#pragma unroll
        for (int q = 0; q < 8; ++q) v[q] = p[(size_t)(blk + q) * 64 * 8];
#pragma unroll
        for (int q = 0; q < 8; ++q) { float x = v[q];
#pragma unroll
            for (int s = 1; s < 64; s <<= 1) { const float t = __shfl_up(x, s); if (lane >= s) x += t; }
            x += carry; o[(blk + q) * 64] = x; carry = __builtin_bit_cast(float, __builtin_amdgcn_readlane(__builtin_bit_cast(int, x), 63)); }
    }
}
constexpr int CONV_TILE = 128, CONV_ROWS = CONV_TILE + CONV_K - 1;
__device__ __forceinline__ void t1_conv_tile(const Args& a, int l, int tile, LAS unsigned char* lds, int tid, int wave, int lane, const f32x4 (&cwt)[CONV_K], const f32x4 cb, const f32x4 lg, const f32x4 lb) {
    const bf16* HC = (const bf16*)(a.out + DO_HC); bf16* CO = (bf16*)(a.ws + WS_BCAT) + 768;
    const int t0 = tile * CONV_TILE, tl0 = t0 & (SEQ - 1);
    { v4u sv[10];
#pragma unroll
      for (int q = 0; q < 10; ++q) { const int pc = tid + q * NWAVES * 64, r = pc >> 5, c = pc & 31; sv[q] = (v4u){0u, 0u, 0u, 0u};
          if (pc < CONV_ROWS * 32 && tl0 + r - (CONV_K - 1) >= 0) sv[q] = *(const v4u*)(HC + (size_t)(t0 + r - (CONV_K - 1)) * CONV_W + 8 * c); }
#pragma unroll
      for (int q = 0; q < 10; ++q) { const int pc = tid + q * NWAVES * 64, r = pc >> 5, c = pc & 31; if (pc < CONV_ROWS * 32) *(LAS v4u*)(lds + r * 512 + c * 16) = sv[q]; } }
    __syncthreads();
    for (int i = 0; i < 16; ++i) {
        const int tr = wave * 16 + i;
        f32x4 y = cb;
#pragma unroll
        for (int k = 0; k < CONV_K; ++k) { const v2u hv = *(const LAS v2u*)(lds + (tr + k) * 512 + 8 * lane);
            y.x += cwt[k].x * bflo(hv.x); y.y += cwt[k].y * bfhi(hv.x); y.z += cwt[k].z * bflo(hv.y); y.w += cwt[k].w * bfhi(hv.y); }
        const float mu = wave_sum((y.x + y.y) + (y.z + y.w)) * (1.f / 256.f);
        const f32x4 dl = y - mu;
        const float var = wave_sum((dl.x * dl.x + dl.y * dl.y) + (dl.z * dl.z + dl.w * dl.w)) * (1.f / 256.f);
        const float rs = rsqrtf(var + EPS);
        f32x4 z = dl * rs * lg + lb;
        z.x *= sigmoidf_(z.x); z.y *= sigmoidf_(z.y); z.z *= sigmoidf_(z.z); z.w *= sigmoidf_(z.w);
        v2u o; o.x = pk2(z.x, z.y); o.y = pk2(z.z, z.w);
        *(v2u*)(CO + (size_t)(t0 + tr) * 1024 + 4 * lane) = o;
    }
    __syncthreads();
}
__device__ __forceinline__ void t1_conv_all(const Args& a, int l, int bid, int G, LAS unsigned char* lds, int tid, int wave, int lane) {
    f32x4 cwt[CONV_K];
#pragma unroll
    for (int k = 0; k < CONV_K; ++k) cwt[k] = *(const f32x4*)(a.in[13] + ((size_t)l * CONV_K + k) * CONV_W + 4 * lane);
    const f32x4 cb = *(const f32x4*)(a.in[14] + l * CONV_W + 4 * lane), lg = *(const f32x4*)(a.in[15] + l * CONV_W + 4 * lane), lb = *(const f32x4*)(a.in[16] + l * CONV_W + 4 * lane);
    for (int tile = bid; tile < M / CONV_TILE; tile += G) t1_conv_tile(a, l, tile, lds, tid, wave, lane, cwt, cb, lg, lb);
}
__device__ __forceinline__ float gelu_tanh(float y) {
    const float z = 0.7978845608028654f * (y + 0.044715f * y * y * y);
    const float th = 1.0f - 2.0f * __builtin_amdgcn_rcpf(__builtin_amdgcn_exp2f(2.885390081777927f * z) + 1.0f);
    return 0.5f * y * (1.0f + th);
}
__device__ __forceinline__ void moe_route(Frame& F, const Args& a, int l, int i) {
    const bf16* xb = (const bf16*)(a.ws + WS_XB); const float* ssq = (const float*)(a.ws + WS_SSQ);
    int* toke = (int*)(a.ws + WS_TOKE); float* tokw = (float*)(a.ws + WS_TOKW); int* cntw = (int*)(a.ws + WS_CNTW);
    const int lane = F.lane, k0 = 16 * lane;
    float wr[16][8];
#pragma unroll
    for (int j = 0; j < 16; ++j) { const float gk = a.in[21][l * D + k0 + j];
        const f32x4 w0 = *(const f32x4*)(a.in[25] + ((size_t)i * D + k0 + j) * NE), w1 = *(const f32x4*)(a.in[25] + ((size_t)i * D + k0 + j) * NE + 4);
        wr[j][0] = gk * w0.x; wr[j][1] = gk * w0.y; wr[j][2] = gk * w0.z; wr[j][3] = gk * w0.w; wr[j][4] = gk * w1.x; wr[j][5] = gk * w1.y; wr[j][6] = gk * w1.z; wr[j][7] = gk * w1.w; }
    float rb[8];
#pragma unroll
    for (int e = 0; e < 8; ++e) rb[e] = a.in[26][i * NE + e];
    const bool b5 = (lane & 32) != 0, b4 = (lane & 16) != 0, b3 = (lane & 8) != 0;
    for (int run = F.gw; run < M / 32; run += F.NGW) {
        int cnt[8];
#pragma unroll
        for (int e = 0; e < 8; ++e) cnt[e] = 0;
        const float rstd_l = row_rstd(ssq, run * 32 + (lane & 31));
        v4u x0n = *(const v4u*)(xb + (size_t)(run * 32) * D + k0), x1n = *(const v4u*)(xb + (size_t)(run * 32) * D + k0 + 8);
        for (int ti = 0; ti < 32; ++ti) {
            const int t = run * 32 + ti;
            const v4u x0 = x0n, x1 = x1n;
            if (ti + 1 < 32) { x0n = *(const v4u*)(xb + (size_t)(t + 1) * D + k0); x1n = *(const v4u*)(xb + (size_t)(t + 1) * D + k0 + 8); }
            float xv[16] = {bflo(x0.x), bfhi(x0.x), bflo(x0.y), bfhi(x0.y), bflo(x0.z), bfhi(x0.z), bflo(x0.w), bfhi(x0.w), bflo(x1.x), bfhi(x1.x), bflo(x1.y), bfhi(x1.y), bflo(x1.z), bfhi(x1.z), bflo(x1.w), bfhi(x1.w)};
            float v[8];
#pragma unroll
            for (int e = 0; e < 8; ++e) { float s = 0.f;
#pragma unroll
                for (int j = 0; j < 16; ++j) s += xv[j] * wr[j][e];
                v[e] = s; }
            float w4[4], w2[2];
#pragma unroll
            for (int q = 0; q < 4; ++q) { const float keep = b5 ? v[q + 4] : v[q], send = b5 ? v[q] : v[q + 4]; w4[q] = keep + __shfl_xor(send, 32); }
#pragma unroll
            for (int q = 0; q < 2; ++q) { const float keep = b4 ? w4[q + 2] : w4[q], send = b4 ? w4[q] : w4[q + 2]; w2[q] = keep + __shfl_xor(send, 16); }
            float w1; { const float keep = b3 ? w2[1] : w2[0], send = b3 ? w2[0] : w2[1]; w1 = keep + __shfl_xor(send, 8); }
            w1 += __shfl_xor(w1, 4); w1 += __shfl_xor(w1, 2); w1 += __shfl_xor(w1, 1);
            const float rstd = __builtin_bit_cast(float, __builtin_amdgcn_readlane(__builtin_bit_cast(int, rstd_l), ti));
            float lg[8];
#pragma unroll
            for (int e = 0; e < 8; ++e) lg[e] = __builtin_bit_cast(float, __builtin_amdgcn_readlane(__builtin_bit_cast(int, w1), 8 * e)) * rstd + rb[e];
            int e0 = 0; float l0 = lg[0];
#pragma unroll
            for (int e = 1; e < 8; ++e) if (lg[e] > l0) { l0 = lg[e]; e0 = e; }
            int e1 = (e0 == 0) ? 1 : 0; float l1 = -INFINITY;
#pragma unroll
            for (int e = 0; e < 8; ++e) if (e != e0 && lg[e] > l1) { l1 = lg[e]; e1 = e; }
            const float p0 = 1.0f / (1.0f + __expf(l1 - l0)), p1 = 1.0f - p0;
            if (lane == 0) { toke[t] = e0 | (e1 << 8); tokw[2 * t] = p0; tokw[2 * t + 1] = p1; }
#pragma unroll
            for (int e = 0; e < 8; ++e) cnt[e] += (e0 == e) + (e1 == e);
        }
        int cv = 0;
#pragma unroll
        for (int e = 0; e < 8; ++e) if (lane == e) cv = cnt[e];
        if (lane < 8) cntw[run * 8 + lane] = cv;
    }
}
__device__ __forceinline__ int wave_sum_i(int v) {
#pragma unroll
    for (int o = 1; o < 64; o <<= 1) v += __shfl_xor(v, o);
    return v;
}
__device__ __forceinline__ void moe_slots(Frame& F, const Args& a) {
    const bf16* xb = (const bf16*)(a.ws + WS_XB); const float* ssq = (const float*)(a.ws + WS_SSQ);
    const int* toke = (const int*)(a.ws + WS_TOKE); const float* tokw = (const float*)(a.ws + WS_TOKW); const int* cntw = (const int*)(a.ws + WS_CNTW);
    int* meta = (int*)(a.ws + WS_META); int* rdest = (int*)(a.ws + WS_RDEST); float* rw = (float*)(a.ws + WS_RW); float* rrstd = (float*)(a.ws + WS_RRSTD);
    const int lane = F.lane;
    for (int run = F.gw; run < M / 32; run += F.NGW) {
        int pre[8], tot[8];
#pragma unroll
        for (int e = 0; e < 8; ++e) { pre[e] = 0; tot[e] = 0; }
#pragma unroll 8
        for (int r2 = lane; r2 < M / 32; r2 += 64) {
            const int4 c0 = *(const int4*)(cntw + r2 * 8), c1 = *(const int4*)(cntw + r2 * 8 + 4); const int f = r2 < run ? 1 : 0;
            tot[0] += c0.x; tot[1] += c0.y; tot[2] += c0.z; tot[3] += c0.w; tot[4] += c1.x; tot[5] += c1.y; tot[6] += c1.z; tot[7] += c1.w;
            pre[0] += f * c0.x; pre[1] += f * c0.y; pre[2] += f * c0.z; pre[3] += f * c0.w; pre[4] += f * c1.x; pre[5] += f * c1.y; pre[6] += f * c1.z; pre[7] += f * c1.w;
        }
        int seg[9]; seg[0] = 0;
#pragma unroll
        for (int e = 0; e < 8; ++e) { tot[e] = __builtin_amdgcn_readfirstlane(wave_sum_i(tot[e])); pre[e] = __builtin_amdgcn_readfirstlane(wave_sum_i(pre[e])); seg[e + 1] = seg[e] + ((tot[e] + 255) & ~255); }
        if (run == 0 && lane < 9) { int sv = 0;
#pragma unroll
            for (int e = 0; e < 9; ++e) if (lane == e) sv = seg[e] >> 8;
            meta[lane] = sv; }
        if (run < 8) {
#pragma unroll
            for (int e = 0; e < 8; ++e) if (run == e) { for (int r = tot[e] + lane; r < ((tot[e] + 255) & ~255); r += 64) { rdest[seg[e] + r] = -1; rw[seg[e] + r] = 0.f; rrstd[seg[e] + r] = 0.f; } }
        }
        int base[8];
#pragma unroll
        for (int e = 0; e < 8; ++e) base[e] = seg[e] + pre[e];
        const int tl = run * 32 + (lane & 31);
        const int ee_l = toke[tl]; const float w0_l = tokw[2 * tl], w1_l = tokw[2 * tl + 1], rstd_l = row_rstd(ssq, tl);
        int s0_l = 0, s1_l = 0;
        for (int ti = 0; ti < 32; ++ti) {
            const int ee = __builtin_amdgcn_readlane(ee_l, ti); const int e0 = ee & 255, e1 = ee >> 8;
            int s0 = 0, s1 = 0;
#pragma unroll
            for (int e = 0; e < 8; ++e) { if (e0 == e) { s0 = base[e]; base[e] += 1; } if (e1 == e) { s1 = base[e]; base[e] += 1; } }
            if (lane == ti) { s0_l = s0; s1_l = s1; }
        }
        if (lane < 32) { rdest[s0_l] = 2 * tl; rdest[s1_l] = 2 * tl + 1; rw[s0_l] = w0_l; rw[s1_l] = w1_l; rrstd[s0_l] = rstd_l; rrstd[s1_l] = rstd_l; }
    }
}
__device__ __forceinline__ void moe_combine(Frame& F, const Args& a, bool last) {
    bf16* xb = (bf16*)(a.ws + WS_XB); float* ssq = (float*)(a.ws + WS_SSQ); const bf16* yb = (const bf16*)a.out; float* outp = (float*)a.out;
    const int lane = F.lane;
    v4u nx[6]; int tt = F.gw;
#define CMB_LOAD(dst, tok) do { const int t_ = (tok); dst[0] = *(const v4u*)(xb + (size_t)t_ * D + 16 * lane); dst[1] = *(const v4u*)(xb + (size_t)t_ * D + 16 * lane + 8); \
        dst[2] = *(const v4u*)(yb + (size_t)(2 * t_) * D + 16 * lane); dst[3] = *(const v4u*)(yb + (size_t)(2 * t_) * D + 16 * lane + 8); \
        dst[4] = *(const v4u*)(yb + (size_t)(2 * t_ + 1) * D + 16 * lane); dst[5] = *(const v4u*)(yb + (size_t)(2 * t_ + 1) * D + 16 * lane + 8); } while (0)
    if (tt < M) CMB_LOAD(nx, M - 1 - tt);
    for (; tt < M; tt += F.NGW) {
        const int t = M - 1 - tt;
        const v4u x0 = nx[0], x1 = nx[1], y00 = nx[2], y01 = nx[3], y10 = nx[4], y11 = nx[5];
        if (tt + F.NGW < M) CMB_LOAD(nx, M - 1 - (tt + F.NGW));
        A4 xa, xb_, xc, xd, t0, t1;
        unpack8(x0, xa, xb_); unpack8(x1, xc, xd);
        unpack8(y00, t0, t1); xa = xa + t0; xb_ = xb_ + t1; unpack8(y01, t0, t1); xc = xc + t0; xd = xd + t1;
        unpack8(y10, t0, t1); xa = xa + t0; xb_ = xb_ + t1; unpack8(y11, t0, t1); xc = xc + t0; xd = xd + t1;
        if (!last) {
            const v4u w0 = pack8(xa, xb_), w1 = pack8(xc, xd);
            *(v4u*)(xb + (size_t)t * D + 16 * lane) = w0; *(v4u*)(xb + (size_t)t * D + 16 * lane + 8) = w1;
            unpack8(w0, xa, xb_); unpack8(w1, xc, xd);
            { v4u o8; o8.x = pk4_fp8(xa[0], xa[1], xa[2], xa[3]); o8.y = pk4_fp8(xb_[0], xb_[1], xb_[2], xb_[3]); o8.z = pk4_fp8(xc[0], xc[1], xc[2], xc[3]); o8.w = pk4_fp8(xd[0], xd[1], xd[2], xd[3]); *(v4u*)(a.ws + WS_XB8 + (size_t)t * D + 16 * lane) = o8; }
        }
        float ss = 0.f;
#pragma unroll
        for (int j = 0; j < 4; ++j) ss += xa[j] * xa[j] + xb_[j] * xb_[j] + xc[j] * xc[j] + xd[j] * xd[j];
        const float tot = wave_sum(ss);
        if (!last) { if (lane < 16) ssq[(size_t)t * 16 + lane] = lane == 0 ? tot : 0.f; }
        else {
            const float r = rsqrtf(tot * (1.0f / 1024.0f) + EPS); const f32x4* gf = (const f32x4*)(a.in[30] + 16 * lane); f32x4* op = (f32x4*)(outp + (size_t)t * D + 16 * lane);
            op[0] = xa * r * gf[0]; op[1] = xb_ * r * gf[1]; op[2] = xc * r * gf[2]; op[3] = xd * r * gf[3];
        }
    }
#undef CMB_LOAD
}
constexpr int SSM_T = 64, SSM_KA = 1152;
__device__ __forceinline__ void ssm_abar(const Args& a, int lg, int p, float& lam_re, float& lam_im, float& dt) { lam_re = a.in[4][lg * SSM_P + p]; lam_im = a.in[5][lg * SSM_P + p]; dt = expf(a.in[6][lg]); }
__device__ __forceinline__ void cpow(float lam_re, float lam_im, float dt, int tau, float& re, float& im) { const float mag = expf(lam_re * dt * (float)tau); float sn, cs; sincosf(lam_im * dt * (float)tau, &sn, &cs); re = mag * cs; im = mag * sn; }
__device__ __forceinline__ void ssm_tables(Frame& F, const Args& a) {
    float* APOW = (float*)(a.ws + WS_APOW); float* BBAR = (float*)(a.ws + WS_BBAR); float* KTAB = (float*)(a.ws + WS_KTAB);
    const int lane = F.lane, p = lane;
    const bool b5 = (lane & 32) != 0, b4 = (lane & 16) != 0, b3 = (lane & 8) != 0, b2 = (lane & 4) != 0;
    for (int task = F.gw; task < DEPTH * SSM_G * 65; task += F.NGW) {
        const int lg = task / 65, tau = task - lg * 65;
        float lam_re, lam_im, dt; ssm_abar(a, lg, p, lam_re, lam_im, dt);
        float pr, pi; cpow(lam_re, lam_im, dt, tau, pr, pi);
        *(f32x2*)(APOW + (((size_t)lg * 65 + tau) * SSM_P + p) * 2) = (f32x2){pr, pi};
        float ar, ai; cpow(lam_re, lam_im, dt, 1, ar, ai);
        const float nr = ar - 1.0f, ni = ai, den = lam_re * lam_re + lam_im * lam_im;
        const float cr = (nr * lam_re + ni * lam_im) / den, ci = (ni * lam_re - nr * lam_im) / den;
        float br[16], bi[16];
#pragma unroll
        for (int h = 0; h < 16; ++h) { const float bre = a.in[7][((size_t)lg * SSM_P + p) * SSM_H + h], bim = a.in[8][((size_t)lg * SSM_P + p) * SSM_H + h]; br[h] = cr * bre - ci * bim; bi[h] = cr * bim + ci * bre; }
        if (tau == 0) {
#pragma unroll
            for (int h = 0; h < 16; ++h) *(f32x2*)(BBAR + (((size_t)lg * SSM_P + p) * SSM_H + h) * 2) = (f32x2){br[h], bi[h]};
        }
        if (tau < 64) {
            for (int ho = 0; ho < 16; ++ho) {
                const float cre = a.in[9][((size_t)lg * SSM_H + ho) * SSM_P + p], cim = a.in[10][((size_t)lg * SSM_H + ho) * SSM_P + p];
                const float wr_ = cre * pr - cim * pi, wi_ = cre * pi + cim * pr;
                float v[16];
#pragma unroll
                for (int h = 0; h < 16; ++h) v[h] = wr_ * br[h] - wi_ * bi[h];
                float w8[8], w4[4], w2[2];
#pragma unroll
                for (int i = 0; i < 8; ++i) { const float keep = b5 ? v[i + 8] : v[i], send = b5 ? v[i] : v[i + 8]; w8[i] = keep + __shfl_xor(send, 32); }
#pragma unroll
                for (int i = 0; i < 4; ++i) { const float keep = b4 ? w8[i + 4] : w8[i], send = b4 ? w8[i] : w8[i + 4]; w4[i] = keep + __shfl_xor(send, 16); }
#pragma unroll
                for (int i = 0; i < 2; ++i) { const float keep = b3 ? w4[i + 2] : w4[i], send = b3 ? w4[i] : w4[i + 2]; w2[i] = keep + __shfl_xor(send, 8); }
                float w1; { const float keep = b2 ? w2[1] : w2[0], send = b2 ? w2[0] : w2[1]; w1 = keep + __shfl_xor(send, 4); }
                w1 += __shfl_xor(w1, 2); w1 += __shfl_xor(w1, 1);
                const int hi = lane >> 2;
                if (tau == 0 && hi == ho) w1 += a.in[11][lg * SSM_H + ho];
                if ((lane & 3) == 0) KTAB[(((size_t)lg * 64 + tau) * 16 + ho) * 16 + hi] = w1;
            }
        }
    }
}
__device__ __forceinline__ void ssm_gather_u(const Args& a, int chunk, int lane) {
    const bf16* U = (const bf16*)(a.out + DO_U); bf16* Ua = (bf16*)(a.ws + WS_UA);
    const int g = lane >> 2, o4 = (lane & 3) * 4;
#pragma unroll 16
    for (int j = 0; j < SSM_T; ++j) { const v2u w = *(const v2u*)(U + ((size_t)chunk * SSM_T + j) * SSM_W + 4 * lane);
        *(v2u*)(Ua + ((size_t)g * (M / SSM_T) + chunk) * SSM_KA + j * 16 + o4) = w; }
}
__device__ __forceinline__ void ssm_expand_mv(const Args& a, int l, int task, int lane) {
    const float* APOW = (const float*)(a.ws + WS_APOW); const float* KTAB = (const float*)(a.ws + WS_KTAB); bf16* MV = (bf16*)(a.ws + WS_MV);
    const int g = task >> 10, n = task & 1023, i = n >> 4, ho = n & 15, lg = l * SSM_G + g, j = lane;
    bf16* row = MV + (size_t)task * SSM_KA;
    v4u o0 = (v4u){0u, 0u, 0u, 0u}, o1 = o0;
    if (j <= i) { const f32x4* kt = (const f32x4*)(KTAB + (((size_t)lg * 64 + (i - j)) * 16 + ho) * 16); const f32x4 k0 = kt[0], k1 = kt[1], k2 = kt[2], k3 = kt[3];
        o0.x = pk2(k0.x, k0.y); o0.y = pk2(k0.z, k0.w); o0.z = pk2(k1.x, k1.y); o0.w = pk2(k1.z, k1.w); o1.x = pk2(k2.x, k2.y); o1.y = pk2(k2.z, k2.w); o1.z = pk2(k3.x, k3.y); o1.w = pk2(k3.z, k3.w); }
    *(v4u*)(row + j * 16) = o0; *(v4u*)(row + j * 16 + 8) = o1;
    const int p = lane; const f32x2 ap = *(const f32x2*)(APOW + (((size_t)lg * 65 + (i + 1)) * SSM_P + p) * 2);
    const float cre = a.in[9][((size_t)lg * SSM_H + ho) * SSM_P + p], cim = a.in[10][((size_t)lg * SSM_H + ho) * SSM_P + p];
    row[1024 + p] = (bf16)f2bf(cre * ap.x - cim * ap.y); row[1024 + 64 + p] = (bf16)f2bf(-(cre * ap.y + cim * ap.x));
}
__device__ __forceinline__ void ssm_expand_w(const Args& a, int l, int task, int lane) {
    const float* APOW = (const float*)(a.ws + WS_APOW); const float* BBAR = (const float*)(a.ws + WS_BBAR); bf16* WG = (bf16*)(a.ws + WS_WG);
    const int g = task >> 7, q = task & 127, p = q & 63, im = q >> 6, lg = l * SSM_G + g, j = lane;
    { bf16* zr = WG + ((size_t)g * 256 + 128 + q) * 1024 + j * 16; *(v4u*)zr = (v4u){0u, 0u, 0u, 0u}; *(v4u*)(zr + 8) = (v4u){0u, 0u, 0u, 0u}; }
    const f32x2 ap = *(const f32x2*)(APOW + (((size_t)lg * 65 + (63 - j)) * SSM_P + p) * 2);
    float v[16];
#pragma unroll
    for (int h = 0; h < 16; ++h) { const f32x2 bb = *(const f32x2*)(BBAR + (((size_t)lg * SSM_P + p) * SSM_H + h) * 2); v[h] = im ? (ap.x * bb.y + ap.y * bb.x) : (ap.x * bb.x - ap.y * bb.y); }
    bf16* row = WG + ((size_t)g * 256 + q) * 1024 + j * 16;
    v4u o0, o1; o0.x = pk2(v[0], v[1]); o0.y = pk2(v[2], v[3]); o0.z = pk2(v[4], v[5]); o0.w = pk2(v[6], v[7]); o1.x = pk2(v[8], v[9]); o1.y = pk2(v[10], v[11]); o1.z = pk2(v[12], v[13]); o1.w = pk2(v[14], v[15]);
    *(v4u*)row = o0; *(v4u*)(row + 8) = o1;
}
struct GroupOrder {
    pg8::StaticOrder so; int b_rows;
    __device__ __forceinline__ bool next(int i, pg8::Unit& u) const { if (!so.next(i, u)) return false; u.brow = (u.pm >> 2) * b_rows + u.pn * 256; return true; }
};
struct EpiSsmScan {
    static constexpr bool PERM = true, AFTER_DRAIN = true, HOOKS = false, RMW = false;
    const float* APOW; bf16* Ua; int layer;
    __device__ __forceinline__ void fused(const AccT& acc, const pg8::Unit& u, int wr, int wc, int fr, int fq, PG8_LAS unsigned char* lds, int tid) const {
        PG8_LAS float* SL = (PG8_LAS float*)lds;
        const int rl0 = wr * 64 + fr, cw = wc * 32 + 8 * fq;
#pragma unroll
        for (int ai = 0; ai < 2; ++ai)
#pragma unroll
            for (int m = 0; m < 4; ++m) { PG8_LAS float* sp = SL + (rl0 + ai * 128 + m * 16) * 128 + cw; *(PG8_LAS A4*)sp = acc[ai][0][m][0]; *(PG8_LAS A4*)(sp + 4) = acc[ai][0][m][1]; }
        __syncthreads();
        if (tid < 256) {
            const int bl = tid >> 6, p = tid & 63, g = u.pm >> 2, lg = layer * SSM_G + g;
            const f32x2 a64 = *(const f32x2*)(APOW + (((size_t)lg * 65 + 64) * SSM_P + p) * 2);
            float xr = 0.f, xi = 0.f; bf16* xrow = Ua + ((size_t)u.pm * 256 + bl * 64) * SSM_KA + 1024 + p; const PG8_LAS float* sl = SL + (bl * 64) * 128 + p;
#pragma unroll 8
            for (int c = 0; c < 64; ++c) { const float sr = sl[c * 128], si = sl[c * 128 + 64];
                xrow[(size_t)c * SSM_KA] = (bf16)f2bf(xr); xrow[(size_t)c * SSM_KA + 64] = (bf16)f2bf(xi);
                const float nr = a64.x * xr - a64.y * xi + sr, ni = a64.x * xi + a64.y * xr + si; xr = nr; xi = ni; }
        }
        __syncthreads();
    }
};
struct EpiSsmY {
    static constexpr bool PERM = true, AFTER_DRAIN = false, HOOKS = false, RMW = false;
    bf16* YGp;
    __device__ __forceinline__ void operator()(const AccT& acc, const pg8::Unit& u, int wr, int wc, int fr, int fq) const {
        const int row0 = u.pm * 256 + wr * 64 + fr, g = u.pm >> 2;
#pragma unroll
        for (int ai = 0; ai < 2; ++ai)
#pragma unroll
            for (int m = 0; m < 4; ++m) { const int chunk = (row0 + ai * 128 + m * 16) & 1023;
#pragma unroll
                for (int bj = 0; bj < 2; ++bj) { const int i = 16 * u.pn + 8 * bj + 2 * wc + (fq >> 1);
                    const A4 v0 = acc[ai][bj][m][0], v1 = acc[ai][bj][m][1];
                    v4u w; w.x = pk2(gelu_tanh(v0[0]), gelu_tanh(v0[1])); w.y = pk2(gelu_tanh(v0[2]), gelu_tanh(v0[3])); w.z = pk2(gelu_tanh(v1[0]), gelu_tanh(v1[1])); w.w = pk2(gelu_tanh(v1[2]), gelu_tanh(v1[3]));
                    *(v4u*)(YGp + ((size_t)chunk * SSM_T + i) * SSM_W + 16 * g + 8 * (fq & 1)) = w; } }
    }
};
#ifndef MK_N_LAUNCHES
#define MK_N_LAUNCHES 1
#endif
#ifndef NARROW_WGM
#define NARROW_WGM 2
#endif
#ifndef SSM_FAST
#define SSM_FAST 1
#endif
constexpr int N_PHASES = 1 + 2 * (7 + (8 + MOE_NCHUNK + 1)) + (SSM_FAST ? 2 * DEPTH : 0);

__global__ void __launch_bounds__(NWAVES * 64, 2) fwd(Args args) {
    extern __shared__ __attribute__((aligned(16))) unsigned char lds[];
    Frame F;
    F.lds = (LAS unsigned char*)lds;
    F.MISC = (volatile LAS unsigned*)(F.lds + MISC_OFF);
    F.tid = threadIdx.x; F.lane = F.tid & 63; F.wave = __builtin_amdgcn_readfirstlane(F.tid >> 6);
    F.G = gridDim.x; F.gw = blockIdx.x * NWAVES + F.wave; F.NGW = F.G * NWAVES;
    unsigned char* ws = args.ws;
    F.ctl = (gu32*)(ws + WS_CTL);
    for (int u = F.tid; u < (LDS_BYTES - LDSCTL_OFF) / 4; u += NWAVES * 64) ((LAS unsigned*)(F.lds + LDSCTL_OFF))[u] = 0u;
    __syncthreads();
    XcdBarrier bar; bar.bar = (unsigned*)(F.ctl + CW_BAR); bar.x = 0; bar.st = nullptr;
    if (args.use_bar) bar = xcd_barrier_post((unsigned*)(F.ctl + CW_BAR), F.MISC + 8, F.wave);
    const int lo = args.ph_lo, hi = args.ph_hi; int ph = 0;
#ifndef MERGE_MASK
#define MERGE_MASK 7
#endif
#ifndef PHASE_MASK
#define PHASE_MASK 0xffffffffu
#endif
#define INP(k) ((lo <= ph && ph < hi) && ((PHASE_MASK >> (k)) & 1u))
#define OPQ() Frame Fp = F; { const int l_ = lane_id_fresh(); Fp.lane = l_; Fp.tid = (F.wave << 6) | l_; }
#ifdef PROBE_MASK
    unsigned long long tacc_ = 0ull, tst_ = 0ull;
#define PB_START(k) do { if ((PROBE_MASK >> (k)) & 1u) tst_ = __builtin_amdgcn_s_memrealtime(); } while (0)
#define PB_END(k) do { if ((PROBE_MASK >> (k)) & 1u) tacc_ += __builtin_amdgcn_s_memrealtime() - tst_; } while (0)
#else
#define PB_START(k) do {} while (0)
#define PB_END(k) do {} while (0)
#endif
#define SEAM() do { if (lo <= ph && ph + 1 < hi) xcd_barrier(bar, F.wave); ++ph; } while (0)
#define BIDQ() ({ int b_ = (int)blockIdx.x; asm volatile("" : "+s"(b_)); b_; })
    LAS unsigned char* ring = F.lds + RING_OFF;
#define XB ((bf16*)(ws + WS_XB))
#define SSQ ((float*)(ws + WS_SSQ))
#define Qb ((bf16*)(args.out + DO_Q))
#define MRG ((bf16*)(args.out + DO_MERGED))
#define GATES ((bf16*)(ws + WS_GATES))
#define YG ((bf16*)(ws + WS_YG))
#define BCAT ((bf16*)(ws + WS_BCAT))

    PB_START(0); if (INP(0)) { OPQ(); p0_prologue(Fp, args); if (SSM_FAST) ssm_tables(Fp, args); } SEAM(); PB_END(0);

    for (int l = 0; l < DEPTH; ++l) {
        unsigned char* wm = ws + WS_WMIX + (size_t)l * WMIX_STRIDE;
        PB_START(1); if (INP(1)) {
            if (FP8_INPROJ(l)) {
            pg8::Gemm g{(const bf16*)(ws + WS_XB8), (const bf16*)(wm + WM_IN), D / 2, D / 2, D / 2};   pg8::StaticOrder S; S.init(M / 256, N_INP / 256, F.G, BIDQ());
            EpiInProj<true> E{args.out, ws, l};
            pg8::gemm_phase<EpiInProj<true>, pg8::StaticOrder, true, true, false, true>(ring, g, S, E, F.wave);
            } else {
            pg8::Gemm g{XB, (const bf16*)(wm + WM_IN), D, D, D}; pg8::StaticOrder S; S.init(M / 256, N_INP / 256, F.G, BIDQ());
            EpiInProj<false> E{args.out, ws, l};
            pg8::gemm_phase<EpiInProj<false>, pg8::StaticOrder, true, true>(ring, g, S, E, F.wave);
            }
        } SEAM(); PB_END(1);
        PB_START(2); if (INP(2)) {
            OPQ();
#if SSM_FAST
            {
                const int gq = Fp.gw >> 4, gr = Fp.gw & 15, gwl = gq * 15 + (gr - 1), ngw = (Fp.NGW >> 4) * 15;
                if (gr == 0) { PB_START(16); for (int bh = gq; bh < BATCH * NH; bh += (Fp.NGW >> 4)) t1_cumsum(args, bh, Fp.lane); PB_END(16); }
                else {
                PB_START(19); for (int t = gwl; t < SSM_G * 128; t += ngw) ssm_expand_w(args, l, t, Fp.lane); PB_END(19);
#pragma unroll 4
                for (int t = gwl; t < SSM_G * 1024; t += ngw) ssm_expand_mv(args, l, t, Fp.lane);
                if (l & 1) cvt_moe_layer(args, l >> 1, l, (LAS float*)(F.lds + RING_OFF + F.wave * 16384), Fp.lane, gwl, ngw);
                }
                __syncthreads();
                PB_START(21); t1_conv_all(args, l, BIDQ(), F.G, ring, Fp.tid, F.wave, Fp.lane); PB_END(21);
            }
#endif
        } SEAM(); PB_END(2);
#if SSM_FAST
        PB_START(13); if (INP(13)) {
            pg8::Gemm g{(const bf16*)(ws + WS_UA), (const bf16*)(ws + WS_WG), SSM_KA, 1024, 1024}; GroupOrder S; S.so.init(SSM_G * 4, 1, F.G, BIDQ()); S.b_rows = 256; EpiSsmScan E{(const float*)(ws + WS_APOW), (bf16*)(ws + WS_UA), l};
            pg8::gemm_phase<EpiSsmScan, GroupOrder, true, true>(ring, g, S, E, F.wave);
        } SEAM(); PB_END(13);
        PB_START(15); if (INP(15)) {
            pg8::Gemm g{(const bf16*)(ws + WS_UA), (const bf16*)(ws + WS_MV), SSM_KA, SSM_KA, SSM_KA}; GroupOrder S; S.so.init(SSM_G * 4, 4, F.G, BIDQ()); S.b_rows = 1024; EpiSsmY E{YG};
            pg8::gemm_phase<EpiSsmY, GroupOrder, true, true>(ring, g, S, E, F.wave);
        } SEAM(); PB_END(15);
#endif
        PB_START(3); if (INP(3)) {
            { pg8::Gemm g{YG, (const bf16*)(wm + WM_GLU), 256, 256, 256}; pg8::StaticOrder S; S.init(M / 256, 2, F.G, BIDQ()); EpiGluSsm E{BCAT};
              pg8::gemm_phase<EpiGluSsm, pg8::StaticOrder, true, true>(ring, g, S, E, F.wave); }
#if ATTN_FAST
            { const attn_body::AttnTensors AT{(const attn_body::bf16*)Qb, (const attn_body::bf16*)(args.out + DO_K), (const attn_body::bf16*)(args.out + DO_V), (attn_body::bf16*)BCAT, (const float*)(ws + WS_FH)};
              const attn_body::StaticOrder SA((int)F.G, BIDQ());
              attn_body::attn_phase<attn_body::StaticOrder>((char*)lds + RING_OFF, AT, SA, F.wave); }
#endif
        } SEAM(); PB_END(3);
        PB_START(4); if (INP(4)) {
            pg8::StaticOrder S; S.init(M / 256, 4, F.G, BIDQ()); S.wgm = NARROW_WGM;
            pg8::Gemm g{BCAT, (const bf16*)(wm + WM_A), D, D, D};
            if (FP8_WO(l)) { EpiMergeCat<true> E{GATES, MRG}; pg8::gemm_phase<EpiMergeCat<true>, pg8::StaticOrder, true, true>(ring, g, S, E, F.wave); }
            else { EpiMergeCat<false> E{GATES, MRG}; pg8::gemm_phase<EpiMergeCat<false>, pg8::StaticOrder, true, true>(ring, g, S, E, F.wave); }
        } SEAM(); PB_END(4);
        PB_START(5); if (INP(5)) {
            pg8::StaticOrder S; S.init(M / 256, 4, F.G, BIDQ(), 1); S.wgm = NARROW_WGM;
            if (FP8_WO(l)) { pg8::Gemm g{MRG, (const bf16*)(wm + WM_O), D / 2, D / 2, D / 2};   EpiResid<true, 5> E{XB, SSQ, ws + WS_XB8}; pg8::gemm_phase<EpiResid<true, 5>, pg8::StaticOrder, true, true, false, true>(ring, g, S, E, F.wave); }
            else { pg8::Gemm g{MRG, (const bf16*)(wm + WM_O), D, D, D}; EpiResid<true, 0> E{XB, SSQ, ws + WS_XB8}; pg8::gemm_phase<EpiResid<true, 0>, pg8::StaticOrder, true, true>(ring, g, S, E, F.wave); }
        } SEAM(); PB_END(5);
        if (!(l & 1)) {
            unsigned char* wd = ws + WS_WDENSE + (size_t)(l >> 1) * WDENSE_STRIDE; bf16* const HID = (bf16*)(ws + WS_HID);
            PB_START(6); if (INP(6)) {
                if ((l >> 1) == FP8_DENSE_I) {
                pg8::Gemm g{(const bf16*)(ws + WS_XB8), (const bf16*)(wd + WD_GU), D / 2, D / 2, D / 2};   pg8::StaticOrder S; S.init(M / 256, 2 * D_FF / 256, F.G, BIDQ()); EpiSwiGlu<false, true> E{HID, D_FF, SSQ};
                pg8::gemm_phase<EpiSwiGlu<false, true>, pg8::StaticOrder, true, true, false, true>(ring, g, S, E, F.wave);
                } else {
                pg8::Gemm g{XB, (const bf16*)(wd + WD_GU), D, D, D}; pg8::StaticOrder S; S.init(M / 256, 2 * D_FF / 256, F.G, BIDQ()); EpiSwiGlu<false> E{HID, D_FF, SSQ};
                pg8::gemm_phase<EpiSwiGlu<false>, pg8::StaticOrder, true, true>(ring, g, S, E, F.wave);
                }
            } SEAM(); PB_END(6);
            PB_START(7); if (INP(7)) {
                if ((l >> 1) == FP8_DENSE_I) {
                pg8::Gemm g{HID, (const bf16*)(wd + WD_D), 64, D_FF / 2, D_FF / 2, nullptr, 256 * 128, (long)(D_FF / 128) * 256 * 128};   pg8::StaticOrder S; S.init(M / 256, 4, F.G, BIDQ(), 1); S.wgm = NARROW_WGM; EpiResid<true, 6> E{XB, SSQ, ws + WS_XB8};
                pg8::gemm_phase<EpiResid<true, 6>, pg8::StaticOrder, true, true, false, true>(ring, g, S, E, F.wave);
                } else {
                pg8::Gemm g{HID, (const bf16*)(wd + WD_D), 64, D_FF, D_FF, nullptr, 256 * 64 * 2, (long)(D_FF / 64) * 256 * 64 * 2};   pg8::StaticOrder S; S.init(M / 256, 4, F.G, BIDQ(), 1); S.wgm = NARROW_WGM; EpiResid<true, 0> E{XB, SSQ, ws + WS_XB8};
                pg8::gemm_phase<EpiResid<true, 0>, pg8::StaticOrder, true, true>(ring, g, S, E, F.wave);
                }
            } SEAM(); PB_END(7);
        } else {
            PB_START(8); if (INP(8)) { OPQ(); moe_route(Fp, args, l, l >> 1); } SEAM(); PB_END(8);
            PB_START(9); if (INP(9)) { OPQ(); moe_slots(Fp, args); } SEAM(); PB_END(9);
            const int* meta = (const int*)(ws + WS_META);
            for (int q = 0; q <= MOE_NCHUNK; ++q) {
                PB_START(10); if (INP(10)) {
                    const int total = meta[8], per = (total + MOE_NCHUNK - 1) / MOE_NCHUNK;
                    auto bnd = [&](int c) -> int { if (c <= 0) return 0; if (c >= MOE_NCHUNK) return total; if (MOE_NCHUNK == 2) return total > 256 ? total - 256 : total; return c * per < total ? c * per : total; };
                    int nMd = 0;
                    if (q > 0) {
                        const int ch = q - 1, tile0 = bnd(ch); const int nM = bnd(ch + 1) - tile0; nMd = nM;
                        pg8::Gemm g{(const bf16*)(ws + WS_MHID + (size_t)(ch & 1) * MHID_BYTES), (const bf16*)(ws + WS_WMOE + WMOE_D), 64, D_FFE / 2, D_FFE / 2, nullptr, 256 * 128, (long)(D_FFE / 128) * 256 * 128};
                        MoeOrder S; S.so.init(nM, 4, F.G, BIDQ(), 1); S.so.wgm = NARROW_WGM; S.tile0 = tile0; S.a_tile_off = 0; S.b_rows = D;
                        S.s1 = meta[1]; S.s2 = meta[2]; S.s3 = meta[3]; S.s4 = meta[4]; S.s5 = meta[5]; S.s6 = meta[6]; S.s7 = meta[7];
                        EpiMoeDown<true> E{(bf16*)args.out, (const int*)(ws + WS_RDEST) + (size_t)tile0 * 256, (const float*)(ws + WS_RW) + (size_t)tile0 * 256};
                        pg8::gemm_phase<EpiMoeDown<true>, MoeOrder, true, true, false, true>(ring, g, S, E, F.wave);
                    }
                    if (q < MOE_NCHUNK) {
                        const int ch = q, tile0 = bnd(ch); const int nM = bnd(ch + 1) - tile0;
                        pg8::Gemm g{(const bf16*)(ws + WS_XB8), (const bf16*)(ws + WS_WMOE + WMOE_GU), D / 2, D / 2, D / 2, (const int*)(ws + WS_RDEST)};
                        MoeOrder S; S.so.init(nM, 2 * D_FFE / 256, F.G, BIDQ()); S.tile0 = tile0; S.a_tile_off = tile0; S.b_rows = 2 * D_FFE;
                        S.s1 = meta[1]; S.s2 = meta[2]; S.s3 = meta[3]; S.s4 = meta[4]; S.s5 = meta[5]; S.s6 = meta[6]; S.s7 = meta[7];
                        if (q > 0) S.skew(4 * nMd);
                        EpiSwiGlu<true, true> E{(bf16*)(ws + WS_MHID + (size_t)(ch & 1) * MHID_BYTES), D_FFE, (const float*)(ws + WS_RRSTD) + (size_t)tile0 * 256};
                        pg8::gemm_phase<EpiSwiGlu<true, true>, MoeOrder, true, true, true, true>(ring, g, S, E, F.wave);
                    }
                } SEAM(); PB_END(10);
            }
            PB_START(12); if (INP(12)) { OPQ(); moe_combine(Fp, args, l == DEPTH - 1); } SEAM(); PB_END(12);
        }
    }
#ifdef PROBE_MASK
    if (blockIdx.x == 0) { const unsigned long long t0_ = __builtin_amdgcn_s_memrealtime(); while (__builtin_amdgcn_s_memrealtime() - t0_ < tacc_) __builtin_amdgcn_s_sleep(8); }
#endif
#undef INP
#undef BIDQ
#undef OPQ
#undef SEAM
}

extern "C" void kernel_launch(void* const* d_in, const int* in_sizes, int n_in, void* d_out, int out_size, void* d_ws, size_t ws_size, hipStream_t stream) {
    static int grid = 0;
    if (grid == 0) {
        if (n_in != 31 || in_sizes[0] != M * D || out_size != M * D || ws_size < WS_END) { fprintf(stderr, "kernel_launch: unexpected shapes/workspace (n_in %d, ws %zu, need %zu); nothing launched\n", n_in, ws_size, (size_t)WS_END); grid = -1; return; }
        int dev = 0, cus = 0, per_cu = 0;
        if (hipGetDevice(&dev) != hipSuccess || hipDeviceGetAttribute(&cus, hipDeviceAttributeMultiprocessorCount, dev) != hipSuccess) { grid = -1; return; }
        if (hipFuncSetAttribute((const void*)fwd, hipFuncAttributeMaxDynamicSharedMemorySize, LDS_BYTES) != hipSuccess) { fprintf(stderr, "kernel_launch: hipFuncSetAttribute failed\n"); grid = -1; return; }
        if (hipOccupancyMaxActiveBlocksPerMultiprocessor(&per_cu, (const void*)fwd, NWAVES * 64, LDS_BYTES) != hipSuccess || per_cu < 1)
            fprintf(stderr, "kernel_launch: note: occupancy query reports %d workgroups per CU\n", per_cu);
        (void)hipGetLastError();
        grid = cus;
    }
    if (grid < 0) return;
    if (hipMemsetAsync((char*)d_ws + WS_CTL, 0, CTL_ZERO_BYTES, stream) != hipSuccess) return;
    Args a{};
    for (int i = 0; i < 31; ++i) a.in[i] = (const float*)d_in[i];
    a.out = (unsigned char*)d_out; a.ws = (unsigned char*)d_ws; a.pad = 0;
#if MK_N_LAUNCHES == 1
    a.ph_lo = 0; a.ph_hi = N_PHASES; a.use_bar = 1;
    hipLaunchKernelGGL(fwd, dim3(grid), dim3(NWAVES * 64), LDS_BYTES, stream, a);
#else
    for (int p = 0; p < N_PHASES; ++p) { a.ph_lo = p; a.ph_hi = p + 1; a.use_bar = 0; hipLaunchKernelGGL(fwd, dim3(grid), dim3(NWAVES * 64), LDS_BYTES, stream, a); }
#endif
}
```
